# Optimizing an MI355X kernel written in HIP

```python
import jax
import jax.numpy as jnp
from jax import lax
import numpy as np

D_MODEL = 1024
BATCH = 2
SEQ = 8192
DEPTH = 4
DEC_BATCH = 128
DEC_SEQ = 1
PAST_LEN = 8192
PAGE_SIZE = 128

HEAD_DIM = 64
BLOCK = 128
A_HEADS = 8
A_KV_HEADS = 2
A_GROUP = A_HEADS // A_KV_HEADS
A_WINDOW = 128
B_HEADS = 8
B_DIM = 64
B_CHUNK = 128
C_WINDOWS = (128, 512, 2048)
C_DILATIONS = (1, 4, 16)
C_HEADS = 8
C_KV_HEADS = 2
C_GROUP = C_HEADS // C_KV_HEADS
D_FF = 2816
FFN_RESIDUAL = 0.5
N_MOD = 9
N_EVEN = (DEPTH + 1) // 2
N_ODD = DEPTH // 2
EPS = 1e-6
EVEN_SIZES = (A_HEADS * HEAD_DIM, A_KV_HEADS * HEAD_DIM, A_KV_HEADS * HEAD_DIM,
              B_HEADS * B_DIM, B_HEADS * B_DIM, B_HEADS * B_DIM, B_HEADS * B_DIM,
              B_HEADS, B_HEADS)
ODD_SIZES = (C_HEADS * HEAD_DIM, C_KV_HEADS * HEAD_DIM, C_KV_HEADS * HEAD_DIM) * 3
EVEN_OUT = A_HEADS * HEAD_DIM + B_HEADS * B_DIM
ODD_OUT = C_HEADS * HEAD_DIM

kernel_name = 'hybrid_swa_mlstm_dilated_decode_step'


def split_cols(z, sizes):
    offs, acc = [], 0
    for s in sizes[:-1]:
        acc += s
        offs.append(acc)
    return jnp.split(z, offs, axis=-1)


def rmsnorm(x, gain):
    xf = x.astype(jnp.float32)
    y = xf * lax.rsqrt(jnp.mean(xf * xf, axis=-1, keepdims=True) + EPS)
    return (y * gain.astype(jnp.float32)).astype(x.dtype)


def modulation(c, w_mod, b_mod):
    m = jax.nn.silu(c) @ w_mod + b_mod
    return m.reshape(c.shape[0], N_MOD, D_MODEL)


def mod_in(x, gain, mod, j):
    return rmsnorm(x, gain) * (1 + mod[:, 3 * j + 1, None, :]) + mod[:, 3 * j, None, :]


def gate(mod, j):
    return mod[:, 3 * j + 2, None, :]


def swiglu(h, w_in, w_out):
    g, u = jnp.split(h @ w_in, 2, axis=-1)
    return (jax.nn.silu(g) * u) @ w_out


def ffn_sub(x, mod, j, gain, w_in, w_out):
    return x + FFN_RESIDUAL * gate(mod, j) * swiglu(mod_in(x, gain, mod, j), w_in, w_out)


def attend(q, k, v, mask, sink):
    scale = q.shape[-1] ** -0.5
    s = jnp.einsum('...qhgd,...khd->...hgqk', q, k, preferred_element_type=jnp.float32) * scale
    s = jnp.where(mask[..., None, None, :, :], s, -jnp.inf)
    m = jnp.max(s, axis=-1, keepdims=True)
    if sink is not None:
        sk = sink.astype(jnp.float32)[:, :, None, None]
        m = jnp.maximum(m, sk)
    p = jnp.exp(s - m)
    den = jnp.sum(p, axis=-1, keepdims=True)
    if sink is not None:
        den = den + jnp.exp(sk - m)
    o = jnp.einsum('...hgqk,...khd->...qhgd', (p / den).astype(v.dtype), v)
    lse = jnp.moveaxis((m + jnp.log(den))[..., 0], -1, -3)
    return o, lse


def banded_window_attn(q, k, v, window, sink):
    n, t = q.shape[:2]
    nb = -(-t // BLOCK)
    pad = nb * BLOCK - t

    def padt(x):
        return jnp.pad(x, [(0, 0), (0, pad)] + [(0, 0)] * (x.ndim - 2))

    def with_prev(xb):
        prev = jnp.pad(xb[:, :-1], [(0, 0), (1, 0)] + [(0, 0)] * (xb.ndim - 2))
        return jnp.concatenate([prev, xb], axis=2)

    qb = padt(q).reshape(n, nb, BLOCK, *q.shape[2:])
    kb = padt(k).reshape(n, nb, BLOCK, *k.shape[2:])
    vb = padt(v).reshape(n, nb, BLOCK, *v.shape[2:])
    blk = jnp.arange(nb)[:, None] * BLOCK
    qpos = blk + jnp.arange(BLOCK)[None, :]
    kpos = blk - BLOCK + jnp.arange(2 * BLOCK)[None, :]
    dist = qpos[:, :, None] - kpos[:, None, :]
    mask = (dist >= 0) & (dist <= window) & (kpos[:, None, :] >= 0)
    o, lse = attend(qb, with_prev(kb), with_prev(vb), mask, sink)
    o = o.reshape(n, nb * BLOCK, *q.shape[2:])[:, :t]
    lse = lse.reshape(n, nb * BLOCK, *lse.shape[3:])[:, :t]
    return o, lse


def dilated_window_attn(q, k, v, window, dilation):
    n, t = q.shape[:2]

    def to_sub(x):
        x = x.reshape(n, t // dilation, dilation, *x.shape[2:]).swapaxes(1, 2)
        return x.reshape(n * dilation, t // dilation, *x.shape[3:])

    def from_sub(x):
        x = x.reshape(n, dilation, t // dilation, *x.shape[2:]).swapaxes(1, 2)
        return x.reshape(n, t, *x.shape[3:])

    o, lse = banded_window_attn(to_sub(q), to_sub(k), to_sub(v), window // dilation, None)
    return from_sub(o), from_sub(lse)


def gathered_window_attn(q, k_all, v_all, n_past, window, dilation, sink):
    s_new = q.shape[1]
    n_keys = window // dilation + 1
    idx = n_past + jnp.arange(s_new)[:, None] - dilation * jnp.arange(n_keys)[None, :]
    valid = idx >= 0
    idx = jnp.maximum(idx, 0)
    o, lse = attend(q[:, :, None], k_all[:, idx], v_all[:, idx], valid[:, None, :], sink)
    return o[:, :, 0], lse[:, :, 0]


def combine_groups(outs, lses):
    w = jax.nn.softmax(jnp.stack(lses), axis=0)
    o = jnp.sum(w[..., None] * jnp.stack(outs).astype(jnp.float32), axis=0)
    return o.astype(outs[0].dtype)


def mlstm_chunk(carry, xs):
    c_st, n_st, m_st = carry
    q, k, v, ig, lf = xs
    q = q.astype(jnp.float32)
    k = k.astype(jnp.float32)
    v = v.astype(jnp.float32)
    L = q.shape[1]
    b = lax.cumsum(lf, axis=1)
    m_t = b + jnp.maximum(m_st[:, None, :], lax.cummax(ig - b, axis=1))
    causal = jnp.tril(jnp.ones((L, L), dtype=bool))[None, :, :, None]
    log_d = b[:, :, None, :] - b[:, None, :, :] + ig[:, None, :, :] - m_t[:, :, None, :]
    dmat = jnp.exp(jnp.where(causal, log_d, -jnp.inf))
    w = jnp.einsum('nqhd,nshd->nqsh', q, k) * dmat
    inter = jnp.exp(b + m_st[:, None, :] - m_t)
    num = jnp.einsum('nqsh,nshe->nqhe', w, v) + inter[..., None] * jnp.einsum('nqhd,nhde->nqhe', q, c_st)
    qn = jnp.sum(w, axis=2) + inter * jnp.einsum('nqhd,nhd->nqh', q, n_st)
    h = num / jnp.maximum(jnp.abs(qn), jnp.exp(-m_t))[..., None]
    m_new = m_t[:, -1]
    wk = jnp.exp(b[:, -1:, :] - b + ig - m_new[:, None, :])
    decay = jnp.exp(b[:, -1] + m_st - m_new)
    c_new = decay[..., None, None] * c_st + jnp.einsum('nsh,nshd,nshe->nhde', wk, k, v)
    n_new = decay[..., None] * n_st + jnp.einsum('nsh,nshd->nhd', wk, k)
    return (c_new, n_new, m_new), h


def even_heads(h, w_in, b_gate):
    n, t = h.shape[:2]
    aq, ak, av, bq, bk, bv, bo, bi, bf = split_cols(h @ w_in, EVEN_SIZES)
    aq = aq.reshape(n, t, A_KV_HEADS, A_GROUP, HEAD_DIM)
    ak = ak.reshape(n, t, A_KV_HEADS, HEAD_DIM)
    av = av.reshape(n, t, A_KV_HEADS, HEAD_DIM)
    bq = bq.reshape(n, t, B_HEADS, B_DIM)
    bk = bk.reshape(n, t, B_HEADS, B_DIM) * (B_DIM ** -0.5)
    bv = bv.reshape(n, t, B_HEADS, B_DIM)
    gates = jnp.concatenate([bi, bf], axis=-1).astype(jnp.float32) + b_gate.astype(jnp.float32)
    ig = gates[..., :B_HEADS]
    lf = jax.nn.log_sigmoid(gates[..., B_HEADS:])
    return (aq, ak, av), (bq, bk, bv, ig, lf), bo


def even_merge(a_out, b_h, bo, head_gain, w_out):
    n, t = a_out.shape[:2]
    b_y = jax.nn.sigmoid(bo.astype(jnp.float32)) * rmsnorm(b_h, head_gain).reshape(n, t, -1)
    return jnp.concatenate([a_out.reshape(n, t, -1), b_y.astype(a_out.dtype)], axis=-1) @ w_out


def even_prompt(h, w_in, b_gate, sinks, head_gain, w_out):
    n, t = h.shape[:2]
    (aq, ak, av), bx, bo = even_heads(h, w_in, b_gate)
    a_out, _ = banded_window_attn(aq, ak, av, A_WINDOW, sinks.reshape(A_KV_HEADS, A_GROUP))
    cl = min(B_CHUNK, t)
    nc = t // cl
    xs = tuple(x.reshape(n, nc, cl, *x.shape[2:]).swapaxes(0, 1) for x in bx)
    init = (jnp.zeros((n, B_HEADS, B_DIM, B_DIM), jnp.float32),
            jnp.zeros((n, B_HEADS, B_DIM), jnp.float32),
            jnp.zeros((n, B_HEADS), jnp.float32))
    (c_st, n_st, m_st), hs = lax.scan(mlstm_chunk, init, xs)
    b_h = hs.swapaxes(0, 1).reshape(n, t, B_HEADS, B_DIM)
    y = even_merge(a_out, b_h, bo, head_gain, w_out)
    la = min(A_WINDOW, t)
    kv = jnp.stack([ak[:, t - la:], av[:, t - la:]], axis=2)
    return y, kv, c_st.astype(h.dtype), n_st.astype(h.dtype), m_st.astype(h.dtype)


def even_sample(h, kv_buf, c_st, n_st, m_st, w_in, b_gate, sinks, head_gain, w_out):
    (aq, ak, av), bx, bo = even_heads(h, w_in, b_gate)
    kv_buf = kv_buf.astype(ak.dtype)
    la = kv_buf.shape[1]
    k_all = jnp.concatenate([kv_buf[:, :, 0], ak], axis=1)
    v_all = jnp.concatenate([kv_buf[:, :, 1], av], axis=1)
    a_out, _ = gathered_window_attn(aq, k_all, v_all, la, A_WINDOW, 1, sinks.reshape(A_KV_HEADS, A_GROUP))
    carry = (c_st.astype(jnp.float32), n_st.astype(jnp.float32), m_st.astype(jnp.float32))
    (c2, n2, m2), b_h = mlstm_chunk(carry, bx)
    y = even_merge(a_out, b_h, bo, head_gain, w_out)
    new_kv = jnp.concatenate([kv_buf, jnp.stack([ak, av], axis=2)], axis=1)[:, -la:]
    return y, new_kv, c2.astype(h.dtype), n2.astype(h.dtype), m2.astype(h.dtype)


def odd_split(h, w_in):
    n, t = h.shape[:2]
    parts = split_cols(h @ w_in, ODD_SIZES)
    qkv = []
    for g in range(len(C_WINDOWS)):
        q = parts[3 * g].reshape(n, t, C_KV_HEADS, C_GROUP, HEAD_DIM)
        k = parts[3 * g + 1].reshape(n, t, C_KV_HEADS, HEAD_DIM)
        v = parts[3 * g + 2].reshape(n, t, C_KV_HEADS, HEAD_DIM)
        qkv.append((q, k, v))
    return qkv


def odd_prompt(h, w_in, w_out):
    n, t = h.shape[:2]
    outs, lses, states = [], [], []
    for (q, k, v), win, dil in zip(odd_split(h, w_in), C_WINDOWS, C_DILATIONS):
        o, lse = dilated_window_attn(q, k, v, win, dil)
        outs.append(o)
        lses.append(lse)
        keep = min(win, t)
        states.append(jnp.stack([k[:, t - keep:], v[:, t - keep:]], axis=2))
    y = combine_groups(outs, lses).reshape(n, t, ODD_OUT) @ w_out
    return y, states


def odd_sample(h, bufs, w_in, w_out):
    n, t = h.shape[:2]
    outs, lses, states = [], [], []
    for (q, k, v), buf, win, dil in zip(odd_split(h, w_in), bufs, C_WINDOWS, C_DILATIONS):
        buf = buf.astype(k.dtype)
        keep = buf.shape[1]
        k_all = jnp.concatenate([buf[:, :, 0], k], axis=1)
        v_all = jnp.concatenate([buf[:, :, 1], v], axis=1)
        o, lse = gathered_window_attn(q, k_all, v_all, keep, win, dil, None)
        outs.append(o)
        lses.append(lse)
        states.append(jnp.concatenate([buf, jnp.stack([k, v], axis=2)], axis=1)[:, -keep:])
    y = combine_groups(outs, lses).reshape(n, t, ODD_OUT) @ w_out
    return y, states


def setup_inputs(seed: int = 0) -> dict:
    key = jax.random.key(seed)
    ks = iter(jax.random.split(key, 32))

    def nrm(shape, scale=1.0):
        return jax.random.normal(next(ks), shape, jnp.float32) * scale

    la = min(A_WINDOW, PAST_LEN)
    lc = [min(w, PAST_LEN) for w in C_WINDOWS]
    x_prompt = nrm((BATCH, SEQ, D_MODEL))
    x_sample = nrm((DEC_BATCH, DEC_SEQ, D_MODEL))
    cache_a_kv = nrm((N_EVEN, DEC_BATCH, la, 2, A_KV_HEADS, HEAD_DIM))
    state_b_c = nrm((N_EVEN, DEC_BATCH, B_HEADS, B_DIM, B_DIM), 0.05)
    state_b_n = nrm((N_EVEN, DEC_BATCH, B_HEADS, B_DIM), 0.1)
    state_b_m = nrm((N_EVEN, DEC_BATCH, B_HEADS), 1.0)
    cache_c1_kv = nrm((N_ODD, DEC_BATCH, lc[0], 2, C_KV_HEADS, HEAD_DIM))
    cache_c2_kv = nrm((N_ODD, DEC_BATCH, lc[1], 2, C_KV_HEADS, HEAD_DIM))
    cache_c3_kv = nrm((N_ODD, DEC_BATCH, lc[2], 2, C_KV_HEADS, HEAD_DIM))
    c_prompt = nrm((BATCH, D_MODEL))
    c_sample = nrm((DEC_BATCH, D_MODEL))
    gate_bias = jnp.concatenate([nrm((N_EVEN, B_HEADS), 0.1),
                                 3.0 + nrm((N_EVEN, B_HEADS), 0.5)], axis=-1)
    return dict(
        x_prompt=x_prompt,
        x_sample=x_sample,
        cache_a_kv=cache_a_kv,
        state_b_c=state_b_c,
        state_b_n=state_b_n,
        state_b_m=state_b_m,
        cache_c1_kv=cache_c1_kv,
        cache_c2_kv=cache_c2_kv,
        cache_c3_kv=cache_c3_kv,
        c_prompt=c_prompt,
        c_sample=c_sample,
        w_mod=nrm((DEPTH, D_MODEL, N_MOD * D_MODEL), 0.5 * D_MODEL ** -0.5),
        b_mod=nrm((DEPTH, N_MOD * D_MODEL), 0.02),
        norm_gain=1.0 + nrm((DEPTH, 3, D_MODEL), 0.02),
        ffn_w_in=nrm((DEPTH, 2, D_MODEL, 2 * D_FF), D_MODEL ** -0.5),
        ffn_w_out=nrm((DEPTH, 2, D_FF, D_MODEL), D_FF ** -0.5),
        even_w_in=nrm((N_EVEN, D_MODEL, sum(EVEN_SIZES)), D_MODEL ** -0.5),
        even_b_gate=gate_bias,
        even_sinks=nrm((N_EVEN, A_HEADS), 0.5),
        even_head_gain=1.0 + nrm((N_EVEN, B_HEADS, B_DIM), 0.02),
        even_w_out=nrm((N_EVEN, EVEN_OUT, D_MODEL), EVEN_OUT ** -0.5),
        odd_w_in=nrm((N_ODD, D_MODEL, sum(ODD_SIZES)), D_MODEL ** -0.5),
        odd_w_out=nrm((N_ODD, ODD_OUT, D_MODEL), ODD_OUT ** -0.5),
        final_gain=1.0 + nrm((D_MODEL,), 0.02),
    )


def reference(x_prompt, x_sample, cache_a_kv, state_b_c, state_b_n, state_b_m, cache_c1_kv, cache_c2_kv,
              cache_c3_kv, c_prompt, c_sample, w_mod, b_mod, norm_gain, ffn_w_in, ffn_w_out, even_w_in,
              even_b_gate, even_sinks, even_head_gain, even_w_out, odd_w_in, odd_w_out, final_gain):
    xp, xs = x_prompt, x_sample
    c_caches = (cache_c1_kv, cache_c2_kv, cache_c3_kv)
    a_p, a_s, bc_p, bc_s, bn_p, bn_s, bm_p, bm_s = [], [], [], [], [], [], [], []
    cg_p = [[], [], []]
    cg_s = [[], [], []]
    for l in range(DEPTH):
        mod_p = modulation(c_prompt, w_mod[l], b_mod[l])
        mod_s = modulation(c_sample, w_mod[l], b_mod[l])
        xp = ffn_sub(xp, mod_p, 0, norm_gain[l, 0], ffn_w_in[l, 0], ffn_w_out[l, 0])
        xs = ffn_sub(xs, mod_s, 0, norm_gain[l, 0], ffn_w_in[l, 0], ffn_w_out[l, 0])
        hp = mod_in(xp, norm_gain[l, 1], mod_p, 1)
        hs = mod_in(xs, norm_gain[l, 1], mod_s, 1)
        if l % 2 == 0:
            e = l // 2
            wts = (even_w_in[e], even_b_gate[e], even_sinks[e], even_head_gain[e], even_w_out[e])
            yp, kv_p, cst_p, nst_p, mst_p = even_prompt(hp, *wts)
            ys, kv_s, cst_s, nst_s, mst_s = even_sample(hs, cache_a_kv[e], state_b_c[e], state_b_n[e],
                                                        state_b_m[e], *wts)
            a_p.append(kv_p)
            a_s.append(kv_s)
            bc_p.append(cst_p)
            bc_s.append(cst_s)
            bn_p.append(nst_p)
            bn_s.append(nst_s)
            bm_p.append(mst_p)
            bm_s.append(mst_s)
        else:
            o = l // 2
            yp, st_p = odd_prompt(hp, odd_w_in[o], odd_w_out[o])
            ys, st_s = odd_sample(hs, [cc[o] for cc in c_caches], odd_w_in[o], odd_w_out[o])
            for g in range(len(C_WINDOWS)):
                cg_p[g].append(st_p[g])
                cg_s[g].append(st_s[g])
        xp = xp + gate(mod_p, 1) * yp
        xs = xs + gate(mod_s, 1) * ys
        xp = ffn_sub(xp, mod_p, 2, norm_gain[l, 2], ffn_w_in[l, 1], ffn_w_out[l, 1])
        xs = ffn_sub(xs, mod_s, 2, norm_gain[l, 2], ffn_w_in[l, 1], ffn_w_out[l, 1])
    y_prompt = rmsnorm(xp, final_gain)
    y_sample = rmsnorm(xs, final_gain)
    return (y_prompt, y_sample,
            jnp.stack(a_p), jnp.stack(a_s),
            jnp.stack(bc_p), jnp.stack(bc_s),
            jnp.stack(bn_p), jnp.stack(bn_s),
            jnp.stack(bm_p), jnp.stack(bm_s),
            jnp.stack(cg_p[0]), jnp.stack(cg_s[0]),
            jnp.stack(cg_p[1]), jnp.stack(cg_s[1]),
            jnp.stack(cg_p[2]), jnp.stack(cg_s[2]))
```

```cpp
#include <hip/hip_runtime.h>
#include <cstdio>
#include <cstdint>

#ifndef PROBE_DUP
#define PROBE_DUP 0
#endif
#ifndef PROBE_TMASK
#define PROBE_TMASK 19
#endif
#ifndef MK_N_LAUNCHES
#define MK_N_LAUNCHES 1
#endif

#define GAS __attribute__((address_space(1)))
#define LAS __attribute__((address_space(3)))
typedef _Float16 f16;
typedef _Float16 f16x8 __attribute__((ext_vector_type(8)));
typedef _Float16 f16x4 __attribute__((ext_vector_type(4)));
typedef float f32x4 __attribute__((ext_vector_type(4)));
typedef float f32x16 __attribute__((ext_vector_type(16)));
typedef unsigned u32x4 __attribute__((ext_vector_type(4)));
typedef unsigned u32x2 __attribute__((ext_vector_type(2)));
typedef LAS unsigned char* ldsp_t;

constexpr int D = 1024, T = 8192, NB = 2, MP = NB * T, NS = 128, MALL = MP + NS, NBAT = NB + NS;
constexpr int FF = 2816, FF2 = 5632, NEV = 3072, NEVR = 2832, NOD = 2304, NMODC = 9216;
constexpr int NSITE = 12;
constexpr float EPS = 1e-6f;
__host__ __device__ __forceinline__ constexpr int site_N(int s) { return (s % 3 != 1) ? FF2 : (((s / 3) % 2 == 0) ? NEV : NOD); }
__host__ __device__ __forceinline__ constexpr int site_off(int s) { const int r = s % 6; return (s / 6) * 27904 + (r == 0 ? 0 : r == 1 ? 5632 : r == 2 ? 8704 : r == 3 ? 14336 : r == 4 ? 19968 : 22272); }
static_assert(site_off(1) == 5632 && site_off(2) == 8704 && site_off(3) == 14336 && site_off(4) == 19968 && site_off(5) == 22272 && site_off(6) == 27904 && site_off(7) == 27904 + 5632, "site_off");
constexpr int NWIN = site_off(NSITE);
static_assert(NWIN == 55808, "win rows");

constexpr size_t alignup(size_t x) { return (x + 4095) & ~(size_t)4095; }
constexpr size_t WS_CTL = 0, CTL_ZERO_BYTES = 1u << 20;
constexpr int CW_BAR = 1024;
constexpr size_t RSS_OFF = 65536;
static_assert(RSS_OFF + (size_t)13 * MALL * 4 <= CTL_ZERO_BYTES, "ctl");
constexpr size_t WS_WIN = alignup(CTL_ZERO_BYTES);
constexpr size_t WS_WFO = alignup(WS_WIN + (size_t)NWIN * D * 2);
constexpr size_t WS_WEO = alignup(WS_WFO + (size_t)8 * D * FF * 2);
constexpr size_t WS_WOO = alignup(WS_WEO + (size_t)2 * D * D * 2);
constexpr size_t WS_WMOD = alignup(WS_WOO + (size_t)2 * D * 512 * 2);
constexpr size_t WS_AC = alignup(WS_WMOD + (size_t)4 * NMODC * D * 2);
constexpr size_t WS_MOD = alignup(WS_AC + (size_t)256 * D * 2);
constexpr size_t WS_CS = alignup(WS_MOD + (size_t)NBAT * 4 * NMODC * 4);
constexpr size_t WS_GT = alignup(WS_CS + (size_t)NSITE * NBAT * D * 4);
constexpr size_t WS_RCS = alignup(WS_GT + (size_t)NSITE * NBAT * D * 4);
constexpr size_t WS_SHA = alignup(WS_RCS + (size_t)NSITE * NBAT * D * 4);
constexpr size_t WS_BW = alignup(WS_SHA + (size_t)NSITE * 256 * D * 2);
constexpr size_t WS_X = alignup(WS_BW + (size_t)NBAT * NWIN * 4);
constexpr size_t WS_A = alignup(WS_X + (size_t)MALL * D * 4);
constexpr size_t WS_H = alignup(WS_A + (size_t)MALL * D * 2);
constexpr size_t WS_Z = alignup(WS_H + (size_t)MALL * FF * 2);
constexpr size_t WS_GATES = alignup(WS_Z + (size_t)MALL * NEV * 2);
constexpr size_t WS_O = alignup(WS_GATES + (size_t)MALL * 16 * 4);
constexpr size_t WS_OG = alignup(WS_O + (size_t)MALL * D * 2);
constexpr size_t WS_LSE = alignup(WS_OG + (size_t)3 * MP * 512 * 2);
constexpr size_t WS_DC = alignup(WS_LSE + (size_t)3 * MP * 8 * 4);
constexpr size_t WS_DN = alignup(WS_DC + (size_t)16 * 64 * 4096 * 4);
constexpr size_t WS_CP = alignup(WS_DN + (size_t)16 * 64 * 64 * 4);
constexpr size_t WS_NP = alignup(WS_CP + (size_t)16 * 64 * 4096 * 2);
constexpr size_t WS_SC = alignup(WS_NP + (size_t)16 * 64 * 64 * 4);
constexpr size_t WS_END = alignup(WS_SC + (size_t)3 * 16 * 64 * 4);

constexpr size_t O_Y = 0;
constexpr size_t O_AKVP = O_Y + (size_t)MALL * D;
constexpr size_t O_AKVS = O_AKVP + (size_t)2 * 2 * 128 * 256;
constexpr size_t O_BCP = O_AKVS + (size_t)2 * 128 * 128 * 256;
constexpr size_t O_BCS = O_BCP + (size_t)2 * 2 * 8 * 4096;
constexpr size_t O_BNP = O_BCS + (size_t)2 * 128 * 8 * 4096;
constexpr size_t O_BNS = O_BNP + (size_t)2 * 2 * 8 * 64;
constexpr size_t O_BMP = O_BNS + (size_t)2 * 128 * 8 * 64;
constexpr size_t O_BMS = O_BMP + (size_t)2 * 2 * 8;
constexpr size_t O_C1P = O_BMS + (size_t)2 * 128 * 8;
constexpr size_t O_C1S = O_C1P + (size_t)2 * 2 * 128 * 256;
constexpr size_t O_C2P = O_C1S + (size_t)2 * 128 * 128 * 256;
constexpr size_t O_C2S = O_C2P + (size_t)2 * 2 * 512 * 256;
constexpr size_t O_C3P = O_C2S + (size_t)2 * 128 * 512 * 256;
constexpr size_t O_C3S = O_C3P + (size_t)2 * 2 * 2048 * 256;
constexpr size_t O_END = O_C3S + (size_t)2 * 128 * 2048 * 256;

enum { I_XP = 0, I_XS, I_CA, I_SBC, I_SBN, I_SBM, I_CC1, I_CC2, I_CC3, I_CP, I_CSMP, I_WMOD, I_BMOD, I_NG, I_FWI, I_FWO, I_EWI, I_EBG, I_ESK, I_EHG, I_EWO, I_OWI, I_OWO, I_FG, N_IN };

constexpr int RING_BYTES = 131072;
constexpr int MISC_OFF = RING_BYTES + 320;
constexpr int PF_OFF = 139264;
constexpr int EPI_OFF = 133120, EPI_STRIDE = 4096;
constexpr int LDS_BYTES = 147456;

#define RLX_AGENT __ATOMIC_RELAXED, __HIP_MEMORY_SCOPE_AGENT
#define LDS_WAIT() asm volatile("s_waitcnt lgkmcnt(0)" ::: "memory")
#define VM_WAIT() asm volatile("s_waitcnt vmcnt(0)" ::: "memory")

#define XB_TMO      128
#define XB_XCNT(j)  (256  + 64 * (j))
#define XB_XSUB(j)  (1280 + 64 * (j))
#define XB_XGEN(j)  (2304 + 64 * (j))
#define XB_TOP      3328
#define XB_TOPGEN   3392
#define XB_LSUB(j)  (3456 + 64 * (j))
#define XCD_BAR_WORDS 4480
#define XB_SPIN_CAP (1u << 21)
__device__ __forceinline__ unsigned xb_ld(unsigned* p)              { return __hip_atomic_load(p, __ATOMIC_RELAXED, __HIP_MEMORY_SCOPE_AGENT); }
__device__ __forceinline__ unsigned xb_add(unsigned* p, unsigned v) { return __hip_atomic_fetch_add(p, v, __ATOMIC_RELAXED, __HIP_MEMORY_SCOPE_AGENT); }
__device__ __forceinline__ unsigned xb_xcc_id() { return (unsigned)__builtin_amdgcn_s_getreg((3 << 11) | 20) & 0xFu; }
#define XB_SPIN(cond, bar) do { unsigned _sp = 0; while (cond) { __builtin_amdgcn_s_sleep(1); \
    if ((++_sp & 255u) == 0u) { if (xb_ld(&(bar)[XB_TMO])) break; if (_sp > XB_SPIN_CAP) { atomicAdd(&(bar)[XB_TMO], 1u); break; } } } } while (0)
struct XcdBarrier { unsigned* bar; unsigned x; volatile LAS unsigned* st; };
__device__ __forceinline__ XcdBarrier xcd_barrier_post(unsigned* bar, volatile LAS unsigned* st) {
    XcdBarrier b; b.bar = bar; b.x = xb_xcc_id(); b.st = st;
    if (threadIdx.x == 0) st[12] = xb_add(&bar[XB_XCNT(b.x)], 1u);
    return b;
}
__device__ __forceinline__ void xcd_barrier_complete(unsigned* bar, unsigned x, unsigned& nloc, unsigned& nx) {
    const unsigned G = gridDim.x * gridDim.y * gridDim.z;
    unsigned sum, cnt, mine, sp = 0u;
    for (;;) {
        sum = 0u; cnt = 0u; mine = 0u;
#pragma unroll
        for (unsigned j = 0; j < 16; ++j) { const unsigned c = xb_ld(&bar[XB_XCNT(j)]); sum += c; cnt += (c > 0u) ? 1u : 0u; mine = (j == x) ? c : mine; }
        if (sum == G) break;
        __builtin_amdgcn_s_sleep(1);
        if ((++sp & 255u) == 0u) { if (xb_ld(&bar[XB_TMO])) break; if (sp > XB_SPIN_CAP) { atomicAdd(&bar[XB_TMO], 1u); break; } }
    }
    nloc = mine > 0u ? mine : 1u; nx = cnt > 0u ? cnt : 1u;
}
__device__ __forceinline__ unsigned xcd_census_even(unsigned* bar) {
    const unsigned G = gridDim.x; if (G % 8u) return 0u;
    unsigned ok = 1u;
#pragma unroll
    for (unsigned j = 0; j < 16; ++j) { const unsigned c = xb_ld(&bar[XB_XCNT(j)]); ok &= (c == (j < 8u ? G / 8u : 0u)) ? 1u : 0u; }
    return ok;
}
constexpr int CQ_CH = 4096;
constexpr int CQ_N3 = 2047 * 16384 / CQ_CH, CQ_N2 = 511 * 16384 / CQ_CH, CQ_NA = 127 * 16384 / CQ_CH, CQ_N = CQ_N3 + CQ_N2 + 2 * CQ_NA;
constexpr int CW_Q = 512;
struct CopyQ { const float* c3; const float* c2; const float* ca; const float* c1; float* out; unsigned* head; };
__device__ __forceinline__ void copy_chunk(const CopyQ& Q, int chunk, int tid) {
    const float* in; float* out; int W;
    if (chunk < CQ_N3) { in = Q.c3; out = Q.out + O_C3S; W = 2048; }
    else if (chunk < CQ_N3 + CQ_N2) { chunk -= CQ_N3; in = Q.c2; out = Q.out + O_C2S; W = 512; }
    else if (chunk < CQ_N3 + CQ_N2 + CQ_NA) { chunk -= CQ_N3 + CQ_N2; in = Q.ca; out = Q.out + O_AKVS; W = 128; }
    else { chunk -= CQ_N3 + CQ_N2 + CQ_NA; in = Q.c1; out = Q.out + O_C1S; W = 128; }
    const unsigned wm1 = (unsigned)(W - 1);
    f32x4 v[8]; size_t doff[8];
#pragma unroll
    for (int j = 0; j < 8; ++j) {
        const unsigned i = (unsigned)chunk * CQ_CH + j * 512 + tid, r = i >> 6, es = r / wm1, rr = r - es * wm1;
        const size_t o = ((size_t)es * W + rr) * 256 + (i & 63) * 4; doff[j] = o;
        v[j] = __builtin_nontemporal_load((const f32x4*)(in + o + 256));
    }
#pragma unroll
    for (int j = 0; j < 8; ++j) __builtin_nontemporal_store(v[j], (f32x4*)(out + doff[j]));
}
template <int MODE  >
__device__ __forceinline__ void xb_wait_work(unsigned* bar, unsigned* pw, unsigned same, bool need_wait, volatile LAS unsigned* W, const CopyQ& Q) {
    const int tid = threadIdx.x;
    for (unsigned it = 0;; ++it) {
        const unsigned par = (it & 1u) * 2u;
        if (tid == 0) {
            unsigned rel = need_wait ? 0u : 1u;
            if (!rel) { for (int sp = 0; sp < 12; ++sp) { const unsigned v_ = xb_ld(pw); if (MODE == 0 ? (v_ != same) : (v_ >= same)) { rel = 1u; break; } __builtin_amdgcn_s_sleep(1); } }
            if (!rel && (it & 255u) == 255u) { if (xb_ld(&bar[XB_TMO])) rel = 1u; else if (it > (1u << 16)) { atomicAdd(&bar[XB_TMO], 1u); rel = 1u; } }
            unsigned ch = 0xffffffffu;
            if ((PROBE_DUP & 2048) == 0 && !rel && xb_ld(Q.head) < (unsigned)CQ_N) ch = xb_add(Q.head, 1u);
            W[par] = rel; W[par + 1] = ch;
        }
        __syncthreads();
        const unsigned rel = W[par], ch = W[par + 1];
        if (rel) break;
        if (ch < (unsigned)CQ_N) copy_chunk(Q, (int)ch, tid);
    }
}
__device__ __forceinline__ void xcd_barrier(const XcdBarrier& b, const CopyQ& Q) {
    asm volatile("s_waitcnt vmcnt(0)" ::: "memory");
    __syncthreads();
    unsigned* bar = b.bar;
    volatile LAS unsigned* W = b.st + 4;
    if (threadIdx.x == 0) {
        __builtin_amdgcn_s_waitcnt(0);
        unsigned nloc = b.st[0], nx = b.st[1];
        if (nloc == 0u) { xcd_barrier_complete(bar, b.x, nloc, nx); b.st[0] = nloc; b.st[1] = nx; b.st[10] = xcd_census_even(bar); }
        const unsigned old = xb_add(&bar[XB_XSUB(b.x)], 1u);
        const unsigned gen = old / nloc;
        unsigned role, val;
        if (old + 1u == (gen + 1u) * nloc) {
            __builtin_amdgcn_fence(__ATOMIC_RELEASE, "agent");
            asm volatile("s_waitcnt vmcnt(0)" ::: "memory");
            const unsigned og = xb_add(&bar[XB_TOP], 1u);
            const unsigned tg = og / nx;
            if (og + 1u == (tg + 1u) * nx) { xb_add(&bar[XB_TOPGEN], 1u); role = 2u; val = 0u; }
            else { role = 1u; val = tg; }
        } else { role = 0u; val = gen; }
        b.st[8] = role; b.st[9] = val;
    }
    __syncthreads();
    const unsigned role = b.st[8], val = b.st[9];
    xb_wait_work<0>(bar, role == 1u ? &bar[XB_TOPGEN] : &bar[XB_XGEN(b.x)], val, role != 2u, W, Q);
    if (threadIdx.x == 0) {
        __builtin_amdgcn_fence(__ATOMIC_ACQUIRE, "agent");
        if (role != 0u) xb_add(&bar[XB_XGEN(b.x)], 1u);
        asm volatile("s_waitcnt vmcnt(0)" ::: "memory");
    }
    __syncthreads();
}

__device__ __forceinline__ void xcc_barrier(const XcdBarrier& b, const CopyQ& Q) {
    asm volatile("s_waitcnt vmcnt(0)" ::: "memory");
    __syncthreads();
    unsigned* bar = b.bar;
    if (threadIdx.x == 0) {
        __builtin_amdgcn_s_waitcnt(0);
        const unsigned gen = b.st[11]; b.st[11] = gen + 1u;
        (void)xb_add(&bar[XB_LSUB(b.x)], 1u);
        b.st[9] = (gen + 1u) * b.st[0];
    }
    __syncthreads();
    const unsigned target = b.st[9];
    xb_wait_work<1>(bar, &bar[XB_LSUB(b.x)], target, true, b.st + 4, Q);
    asm volatile("" ::: "memory");
    __syncthreads();
}

__device__ __forceinline__ int opaque_v(int x) { asm volatile("" : "+v"(x)); return x; }
template <class P> __device__ __forceinline__ P* opaque_p(P* p) { asm volatile("" : "+s"(p)); return p; }
__device__ __forceinline__ float wave_sum(float v) {
#pragma unroll
    for (int o = 1; o < 64; o <<= 1) v += __shfl_xor(v, o);
    return v;
}
__device__ __forceinline__ float wave_max(float v) {
#pragma unroll
    for (int o = 1; o < 64; o <<= 1) v = fmaxf(v, __shfl_xor(v, o));
    return v;
}
__device__ __forceinline__ f16x4 cvt4(f32x4 v) { f16x4 r; r[0] = (f16)v[0]; r[1] = (f16)v[1]; r[2] = (f16)v[2]; r[3] = (f16)v[3]; return r; }
__device__ __forceinline__ f16x8 cat4(f16x4 lo, f16x4 hi) { f16x8 a; a[0] = lo[0]; a[1] = lo[1]; a[2] = lo[2]; a[3] = lo[3]; a[4] = hi[0]; a[5] = hi[1]; a[6] = hi[2]; a[7] = hi[3]; return a; }
__device__ __forceinline__ float sigmoidf_(float x) { return __builtin_amdgcn_rcpf(1.0f + __expf(-x)); }
__device__ __forceinline__ float logsigmoidf_(float x) { return fminf(x, 0.f) - log1pf(__expf(-fabsf(x))); }
__device__ __forceinline__ int row_batch(int m) { return m < MP ? (m >> 13) : (NB + m - MP); }

namespace pg8 {
constexpr int BM = 256, BK = 64, HALF = 128, HTB = HALF * BK * 2, STAGE_BYTES = 8 * HTB, NXCD = 8, WGM = 8;
__host__ __device__ __forceinline__ int lds_byte(int r, int c) { const int st = (r >> 4) * 2 + (c >> 5), rr = r & 15, cc = c & 31, ob = rr * 64 + cc * 2; return st * 1024 + (ob ^ (((ob >> 9) & 1) << 5)); }
__host__ __device__ __forceinline__ void stage_rc(int b, int& R, int& C) { const int st = b / 1024, sb = b % 1024, swz = sb ^ (((sb >> 9) & 1) << 5); R = (st >> 1) * 16 + swz / 64; C = (st & 1) * 32 + (swz % 64) / 2; }
struct Unit { int pm, pn; };
struct Gemm { const f16* A; const f16* Bt; int M, N, K; };
struct StaticOrder {
    int nM, nN, nwg, G, c;
    __host__ __device__ void init(int M, int N, int G_, int c_) { nM = M / BM; nN = N / BM; nwg = nM * nN; G = G_; c = c_; }
    __host__ __device__ bool next(int i, Unit& u) const {
        const long L = (long)i * G + c; if (L >= nwg) return false;
        int wgid = (int)L; { const int q = nwg / NXCD, r = nwg % NXCD, xcd = wgid % NXCD, off = wgid / NXCD; wgid = (xcd < r ? xcd * (q + 1) : r * (q + 1) + (xcd - r) * q) + off; }
        const int nig = WGM * nN, gid = wgid / nig, fm = gid * WGM, gsz = (nM - fm) < WGM ? (nM - fm) : WGM;
        u.pm = fm + ((wgid % nig) % gsz); u.pn = (wgid % nig) / gsz; return true;
    }
    __device__ __forceinline__ void a_ready(const Unit&) const {}
    __device__ __forceinline__ void done(const Unit&) const {}
};
struct DiagOrder {
    int G, c;
    __device__ bool next(int i, Unit& u) const {
        const int L = i * G + c; if (L >= NWIN / BM) return false;
        int s = 0, acc = 0;
#pragma unroll
        for (int k = 0; k < NSITE; ++k) { const int n = site_N(k) / BM; if (L >= acc + n) { s = k + 1; } acc += n; }
        u.pm = s; u.pn = L; return true;
    }
    __device__ __forceinline__ void a_ready(const Unit&) const {}
    __device__ __forceinline__ void done(const Unit&) const {}
};

template <class Epi, class Sched, bool ALIGN_EPI = true>
__device__ __forceinline__ void gemm_phase(ldsp_t lds, const Gemm g, const Sched& S, const Epi& E) {
    const int tid = opaque_v(threadIdx.x), wid = __builtin_amdgcn_readfirstlane(tid >> 6), lane = tid & 63, wr = wid >> 2, wc = wid & 3, fr = lane & 15, fq = lane >> 4;
    const int K = g.K, nt = K / BK;
    const int rot = (((S.c & 7) * nt) >> 3) & ~1;
    unsigned voffA[2];
#pragma unroll
    for (int i = 0; i < 2; ++i) voffA[i] = (unsigned)(tid * 16 + i * 8192);
#define voffB voffA
    const size_t kstep = (size_t)(2 * HTB);
    const size_t hstep = (size_t)HTB;
    const size_t tstep = (size_t)nt * kstep;
    const unsigned ldsw = (unsigned)wid * 1024u;
    const int aoff = lds_byte(wr * 64 + fr, fq * 8), boff = lds_byte(wc * 32 + fr, fq * 8);
#define PG8_SA(b, h) (((b) * 2 + (h)) * HTB)
#define PG8_SB(b, h) ((4 + (b) * 2 + (h)) * HTB)
#define PG8_STAGE_X(bufoff, gbase, voff, AUX) do { _Pragma("unroll") for (int _i = 0; _i < 2; ++_i) \
        __builtin_amdgcn_global_load_lds((const unsigned*)((const char*)(gbase) + (voff)[_i]), (LAS unsigned*)(lds + (bufoff) + ldsw + _i * 8192), 16, 0, AUX); } while (0)
#define PG8_STAGE(bufoff, gbase, voff) PG8_STAGE_X(bufoff, gbase, voff, 0)
#define PG8_STAGEA(bufoff, gbase, voff) PG8_STAGE_X(bufoff, gbase, voff, 16)
#define PG8_LDA(dst, b, h) do { _Pragma("unroll") for (int m = 0; m < 4; ++m) _Pragma("unroll") for (int k = 0; k < 2; ++k) dst[m][k] = *(const LAS f16x8*)(lds + PG8_SA(b, h) + aoff + m * 2048 + k * 1024); } while (0)
#define PG8_LDB(dst, b, h) do { _Pragma("unroll") for (int n = 0; n < 2; ++n) _Pragma("unroll") for (int k = 0; k < 2; ++k) dst[n][k] = *(const LAS f16x8*)(lds + PG8_SB(b, h) + boff + n * 2048 + k * 1024); } while (0)
#define PG8_MMA(ai, bj, At, Bt) do { __builtin_amdgcn_s_setprio(1); _Pragma("unroll") for (int m = 0; m < 4; ++m) _Pragma("unroll") for (int n = 0; n < 2; ++n) _Pragma("unroll") for (int k = 0; k < 2; ++k) \
        acc[ai][bj][m][n] = __builtin_amdgcn_mfma_f32_16x16x32_f16(Bt[n][k], At[m][k], acc[ai][bj][m][n], 0, 0, 0); __builtin_amdgcn_s_setprio(0); } while (0)
#define PG8_WAIT_V(n) asm volatile("s_waitcnt vmcnt(" #n ")" ::: "memory")
#define PG8_WAIT_L(n) asm volatile("s_waitcnt lgkmcnt(" #n ")" ::: "memory")
#define PG8_BAR __builtin_amdgcn_s_barrier()
#define PG8_SCHED __builtin_amdgcn_sched_barrier(0)
    Unit cur, nxt; int ui = 0;
    if (!S.next(0, cur)) return;
    f32x4 acc[2][2][4][2];
#pragma unroll
    for (int a = 0; a < 2; ++a)
#pragma unroll
        for (int b = 0; b < 2; ++b)
#pragma unroll
            for (int m = 0; m < 4; ++m)
#pragma unroll
                for (int n = 0; n < 2; ++n) acc[a][b][m][n] = (f32x4){0.f, 0.f, 0.f, 0.f};
    f16x8 At[4][2], B0[2][2], B1[2][2];
    const char* cA = (const char*)g.A + (size_t)cur.pm * tstep; const char* cB = (const char*)g.Bt + (size_t)cur.pn * tstep;
    S.a_ready(cur);
    const size_t rstep = (size_t)rot * kstep;
    PG8_STAGE(PG8_SB(0, 0), cB + rstep, voffB); PG8_STAGE(PG8_SB(0, 1), cB + rstep + hstep, voffB); PG8_STAGEA(PG8_SA(0, 0), cA + rstep, voffA); PG8_STAGEA(PG8_SA(0, 1), cA + rstep + hstep, voffA);
    if (wr == 1) PG8_BAR;
    PG8_WAIT_V(2); PG8_BAR;
    PG8_STAGE(PG8_SB(1, 0), cB + rstep + kstep, voffB); PG8_STAGEA(PG8_SA(1, 0), cA + rstep + kstep, voffA); PG8_STAGE(PG8_SB(1, 1), cB + rstep + hstep + kstep, voffB);
    PG8_WAIT_V(6); PG8_BAR;
    if constexpr (Epi::HAS_PRE) E.pre(cur, (LAS float*)(lds + EPI_OFF), wid, opaque_v(lane));
    for (;;) {
        const bool has_next = S.next(ui + 1, nxt);
        const char* nA = has_next ? (const char*)g.A + (size_t)nxt.pm * tstep : cA; const char* nB = has_next ? (const char*)g.Bt + (size_t)nxt.pn * tstep : cB;
        for (int t = 0; t < nt; t += 2) {
            const bool last = (t == nt - 2);
            int t1 = t + 1 + rot, t2 = t + 2 + rot; t1 -= (t1 >= nt) ? nt : 0; t2 -= (t2 >= nt) ? nt : 0;
            const char* a1 = cA + (size_t)t1 * kstep;
            const size_t nxoff = has_next ? rstep : (size_t)((nt - 2 + rot) % nt) * kstep;
            const char* a2 = last ? nA + nxoff : cA + (size_t)t2 * kstep; const char* b2 = last ? nB + nxoff : cB + (size_t)t2 * kstep;
            const char* a3 = a2 + kstep; const char* b3 = b2 + kstep;
            if (last && has_next) S.a_ready(nxt);
            PG8_LDB(B0, 0, 0); PG8_LDB(B1, 0, 1); PG8_SCHED; PG8_LDA(At, 0, 0); PG8_STAGEA(PG8_SA(1, 1), a1 + hstep, voffA);
            PG8_WAIT_V(8); PG8_WAIT_L(0); PG8_BAR; PG8_MMA(0, 0, At, B0); PG8_MMA(0, 1, At, B1); PG8_BAR; PG8_SCHED;
            PG8_LDA(At, 0, 1); PG8_STAGE(PG8_SB(0, 0), b2, voffB); PG8_STAGE(PG8_SB(0, 1), b2 + hstep, voffB); PG8_STAGEA(PG8_SA(0, 0), a2, voffA);
            PG8_WAIT_V(8); PG8_WAIT_L(0); PG8_BAR; PG8_MMA(1, 0, At, B0); PG8_MMA(1, 1, At, B1); PG8_BAR; PG8_SCHED;
            PG8_LDB(B0, 1, 0); PG8_LDB(B1, 1, 1); PG8_SCHED; PG8_LDA(At, 1, 0); PG8_STAGEA(PG8_SA(0, 1), a2 + hstep, voffA);
            PG8_WAIT_V(8); PG8_WAIT_L(0); PG8_BAR; PG8_MMA(0, 0, At, B0); PG8_MMA(0, 1, At, B1); PG8_BAR; PG8_SCHED;
            PG8_LDA(At, 1, 1); PG8_STAGE(PG8_SB(1, 0), b3, voffB); PG8_STAGE(PG8_SB(1, 1), b3 + hstep, voffB); PG8_STAGEA(PG8_SA(1, 0), a3, voffA);
            PG8_WAIT_V(8); PG8_WAIT_L(0); PG8_BAR; PG8_MMA(1, 0, At, B0); PG8_MMA(1, 1, At, B1); PG8_BAR; PG8_SCHED;
        }
        if constexpr (ALIGN_EPI) { if (wr == 0) PG8_BAR; }
        E(acc, cur, wr, wc, fr, fq, (const LAS float*)(lds + EPI_OFF + (ui & 1) * EPI_STRIDE)); S.done(cur);
        if (!has_next) break;
#pragma unroll
        for (int a = 0; a < 2; ++a)
#pragma unroll
            for (int b = 0; b < 2; ++b)
#pragma unroll
                for (int m = 0; m < 4; ++m)
#pragma unroll
                    for (int n = 0; n < 2; ++n) acc[a][b][m][n] = (f32x4){0.f, 0.f, 0.f, 0.f};
        cur = nxt; cA = nA; cB = nB; ++ui;
        if constexpr (Epi::HAS_PRE) E.pre(cur, (LAS float*)(lds + EPI_OFF + (ui & 1) * EPI_STRIDE), wid, opaque_v(lane));
        if constexpr (ALIGN_EPI) { if (wr == 1) PG8_BAR; }
    }
    PG8_WAIT_V(0);
    if constexpr (!ALIGN_EPI) { if (wr == 0) PG8_BAR; }
    PG8_BAR;
#undef PG8_SA
#undef PG8_SB
#undef PG8_STAGE
#undef voffB
#undef PG8_STAGEA
#undef PG8_STAGE_X
#undef PG8_LDA
#undef PG8_LDB
#undef PG8_MMA
#undef PG8_WAIT_V
#undef PG8_WAIT_L
#undef PG8_BAR
#undef PG8_SCHED
}
}
__host__ __device__ __forceinline__ size_t tiled_byte(int row, int col, int K) {
    return ((size_t)((row >> 8) * (K >> 6) + (col >> 6)) * 2 + ((row >> 7) & 1)) * 16384 + (size_t)pg8::lds_byte(row & 127, col & 63);
}
template <class V> __device__ __forceinline__ V* tiled_ptr(f16* base, int row, int col, int K) { return (V*)((char*)base + tiled_byte(row, col, K)); }

using pg8::Unit;
struct EpiSwiglu {
    static constexpr bool HAS_PRE = true;
    const float* rowss; const float* BW; f16* H;
    __device__ __forceinline__ void pre(const Unit& u, LAS float* ev, int wid, int lane) const {
        const int i = (wid & 3) * 64 + lane;
        const float* src = (wid < 4) ? rowss + u.pm * 256 + i : BW + (size_t)(u.pm >> 5) * NWIN + u.pn * 256 + i;
        __builtin_amdgcn_global_load_lds((const unsigned*)src, (LAS unsigned*)(ev + (wid < 4 ? 0 : 256) + (wid & 3) * 64), 4, 0, 0);
    }
    __device__ __forceinline__ static f16x4 act(f32x4 g, f32x4 u, float r, f32x4 bg, f32x4 bu) {
        f32x4 o;
#pragma unroll
        for (int e = 0; e < 4; ++e) { const float gg = g[e] * r + bg[e], uu = u[e] * r + bu[e]; o[e] = gg * uu * __builtin_amdgcn_rcpf(1.0f + __expf(-gg)); }
        return cvt4(o);
    }
    __device__ __forceinline__ void operator()(const f32x4 (&acc)[2][2][4][2], const Unit& u, int wr, int wc, int fr_in, int fq_in, const LAS float* ev) const {
        const int fr = opaque_v(fr_in), fq = opaque_v(fq_in);
        f32x4 bg[2], bu[2];
#pragma unroll
        for (int bj = 0; bj < 2; ++bj) { const int cg = 256 + bj * 128 + wc * 32 + 4 * fq; bg[bj] = *(const LAS f32x4*)(ev + cg); bu[bj] = *(const LAS f32x4*)(ev + cg + 16); }
        char* hb = (char*)H + (size_t)(u.pm * (FF / 64) + 2 * u.pn + (wc >> 1)) * 32768 + (size_t)(8 * wr + (wc & 1)) * 1024;
        const unsigned lo = (unsigned)(fr * 64 + ((16 * fq) ^ (32 * (fr >> 3))));
#pragma unroll
        for (int ai = 0; ai < 2; ++ai)
#pragma unroll
            for (int m = 0; m < 4; ++m) {
                const float r = rsqrtf(ev[ai * 128 + wr * 64 + m * 16 + fr] * (1.0f / D) + EPS);
                const f16x4 h0 = act(acc[ai][0][m][0], acc[ai][0][m][1], r, bg[0], bu[0]), h1 = act(acc[ai][1][m][0], acc[ai][1][m][1], r, bg[1], bu[1]);
                *(f16x8*)(hb + lo + (ai * 16384 + m * 2048)) = cat4(h0, h1);
            }
    }
    __device__ __forceinline__ void sk(int row, int q32, int e4, f32x4 g, f32x4 u) const {
        const int b = row_batch(row); const float* bias = BW + (size_t)b * NWIN + q32 * 32 + e4;
        const float r = rsqrtf(rowss[row] * (1.0f / D) + EPS);
        *(f16x4*)(H + (size_t)row * FF + 128 * (q32 >> 3) + 32 * (q32 & 3) + 2 * e4 + 4 * ((q32 >> 2) & 1)) = act(g, u, r, *(const f32x4*)bias, *(const f32x4*)(bias + 16));
    }
};
struct EpiRes {
    static constexpr bool HAS_PRE = true;
    f16* X; f16* A; float* rowss_next; const float* GT; const float* CS; const float* RCS;
    __device__ __forceinline__ void pre(const Unit& u, LAS float* ev, int wid, int lane) const {
        const int i = (wid & 3) * 64 + lane; const size_t o = (size_t)(u.pm >> 5) * D + u.pn * 256 + i;
        if (wid < 4) { __builtin_amdgcn_global_load_lds((const unsigned*)(GT + o), (LAS unsigned*)(ev + (wid & 3) * 64), 4, 0, 0);
                       __builtin_amdgcn_global_load_lds((const unsigned*)(RCS + o), (LAS unsigned*)(ev + 512 + (wid & 3) * 64), 4, 0, 0); }
        else if (CS) __builtin_amdgcn_global_load_lds((const unsigned*)(CS + o), (LAS unsigned*)(ev + 256 + (wid & 3) * 64), 4, 0, 0);
    }
    __device__ __forceinline__ void operator()(const f32x4 (&acc)[2][2][4][2], const Unit& u, int wr, int wc, int fr_in, int fq_in, const LAS float* ev) const {
        const int fr = opaque_v(fr_in), fq = opaque_v(fq_in);
        const int col0 = u.pn * 256 + wc * 32 + 8 * fq;
        const LAS float* gt = ev + wc * 32 + 8 * fq; const LAS float* cs = ev + 256 + wc * 32 + 8 * fq; const LAS float* rc = ev + 512 + wc * 32 + 8 * fq;
        char* ab = (char*)A + (size_t)(u.pm * (D / 64) + 4 * u.pn + (wc >> 1)) * 32768 + (size_t)(8 * wr + (wc & 1)) * 1024;
        const unsigned lo = (unsigned)(fr * 64 + ((16 * fq) ^ (32 * (fr >> 3))));
        const bool lastsite = (CS == nullptr);
        f32x4 gv[2][2], rv[2][2], cv[2][2];
#pragma unroll
        for (int bj = 0; bj < 2; ++bj)
#pragma unroll
            for (int n = 0; n < 2; ++n) { gv[bj][n] = *(const LAS f32x4*)(gt + bj * 128 + 4 * n); rv[bj][n] = *(const LAS f32x4*)(rc + bj * 128 + 4 * n); cv[bj][n] = *(const LAS f32x4*)(cs + bj * 128 + 4 * n); }
#pragma unroll
        for (int ai = 0; ai < 2; ++ai)
#pragma unroll
            for (int m = 0; m < 4; ++m) {
                const int row = u.pm * 256 + ai * 128 + wr * 64 + m * 16 + fr;
                float ss = 0.f;
#pragma unroll
                for (int bj = 0; bj < 2; ++bj) {
                    const int off = bj * 128;
                    f16x8* ap = (f16x8*)(ab + lo + (bj * 65536 + ai * 16384 + m * 2048));
                    const f16x8 ah = *ap;
                    f16x4 ao[2];
#pragma unroll
                    for (int n = 0; n < 2; ++n) {
                        f32x4 x = {(float)ah[4 * n], (float)ah[4 * n + 1], (float)ah[4 * n + 2], (float)ah[4 * n + 3]}; x = x * rv[bj][n] + gv[bj][n] * acc[ai][bj][m][n];
                        ss += (x[0] * x[0] + x[1] * x[1]) + (x[2] * x[2] + x[3] * x[3]);
                        ao[n] = cvt4(lastsite ? x : x * cv[bj][n]);
                    }
                    if (lastsite) *(f16x8*)(X + (size_t)row * D + col0 + off) = cat4(ao[0], ao[1]);
                    else *ap = cat4(ao[0], ao[1]);
                }
                ss += __shfl_xor(ss, 16); ss += __shfl_xor(ss, 32);
                if (fq == 0) atomicAdd(rowss_next + row, ss);
            }
    }
    __device__ __forceinline__ static int slot2col(int slot) { return (slot & ~31) + 8 * ((slot & 15) >> 2) + 4 * ((slot >> 4) & 1); }
    __device__ __forceinline__ void sk(int row, int slot, f32x4 v) const {
        const int col = slot2col(slot);
        const int b = row_batch(row);
        const f32x4 g4 = *(const f32x4*)(GT + (size_t)b * D + col), r4 = *(const f32x4*)(RCS + (size_t)b * D + col);
        f16* ar = A + (size_t)row * D + col; const f16x4 ah = *(const f16x4*)ar;
        f32x4 x = {(float)ah[0], (float)ah[1], (float)ah[2], (float)ah[3]}; x = x * r4 + g4 * v;
        if (CS) *(f16x4*)ar = cvt4(x * *(const f32x4*)(CS + (size_t)b * D + col));
        else *(f16x4*)(X + (size_t)row * D + col) = cvt4(x);
        atomicAdd(rowss_next + row, (x[0] * x[0] + x[1] * x[1]) + (x[2] * x[2] + x[3] * x[3]));
    }
};
template <bool EVEN> struct EpiZ {
    static constexpr bool HAS_PRE = true;
    const float* rowss; const float* BW; f16* Z; float* GATES;
    __device__ __forceinline__ void pre(const Unit& u, LAS float* ev, int wid, int lane) const {
        const int i = (wid & 3) * 64 + lane;
        const float* src = (wid < 4) ? rowss + u.pm * 256 + i : BW + (size_t)(u.pm >> 5) * NWIN + u.pn * 256 + i;
        __builtin_amdgcn_global_load_lds((const unsigned*)src, (LAS unsigned*)(ev + (wid < 4 ? 0 : 256) + (wid & 3) * 64), 4, 0, 0);
    }
    static constexpr int LDZ = EVEN ? NEV : NOD;
    __device__ __forceinline__ void put(int row, int col, f32x4 z) const {
        if (EVEN) {
            if (col < 2816) { if (col >= 1280 && col < 1792) z = z * 0.125f; *(f16x4*)(Z + (size_t)row * LDZ + col) = cvt4(z); }
            else if (col < NEVR) *(f32x4*)(GATES + (size_t)row * 16 + (col - 2816)) = z;
        } else *(f16x4*)(Z + (size_t)row * LDZ + col) = cvt4(z);
    }
    __device__ __forceinline__ void put8(int row, int col, f32x4 z0, f32x4 z1) const {
        if (EVEN) {
            if (col < 2816) { if (col >= 1280 && col < 1792) { z0 = z0 * 0.125f; z1 = z1 * 0.125f; } *(f16x8*)(Z + (size_t)row * LDZ + col) = cat4(cvt4(z0), cvt4(z1)); }
            else if (col < NEVR) { float* gp = GATES + (size_t)row * 16 + (col - 2816); *(f32x4*)gp = z0; *(f32x4*)(gp + 4) = z1; }
        } else *(f16x8*)(Z + (size_t)row * LDZ + col) = cat4(cvt4(z0), cvt4(z1));
    }
    __device__ __forceinline__ static int slot2col(int slot) { return (slot & ~31) + 8 * ((slot & 15) >> 2) + 4 * ((slot >> 4) & 1); }
    __device__ __forceinline__ void operator()(const f32x4 (&acc)[2][2][4][2], const Unit& u, int wr, int wc, int fr_in, int fq_in, const LAS float* ev) const {
        const int fr = opaque_v(fr_in), fq = opaque_v(fq_in);
        const int col0 = u.pn * 256 + wc * 32 + 8 * fq;
        f32x4 bv[2][2];
#pragma unroll
        for (int bj = 0; bj < 2; ++bj)
#pragma unroll
            for (int n = 0; n < 2; ++n) bv[bj][n] = *(const LAS f32x4*)(ev + 256 + wc * 32 + 4 * fq + bj * 128 + n * 16);
#pragma unroll
        for (int ai = 0; ai < 2; ++ai)
#pragma unroll
            for (int m = 0; m < 4; ++m) {
                const int row = u.pm * 256 + ai * 128 + wr * 64 + m * 16 + fr;
                const float r = rsqrtf(ev[ai * 128 + wr * 64 + m * 16 + fr] * (1.0f / D) + EPS);
#pragma unroll
                for (int bj = 0; bj < 2; ++bj) put8(row, col0 + bj * 128, acc[ai][bj][m][0] * r + bv[bj][0], acc[ai][bj][m][1] * r + bv[bj][1]);
            }
    }
    __device__ __forceinline__ void sk(int row, int slot, f32x4 v) const {
        const int b = row_batch(row); const float r = rsqrtf(rowss[row] * (1.0f / D) + EPS);
        put(row, slot2col(slot), v * r + *(const f32x4*)(BW + (size_t)b * NWIN + slot));
    }
};
struct EpiMod {
    static constexpr bool HAS_PRE = false;
    float* CS; float* GT; f16* SHA; const float* bmod; const float* NG; float* RCS;
    __device__ __forceinline__ void operator()(const f32x4 (&acc)[2][2][4][2], const Unit& u, int wr, int wc, int fr_in, int fq_in, const LAS float* ev) const {
        const int fr = opaque_v(fr_in), fq = opaque_v(fq_in);
        const int cu = u.pn * 256, l = cu / NMODC, jj = (cu - l * NMODC) >> 10, j = jj / 3, kind = jj - 3 * j, s = 3 * l + j;
        const int d0 = (cu & 1023) + wc * 32 + 4 * fq;
#pragma unroll
        for (int ai = 0; ai < 2; ++ai)
#pragma unroll
            for (int m = 0; m < 4; ++m) {
                const int row = ai * 128 + wr * 64 + m * 16 + fr;
#pragma unroll
                for (int bj = 0; bj < 2; ++bj)
#pragma unroll
                    for (int n = 0; n < 2; ++n) {
                        const int d = d0 + bj * 128 + n * 16;
                        const f32x4 v = acc[ai][bj][m][n] + *(const f32x4*)(bmod + cu - (cu & 1023) + d);
                        if (kind == 0) *tiled_ptr<f16x4>(SHA, s * 256 + row, d, D) = row < NBAT ? cvt4(v) : (f16x4){0, 0, 0, 0};
                        else if (row < NBAT) {
                            if (kind == 1) { const f32x4 c4 = *(const f32x4*)(NG + (l * 3 + j) * D + d) * (v + 1.0f); *(f32x4*)(CS + ((size_t)s * NBAT + row) * D + d) = c4;
                                *(f32x4*)(RCS + ((size_t)s * NBAT + row) * D + d) = (f32x4){1.0f / c4[0], 1.0f / c4[1], 1.0f / c4[2], 1.0f / c4[3]}; }
                            else *(f32x4*)(GT + ((size_t)s * NBAT + row) * D + d) = v * (j == 1 ? 1.0f : 0.5f);
                        }
                    }
            }
    }
};
struct EpiBias {
    static constexpr bool HAS_PRE = false;
    float* BW;
    __device__ __forceinline__ void operator()(const f32x4 (&acc)[2][2][4][2], const Unit& u, int wr, int wc, int fr_in, int fq_in, const LAS float* ev) const {
        const int fr = opaque_v(fr_in), fq = opaque_v(fq_in);
        const int col0 = u.pn * 256 + wc * 32 + 4 * fq;
#pragma unroll
        for (int ai = 0; ai < 2; ++ai)
#pragma unroll
            for (int m = 0; m < 4; ++m) {
                const int row = ai * 128 + wr * 64 + m * 16 + fr;
                if (row < NBAT) {
#pragma unroll
                    for (int bj = 0; bj < 2; ++bj)
#pragma unroll
                        for (int n = 0; n < 2; ++n) *(f32x4*)(BW + (size_t)row * NWIN + col0 + bj * 128 + n * 16) = acc[ai][bj][m][n];
                }
            }
    }
};

template <bool SWIGLU, int K, class Epi>
__device__ __forceinline__ void skinny_phase(ldsp_t lds, const f16* A, const f16* Bt, int N, const Epi& E, int G, int c, int nunits) {
    const int tid = opaque_v(threadIdx.x), wid = __builtin_amdgcn_readfirstlane(tid >> 6), lane = tid & 63, fr = lane & 15, fq = lane >> 4;
    const int grp = c & 7, rem = nunits % G, r0 = (rem + 7 - grp) >> 3;
    int r = (c >> 3) - r0, nr = ((G - grp + 7) >> 3) - r0;
    if (r < 0 || nr <= 0) { if (nr > 0) return; r = c >> 3; nr = (G - grp + 7) >> 3; }
    constexpr int AS = K + 8;
    constexpr int KS = (!SWIGLU && K > 2048) ? 4 : 1;
    LAS f16* As = (LAS f16*)lds;
    LAS float* red = (LAS float*)(lds + 16 * AS * 2);
    const f16* Ag = A + (size_t)(16 * grp) * K;
    for (int i = tid; i < 16 * (K / 8); i += 512) { const int row = i / (K / 8), ch = i - row * (K / 8);
        const unsigned long long* gp = (const unsigned long long*)(Ag + (size_t)row * K + 8 * ch);
        const unsigned long long lo = __hip_atomic_load(gp, __ATOMIC_RELAXED, __HIP_MEMORY_SCOPE_AGENT), hi = __hip_atomic_load(gp + 1, __ATOMIC_RELAXED, __HIP_MEMORY_SCOPE_AGENT);
        LAS unsigned long long* lp = (LAS unsigned long long*)(As + row * AS + 8 * ch); lp[0] = lo; lp[1] = hi; }
    __syncthreads();
    const int nitem = SWIGLU ? N / 32 : N / 16;
    const LAS f16* ap = As + fr * AS + 8 * fq;
    const int wq = wid / KS, kq = wid - wq * KS, nwq = 8 / KS;
    constexpr int KSTEPS = K / 32 / KS;
    for (int t0 = 0; t0 < nitem; t0 += nwq * nr) {
        const int t = t0 + wq * nr + r; const bool on = t < nitem;
        const int n0 = SWIGLU ? 32 * t : 16 * t;
        f32x4 acc0 = {0.f, 0.f, 0.f, 0.f}, acc1 = {0.f, 0.f, 0.f, 0.f};
        if (on) {
            const char* bp = (const char*)Bt + tiled_byte(n0 + fr, 8 * fq, K);
            const LAS f16* apk = ap + 32 * KSTEPS * kq;
#pragma unroll 8
            for (int ks = 0; ks < KSTEPS; ++ks) {
                const int kg = KSTEPS * kq + ks; const size_t ko = (size_t)(kg >> 1) * 32768 + (size_t)(kg & 1) * 1024;
                const f16x8 a = *(const LAS f16x8*)(apk + 32 * ks);
                const f16x8 b0 = *(const f16x8*)(bp + ko);
                acc0 = __builtin_amdgcn_mfma_f32_16x16x32_f16(b0, a, acc0, 0, 0, 0);
                if constexpr (SWIGLU) { const f16x8 b1 = *(const f16x8*)(bp + ko + 2048); acc1 = __builtin_amdgcn_mfma_f32_16x16x32_f16(b1, a, acc1, 0, 0, 0); }
            }
        }
        if constexpr (KS > 1) {
            *(LAS f32x4*)(red + (wid * 64 + lane) * 4) = acc0;
            __syncthreads();
            if (kq == 0) {
#pragma unroll
                for (int j = 1; j < KS; ++j) acc0 = acc0 + *(const LAS f32x4*)(red + ((wid + j) * 64 + lane) * 4);
            }
            __syncthreads();
        }
        const int row = MP + 16 * grp + fr;
        if (on && kq == 0) {
            if constexpr (SWIGLU) E.sk(row, t, 4 * fq, acc0, acc1);
            else E.sk(row, n0 + 4 * fq, acc0);
        }
    }
    __syncthreads();
}

struct Frame {
    ldsp_t lds; int tid, lane, wave, G, bid;
    float* out; unsigned char* ws;
};
#define FIN(i) (((const float* const __attribute__((address_space(4)))*)__builtin_amdgcn_kernarg_segment_ptr())[i])
#define WSP(T_, off) ((T_*)(F.ws + (off)))

struct MatDesc { const float* src; int K, Nsrc, Ndst, perm; f16* dst; };
__device__ __forceinline__ void tr_load(const MatDesc& d, int item, int lane, f32x4 (&v)[8]) {
    const int nblk = d.Ndst / 64, kb = item / nblk, nb64 = item - kb * nblk, k0 = 32 * kb;
    const int kr = lane >> 4, c16 = lane & 15, nb = 2 * nb64 + (c16 >> 3), c4 = c16 & 7;
    int sc = 32 * nb + 4 * c4;
    if (d.perm == 2) sc = 32 * nb + 8 * (c4 & 3) + 4 * (c4 >> 2);
    else if (d.perm == 1) sc = (c4 >> 2) * FF + 128 * (nb >> 3) + 32 * (nb & 3) + 8 * (c4 & 3) + 4 * ((nb >> 2) & 1);
    const bool ok = sc < d.Nsrc;
#pragma unroll
    for (int i = 0; i < 8; ++i) v[i] = ok ? __builtin_nontemporal_load((const f32x4*)(d.src + (size_t)(k0 + 4 * i + kr) * d.Nsrc + sc)) : (f32x4){0.f, 0.f, 0.f, 0.f};
}
__device__ __forceinline__ void tr_store(const MatDesc& d, int item, int lane, LAS float* scr, const f32x4 (&v)[8]) {
    const int nblk = d.Ndst / 64, kb = item / nblk, nb64 = item - kb * nblk, k0 = 32 * kb, n0 = 64 * nb64;
    const int kr = lane >> 4, c16 = lane & 15;
#pragma unroll
    for (int i = 0; i < 8; ++i) { LAS float* q = scr + (4 * i + kr) * 65 + 4 * c16; q[0] = v[i][0]; q[1] = v[i][1]; q[2] = v[i][2]; q[3] = v[i][3]; }
    LDS_WAIT(); asm volatile("" ::: "memory");
    const int c = lane & 3;
#pragma unroll
    for (int j = 0; j < 4; ++j) { const int n = (lane >> 2) + 16 * j; const LAS float* sp = scr + (8 * c) * 65 + n;
        f16x8 o;
#pragma unroll
        for (int e = 0; e < 8; ++e) o[e] = (f16)sp[e * 65];
        *tiled_ptr<f16x8>(d.dst, n0 + n, k0 + 8 * c, d.K) = o; }
    LDS_WAIT(); asm volatile("" ::: "memory");
}
__device__ __forceinline__ void mat_desc(Frame& F, int mi, MatDesc& d) {
    if (mi < 8) { const int l = mi >> 1, i = mi & 1; d = {FIN(I_FWI) + (size_t)mi * D * FF2, D, FF2, FF2, 1, WSP(f16, WS_WIN) + (size_t)site_off(3 * l + 2 * i) * D}; }
    else if (mi < 10) { const int e = mi - 8; d = {FIN(I_EWI) + (size_t)e * D * NEVR, D, NEVR, NEV, 2, WSP(f16, WS_WIN) + (size_t)site_off(6 * e + 1) * D}; }
    else if (mi < 12) { const int o = mi - 10; d = {FIN(I_OWI) + (size_t)o * D * NOD, D, NOD, NOD, 2, WSP(f16, WS_WIN) + (size_t)site_off(6 * o + 4) * D}; }
    else if (mi < 20) { const int k = mi - 12; d = {FIN(I_FWO) + (size_t)k * FF * D, FF, D, D, 2, WSP(f16, WS_WFO) + (size_t)k * D * FF}; }
    else if (mi < 22) { const int e = mi - 20; d = {FIN(I_EWO) + (size_t)e * D * D, D, D, D, 2, WSP(f16, WS_WEO) + (size_t)e * D * D}; }
    else if (mi < 24) { const int o = mi - 22; d = {FIN(I_OWO) + (size_t)o * 512 * D, 512, D, D, 2, WSP(f16, WS_WOO) + (size_t)o * D * 512}; }
    else { const int l = mi - 24; d = {FIN(I_WMOD) + (size_t)l * D * NMODC, D, NMODC, NMODC, 0, WSP(f16, WS_WMOD) + (size_t)l * NMODC * D}; }
}
__device__ __forceinline__ void cache_shift(const float* in, float* out, int W, size_t gtid, size_t gstride) {
    const size_t per = (size_t)(W - 1) * 64, total = per * 256;
    for (size_t i = gtid; i < total; i += gstride) {
        const size_t es = i / per, off = i - es * per;
        const f32x4 v = __builtin_nontemporal_load((const f32x4*)(in + es * (size_t)W * 256 + 256) + off);
        __builtin_nontemporal_store(v, (f32x4*)(out + es * (size_t)W * 256) + off);
    }
}
__device__ __forceinline__ void phase_pr0(Frame& F, int mlo, int mhi, bool do_ac, unsigned* ctr) {
    LAS float* scr = (LAS float*)(F.lds + F.wave * 16384);
    const int gw = F.bid * 8 + F.wave, NGW = F.G * 8;
    f32x4 va[8], vb[8];
    if (ctr) {
        int total = 0;
        for (int mi = mlo; mi < mhi; ++mi) { MatDesc d; mat_desc(F, mi, d); total += (d.K / 64) * (d.Ndst / 32); }
        for (;;) {
            unsigned g0 = 0; if (F.lane == 0) g0 = xb_add(ctr, 4u);
            g0 = (unsigned)__builtin_amdgcn_readfirstlane((int)g0);
            if ((int)g0 >= total) break;
            const int nj = min(4, total - (int)g0);
            MatDesc d0, d1, d2, d3; int i0 = 0, i1 = 0, i2 = 0, i3 = 0;
#define TR_LOCATE(J, DD, II) if (nj > (J)) { int g = (int)g0 + (J), mi = mlo; mat_desc(F, mi, DD); int items = (DD.K / 64) * (DD.Ndst / 32); \
                while (g >= items) { g -= items; ++mi; mat_desc(F, mi, DD); items = (DD.K / 64) * (DD.Ndst / 32); } II = g; }
            TR_LOCATE(0, d0, i0) TR_LOCATE(1, d1, i1) TR_LOCATE(2, d2, i2) TR_LOCATE(3, d3, i3)
#undef TR_LOCATE
            tr_load(d0, i0, F.lane, va);
            if (nj > 1) tr_load(d1, i1, F.lane, vb);
            tr_store(d0, i0, F.lane, scr, va);
            if (nj > 2) tr_load(d2, i2, F.lane, va);
            if (nj > 1) tr_store(d1, i1, F.lane, scr, vb);
            if (nj > 3) tr_load(d3, i3, F.lane, vb);
            if (nj > 2) tr_store(d2, i2, F.lane, scr, va);
            if (nj > 3) tr_store(d3, i3, F.lane, scr, vb);
        }
    } else {
    int base = 0;
    for (int mi = mlo; mi < mhi; ++mi) {
        MatDesc d; mat_desc(F, mi, d);
        const int items = (d.K / 64) * (d.Ndst / 32);
        int it = gw - (base % NGW); if (it < 0) it += NGW;
        if (it < items) tr_load(d, it, F.lane, va);
        while (it < items) {
            const int itb = it + NGW, itc = itb + NGW;
            if (itb < items) tr_load(d, itb, F.lane, vb);
            tr_store(d, it, F.lane, scr, va);
            if (itb >= items) break;
            if (itc < items) tr_load(d, itc, F.lane, va);
            tr_store(d, itb, F.lane, scr, vb);
            it = itc;
        }
        base += items;
    }
    }
    if (do_ac) { f16* AC = WSP(f16, WS_AC);
      for (int i = F.bid * 512 + F.tid; i < 256 * D; i += F.G * 512) { const int b = i >> 10, d = i & 1023; float v = 0.f;
          if (b < NBAT) { const float c = b < NB ? FIN(I_CP)[b * D + d] : FIN(I_CSMP)[(b - NB) * D + d]; v = c / (1.0f + __expf(-c)); }
          *tiled_ptr<f16>(AC, b, d, D) = (f16)v; } }
}
__device__ __forceinline__ void phase_pr2(Frame& F) {
    const float* CS0 = WSP(float, WS_CS);
    f16* X = WSP(f16, WS_X); f16* A = WSP(f16, WS_A); float* rowss = (float*)(F.ws + RSS_OFF);
    for (int m0 = (F.bid * 8 + F.wave) * 4; m0 < MALL; m0 += F.G * 32) {
        f32x4 xv[4][4];
#pragma unroll
        for (int r = 0; r < 4; ++r) { const int m = m0 + r; const float* xr = m < MP ? FIN(I_XP) + (size_t)m * D : FIN(I_XS) + (size_t)(m - MP) * D;
#pragma unroll
            for (int q = 0; q < 4; ++q) xv[r][q] = __builtin_nontemporal_load((const f32x4*)(xr + q * 256 + F.lane * 4)); }
#pragma unroll
        for (int r = 0; r < 4; ++r) { const int m = m0 + r; const float* cs = CS0 + (size_t)row_batch(m) * D; float ss = 0.f;
#pragma unroll
            for (int q = 0; q < 4; ++q) { const int d = q * 256 + F.lane * 4;
                const f32x4 x = xv[r][q];
                ss += (x[0] * x[0] + x[1] * x[1]) + (x[2] * x[2] + x[3] * x[3]);
                const f16x4 av = cvt4(x * *(const f32x4*)(cs + d));
                if (m < MP) *tiled_ptr<f16x4>(A, m, d, D) = av; else *(f16x4*)(A + (size_t)m * D + d) = av; }
            ss = wave_sum(ss);
            if (F.lane == 0) rowss[m] = ss; }
    }
}
template <int O0, int O1, int O2, int O3, int O4, int O5, int O6, int O7>
__device__ __forceinline__ void tr_read8(unsigned base, f16x4 (&r)[8]) {
    asm volatile("ds_read_b64_tr_b16 %0, %8 offset:%9\n\tds_read_b64_tr_b16 %1, %8 offset:%10\n\tds_read_b64_tr_b16 %2, %8 offset:%11\n\tds_read_b64_tr_b16 %3, %8 offset:%12\n\t"
                 "ds_read_b64_tr_b16 %4, %8 offset:%13\n\tds_read_b64_tr_b16 %5, %8 offset:%14\n\tds_read_b64_tr_b16 %6, %8 offset:%15\n\tds_read_b64_tr_b16 %7, %8 offset:%16\n\ts_waitcnt lgkmcnt(0)"
                 : "=&v"(r[0]), "=&v"(r[1]), "=&v"(r[2]), "=&v"(r[3]), "=&v"(r[4]), "=&v"(r[5]), "=&v"(r[6]), "=&v"(r[7])
                 : "v"(base), "n"(O0), "n"(O1), "n"(O2), "n"(O3), "n"(O4), "n"(O5), "n"(O6), "n"(O7) : "memory");
}
__device__ __forceinline__ unsigned lds_addr(const LAS void* p) { return (unsigned)(unsigned long long)p; }
struct BandAttn { const f16* Z; int ldz, qcol, kcol, vcol; f16* O; int ldo, ocol; float* LSE; const float* sinks; int tiledO; };
constexpr int KS_STR = 72, VS_STR = 96;
constexpr int ATT_KS = 0, ATT_VS = 256 * KS_STR * 2;
__device__ __forceinline__ void band_attn_unit(ldsp_t lds, const BandAttn& P, int tokbase, int stride, int blk, int kvh) {
    const int tid = opaque_v(threadIdx.x), w = __builtin_amdgcn_readfirstlane(tid >> 6), lane = tid & 63, c = lane & 31, hh = lane >> 5;
    LAS f16* Ks = (LAS f16*)(lds + ATT_KS); LAS f16* Vs = (LAS f16*)(lds + ATT_VS);
    f16x8 qfa[2][4];
    { const int head_ = kvh * 4 + (w >> 1);
#pragma unroll
      for (int qt = 0; qt < 2; ++qt) { const int mr_ = tokbase + stride * (128 * blk + 64 * (w & 1) + 32 * qt + c);
#pragma unroll
          for (int ks = 0; ks < 4; ++ks) qfa[qt][ks] = *(const f16x8*)(P.Z + (size_t)mr_ * P.ldz + P.qcol + head_ * 64 + 16 * ks + 8 * hh); } }
#pragma unroll
    for (int i = 0; i < 4; ++i) {
        const int cid = tid + 512 * i, key = cid >> 3, ch = cid & 7, p = 128 * blk - 128 + key;
        f16x8 kv = {0, 0, 0, 0, 0, 0, 0, 0}, vv = {0, 0, 0, 0, 0, 0, 0, 0};
        if (p >= 0) { const f16* zr = P.Z + (size_t)(tokbase + stride * p) * P.ldz + kvh * 64 + 8 * ch; kv = *(const f16x8*)(zr + P.kcol); vv = *(const f16x8*)(zr + P.vcol); }
        *(LAS f16x8*)(Ks + key * KS_STR + 8 * ch) = kv;
        *(LAS f16x8*)(Vs + key * VS_STR + 8 * ch) = vv;
    }
    __syncthreads();
    const int g = w >> 1, qh = w & 1, head = kvh * 4 + g;
    const unsigned vlane = lds_addr(Vs) + (unsigned)((4 * hh + ((lane & 15) >> 2)) * (VS_STR * 2) + (16 * ((lane >> 4) & 1) + 4 * (lane & 3)) * 2);
    const float sink = P.sinks ? P.sinks[head] : -INFINITY;
    constexpr float SC = 0.125f, L2E = 1.4426950408889634f;
#pragma unroll
    for (int qt = 0; qt < 2; ++qt) {
        const int i0 = 64 * qh + 32 * qt;
        const int mrow = tokbase + stride * (128 * blk + i0 + c);
        f16x8 qf[4];
#pragma unroll
        for (int ks = 0; ks < 4; ++ks) qf[ks] = qt ? qfa[1][ks] : qfa[0][ks];
        f32x16 s[5];
#pragma unroll
        for (int kt = 0; kt < 5; ++kt) {
#pragma unroll
            for (int i = 0; i < 16; ++i) s[kt][i] = 0.f;
#pragma unroll
            for (int ks = 0; ks < 4; ++ks) {
                const f16x8 a = *(const LAS f16x8*)(Ks + (i0 + 32 * kt + c) * KS_STR + 16 * ks + 8 * hh);
                s[kt] = __builtin_amdgcn_mfma_f32_32x32x16_f16(a, qf[ks], s[kt], 0, 0, 0);
            }
        }
        float mx = -INFINITY;
        const int cm = c - 4 * hh;
#pragma unroll
        for (int i = 0; i < 16; ++i) { const int kb = (i & 3) + 8 * (i >> 2);
            s[0][i] = (kb >= cm) ? s[0][i] : -INFINITY; s[4][i] = (kb <= cm) ? s[4][i] : -INFINITY; }
        if (blk == 0) {
            asm volatile("" ::: "memory");
#pragma unroll
            for (int kt = 0; kt < 5; ++kt)
#pragma unroll
                for (int i = 0; i < 16; ++i) { const int kr = (i & 3) + 8 * (i >> 2) + 4 * hh; s[kt][i] = (i0 + 32 * kt + kr >= 128) ? s[kt][i] : -INFINITY; }
        }
#pragma unroll
        for (int kt = 0; kt < 5; ++kt)
#pragma unroll
            for (int i = 0; i < 16; ++i) mx = fmaxf(mx, s[kt][i]);
        mx = fmaxf(mx, __shfl_xor(mx, 32));
        mx = fmaxf(mx * SC, sink);
        constexpr float CE = SC * L2E; const float moff = mx * L2E;
        float sum = 0.f; f16x8 pf[5][2];
#pragma unroll
        for (int kt = 0; kt < 5; ++kt)
#pragma unroll
            for (int i = 0; i < 16; ++i) { const float pv = __builtin_amdgcn_exp2f(__builtin_fmaf(s[kt][i], CE, -moff)); sum += pv; pf[kt][i >> 3][i & 7] = (f16)pv; }
        sum += __shfl_xor(sum, 32);
        sum += __builtin_amdgcn_exp2f((sink - mx) * L2E);
        const float inv = __builtin_amdgcn_rcpf(sum);
        f32x16 o[2];
#pragma unroll
        for (int i = 0; i < 16; ++i) { o[0][i] = 0.f; o[1][i] = 0.f; }
        const unsigned vb = vlane + (unsigned)(i0 * (VS_STR * 2));
#define BA_PV(KT) { f16x4 r[8]; constexpr int B_ = (KT) * 32 * VS_STR * 2, S_ = 16 * VS_STR * 2, H_ = 8 * VS_STR * 2; \
            tr_read8<B_, B_ + H_, B_ + S_, B_ + S_ + H_, B_ + 64, B_ + 64 + H_, B_ + 64 + S_, B_ + 64 + S_ + H_>(vb, r); \
            o[0] = __builtin_amdgcn_mfma_f32_32x32x16_f16(cat4(r[0], r[1]), pf[KT][0], o[0], 0, 0, 0); o[0] = __builtin_amdgcn_mfma_f32_32x32x16_f16(cat4(r[2], r[3]), pf[KT][1], o[0], 0, 0, 0); \
            o[1] = __builtin_amdgcn_mfma_f32_32x32x16_f16(cat4(r[4], r[5]), pf[KT][0], o[1], 0, 0, 0); o[1] = __builtin_amdgcn_mfma_f32_32x32x16_f16(cat4(r[6], r[7]), pf[KT][1], o[1], 0, 0, 0); }
        BA_PV(0) BA_PV(1) BA_PV(2) BA_PV(3) BA_PV(4)
#undef BA_PV
#pragma unroll
        for (int dt = 0; dt < 2; ++dt) {
            const int ocol = P.ocol + head * 64 + 32 * dt + 4 * hh;
#pragma unroll
            for (int rg = 0; rg < 4; ++rg) { f32x4 v = {o[dt][4 * rg] * inv, o[dt][4 * rg + 1] * inv, o[dt][4 * rg + 2] * inv, o[dt][4 * rg + 3] * inv};
                f16x4* op = P.tiledO ? tiled_ptr<f16x4>(P.O, mrow, ocol + 8 * rg, P.ldo) : (f16x4*)(P.O + (size_t)mrow * P.ldo + ocol + 8 * rg);
                *op = cvt4(v); }
        }
        if (P.LSE && hh == 0) P.LSE[(size_t)mrow * 8 + head] = mx + __logf(sum);
    }
    __syncthreads();
}
__device__ __forceinline__ void kv_export(const f16* Z, int ldz, int kcol, int vcol, int m0, int nrows, float* out, int tid0, int nthr) {
    for (int i = tid0; i < nrows * 32; i += nthr) {
        const int r = i >> 5, ch = i & 31, isv = ch >> 4, c8 = (ch & 15) * 8;
        const f16x8 v = *(const f16x8*)(Z + (size_t)(m0 + r) * ldz + (isv ? vcol : kcol) + c8);
        float* o = out + (size_t)r * 256 + isv * 128 + c8;
        *(f32x4*)o = (f32x4){(float)v[0], (float)v[1], (float)v[2], (float)v[3]}; *(f32x4*)(o + 4) = (f32x4){(float)v[4], (float)v[5], (float)v[6], (float)v[7]};
    }
}

__device__ __forceinline__ void gate_scan(const float* GATES, const float* bg, int m0, int h, int lane, LAS float* gb, LAS float* ga, LAS float* gcm, float& amax, float& bL, float& a0o, float& a1o) {
    const float* g0 = GATES + (size_t)(m0 + 2 * lane) * 16;
    const float ig0 = g0[h] + bg[h], ig1 = g0[16 + h] + bg[h];
    const float lf0 = logsigmoidf_(g0[8 + h] + bg[8 + h]), lf1 = logsigmoidf_(g0[24 + h] + bg[8 + h]);
    float s = lf0 + lf1;
#pragma unroll
    for (int o = 1; o < 64; o <<= 1) { const float t = __shfl_up(s, o); if (lane >= o) s += t; }
    const float b0 = (s - (lf0 + lf1)) + lf0, b1 = b0 + lf1;
    const float a0 = ig0 - b0, a1 = ig1 - b1;
    float mx = fmaxf(a0, a1);
#pragma unroll
    for (int o = 1; o < 64; o <<= 1) { const float t = __shfl_up(mx, o); if (lane >= o) mx = fmaxf(mx, t); }
    float ex = __shfl_up(mx, 1); if (lane == 0) ex = -INFINITY;
    const float c0 = fmaxf(ex, a0), c1 = fmaxf(c0, a1);
    gb[2 * lane] = b0; gb[2 * lane + 1] = b1; ga[2 * lane] = a0; ga[2 * lane + 1] = a1; gcm[2 * lane] = c0; gcm[2 * lane + 1] = c1;
    amax = __shfl(mx, 63); bL = __shfl(s, 63); a0o = a0; a1o = a1;
}
constexpr int X1_KS = 0, X1_VS = 18432, X1_G = 36864, X1_HEAD = 38912, X1_STR = 72;
__device__ __forceinline__ void mlstm_x1_unit(Frame& F, int e, int b, int ch, int hp) {
    const int tid = F.tid, w = F.wave, lane = F.lane, hg = w >> 2, wv = w & 3, gt = tid & 255, h = 2 * hp + hg;
    ldsp_t base = F.lds + hg * X1_HEAD;
    LAS f16* Ksm = (LAS f16*)(base + X1_KS); LAS f16* Vsm = (LAS f16*)(base + X1_VS);
    LAS float* gb = (LAS float*)(base + X1_G); LAS float* ga = gb + 128; LAS float* gcm = ga + 128; LAS float* gwk = gcm + 128;
    const f16* Z = WSP(f16, WS_Z); const float* GATES = WSP(float, WS_GATES); const float* bg = FIN(I_EBG) + e * 16;
    const int m0 = b * T + 128 * ch, idx = (b * 8 + h) * 64 + ch;
    float amax = 0.f, bL = 0.f;
    f16x8 kxa[4], vxa[4];
#pragma unroll
    for (int i = 0; i < 4; ++i) { const int cid = gt + 256 * i, s_ = cid >> 3, c8 = cid & 7; const f16* zr = Z + (size_t)(m0 + s_) * NEV + h * 64 + 8 * c8;
        kxa[i] = *(const f16x8*)(zr + 1280); vxa[i] = *(const f16x8*)(zr + 1792); }
    if (wv == 0) { float a0, a1; gate_scan(GATES, bg, m0, h, lane, gb, ga, gcm, amax, bL, a0, a1); gwk[2 * lane] = __expf(a0 - amax); gwk[2 * lane + 1] = __expf(a1 - amax); }
    __syncthreads();
#pragma unroll
    for (int i = 0; i < 4; ++i) {
        const int cid = gt + 256 * i, s_ = cid >> 3, c8 = cid & 7;
        const f16x8 kx = kxa[i], vx = vxa[i]; const float wk = gwk[s_];
        f16x8 ks;
#pragma unroll
        for (int q = 0; q < 8; ++q) ks[q] = (f16)((float)kx[q] * wk);
        *(LAS f16x8*)(Ksm + s_ * X1_STR + 8 * c8) = ks; *(LAS f16x8*)(Vsm + s_ * X1_STR + 8 * c8) = vx;
    }
    __syncthreads();
    const int fr = lane & 15, fq = lane >> 4;
    const unsigned lof = (unsigned)((8 * fq + (fr >> 2)) * (X1_STR * 2) + 4 * (fr & 3) * 2);
    const unsigned vaddr = lds_addr(Vsm) + lof + (unsigned)(16 * wv * 2), kaddr = lds_addr(Ksm) + lof;
    constexpr int R4 = 4 * X1_STR * 2, R32 = 32 * X1_STR * 2;
    f16x4 rv[8];
    tr_read8<0, R4, R32, R32 + R4, 2 * R32, 2 * R32 + R4, 3 * R32, 3 * R32 + R4>(vaddr, rv);
    float* DC = WSP(float, WS_DC) + (size_t)idx * 4096;
    f32x4 accn = {0.f, 0.f, 0.f, 0.f};
    f16x8 ones;
#pragma unroll
    for (int q = 0; q < 8; ++q) ones[q] = (fr == 0) ? (f16)1.0f : (f16)0.0f;
#define X1_TILE(DKT) { f16x4 rk[8]; tr_read8<(DKT) * 32, (DKT) * 32 + R4, (DKT) * 32 + R32, (DKT) * 32 + R32 + R4, (DKT) * 32 + 2 * R32, (DKT) * 32 + 2 * R32 + R4, (DKT) * 32 + 3 * R32, (DKT) * 32 + 3 * R32 + R4>(kaddr, rk); \
        f32x4 acc = {0.f, 0.f, 0.f, 0.f}; \
        _Pragma("unroll") for (int ks = 0; ks < 4; ++ks) { const f16x8 bf = cat4(rk[2 * ks], rk[2 * ks + 1]); acc = __builtin_amdgcn_mfma_f32_16x16x32_f16(cat4(rv[2 * ks], rv[2 * ks + 1]), bf, acc, 0, 0, 0); \
            if ((DKT) == wv) accn = __builtin_amdgcn_mfma_f32_16x16x32_f16(ones, bf, accn, 0, 0, 0); } \
        _Pragma("unroll") for (int r = 0; r < 4; ++r) DC[(16 * wv + 4 * fq + r) * 64 + 16 * (DKT) + fr] = acc[r]; }
    X1_TILE(0) X1_TILE(1) X1_TILE(2) X1_TILE(3)
#undef X1_TILE
    if (fq == 0) WSP(float, WS_DN)[(size_t)idx * 64 + 16 * wv + fr] = accn[0];
    if (gt == 0) { float* SC = WSP(float, WS_SC); SC[idx] = bL + amax; SC[1024 + idx] = bL; }
    __syncthreads();
}
__device__ __forceinline__ void mlstm_scan(Frame& F, int e) {
    const int gid = F.bid * 512 + F.tid; if (gid >= 16 * 4160) return;
    const int bh = gid / 4160, el = gid - bh * 4160; const bool isc = el < 4096;
    const float* SC = WSP(float, WS_SC); float* MPV = WSP(float, WS_SC) + 2048;
    const float* src = isc ? WSP(float, WS_DC) + (size_t)bh * 64 * 4096 + el : WSP(float, WS_DN) + (size_t)bh * 64 * 64 + (el - 4096);
    const int sstr = isc ? 4096 : 64;
    f16* cp = WSP(f16, WS_CP) + (size_t)bh * 64 * 4096 + el; float* np = WSP(float, WS_NP) + (size_t)bh * 64 * 64 + (el - 4096);
    float st = 0.f, mst = 0.f;
#pragma unroll 8
    for (int c = 0; c < 64; ++c) {
        const float dv = src[(size_t)c * sstr], mloc = SC[bh * 64 + c], bL = SC[1024 + bh * 64 + c];
        if (isc) cp[(size_t)c * 4096] = (f16)st; else np[c * 64] = st;
        if (el == 0) MPV[bh * 64 + c] = mst;
        const float mnew = fmaxf(bL + mst, mloc);
        st = __expf(bL + mst - mnew) * st + __expf(mloc - mnew) * dv; mst = mnew;
    }
    const int b = bh >> 3, h = bh & 7;
    if (isc) { const int dv = el >> 6, dk = el & 63; F.out[O_BCP + ((size_t)((e * 2 + b) * 8 + h) * 64 + dk) * 64 + dv] = st; }
    else F.out[O_BNP + (size_t)((e * 2 + b) * 8 + h) * 64 + (el - 4096)] = st;
    if (el == 0) F.out[O_BMP + (e * 2 + b) * 8 + h] = mst;
}
constexpr int X3_KR = 0, X3_VS = 18432, X3_G = 43008, X3_HEAD = 45056;
__device__ __forceinline__ void mlstm_x3_unit(Frame& F, int e, int b, int ch, int hp) {
    const int tid = F.tid, w = F.wave, lane = F.lane, hg = w >> 2, tt = hg ? 3 - (w & 3) : (w & 3), gt = tid & 255, h = 2 * hp + hg, c = lane & 31, hh = lane >> 5;
    ldsp_t base = F.lds + hg * X3_HEAD;
    LAS f16* Kr = (LAS f16*)(base + X3_KR); LAS f16* Vs = (LAS f16*)(base + X3_VS);
    LAS float* gb = (LAS float*)(base + X3_G); LAS float* ga = gb + 128; LAS float* gcm = ga + 128; LAS float* npv = gcm + 128;
    const f16* Z = WSP(f16, WS_Z); const float* GATES = WSP(float, WS_GATES); const float* bg = FIN(I_EBG) + e * 16;
    const int m0 = b * T + 128 * ch, idx = (b * 8 + h) * 64 + ch;
    f16x8 kxa[4], vxa[4];
#pragma unroll
    for (int i = 0; i < 4; ++i) { const int cid = gt + 256 * i, s = cid >> 3, c8 = cid & 7; const f16* zr = Z + (size_t)(m0 + s) * NEV + h * 64 + 8 * c8;
        kxa[i] = *(const f16x8*)(zr + 1280); vxa[i] = *(const f16x8*)(zr + 1792); }
    if (tt == 0) { float t0, t1, t2, t3; gate_scan(GATES, bg, m0, h, lane, gb, ga, gcm, t0, t1, t2, t3); }
#pragma unroll
    for (int i = 0; i < 4; ++i) {
        const int cid = gt + 256 * i, s = cid >> 3, c8 = cid & 7;
        const f16x8 kx = kxa[i], vx = vxa[i];
        *(LAS f16x8*)(Kr + s * KS_STR + 8 * c8) = kx;
        *(LAS f16x8*)(Vs + s * VS_STR + 8 * c8) = vx;
    }
    if (gt < 64) npv[gt] = WSP(float, WS_NP)[(size_t)idx * 64 + gt];
    __syncthreads();
    const float mst = WSP(float, WS_SC)[2048 + idx];
    const int t = 32 * tt + c, mrow = m0 + t;
    const float bt = gb[t], mm = fmaxf(mst, gcm[t]), mt = bt + mm;
    f16x8 qf[4];
#pragma unroll
    for (int ks = 0; ks < 4; ++ks) qf[ks] = *(const f16x8*)(Z + (size_t)mrow * NEV + 768 + h * 64 + 16 * ks + 8 * hh);
    f32x16 num[2];
#pragma unroll
    for (int i = 0; i < 16; ++i) { num[0][i] = 0.f; num[1][i] = 0.f; }
    float qsum = 0.f;
    const unsigned vlane = lds_addr(Vs) + (unsigned)((4 * hh + ((lane & 15) >> 2)) * (VS_STR * 2) + (16 * ((lane >> 4) & 1) + 4 * (lane & 3)) * 2);
    for (int st = 0; st <= tt; ++st) {
        f32x16 sa;
#pragma unroll
        for (int i = 0; i < 16; ++i) sa[i] = 0.f;
#pragma unroll
        for (int ks = 0; ks < 4; ++ks) { const f16x8 a = *(const LAS f16x8*)(Kr + (32 * st + c) * KS_STR + 16 * ks + 8 * hh); sa = __builtin_amdgcn_mfma_f32_32x32x16_f16(a, qf[ks], sa, 0, 0, 0); }
        f16x8 wf[2];
        const bool diag = (st == tt);
        constexpr float L2E_ = 1.4426950408889634f; const float mml = mm * L2E_;
#pragma unroll
        for (int rg = 0; rg < 4; ++rg) {
            const int s0 = 32 * st + 8 * rg + 4 * hh;
            const f32x4 g4 = *(const LAS f32x4*)(ga + s0);
#pragma unroll
            for (int q = 0; q < 4; ++q) {
                const int i = 4 * rg + q;
                float dd = __builtin_amdgcn_exp2f(__builtin_fmaf(g4[q], L2E_, -mml));
                if (diag) dd = (s0 + q <= t) ? dd : 0.f;
                const float wv_ = sa[i] * dd;
                qsum += wv_; wf[i >> 3][i & 7] = (f16)wv_;
            }
        }
        { f16x4 r[8]; constexpr int S_ = 16 * VS_STR * 2, H_ = 8 * VS_STR * 2;
          tr_read8<0, H_, S_, S_ + H_, 64, 64 + H_, 64 + S_, 64 + S_ + H_>(vlane + (unsigned)(st * 32 * VS_STR * 2), r);
          num[0] = __builtin_amdgcn_mfma_f32_32x32x16_f16(cat4(r[0], r[1]), wf[0], num[0], 0, 0, 0); num[0] = __builtin_amdgcn_mfma_f32_32x32x16_f16(cat4(r[2], r[3]), wf[1], num[0], 0, 0, 0);
          num[1] = __builtin_amdgcn_mfma_f32_32x32x16_f16(cat4(r[4], r[5]), wf[0], num[1], 0, 0, 0); num[1] = __builtin_amdgcn_mfma_f32_32x32x16_f16(cat4(r[6], r[7]), wf[1], num[1], 0, 0, 0); }
    }
    qsum += __shfl_xor(qsum, 32);
    f32x16 ni[2];
#pragma unroll
    for (int i = 0; i < 16; ++i) { ni[0][i] = 0.f; ni[1][i] = 0.f; }
    const f16* CP = WSP(f16, WS_CP) + (size_t)idx * 4096;
#pragma unroll
    for (int dt = 0; dt < 2; ++dt)
#pragma unroll
        for (int ks = 0; ks < 4; ++ks) { const f16x8 a = *(const f16x8*)(CP + (32 * dt + c) * 64 + 16 * ks + 8 * hh); ni[dt] = __builtin_amdgcn_mfma_f32_32x32x16_f16(a, qf[ks], ni[dt], 0, 0, 0); }
    float qni = 0.f;
#pragma unroll
    for (int ks = 0; ks < 4; ++ks)
#pragma unroll
        for (int j = 0; j < 8; ++j) qni += (float)qf[ks][j] * npv[16 * ks + 8 * hh + j];
    qni += __shfl_xor(qni, 32);
    const float inter = __expf(mst - mm);
    const float qn = qsum + inter * qni, invd = __builtin_amdgcn_rcpf(fmaxf(fabsf(qn), __expf(-mt)));
    float ssq = 0.f;
#pragma unroll
    for (int dt = 0; dt < 2; ++dt)
#pragma unroll
        for (int i = 0; i < 16; ++i) { const float hv = (num[dt][i] + inter * ni[dt][i]) * invd; num[dt][i] = hv; ssq += hv * hv; }
    ssq += __shfl_xor(ssq, 32);
    const float rinv = rsqrtf(ssq * (1.0f / 64.0f) + EPS);
    const float* hgain = FIN(I_EHG) + (e * 8 + h) * 64;
    f16* O = WSP(f16, WS_O);
#pragma unroll
    for (int dt = 0; dt < 2; ++dt)
#pragma unroll
        for (int rg = 0; rg < 4; ++rg) {
            const int dv0 = 32 * dt + 8 * rg + 4 * hh;
            const f16x4 bo = *(const f16x4*)(Z + (size_t)mrow * NEV + 2304 + h * 64 + dv0); const f32x4 gn = *(const f32x4*)(hgain + dv0);
            f32x4 y;
#pragma unroll
            for (int q = 0; q < 4; ++q) y[q] = num[dt][4 * rg + q] * rinv * gn[q] * sigmoidf_((float)bo[q]);
            *tiled_ptr<f16x4>(O, mrow, 512 + h * 64 + dv0, D) = cvt4(y);
        }
    __syncthreads();
}

constexpr int DA_QS = 0, DA_KC = 1024, DA_VC = 36352, DA_SC = 69376, DA_RD = 71488, DA_KSTR = 68;
__device__ __forceinline__ void dec_attn(Frame& F, const float* cache, int dil, int kvh, const f16* zrow, int qcol, int kcol, int vcol, const float* sinks, float& o_out, float& lse_out) {
    const int tid = F.tid, lane = F.lane, w = F.wave;
    LAS float* qs = (LAS float*)(F.lds + DA_QS); LAS float* Kc = (LAS float*)(F.lds + DA_KC); LAS float* Vc = (LAS float*)(F.lds + DA_VC);
    LAS float* sc = (LAS float*)(F.lds + DA_SC); LAS float* rd = (LAS float*)(F.lds + DA_RD);
#pragma unroll
    for (int i = 0; i < 4; ++i) {
        const int cid = tid + 512 * i, j = cid >> 4, c4 = cid & 15;
        const float* src = cache + (size_t)(dil * j) * 256 + kvh * 64 + 4 * c4;
        const f32x4 kk = *(const f32x4*)src, vv = *(const f32x4*)(src + 128);
        *(LAS f32x4*)(Kc + j * DA_KSTR + 4 * c4) = kk;
        *(LAS f32x4*)(Vc + j * 64 + 4 * c4) = vv;
    }
    if (tid < 64) { Kc[128 * DA_KSTR + tid] = (float)zrow[kcol + kvh * 64 + tid]; Vc[128 * 64 + tid] = (float)zrow[vcol + kvh * 64 + tid]; }
    if (tid < 256) qs[tid] = (float)zrow[qcol + kvh * 256 + tid];
    __syncthreads();
    for (int jj = tid; jj < 516; jj += 512) {
        const int j = jj >> 2, g = jj & 3; f32x4 s4 = {0.f, 0.f, 0.f, 0.f};
#pragma unroll
        for (int d = 0; d < 64; d += 4) s4 = s4 + *(const LAS f32x4*)(qs + g * 64 + d) * *(const LAS f32x4*)(Kc + j * DA_KSTR + d);
        sc[g * 132 + j] = ((s4[0] + s4[1]) + (s4[2] + s4[3])) * 0.125f;
    }
    __syncthreads();
    if (w < 4) {
        const float sk = sinks ? sinks[kvh * 4 + w] : -INFINITY;
        const float v0 = sc[w * 132 + lane], v1 = sc[w * 132 + 64 + lane], v2 = lane == 0 ? sc[w * 132 + 128] : -INFINITY;
        float mx = wave_max(fmaxf(fmaxf(v0, v1), v2)); mx = fmaxf(mx, sk);
        const float p0 = __expf(v0 - mx), p1 = __expf(v1 - mx), p2 = lane == 0 ? __expf(v2 - mx) : 0.f;
        const float sum = wave_sum(p0 + p1 + p2) + __expf(sk - mx);
        sc[w * 132 + lane] = p0; sc[w * 132 + 64 + lane] = p1; if (lane == 0) { sc[w * 132 + 128] = p2; rd[w] = sum; rd[4 + w] = mx; }
    }
    __syncthreads();
    if (tid < 256) {
        const int g = tid >> 6, d = tid & 63; float o = 0.f;
#pragma unroll 4
        for (int j = 0; j < 128; j += 4) { const f32x4 p4 = *(const LAS f32x4*)(sc + g * 132 + j);
            o += p4[0] * Vc[j * 64 + d]; o += p4[1] * Vc[(j + 1) * 64 + d]; o += p4[2] * Vc[(j + 2) * 64 + d]; o += p4[3] * Vc[(j + 3) * 64 + d]; }
        o += sc[g * 132 + 128] * Vc[128 * 64 + d];
        const float den = rd[g]; o_out = o * __builtin_amdgcn_rcpf(den); lse_out = rd[4 + g] + __logf(den);
    }
    __syncthreads();
}
__device__ __forceinline__ void sample_attn_even(Frame& F, int e, int s, int kvh) {
    const f16* zrow = WSP(f16, WS_Z) + (size_t)(MP + s) * NEV;
    float o = 0.f, lse = 0.f;
    dec_attn(F, FIN(I_CA) + ((size_t)e * NS + s) * 128 * 256, 1, kvh, zrow, 0, 512, 640, FIN(I_ESK) + e * 8, o, lse);
    if (F.tid < 256) WSP(f16, WS_O)[(size_t)(MP + s) * D + kvh * 256 + F.tid] = (f16)o;
    if (F.tid < 128) { const int isv = F.tid >> 6, d = F.tid & 63;
        F.out[O_AKVS + (((size_t)e * NS + s) * 128 + 127) * 256 + isv * 128 + kvh * 64 + d] = (float)zrow[(isv ? 640 : 512) + kvh * 64 + d]; }
}
__device__ __forceinline__ void sample_attn_odd(Frame& F, int oi, int s, int kvh) {
    const f16* zrow = WSP(f16, WS_Z) + (size_t)(MP + s) * NOD;
    float o[3] = {0.f, 0.f, 0.f}, lse[3] = {0.f, 0.f, 0.f};
    dec_attn(F, FIN(I_CC1) + ((size_t)oi * NS + s) * 128 * 256, 1, kvh, zrow, 0, 512, 640, nullptr, o[0], lse[0]);
    dec_attn(F, FIN(I_CC2) + ((size_t)oi * NS + s) * 512 * 256, 4, kvh, zrow, 768, 1280, 1408, nullptr, o[1], lse[1]);
    dec_attn(F, FIN(I_CC3) + ((size_t)oi * NS + s) * 2048 * 256, 16, kvh, zrow, 1536, 2048, 2176, nullptr, o[2], lse[2]);
    if (F.tid < 256) {
        const float mx = fmaxf(fmaxf(lse[0], lse[1]), lse[2]);
        const float w0 = __expf(lse[0] - mx), w1 = __expf(lse[1] - mx), w2 = __expf(lse[2] - mx);
        WSP(f16, WS_O)[(size_t)(MP + s) * 512 + kvh * 256 + F.tid] = (f16)((w0 * o[0] + w1 * o[1] + w2 * o[2]) / (w0 + w1 + w2));
    }
    if (F.tid < 384) { const int g = F.tid >> 7, r = F.tid & 127, isv = r >> 6, d = r & 63;
        const int W = g == 0 ? 128 : (g == 1 ? 512 : 2048); const size_t ob = g == 0 ? O_C1S : (g == 1 ? O_C2S : O_C3S);
        F.out[ob + (((size_t)oi * NS + s) * W + (W - 1)) * 256 + isv * 128 + kvh * 64 + d] = (float)zrow[768 * g + (isv ? 640 : 512) + kvh * 64 + d]; }
}
__device__ __forceinline__ void sample_mlstm(Frame& F, int e, int s) {
    const int h = F.wave, lane = F.lane, m = MP + s;
    const f16* zrow = WSP(f16, WS_Z) + (size_t)m * NEV; const float* gr = WSP(float, WS_GATES) + (size_t)m * 16; const float* bg = FIN(I_EBG) + e * 16;
    const float q = (float)zrow[768 + h * 64 + lane], k = (float)zrow[1280 + h * 64 + lane], v = (float)zrow[1792 + h * 64 + lane], bo = (float)zrow[2304 + h * 64 + lane];
    const float ig = gr[h] + bg[h], lf = logsigmoidf_(gr[8 + h] + bg[8 + h]);
    const size_t sh = ((size_t)e * NS + s) * 8 + h;
    const float mst = FIN(I_SBM)[sh], nst = FIN(I_SBN)[sh * 64 + lane];
    const float mt = fmaxf(lf + mst, ig), dsc = __expf(ig - mt), inter = __expf(lf + mst - mt);
    const float qk = wave_sum(q * k), qn_i = wave_sum(q * nst);
    const float* C = FIN(I_SBC) + sh * 4096; float* Co = F.out + O_BCS + sh * 4096;
    float qc = 0.f;
#pragma unroll 8
    for (int dk = 0; dk < 64; ++dk) {
        const float cv = C[dk * 64 + lane], qd = __shfl(q, dk), kd = __shfl(k, dk);
        qc += qd * cv; Co[dk * 64 + lane] = inter * cv + dsc * kd * v;
    }
    const float wgt = qk * dsc, num = wgt * v + inter * qc, qn = wgt + inter * qn_i;
    const float hv = num / fmaxf(fabsf(qn), __expf(-mt));
    const float rinv = rsqrtf(wave_sum(hv * hv) * (1.0f / 64.0f) + EPS);
    WSP(f16, WS_O)[(size_t)m * D + 512 + h * 64 + lane] = (f16)(hv * rinv * FIN(I_EHG)[(e * 8 + h) * 64 + lane] * sigmoidf_(bo));
    F.out[O_BNS + sh * 64 + lane] = inter * nst + dsc * k;
    if (lane == 0) F.out[O_BMS + sh] = mt;
}

__device__ __forceinline__ void phase_e1(Frame& F, int e, int tmask) {
    BandAttn P{WSP(f16, WS_Z), NEV, 0, 512, 640, WSP(f16, WS_O), D, 0, nullptr, FIN(I_ESK) + e * 8, 1};
    for (int u = F.bid; u < 1152; u += F.G) {
        if (u < 256) { if (!(tmask & 1)) continue; const int kvh = u & 1, blk = (u >> 1) & 63, b = u >> 7;
            band_attn_unit(F.lds, P, b * T, 1, blk, kvh);
            if (blk == 63 && kvh == 0) kv_export(P.Z, NEV, 512, 640, b * T + T - 128, 128, F.out + O_AKVP + (size_t)(e * 2 + b) * 128 * 256, F.tid, 512);
        } else if (u < 768) { if (!(tmask & 2)) continue; const int v = u - 256; mlstm_x1_unit(F, e, v >> 8, (v >> 2) & 63, v & 3); }
        else if (u < 1024) { if (!(tmask & 4)) continue; const int v = u - 768; sample_attn_even(F, e, v >> 1, v & 1); }
        else { if (!(tmask & 8)) continue; sample_mlstm(F, e, u - 1024); }
    }
}
__device__ __forceinline__ void phase_e3(Frame& F, int e) {
    for (int u = F.bid; u < 512; u += F.G) mlstm_x3_unit(F, e, u >> 8, (u >> 2) & 63, u & 3);
}
__device__ __forceinline__ void phase_o1(Frame& F, int oi, int tmask) {
    const f16* Z = WSP(f16, WS_Z);
    for (int u = F.bid; u < 768 + 256 + 42; u += F.G) {
        if (u < 768) {
            if (!(tmask & 1)) continue;
            const int g = u >> 8, v = u & 255, kvh = v & 1, r = v >> 1;
            const int dil = g == 0 ? 1 : (g == 1 ? 4 : 16), nblk = 64 / dil;
            const int b = r >> 6, rr = r & 63, res = rr / nblk, blk = rr % nblk;
            BandAttn P{Z, NOD, 768 * g, 768 * g + 512, 768 * g + 640, WSP(f16, WS_OG) + (size_t)g * MP * 512, 512, 0, WSP(float, WS_LSE) + (size_t)g * MP * 8, nullptr, 0};
            band_attn_unit(F.lds, P, b * T + res, dil, blk, kvh);
        } else if (u < 1024) { if (!(tmask & 4)) continue; const int v = u - 768; sample_attn_odd(F, oi, v >> 1, v & 1); }
        else {
            if (!(tmask & 16)) continue;
            const int v = u - 1024; int g, q; if (v < 2) { g = 0; q = v; } else if (v < 10) { g = 1; q = v - 2; } else { g = 2; q = v - 10; }
            const int W = 128 << (2 * g), per = W / 128, b = q / per, part = q % per;
            const size_t ob = g == 0 ? O_C1P : (g == 1 ? O_C2P : O_C3P);
            kv_export(Z, NOD, 768 * g + 512, 768 * g + 640, b * T + T - W + part * 128, 128, F.out + ob + ((size_t)(oi * 2 + b) * W + part * 128) * 256, F.tid, 512);
        }
    }
}
__device__ __forceinline__ void phase_o2(Frame& F) {
    const f16* OG = WSP(f16, WS_OG); const float* LSE = WSP(float, WS_LSE); f16* O = WSP(f16, WS_O);
    for (size_t i = (size_t)F.bid * 512 + F.tid; i < (size_t)MP * 64; i += (size_t)F.G * 512) {
        const size_t m = i >> 6; const int c8 = (int)(i & 63), hd = c8 >> 3;
        const float l0 = LSE[m * 8 + hd], l1 = LSE[(size_t)MP * 8 + m * 8 + hd], l2 = LSE[(size_t)2 * MP * 8 + m * 8 + hd];
        const float mx = fmaxf(fmaxf(l0, l1), l2); float w0 = __expf(l0 - mx), w1 = __expf(l1 - mx), w2 = __expf(l2 - mx); const float inv = 1.0f / (w0 + w1 + w2);
        w0 *= inv; w1 *= inv; w2 *= inv;
        const f16x8 a = *(const f16x8*)(OG + m * 512 + c8 * 8), b = *(const f16x8*)(OG + (size_t)MP * 512 + m * 512 + c8 * 8), c = *(const f16x8*)(OG + (size_t)2 * MP * 512 + m * 512 + c8 * 8);
        f16x8 o;
#pragma unroll
        for (int q = 0; q < 8; ++q) o[q] = (f16)(w0 * (float)a[q] + w1 * (float)b[q] + w2 * (float)c[q]);
        *tiled_ptr<f16x8>(O, (int)m, c8 * 8, 512) = o;
    }
}
__device__ __forceinline__ void phase_final(Frame& F) {
    const f16* X = WSP(f16, WS_X); const float* rss = (const float*)(F.ws + RSS_OFF) + (size_t)12 * MALL; const float* fg = FIN(I_FG);
    for (int m = F.bid * 8 + F.wave; m < MALL; m += F.G * 8) {
        const float r = rsqrtf(rss[m] * (1.0f / D) + EPS);
#pragma unroll
        for (int q = 0; q < 4; ++q) { const int d = q * 256 + F.lane * 4; const f16x4 xh = *(const f16x4*)(X + (size_t)m * D + d); const f32x4 x = {(float)xh[0], (float)xh[1], (float)xh[2], (float)xh[3]}, g = *(const f32x4*)(fg + d);
            *(f32x4*)(F.out + O_Y + (size_t)m * D + d) = x * r * g; }
    }
}

struct Args;
__device__ __forceinline__ bool phase_enter(Frame& F, const Args& args);
#define REP(bit) _Pragma("unroll 1") for (int rep_ = 0; rep_ < ((PROBE_DUP & (bit)) ? 2 : 1); ++rep_)
#ifndef P_MASK
#define P_MASK 0
#endif
constexpr bool P_SK = !(P_MASK & 1), P_MIX = !(P_MASK & 2), P_Z = !(P_MASK & 4), P_RES = !(P_MASK & 8), P_SW = !(P_MASK & 16), P_PR = !(P_MASK & 32), P_E1 = !(P_MASK & 64), P_E3 = !(P_MASK & 128), P_O1 = !(P_MASK & 256);
struct Args { const float* in[N_IN]; float* out; unsigned char* ws; int ph_lo, ph_hi; };
constexpr int PH_LAYER0 = 4, PH_PER_LAYER = 9, PH_FINAL = PH_LAYER0 + 4 * PH_PER_LAYER, N_PHASES = PH_FINAL + 1;

__device__ __forceinline__ bool phase_enter(Frame& F, const Args& args) {
    F.tid = opaque_v(threadIdx.x); F.lane = F.tid & 63; F.wave = __builtin_amdgcn_readfirstlane(F.tid >> 6);
    F.out = opaque_p(args.out); F.ws = opaque_p(args.ws);
    return true;
}
__global__ void __launch_bounds__(512, 2) fwd_kernel(Args args) {
    extern __shared__ __attribute__((aligned(16))) unsigned char lds_raw[];
    Frame F;
    F.lds = (ldsp_t)lds_raw; F.tid = threadIdx.x; F.lane = F.tid & 63; F.wave = __builtin_amdgcn_readfirstlane(F.tid >> 6); F.G = gridDim.x; F.bid = blockIdx.x;
    F.out = args.out; F.ws = args.ws;
    volatile LAS unsigned* MISC = (volatile LAS unsigned*)(F.lds + MISC_OFF);
    if (F.tid < 32) MISC[F.tid] = 0u;
    __syncthreads();
    XcdBarrier bar = xcd_barrier_post((unsigned*)(F.ws + WS_CTL) + CW_BAR, MISC + 8);
    const int lo = args.ph_lo, hi = args.ph_hi;
    const CopyQ CQ{args.in[I_CC3], args.in[I_CC2], args.in[I_CA], args.in[I_CC1], args.out, (unsigned*)(args.ws + WS_CTL) + CW_Q};
#define IN(k) (lo <= (k) && (k) < hi && phase_enter(F, args))
#define SEAM(k) do { if (IN((k) + 1)) { xcd_barrier(bar, CQ); if constexpr ((PROBE_DUP & 64) != 0) xcd_barrier(bar, CQ); } } while (0)
#define LSEAM(k) do { if (IN((k) + 1)) { if (fastp) xcc_barrier(bar, CQ); else xcd_barrier(bar, CQ); } } while (0)
    unsigned fastp = 0u;
    float* rowss = (float*)(F.ws + RSS_OFF);

    _Pragma("unroll 1") for (int prep_ = 0; prep_ < ((PROBE_DUP & 32) ? 2 : 1); ++prep_) {
    if (IN(0)) { REP(1) { if constexpr (P_PR) phase_pr0(F, 24, 28, true, nullptr); } SEAM(0);
        if (MK_N_LAUNCHES == 1 && hi == N_PHASES && MISC[8 + 10] != 0u) { fastp = 1u; F.bid = (int)(MISC[8 + 12] * 8u + bar.x); } }
    if (IN(1)) {
        pg8::Gemm g{WSP(f16, WS_AC), WSP(f16, WS_WMOD), 256, 4 * NMODC, D}; pg8::StaticOrder S; S.init(256, 4 * NMODC, F.G, F.bid);
        EpiMod E{WSP(float, WS_CS), WSP(float, WS_GT), WSP(f16, WS_SHA), FIN(I_BMOD), FIN(I_NG), WSP(float, WS_RCS)};
        if constexpr (P_PR) pg8::gemm_phase<EpiMod, pg8::StaticOrder>(F.lds, g, S, E);
        if constexpr (P_PR) { phase_enter(F, args); phase_pr0(F, 0, 24, false, (unsigned*)(F.ws + WS_CTL) + CW_Q + 128); }
        SEAM(1);
    }
    if (IN(3)) {
        pg8::Gemm g{WSP(f16, WS_SHA), WSP(f16, WS_WIN), 256 * NSITE, NWIN, D}; pg8::DiagOrder S{F.G, F.bid};
        EpiBias E{WSP(float, WS_BW)};
        if constexpr (P_PR) pg8::gemm_phase<EpiBias, pg8::DiagOrder>(F.lds, g, S, E);
        if constexpr (P_PR) { phase_enter(F, args); phase_pr2(F); }
        SEAM(3);
    }
    }
    for (int l = 0; l < 4; ++l) {
        const int pb = PH_LAYER0 + PH_PER_LAYER * l, s0 = 3 * l; const bool even = (l & 1) == 0; const int ei = l >> 1;
#pragma unroll 1
        for (int ffn = 0; ffn < 2; ++ffn) {
            if (ffn == 1) {
                if (IN(pb + 2)) {
                    const int so = site_off(s0 + 1), N = even ? NEV : NOD;
                    pg8::Gemm g{WSP(f16, WS_A), WSP(f16, WS_WIN) + (size_t)so * D, MP, N, D}; pg8::StaticOrder S; S.init(MP, N, F.G, F.bid);
                    if (even) { EpiZ<true> E{rowss + (size_t)(s0 + 1) * MALL, WSP(float, WS_BW) + so, WSP(f16, WS_Z), WSP(float, WS_GATES)};
                        if constexpr (P_Z) pg8::gemm_phase<EpiZ<true>, pg8::StaticOrder>(F.lds, g, S, E);
                        if constexpr ((PROBE_DUP & 128) != 0) { phase_enter(F, args); pg8::gemm_phase<EpiZ<true>, pg8::StaticOrder>(F.lds, g, S, E); }
                        if constexpr (P_SK) skinny_phase<false, D>(F.lds, g.A + (size_t)MP * D, g.Bt, N, E, F.G, F.bid, S.nwg); }
                    else { EpiZ<false> E{rowss + (size_t)(s0 + 1) * MALL, WSP(float, WS_BW) + so, WSP(f16, WS_Z), WSP(float, WS_GATES)};
                        if constexpr (P_Z) pg8::gemm_phase<EpiZ<false>, pg8::StaticOrder>(F.lds, g, S, E);
                        if constexpr ((PROBE_DUP & 128) != 0) { phase_enter(F, args); pg8::gemm_phase<EpiZ<false>, pg8::StaticOrder>(F.lds, g, S, E); }
                        if constexpr (P_SK) skinny_phase<false, D>(F.lds, g.A + (size_t)MP * D, g.Bt, N, E, F.G, F.bid, S.nwg); }
                    SEAM(pb + 2);
                }
                if (IN(pb + 3)) { REP(2) if constexpr (P_MIX) { const int tm = rep_ ? PROBE_TMASK : 31; if (even) { if constexpr (P_E1) phase_e1(F, ei, tm); } else { if constexpr (P_O1) phase_o1(F, ei, tm); } } SEAM(pb + 3); }
                if (IN(pb + 4)) { REP(4096) if constexpr (P_MIX) { if (even) mlstm_scan(F, ei); else phase_o2(F); } SEAM(pb + 4); }
                if (even && IN(pb + 5)) { REP(8192) if constexpr (P_MIX && P_E3) { phase_e3(F, ei); } SEAM(pb + 5); }
                if (IN(pb + 6)) {
                    const int K = even ? D : 512; const f16* Bt = even ? WSP(f16, WS_WEO) + (size_t)ei * D * D : WSP(f16, WS_WOO) + (size_t)ei * D * 512;
                    pg8::Gemm g{WSP(f16, WS_O), Bt, MP, D, K}; pg8::StaticOrder S; S.init(MP, D, F.G, F.bid);
                    EpiRes E{WSP(f16, WS_X), WSP(f16, WS_A), rowss + (size_t)(s0 + 2) * MALL, WSP(float, WS_GT) + (size_t)(s0 + 1) * NBAT * D, WSP(float, WS_CS) + (size_t)(s0 + 2) * NBAT * D, WSP(float, WS_RCS) + (size_t)(s0 + 1) * NBAT * D};
                    if constexpr ((PROBE_DUP & 256) != 0) { EpiRes E2{(f16*)(F.ws + WS_END), (f16*)(F.ws + WS_END + (size_t)MALL * D * 4), (float*)(F.ws + WS_END + (size_t)MALL * D * 6), E.GT, E.CS, E.RCS};
                        pg8::gemm_phase<EpiRes, pg8::StaticOrder>(F.lds, g, S, E2); phase_enter(F, args); }
                    if constexpr (P_RES) pg8::gemm_phase<EpiRes, pg8::StaticOrder>(F.lds, g, S, E);
                    if constexpr (P_SK) { if (even) skinny_phase<false, D>(F.lds, g.A + (size_t)MP * D, g.Bt, D, E, F.G, F.bid, S.nwg); else skinny_phase<false, 512>(F.lds, g.A + (size_t)MP * 512, g.Bt, D, E, F.G, F.bid, S.nwg); }
                    LSEAM(pb + 6);
                }
            }
            const int sf = s0 + 2 * ffn, pin = pb + (ffn ? 7 : 0);
            if (IN(pin)) {
                const int so = site_off(sf);
                pg8::Gemm g{WSP(f16, WS_A), WSP(f16, WS_WIN) + (size_t)so * D, MP, FF2, D}; pg8::StaticOrder S; S.init(MP, FF2, F.G, F.bid);
                EpiSwiglu E{rowss + (size_t)sf * MALL, WSP(float, WS_BW) + so, WSP(f16, WS_H)};
                if constexpr (P_SW) pg8::gemm_phase<EpiSwiglu, pg8::StaticOrder>(F.lds, g, S, E);
                if constexpr ((PROBE_DUP & 4) != 0) { phase_enter(F, args); pg8::gemm_phase<EpiSwiglu, pg8::StaticOrder>(F.lds, g, S, E); }
                REP(8) { if constexpr (P_SK) skinny_phase<true, D>(F.lds, g.A + (size_t)MP * D, g.Bt, FF2, E, F.G, F.bid, S.nwg); }
                LSEAM(pin);
            }
            if (IN(pin + 1)) {
                pg8::Gemm g{WSP(f16, WS_H), WSP(f16, WS_WFO) + (size_t)(2 * l + ffn) * D * FF, MP, D, FF}; pg8::StaticOrder S; S.init(MP, D, F.G, F.bid);
                EpiRes E{WSP(f16, WS_X), WSP(f16, WS_A), rowss + (size_t)(sf + 1) * MALL, WSP(float, WS_GT) + (size_t)sf * NBAT * D, (sf + 1 < NSITE) ? WSP(float, WS_CS) + (size_t)(sf + 1) * NBAT * D : nullptr, WSP(float, WS_RCS) + (size_t)sf * NBAT * D};
                if constexpr ((PROBE_DUP & 16) != 0) { EpiRes E2{(f16*)(F.ws + WS_END), (f16*)(F.ws + WS_END + (size_t)MALL * D * 4), (float*)(F.ws + WS_END + (size_t)MALL * D * 6), E.GT, E.CS, E.RCS};
                    pg8::gemm_phase<EpiRes, pg8::StaticOrder>(F.lds, g, S, E2); phase_enter(F, args); }
                if constexpr (P_RES) pg8::gemm_phase<EpiRes, pg8::StaticOrder>(F.lds, g, S, E);
                if constexpr (P_SK) skinny_phase<false, FF>(F.lds, g.A + (size_t)MP * FF, g.Bt, D, E, F.G, F.bid, S.nwg);
                if (pin + 1 == PH_FINAL - 1) SEAM(pin + 1); else LSEAM(pin + 1);
            }
        }
    }
    if (IN(PH_FINAL)) {
        phase_final(F);
        if constexpr ((PROBE_DUP & 512) != 0) { phase_enter(F, args); phase_final(F); }
        for (;;) {
            __syncthreads();
            if (F.tid == 0) MISC[24] = xb_add(CQ.head, 1u);
            __syncthreads();
            const unsigned ch = MISC[24];
            if (ch >= (unsigned)CQ_N) break;
            copy_chunk(CQ, (int)ch, F.tid);
        }
        if constexpr ((PROBE_DUP & 1024) != 0) {
            CopyQ CQ2 = CQ; CQ2.head = CQ.head + 64;
            for (;;) {
                __syncthreads();
                if (F.tid == 0) MISC[24] = xb_add(CQ2.head, 1u);
                __syncthreads();
                const unsigned ch = MISC[24];
                if (ch >= (unsigned)CQ_N) break;
                copy_chunk(CQ2, (int)ch, F.tid);
            }
        }
    }
#undef IN
#undef SEAM
}

extern "C" void kernel_launch(void* const* d_in, const int* in_sizes, int n_in, void* d_out, int out_size, void* d_ws, size_t ws_size, hipStream_t stream) {
    static int grid = 0;
    if (grid == 0) {
        if (n_in != N_IN || (size_t)out_size != O_END || ws_size < WS_END) { fprintf(stderr, "kernel_launch: unexpected shapes n_in %d out %d ws %zu (need %zu / %zu)\n", n_in, out_size, ws_size, (size_t)O_END, (size_t)WS_END); grid = -1; return; }
        int dev = 0, cus = 0, per_cu = 0;
        if (hipGetDevice(&dev) != hipSuccess || hipDeviceGetAttribute(&cus, hipDeviceAttributeMultiprocessorCount, dev) != hipSuccess) { grid = -1; return; }
        if (hipFuncSetAttribute((const void*)fwd_kernel, hipFuncAttributeMaxDynamicSharedMemorySize, LDS_BYTES) != hipSuccess) { fprintf(stderr, "kernel_launch: hipFuncSetAttribute failed\n"); grid = -1; return; }
        if (hipOccupancyMaxActiveBlocksPerMultiprocessor(&per_cu, (const void*)fwd_kernel, 512, LDS_BYTES) != hipSuccess || per_cu < 1) { fprintf(stderr, "kernel_launch: occupancy query says %d\n", per_cu); }
        (void)hipGetLastError();
        grid = cus;
    }
    if (grid < 0) return;
    (void)hipMemsetAsync((char*)d_ws + WS_CTL, 0, CTL_ZERO_BYTES, stream);
    Args a{};
    for (int i = 0; i < N_IN; ++i) a.in[i] = (const float*)d_in[i];
    a.out = (float*)d_out; a.ws = (unsigned char*)d_ws;
#if MK_N_LAUNCHES == 1
    a.ph_lo = 0; a.ph_hi = N_PHASES;
    hipLaunchKernelGGL(fwd_kernel, dim3(grid), dim3(512), LDS_BYTES, stream, a);
#else
    for (int p = 0; p < N_PHASES; ++p) { a.ph_lo = p; a.ph_hi = p + 1; hipLaunchKernelGGL(fwd_kernel, dim3(grid), dim3(512), LDS_BYTES, stream, a); }
#endif
}
```

```cpp
#include <hip/hip_runtime.h>
#include <cstdio>
#include <cstdint>

#ifndef PROBE_DUP
#define PROBE_DUP 0
#endif
#ifndef PROBE_TMASK
#define PROBE_TMASK 19
#endif
#ifndef MK_N_LAUNCHES
#define MK_N_LAUNCHES 1
#endif

#define GAS __attribute__((address_space(1)))
#define LAS __attribute__((address_space(3)))
typedef _Float16 f16;
typedef _Float16 f16x8 __attribute__((ext_vector_type(8)));
typedef _Float16 f16x4 __attribute__((ext_vector_type(4)));
typedef float f32x4 __attribute__((ext_vector_type(4)));
typedef float f32x16 __attribute__((ext_vector_type(16)));
typedef unsigned u32x4 __attribute__((ext_vector_type(4)));
typedef unsigned u32x2 __attribute__((ext_vector_type(2)));
typedef LAS unsigned char* ldsp_t;

constexpr int D = 1024, T = 8192, NB = 2, MP = NB * T, NS = 128, MALL = MP + NS, NBAT = NB + NS;
constexpr int FF = 2816, FF2 = 5632, NEV = 3072, NEVR = 2832, NOD = 2304, NMODC = 9216;
constexpr int NSITE = 12;
constexpr float EPS = 1e-6f;
__host__ __device__ __forceinline__ constexpr int site_N(int s) { return (s % 3 != 1) ? FF2 : (((s / 3) % 2 == 0) ? NEV : NOD); }
__host__ __device__ __forceinline__ constexpr int site_off(int s) { const int r = s % 6; return (s / 6) * 27904 + (r == 0 ? 0 : r == 1 ? 5632 : r == 2 ? 8704 : r == 3 ? 14336 : r == 4 ? 19968 : 22272); }
static_assert(site_off(1) == 5632 && site_off(2) == 8704 && site_off(3) == 14336 && site_off(4) == 19968 && site_off(5) == 22272 && site_off(6) == 27904 && site_off(7) == 27904 + 5632, "site_off");
constexpr int NWIN = site_off(NSITE);
static_assert(NWIN == 55808, "win rows");

constexpr size_t alignup(size_t x) { return (x + 4095) & ~(size_t)4095; }
constexpr size_t WS_CTL = 0, CTL_ZERO_BYTES = 1u << 20;
constexpr int CW_BAR = 1024;
constexpr size_t RSS_OFF = 65536;
static_assert(RSS_OFF + (size_t)13 * MALL * 4 <= CTL_ZERO_BYTES, "ctl");
constexpr size_t WS_WIN = alignup(CTL_ZERO_BYTES);
constexpr size_t WS_WFO = alignup(WS_WIN + (size_t)NWIN * D * 2);
constexpr size_t WS_WEO = alignup(WS_WFO + (size_t)8 * D * FF * 2);
constexpr size_t WS_WOO = alignup(WS_WEO + (size_t)2 * D * D * 2);
constexpr size_t WS_WMOD = alignup(WS_WOO + (size_t)2 * D * 512 * 2);
constexpr size_t WS_AC = alignup(WS_WMOD + (size_t)4 * NMODC * D * 2);
constexpr size_t WS_MOD = alignup(WS_AC + (size_t)256 * D * 2);
constexpr size_t WS_CS = alignup(WS_MOD + (size_t)NBAT * 4 * NMODC * 4);
constexpr size_t WS_GT = alignup(WS_CS + (size_t)NSITE * NBAT * D * 4);
constexpr size_t WS_RCS = alignup(WS_GT + (size_t)NSITE * NBAT * D * 4);
constexpr size_t WS_SHA = alignup(WS_RCS + (size_t)NSITE * NBAT * D * 4);
constexpr size_t WS_BW = alignup(WS_SHA + (size_t)NSITE * 256 * D * 2);
constexpr size_t WS_X = alignup(WS_BW + (size_t)NBAT * NWIN * 4);
constexpr size_t WS_A = alignup(WS_X + (size_t)MALL * D * 4);
constexpr size_t WS_H = alignup(WS_A + (size_t)MALL * D * 2);
constexpr size_t WS_Z = alignup(WS_H + (size_t)MALL * FF * 2);
constexpr size_t WS_GATES = alignup(WS_Z + (size_t)MALL * NEV * 2);
constexpr size_t WS_O = alignup(WS_GATES + (size_t)MALL * 16 * 4);
constexpr size_t WS_OG = alignup(WS_O + (size_t)MALL * D * 2);
constexpr size_t WS_LSE = alignup(WS_OG + (size_t)3 * MP * 512 * 2);
constexpr size_t WS_DC = alignup(WS_LSE + (size_t)3 * MP * 8 * 4);
constexpr size_t WS_DN = alignup(WS_DC + (size_t)16 * 64 * 4096 * 4);
constexpr size_t WS_CP = alignup(WS_DN + (size_t)16 * 64 * 64 * 4);
constexpr size_t WS_NP = alignup(WS_CP + (size_t)16 * 64 * 4096 * 2);
constexpr size_t WS_SC = alignup(WS_NP + (size_t)16 * 64 * 64 * 4);
constexpr size_t WS_END = alignup(WS_SC + (size_t)3 * 16 * 64 * 4);

constexpr size_t O_Y = 0;
constexpr size_t O_AKVP = O_Y + (size_t)MALL * D;
constexpr size_t O_AKVS = O_AKVP + (size_t)2 * 2 * 128 * 256;
constexpr size_t O_BCP = O_AKVS + (size_t)2 * 128 * 128 * 256;
constexpr size_t O_BCS = O_BCP + (size_t)2 * 2 * 8 * 4096;
constexpr size_t O_BNP = O_BCS + (size_t)2 * 128 * 8 * 4096;
constexpr size_t O_BNS = O_BNP + (size_t)2 * 2 * 8 * 64;
constexpr size_t O_BMP = O_BNS + (size_t)2 * 128 * 8 * 64;
constexpr size_t O_BMS = O_BMP + (size_t)2 * 2 * 8;
constexpr size_t O_C1P = O_BMS + (size_t)2 * 128 * 8;
constexpr size_t O_C1S = O_C1P + (size_t)2 * 2 * 128 * 256;
constexpr size_t O_C2P = O_C1S + (size_t)2 * 128 * 128 * 256;
constexpr size_t O_C2S = O_C2P + (size_t)2 * 2 * 512 * 256;
constexpr size_t O_C3P = O_C2S + (size_t)2 * 128 * 512 * 256;
constexpr size_t O_C3S = O_C3P + (size_t)2 * 2 * 2048 * 256;
constexpr size_t O_END = O_C3S + (size_t)2 * 128 * 2048 * 256;

enum { I_XP = 0, I_XS, I_CA, I_SBC, I_SBN, I_SBM, I_CC1, I_CC2, I_CC3, I_CP, I_CSMP, I_WMOD, I_BMOD, I_NG, I_FWI, I_FWO, I_EWI, I_EBG, I_ESK, I_EHG, I_EWO, I_OWI, I_OWO, I_FG, N_IN };

constexpr int RING_BYTES = 131072;
constexpr int MISC_OFF = RING_BYTES + 320;
constexpr int PF_OFF = 139264;
constexpr int EPI_OFF = 133120, EPI_STRIDE = 4096;
constexpr int LDS_BYTES = 147456;

#define RLX_AGENT __ATOMIC_RELAXED, __HIP_MEMORY_SCOPE_AGENT
#define LDS_WAIT() asm volatile("s_waitcnt lgkmcnt(0)" ::: "memory")
#define VM_WAIT() asm volatile("s_waitcnt vmcnt(0)" ::: "memory")

#define XB_TMO      128
#define XB_XCNT(j)  (256  + 64 * (j))
#define XB_XSUB(j)  (1280 + 64 * (j))
#define XB_XGEN(j)  (2304 + 64 * (j))
#define XB_TOP      3328
#define XB_TOPGEN   3392
#define XB_LSUB(j)  (3456 + 64 * (j))
#define XCD_BAR_WORDS 4480
#define XB_SPIN_CAP (1u << 21)
__device__ __forceinline__ unsigned xb_ld(unsigned* p)              { return __hip_atomic_load(p, __ATOMIC_RELAXED, __HIP_MEMORY_SCOPE_AGENT); }
__device__ __forceinline__ unsigned xb_add(unsigned* p, unsigned v) { return __hip_atomic_fetch_add(p, v, __ATOMIC_RELAXED, __HIP_MEMORY_SCOPE_AGENT); }
__device__ __forceinline__ unsigned xb_xcc_id() { return (unsigned)__builtin_amdgcn_s_getreg((3 << 11) | 20) & 0xFu; }
#define XB_SPIN(cond, bar) do { unsigned _sp = 0; while (cond) { __builtin_amdgcn_s_sleep(1); \
    if ((++_sp & 255u) == 0u) { if (xb_ld(&(bar)[XB_TMO])) break; if (_sp > XB_SPIN_CAP) { atomicAdd(&(bar)[XB_TMO], 1u); break; } } } } while (0)
struct XcdBarrier { unsigned* bar; unsigned x; volatile LAS unsigned* st; };
__device__ __forceinline__ XcdBarrier xcd_barrier_post(unsigned* bar, volatile LAS unsigned* st) {
    XcdBarrier b; b.bar = bar; b.x = xb_xcc_id(); b.st = st;
    if (threadIdx.x == 0) st[12] = xb_add(&bar[XB_XCNT(b.x)], 1u);
    return b;
}
__device__ __forceinline__ void xcd_barrier_complete(unsigned* bar, unsigned x, unsigned& nloc, unsigned& nx) {
    const unsigned G = gridDim.x * gridDim.y * gridDim.z;
    unsigned sum, cnt, mine, sp = 0u;
    for (;;) {
        sum = 0u; cnt = 0u; mine = 0u;
#pragma unroll
        for (unsigned j = 0; j < 16; ++j) { const unsigned c = xb_ld(&bar[XB_XCNT(j)]); sum += c; cnt += (c > 0u) ? 1u : 0u; mine = (j == x) ? c : mine; }
        if (sum == G) break;
        __builtin_amdgcn_s_sleep(1);
        if ((++sp & 255u) == 0u) { if (xb_ld(&bar[XB_TMO])) break; if (sp > XB_SPIN_CAP) { atomicAdd(&bar[XB_TMO], 1u); break; } }
    }
    nloc = mine > 0u ? mine : 1u; nx = cnt > 0u ? cnt : 1u;
}
__device__ __forceinline__ unsigned xcd_census_even(unsigned* bar) {
    const unsigned G = gridDim.x; if (G % 8u) return 0u;
    unsigned ok = 1u;
#pragma unroll
    for (unsigned j = 0; j < 16; ++j) { const unsigned c = xb_ld(&bar[XB_XCNT(j)]); ok &= (c == (j < 8u ? G / 8u : 0u)) ? 1u : 0u; }
    return ok;
}
constexpr int CQ_CH = 4096;
constexpr int CQ_N3 = 2047 * 16384 / CQ_CH, CQ_N2 = 511 * 16384 / CQ_CH, CQ_NA = 127 * 16384 / CQ_CH, CQ_N = CQ_N3 + CQ_N2 + 2 * CQ_NA;
constexpr int CW_Q = 512;
struct CopyQ { const float* c3; const float* c2; const float* ca; const float* c1; float* out; unsigned* head; };
__device__ __forceinline__ void copy_chunk(const CopyQ& Q, int chunk, int tid) {
    const float* in; float* out; int W;
    if (chunk < CQ_N3) { in = Q.c3; out = Q.out + O_C3S; W = 2048; }
    else if (chunk < CQ_N3 + CQ_N2) { chunk -= CQ_N3; in = Q.c2; out = Q.out + O_C2S; W = 512; }
    else if (chunk < CQ_N3 + CQ_N2 + CQ_NA) { chunk -= CQ_N3 + CQ_N2; in = Q.ca; out = Q.out + O_AKVS; W = 128; }
    else { chunk -= CQ_N3 + CQ_N2 + CQ_NA; in = Q.c1; out = Q.out + O_C1S; W = 128; }
    const unsigned wm1 = (unsigned)(W - 1);
    f32x4 v[8]; size_t doff[8];
#pragma unroll
    for (int j = 0; j < 8; ++j) {
        const unsigned i = (unsigned)chunk * CQ_CH + j * 512 + tid, r = i >> 6, es = r / wm1, rr = r - es * wm1;
        const size_t o = ((size_t)es * W + rr) * 256 + (i & 63) * 4; doff[j] = o;
        v[j] = __builtin_nontemporal_load((const f32x4*)(in + o + 256));
    }
#pragma unroll
    for (int j = 0; j < 8; ++j) __builtin_nontemporal_store(v[j], (f32x4*)(out + doff[j]));
}
template <int MODE  >
__device__ __forceinline__ void xb_wait_work(unsigned* bar, unsigned* pw, unsigned same, bool need_wait, volatile LAS unsigned* W, const CopyQ& Q) {
    const int tid = threadIdx.x;
    for (unsigned it = 0;; ++it) {
        const unsigned par = (it & 1u) * 2u;
        if (tid == 0) {
            unsigned rel = need_wait ? 0u : 1u;
            if (!rel) { for (int sp = 0; sp < 12; ++sp) { const unsigned v_ = xb_ld(pw); if (MODE == 0 ? (v_ != same) : (v_ >= same)) { rel = 1u; break; } __builtin_amdgcn_s_sleep(1); } }
            if (!rel && (it & 255u) == 255u) { if (xb_ld(&bar[XB_TMO])) rel = 1u; else if (it > (1u << 16)) { atomicAdd(&bar[XB_TMO], 1u); rel = 1u; } }
            unsigned ch = 0xffffffffu;
            if ((PROBE_DUP & 2048) == 0 && !rel && xb_ld(Q.head) < (unsigned)CQ_N) ch = xb_add(Q.head, 1u);
            W[par] = rel; W[par + 1] = ch;
        }
        __syncthreads();
        const unsigned rel = W[par], ch = W[par + 1];
        if (rel) break;
        if (ch < (unsigned)CQ_N) copy_chunk(Q, (int)ch, tid);
    }
}
__device__ __forceinline__ void xcd_barrier(const XcdBarrier& b, const CopyQ& Q) {
    asm volatile("s_waitcnt vmcnt(0)" ::: "memory");
    __syncthreads();
    unsigned* bar = b.bar;
    volatile LAS unsigned* W = b.st + 4;
    if (threadIdx.x == 0) {
        __builtin_amdgcn_s_waitcnt(0);
        unsigned nloc = b.st[0], nx = b.st[1];
        if (nloc == 0u) { xcd_barrier_complete(bar, b.x, nloc, nx); b.st[0] = nloc; b.st[1] = nx; b.st[10] = xcd_census_even(bar); }
        const unsigned old = xb_add(&bar[XB_XSUB(b.x)], 1u);
        const unsigned gen = old / nloc;
        unsigned role, val;
        if (old + 1u == (gen + 1u) * nloc) {
            __builtin_amdgcn_fence(__ATOMIC_RELEASE, "agent");
            asm volatile("s_waitcnt vmcnt(0)" ::: "memory");
            const unsigned og = xb_add(&bar[XB_TOP], 1u);
            const unsigned tg = og / nx;
            if (og + 1u == (tg + 1u) * nx) { xb_add(&bar[XB_TOPGEN], 1u); role = 2u; val = 0u; }
            else { role = 1u; val = tg; }
        } else { role = 0u; val = gen; }
        b.st[8] = role; b.st[9] = val;
    }
    __syncthreads();
    const unsigned role = b.st[8], val = b.st[9];
    xb_wait_work<0>(bar, role == 1u ? &bar[XB_TOPGEN] : &bar[XB_XGEN(b.x)], val, role != 2u, W, Q);
    if (threadIdx.x == 0) {
        __builtin_amdgcn_fence(__ATOMIC_ACQUIRE, "agent");
        if (role != 0u) xb_add(&bar[XB_XGEN(b.x)], 1u);
        asm volatile("s_waitcnt vmcnt(0)" ::: "memory");
    }
    __syncthreads();
}

__device__ __forceinline__ void xcc_barrier(const XcdBarrier& b, const CopyQ& Q) {
    asm volatile("s_waitcnt vmcnt(0)" ::: "memory");
    __syncthreads();
    unsigned* bar = b.bar;
    if (threadIdx.x == 0) {
        __builtin_amdgcn_s_waitcnt(0);
        const unsigned gen = b.st[11]; b.st[11] = gen + 1u;
        (void)xb_add(&bar[XB_LSUB(b.x)], 1u);
        b.st[9] = (gen + 1u) * b.st[0];
    }
    __syncthreads();
    const unsigned target = b.st[9];
    xb_wait_work<1>(bar, &bar[XB_LSUB(b.x)], target, true, b.st + 4, Q);
    asm volatile("" ::: "memory");
    __syncthreads();
}

__device__ __forceinline__ int opaque_v(int x) { asm volatile("" : "+v"(x)); return x; }
template <class P> __device__ __forceinline__ P* opaque_p(P* p) { asm volatile("" : "+s"(p)); return p; }
__device__ __forceinline__ float wave_sum(float v) {
#pragma unroll
    for (int o = 1; o < 64; o <<= 1) v += __shfl_xor(v, o);
    return v;
}
__device__ __forceinline__ float wave_max(float v) {
#pragma unroll
    for (int o = 1; o < 64; o <<= 1) v = fmaxf(v, __shfl_xor(v, o));
    return v;
}
__device__ __forceinline__ f16x4 cvt4(f32x4 v) { f16x4 r; r[0] = (f16)v[0]; r[1] = (f16)v[1]; r[2] = (f16)v[2]; r[3] = (f16)v[3]; return r; }
__device__ __forceinline__ f16x8 cat4(f16x4 lo, f16x4 hi) { f16x8 a; a[0] = lo[0]; a[1] = lo[1]; a[2] = lo[2]; a[3] = lo[3]; a[4] = hi[0]; a[5] = hi[1]; a[6] = hi[2]; a[7] = hi[3]; return a; }
__device__ __forceinline__ float sigmoidf_(float x) { return __builtin_amdgcn_rcpf(1.0f + __expf(-x)); }
__device__ __forceinline__ float logsigmoidf_(float x) { return fminf(x, 0.f) - log1pf(__expf(-fabsf(x))); }
__device__ __forceinline__ int row_batch(int m) { return m < MP ? (m >> 13) : (NB + m - MP); }

namespace pg8 {
constexpr int BM = 256, BK = 64, HALF = 128, HTB = HALF * BK * 2, STAGE_BYTES = 8 * HTB, NXCD = 8, WGM = 8;
__host__ __device__ __forceinline__ int lds_byte(int r, int c) { const int st = (r >> 4) * 2 + (c >> 5), rr = r & 15, cc = c & 31, ob = rr * 64 + cc * 2; return st * 1024 + (ob ^ (((ob >> 9) & 1) << 5)); }
__host__ __device__ __forceinline__ void stage_rc(int b, int& R, int& C) { const int st = b / 1024, sb = b % 1024, swz = sb ^ (((sb >> 9) & 1) << 5); R = (st >> 1) * 16 + swz / 64; C = (st & 1) * 32 + (swz % 64) / 2; }
struct Unit { int pm, pn; };
struct Gemm { const f16* A; const f16* Bt; int M, N, K; };
struct StaticOrder {
    int nM, nN, nwg, G, c;
    __host__ __device__ void init(int M, int N, int G_, int c_) { nM = M / BM; nN = N / BM; nwg = nM * nN; G = G_; c = c_; }
    __host__ __device__ bool next(int i, Unit& u) const {
        const long L = (long)i * G + c; if (L >= nwg) return false;
        int wgid = (int)L; { const int q = nwg / NXCD, r = nwg % NXCD, xcd = wgid % NXCD, off = wgid / NXCD; wgid = (xcd < r ? xcd * (q + 1) : r * (q + 1) + (xcd - r) * q) + off; }
        const int nig = WGM * nN, gid = wgid / nig, fm = gid * WGM, gsz = (nM - fm) < WGM ? (nM - fm) : WGM;
        u.pm = fm + ((wgid % nig) % gsz); u.pn = (wgid % nig) / gsz; return true;
    }
    __device__ __forceinline__ void a_ready(const Unit&) const {}
    __device__ __forceinline__ void done(const Unit&) const {}
};
struct DiagOrder {
    int G, c;
    __device__ bool next(int i, Unit& u) const {
        const int L = i * G + c; if (L >= NWIN / BM) return false;
        int s = 0, acc = 0;
#pragma unroll
        for (int k = 0; k < NSITE; ++k) { const int n = site_N(k) / BM; if (L >= acc + n) { s = k + 1; } acc += n; }
        u.pm = s; u.pn = L; return true;
    }
    __device__ __forceinline__ void a_ready(const Unit&) const {}
    __device__ __forceinline__ void done(const Unit&) const {}
};

template <class Epi, class Sched, bool ALIGN_EPI = true>
__device__ __forceinline__ void gemm_phase(ldsp_t lds, const Gemm g, const Sched& S, const Epi& E) {
    const int tid = opaque_v(threadIdx.x), wid = __builtin_amdgcn_readfirstlane(tid >> 6), lane = tid & 63, wr = wid >> 2, wc = wid & 3, fr = lane & 15, fq = lane >> 4;
    const int K = g.K, nt = K / BK;
    const int rot = (((S.c & 7) * nt) >> 3) & ~1;
    unsigned voffA[2];
#pragma unroll
    for (int i = 0; i < 2; ++i) voffA[i] = (unsigned)(tid * 16 + i * 8192);
#define voffB voffA
    const size_t kstep = (size_t)(2 * HTB);
    const size_t hstep = (size_t)HTB;
    const size_t tstep = (size_t)nt * kstep;
    const unsigned ldsw = (unsigned)wid * 1024u;
    const int aoff = lds_byte(wr * 64 + fr, fq * 8), boff = lds_byte(wc * 32 + fr, fq * 8);
#define PG8_SA(b, h) (((b) * 2 + (h)) * HTB)
#define PG8_SB(b, h) ((4 + (b) * 2 + (h)) * HTB)
#define PG8_STAGE_X(bufoff, gbase, voff, AUX) do { _Pragma("unroll") for (int _i = 0; _i < 2; ++_i) \
        __builtin_amdgcn_global_load_lds((const unsigned*)((const char*)(gbase) + (voff)[_i]), (LAS unsigned*)(lds + (bufoff) + ldsw + _i * 8192), 16, 0, AUX); } while (0)
#define PG8_STAGE(bufoff, gbase, voff) PG8_STAGE_X(bufoff, gbase, voff, 0)
#define PG8_STAGEA(bufoff, gbase, voff) PG8_STAGE_X(bufoff, gbase, voff, 16)
#define PG8_LDA(dst, b, h) do { _Pragma("unroll") for (int m = 0; m < 4; ++m) _Pragma("unroll") for (int k = 0; k < 2; ++k) dst[m][k] = *(const LAS f16x8*)(lds + PG8_SA(b, h) + aoff + m * 2048 + k * 1024); } while (0)
#define PG8_LDB(dst, b, h) do { _Pragma("unroll") for (int n = 0; n < 2; ++n) _Pragma("unroll") for (int k = 0; k < 2; ++k) dst[n][k] = *(const LAS f16x8*)(lds + PG8_SB(b, h) + boff + n * 2048 + k * 1024); } while (0)
#define PG8_MMA(ai, bj, At, Bt) do { __builtin_amdgcn_s_setprio(1); _Pragma("unroll") for (int m = 0; m < 4; ++m) _Pragma("unroll") for (int n = 0; n < 2; ++n) _Pragma("unroll") for (int k = 0; k < 2; ++k) \
        acc[ai][bj][m][n] = __builtin_amdgcn_mfma_f32_16x16x32_f16(Bt[n][k], At[m][k], acc[ai][bj][m][n], 0, 0, 0); __builtin_amdgcn_s_setprio(0); } while (0)
#define PG8_WAIT_V(n) asm volatile("s_waitcnt vmcnt(" #n ")" ::: "memory")
#define PG8_WAIT_L(n) asm volatile("s_waitcnt lgkmcnt(" #n ")" ::: "memory")
#define PG8_BAR __builtin_amdgcn_s_barrier()
#define PG8_SCHED __builtin_amdgcn_sched_barrier(0)
    Unit cur, nxt; int ui = 0;
    if (!S.next(0, cur)) return;
    f32x4 acc[2][2][4][2];
#pragma unroll
    for (int a = 0; a < 2; ++a)
#pragma unroll
        for (int b = 0; b < 2; ++b)
#pragma unroll
            for (int m = 0; m < 4; ++m)
#pragma unroll
                for (int n = 0; n < 2; ++n) acc[a][b][m][n] = (f32x4){0.f, 0.f, 0.f, 0.f};
    f16x8 At[4][2], B0[2][2], B1[2][2];
    const char* cA = (const char*)g.A + (size_t)cur.pm * tstep; const char* cB = (const char*)g.Bt + (size_t)cur.pn * tstep;
    S.a_ready(cur);
    const size_t rstep = (size_t)rot * kstep;
    PG8_STAGE(PG8_SB(0, 0), cB + rstep, voffB); PG8_STAGE(PG8_SB(0, 1), cB + rstep + hstep, voffB); PG8_STAGEA(PG8_SA(0, 0), cA + rstep, voffA); PG8_STAGEA(PG8_SA(0, 1), cA + rstep + hstep, voffA);
    if (wr == 1) PG8_BAR;
    PG8_WAIT_V(2); PG8_BAR;
    PG8_STAGE(PG8_SB(1, 0), cB + rstep + kstep, voffB); PG8_STAGEA(PG8_SA(1, 0), cA + rstep + kstep, voffA); PG8_STAGE(PG8_SB(1, 1), cB + rstep + hstep + kstep, voffB);
    PG8_WAIT_V(6); PG8_BAR;
    if constexpr (Epi::HAS_PRE) E.pre(cur, (LAS float*)(lds + EPI_OFF), wid, opaque_v(lane));
    for (;;) {
        const bool has_next = S.next(ui + 1, nxt);
        const char* nA = has_next ? (const char*)g.A + (size_t)nxt.pm * tstep : cA; const char* nB = has_next ? (const char*)g.Bt + (size_t)nxt.pn * tstep : cB;
        for (int t = 0; t < nt; t += 2) {
            const bool last = (t == nt - 2);
            int t1 = t + 1 + rot, t2 = t + 2 + rot; t1 -= (t1 >= nt) ? nt : 0; t2 -= (t2 >= nt) ? nt : 0;
            const char* a1 = cA + (size_t)t1 * kstep;
            const size_t nxoff = has_next ? rstep : (size_t)((nt - 2 + rot) % nt) * kstep;
            const char* a2 = last ? nA + nxoff : cA + (size_t)t2 * kstep; const char* b2 = last ? nB + nxoff : cB + (size_t)t2 * kstep;
            const char* a3 = a2 + kstep; const char* b3 = b2 + kstep;
            if (last && has_next) S.a_ready(nxt);
            PG8_LDB(B0, 0, 0); PG8_LDB(B1, 0, 1); PG8_SCHED; PG8_LDA(At, 0, 0); PG8_STAGEA(PG8_SA(1, 1), a1 + hstep, voffA);
            PG8_WAIT_V(8); PG8_WAIT_L(0); PG8_BAR; PG8_MMA(0, 0, At, B0); PG8_MMA(0, 1, At, B1); PG8_BAR; PG8_SCHED;
            PG8_LDA(At, 0, 1); PG8_STAGE(PG8_SB(0, 0), b2, voffB); PG8_STAGE(PG8_SB(0, 1), b2 + hstep, voffB); PG8_STAGEA(PG8_SA(0, 0), a2, voffA);
            PG8_WAIT_V(8); PG8_WAIT_L(0); PG8_BAR; PG8_MMA(1, 0, At, B0); PG8_MMA(1, 1, At, B1); PG8_BAR; PG8_SCHED;
            PG8_LDB(B0, 1, 0); PG8_LDB(B1, 1, 1); PG8_SCHED; PG8_LDA(At, 1, 0); PG8_STAGEA(PG8_SA(0, 1), a2 + hstep, voffA);
            PG8_WAIT_V(8); PG8_WAIT_L(0); PG8_BAR; PG8_MMA(0, 0, At, B0); PG8_MMA(0, 1, At, B1); PG8_BAR; PG8_SCHED;
            PG8_LDA(At, 1, 1); PG8_STAGE(PG8_SB(1, 0), b3, voffB); PG8_STAGE(PG8_SB(1, 1), b3 + hstep, voffB); PG8_STAGEA(PG8_SA(1, 0), a3, voffA);
            PG8_WAIT_V(8); PG8_WAIT_L(0); PG8_BAR; PG8_MMA(1, 0, At, B0); PG8_MMA(1, 1, At, B1); PG8_BAR; PG8_SCHED;
        }
        if constexpr (ALIGN_EPI) { if (wr == 0) PG8_BAR; }
        E(acc, cur, wr, wc, fr, fq, (const LAS float*)(lds + EPI_OFF + (ui & 1) * EPI_STRIDE)); S.done(cur);
        if (!has_next) break;
#pragma unroll
        for (int a = 0; a < 2; ++a)
#pragma unroll
            for (int b = 0; b < 2; ++b)
#pragma unroll
                for (int m = 0; m < 4; ++m)
#pragma unroll
                    for (int n = 0; n < 2; ++n) acc[a][b][m][n] = (f32x4){0.f, 0.f, 0.f, 0.f};
        cur = nxt; cA = nA; cB = nB; ++ui;
        if constexpr (Epi::HAS_PRE) E.pre(cur, (LAS float*)(lds + EPI_OFF + (ui & 1) * EPI_STRIDE), wid, opaque_v(lane));
        if constexpr (ALIGN_EPI) { if (wr == 1) PG8_BAR; }
    }
    PG8_WAIT_V(0);
    if constexpr (!ALIGN_EPI) { if (wr == 0) PG8_BAR; }
    PG8_BAR;
#undef PG8_SA
#undef PG8_SB
#undef PG8_STAGE
#undef voffB
#undef PG8_STAGEA
#undef PG8_STAGE_X
#undef PG8_LDA
#undef PG8_LDB
#undef PG8_MMA
#undef PG8_WAIT_V
#undef PG8_WAIT_L
#undef PG8_BAR
#undef PG8_SCHED
}
}
__host__ __device__ __forceinline__ size_t tiled_byte(int row, int col, int K) {
    return ((size_t)((row >> 8) * (K >> 6) + (col >> 6)) * 2 + ((row >> 7) & 1)) * 16384 + (size_t)pg8::lds_byte(row & 127, col & 63);
}
template <class V> __device__ __forceinline__ V* tiled_ptr(f16* base, int row, int col, int K) { return (V*)((char*)base + tiled_byte(row, col, K)); }

using pg8::Unit;
struct EpiSwiglu {
    static constexpr bool HAS_PRE = true;
    const float* rowss; const float* BW; f16* H;
    __device__ __forceinline__ void pre(const Unit& u, LAS float* ev, int wid, int lane) const {
        const int i = (wid & 3) * 64 + lane;
        const float* src = (wid < 4) ? rowss + u.pm * 256 + i : BW + (size_t)(u.pm >> 5) * NWIN + u.pn * 256 + i;
        __builtin_amdgcn_global_load_lds((const unsigned*)src, (LAS unsigned*)(ev + (wid < 4 ? 0 : 256) + (wid & 3) * 64), 4, 0, 0);
    }
    __device__ __forceinline__ static f16x4 act(f32x4 g, f32x4 u, float r, f32x4 bg, f32x4 bu) {
        f32x4 o;
#pragma unroll
        for (int e = 0; e < 4; ++e) { const float gg = g[e] * r + bg[e], uu = u[e] * r + bu[e]; o[e] = gg * uu * __builtin_amdgcn_rcpf(1.0f + __expf(-gg)); }
        return cvt4(o);
    }
    __device__ __forceinline__ void operator()(const f32x4 (&acc)[2][2][4][2], const Unit& u, int wr, int wc, int fr_in, int fq_in, const LAS float* ev) const {
        const int fr = opaque_v(fr_in), fq = opaque_v(fq_in);
        f32x4 bg[2], bu[2];
#pragma unroll
        for (int bj = 0; bj < 2; ++bj) { const int cg = 256 + bj * 128 + wc * 32 + 4 * fq; bg[bj] = *(const LAS f32x4*)(ev + cg); bu[bj] = *(const LAS f32x4*)(ev + cg + 16); }
        char* hb = (char*)H + (size_t)(u.pm * (FF / 64) + 2 * u.pn + (wc >> 1)) * 32768 + (size_t)(8 * wr + (wc & 1)) * 1024;
        const unsigned lo = (unsigned)(fr * 64 + ((16 * fq) ^ (32 * (fr >> 3))));
#pragma unroll
        for (int ai = 0; ai < 2; ++ai)
#pragma unroll
            for (int m = 0; m < 4; ++m) {
                const float r = rsqrtf(ev[ai * 128 + wr * 64 + m * 16 + fr] * (1.0f / D) + EPS);
                const f16x4 h0 = act(acc[ai][0][m][0], acc[ai][0][m][1], r, bg[0], bu[0]), h1 = act(acc[ai][1][m][0], acc[ai][1][m][1], r, bg[1], bu[1]);
                *(f16x8*)(hb + lo + (ai * 16384 + m * 2048)) = cat4(h0, h1);
            }
    }
    __device__ __forceinline__ void sk(int row, int q32, int e4, f32x4 g, f32x4 u) const {
        const int b = row_batch(row); const float* bias = BW + (size_t)b * NWIN + q32 * 32 + e4;
        const float r = rsqrtf(rowss[row] * (1.0f / D) + EPS);
        *(f16x4*)(H + (size_t)row * FF + 128 * (q32 >> 3) + 32 * (q32 & 3) + 2 * e4 + 4 * ((q32 >> 2) & 1)) = act(g, u, r, *(const f32x4*)bias, *(const f32x4*)(bias + 16));
    }
};
struct EpiRes {
    static constexpr bool HAS_PRE = true;
    f16* X; f16* A; float* rowss_next; const float* GT; const float* CS; const float* RCS;
    __device__ __forceinline__ void pre(const Unit& u, LAS float* ev, int wid, int lane) const {
        const int i = (wid & 3) * 64 + lane; const size_t o = (size_t)(u.pm >> 5) * D + u.pn * 256 + i;
        if (wid < 4) { __builtin_amdgcn_global_load_lds((const unsigned*)(GT + o), (LAS unsigned*)(ev + (wid & 3) * 64), 4, 0, 0);
                       __builtin_amdgcn_global_load_lds((const unsigned*)(RCS + o), (LAS unsigned*)(ev + 512 + (wid & 3) * 64), 4, 0, 0); }
        else if (CS) __builtin_amdgcn_global_load_lds((const unsigned*)(CS + o), (LAS unsigned*)(ev + 256 + (wid & 3) * 64), 4, 0, 0);
    }
    __device__ __forceinline__ void operator()(const f32x4 (&acc)[2][2][4][2], const Unit& u, int wr, int wc, int fr_in, int fq_in, const LAS float* ev) const {
        const int fr = opaque_v(fr_in), fq = opaque_v(fq_in);
        const int col0 = u.pn * 256 + wc * 32 + 8 * fq;
        const LAS float* gt = ev + wc * 32 + 8 * fq; const LAS float* cs = ev + 256 + wc * 32 + 8 * fq; const LAS float* rc = ev + 512 + wc * 32 + 8 * fq;
        char* ab = (char*)A + (size_t)(u.pm * (D / 64) + 4 * u.pn + (wc >> 1)) * 32768 + (size_t)(8 * wr + (wc & 1)) * 1024;
        const unsigned lo = (unsigned)(fr * 64 + ((16 * fq) ^ (32 * (fr >> 3))));
        const bool lastsite = (CS == nullptr);
        f32x4 gv[2][2], rv[2][2], cv[2][2];
#pragma unroll
        for (int bj = 0; bj < 2; ++bj)
#pragma unroll
            for (int n = 0; n < 2; ++n) { gv[bj][n] = *(const LAS f32x4*)(gt + bj * 128 + 4 * n); rv[bj][n] = *(const LAS f32x4*)(rc + bj * 128 + 4 * n); cv[bj][n] = *(const LAS f32x4*)(cs + bj * 128 + 4 * n); }
#pragma unroll
        for (int ai = 0; ai < 2; ++ai)
#pragma unroll
            for (int m = 0; m < 4; ++m) {
                const int row = u.pm * 256 + ai * 128 + wr * 64 + m * 16 + fr;
                float ss = 0.f;
#pragma unroll
                for (int bj = 0; bj < 2; ++bj) {
                    const int off = bj * 128;
                    f16x8* ap = (f16x8*)(ab + lo + (bj * 65536 + ai * 16384 + m * 2048));
                    const f16x8 ah = *ap;
                    f16x4 ao[2];
#pragma unroll
                    for (int n = 0; n < 2; ++n) {
                        f32x4 x = {(float)ah[4 * n], (float)ah[4 * n + 1], (float)ah[4 * n + 2], (float)ah[4 * n + 3]}; x = x * rv[bj][n] + gv[bj][n] * acc[ai][bj][m][n];
                        ss += (x[0] * x[0] + x[1] * x[1]) + (x[2] * x[2] + x[3] * x[3]);
                        ao[n] = cvt4(lastsite ? x : x * cv[bj][n]);
                    }
                    if (lastsite) *(f16x8*)(X + (size_t)row * D + col0 + off) = cat4(ao[0], ao[1]);
                    else *ap = cat4(ao[0], ao[1]);
                }
                ss += __shfl_xor(ss, 16); ss += __shfl_xor(ss, 32);
                if (fq == 0) atomicAdd(rowss_next + row, ss);
            }
    }
    __device__ __forceinline__ static int slot2col(int slot) { return (slot & ~31) + 8 * ((slot & 15) >> 2) + 4 * ((slot >> 4) & 1); }
    __device__ __forceinline__ void sk(int row, int slot, f32x4 v) const {
        const int col = slot2col(slot);
        const int b = row_batch(row);
        const f32x4 g4 = *(const f32x4*)(GT + (size_t)b * D + col), r4 = *(const f32x4*)(RCS + (size_t)b * D + col);
        f16* ar = A + (size_t)row * D + col; const f16x4 ah = *(const f16x4*)ar;
        f32x4 x = {(float)ah[0], (float)ah[1], (float)ah[2], (float)ah[3]}; x = x * r4 + g4 * v;
        if (CS) *(f16x4*)ar = cvt4(x * *(const f32x4*)(CS + (size_t)b * D + col));
        else *(f16x4*)(X + (size_t)row * D + col) = cvt4(x);
        atomicAdd(rowss_next + row, (x[0] * x[0] + x[1] * x[1]) + (x[2] * x[2] + x[3] * x[3]));
    }
};
template <bool EVEN> struct EpiZ {
    static constexpr bool HAS_PRE = true;
    const float* rowss; const float* BW; f16* Z; float* GATES;
    __device__ __forceinline__ void pre(const Unit& u, LAS float* ev, int wid, int lane) const {
        const int i = (wid & 3) * 64 + lane;
        const float* src = (wid < 4) ? rowss + u.pm * 256 + i : BW + (size_t)(u.pm >> 5) * NWIN + u.pn * 256 + i;
        __builtin_amdgcn_global_load_lds((const unsigned*)src, (LAS unsigned*)(ev + (wid < 4 ? 0 : 256) + (wid & 3) * 64), 4, 0, 0);
    }
    static constexpr int LDZ = EVEN ? NEV : NOD;
    __device__ __forceinline__ void put(int row, int col, f32x4 z) const {
        if (EVEN) {
            if (col < 2816) { if (col >= 1280 && col < 1792) z = z * 0.125f; *(f16x4*)(Z + (size_t)row * LDZ + col) = cvt4(z); }
            else if (col < NEVR) *(f32x4*)(GATES + (size_t)row * 16 + (col - 2816)) = z;
        } else *(f16x4*)(Z + (size_t)row * LDZ + col) = cvt4(z);
    }
    __device__ __forceinline__ void put8(int row, int col, f32x4 z0, f32x4 z1) const {
        if (EVEN) {
            if (col < 2816) { if (col >= 1280 && col < 1792) { z0 = z0 * 0.125f; z1 = z1 * 0.125f; } *(f16x8*)(Z + (size_t)row * LDZ + col) = cat4(cvt4(z0), cvt4(z1)); }
            else if (col < NEVR) { float* gp = GATES + (size_t)row * 16 + (col - 2816); *(f32x4*)gp = z0; *(f32x4*)(gp + 4) = z1; }
        } else *(f16x8*)(Z + (size_t)row * LDZ + col) = cat4(cvt4(z0), cvt4(z1));
    }
    __device__ __forceinline__ static int slot2col(int slot) { return (slot & ~31) + 8 * ((slot & 15) >> 2) + 4 * ((slot >> 4) & 1); }
    __device__ __forceinline__ void operator()(const f32x4 (&acc)[2][2][4][2], const Unit& u, int wr, int wc, int fr_in, int fq_in, const LAS float* ev) const {
        const int fr = opaque_v(fr_in), fq = opaque_v(fq_in);
        const int col0 = u.pn * 256 + wc * 32 + 8 * fq;
        f32x4 bv[2][2];
#pragma unroll
        for (int bj = 0; bj < 2; ++bj)
#pragma unroll
            for (int n = 0; n < 2; ++n) bv[bj][n] = *(const LAS f32x4*)(ev + 256 + wc * 32 + 4 * fq + bj * 128 + n * 16);
#pragma unroll
        for (int ai = 0; ai < 2; ++ai)
#pragma unroll
            for (int m = 0; m < 4; ++m) {
                const int row = u.pm * 256 + ai * 128 + wr * 64 + m * 16 + fr;
                const float r = rsqrtf(ev[ai * 128 + wr * 64 + m * 16 + fr] * (1.0f / D) + EPS);
#pragma unroll
                for (int bj = 0; bj < 2; ++bj) put8(row, col0 + bj * 128, acc[ai][bj][m][0] * r + bv[bj][0], acc[ai][bj][m][1] * r + bv[bj][1]);
            }
    }
    __device__ __forceinline__ void sk(int row, int slot, f32x4 v) const {
        const int b = row_batch(row); const float r = rsqrtf(rowss[row] * (1.0f / D) + EPS);
        put(row, slot2col(slot), v * r + *(const f32x4*)(BW + (size_t)b * NWIN + slot));
    }
};
struct EpiMod {
    static constexpr bool HAS_PRE = false;
    float* CS; float* GT; f16* SHA; const float* bmod; const float* NG; float* RCS;
    __device__ __forceinline__ void operator()(const f32x4 (&acc)[2][2][4][2], const Unit& u, int wr, int wc, int fr_in, int fq_in, const LAS float* ev) const {
        const int fr = opaque_v(fr_in), fq = opaque_v(fq_in);
        const int cu = u.pn * 256, l = cu / NMODC, jj = (cu - l * NMODC) >> 10, j = jj / 3, kind = jj - 3 * j, s = 3 * l + j;
        const int d0 = (cu & 1023) + wc * 32 + 4 * fq;
#pragma unroll
        for (int ai = 0; ai < 2; ++ai)
#pragma unroll
            for (int m = 0; m < 4; ++m) {
                const int row = ai * 128 + wr * 64 + m * 16 + fr;
#pragma unroll
                for (int bj = 0; bj < 2; ++bj)
#pragma unroll
                    for (int n = 0; n < 2; ++n) {
                        const int d = d0 + bj * 128 + n * 16;
                        const f32x4 v = acc[ai][bj][m][n] + *(const f32x4*)(bmod + cu - (cu & 1023) + d);
                        if (kind == 0) *tiled_ptr<f16x4>(SHA, s * 256 + row, d, D) = row < NBAT ? cvt4(v) : (f16x4){0, 0, 0, 0};
                        else if (row < NBAT) {
                            if (kind == 1) { const f32x4 c4 = *(const f32x4*)(NG + (l * 3 + j) * D + d) * (v + 1.0f); *(f32x4*)(CS + ((size_t)s * NBAT + row) * D + d) = c4;
                                *(f32x4*)(RCS + ((size_t)s * NBAT + row) * D + d) = (f32x4){1.0f / c4[0], 1.0f / c4[1], 1.0f / c4[2], 1.0f / c4[3]}; }
                            else *(f32x4*)(GT + ((size_t)s * NBAT + row) * D + d) = v * (j == 1 ? 1.0f : 0.5f);
                        }
                    }
            }
    }
};
struct EpiBias {
    static constexpr bool HAS_PRE = false;
    float* BW;
    __device__ __forceinline__ void operator()(const f32x4 (&acc)[2][2][4][2], const Unit& u, int wr, int wc, int fr_in, int fq_in, const LAS float* ev) const {
        const int fr = opaque_v(fr_in), fq = opaque_v(fq_in);
        const int col0 = u.pn * 256 + wc * 32 + 4 * fq;
#pragma unroll
        for (int ai = 0; ai < 2; ++ai)
#pragma unroll
            for (int m = 0; m < 4; ++m) {
                const int row = ai * 128 + wr * 64 + m * 16 + fr;
                if (row < NBAT) {
#pragma unroll
                    for (int bj = 0; bj < 2; ++bj)
#pragma unroll
                        for (int n = 0; n < 2; ++n) *(f32x4*)(BW + (size_t)row * NWIN + col0 + bj * 128 + n * 16) = acc[ai][bj][m][n];
                }
            }
    }
};

template <bool SWIGLU, int K, class Epi>
__device__ __forceinline__ void skinny_phase(ldsp_t lds, const f16* A, const f16* Bt, int N, const Epi& E, int G, int c, int nunits) {
    const int tid = opaque_v(threadIdx.x), wid = __builtin_amdgcn_readfirstlane(tid >> 6), lane = tid & 63, fr = lane & 15, fq = lane >> 4;
    const int grp = c & 7, rem = nunits % G, r0 = (rem + 7 - grp) >> 3;
    int r = (c >> 3) - r0, nr = ((G - grp + 7) >> 3) - r0;
    if (r < 0 || nr <= 0) { if (nr > 0) return; r = c >> 3; nr = (G - grp + 7) >> 3; }
    constexpr int AS = K + 8;
    constexpr int KS = (!SWIGLU && K > 2048) ? 4 : 1;
    LAS f16* As = (LAS f16*)lds;
    LAS float* red = (LAS float*)(lds + 16 * AS * 2);
    const f16* Ag = A + (size_t)(16 * grp) * K;
    for (int i = tid; i < 16 * (K / 8); i += 512) { const int row = i / (K / 8), ch = i - row * (K / 8);
        const unsigned long long* gp = (const unsigned long long*)(Ag + (size_t)row * K + 8 * ch);
        const unsigned long long lo = __hip_atomic_load(gp, __ATOMIC_RELAXED, __HIP_MEMORY_SCOPE_AGENT), hi = __hip_atomic_load(gp + 1, __ATOMIC_RELAXED, __HIP_MEMORY_SCOPE_AGENT);
        LAS unsigned long long* lp = (LAS unsigned long long*)(As + row * AS + 8 * ch); lp[0] = lo; lp[1] = hi; }
    __syncthreads();
    const int nitem = SWIGLU ? N / 32 : N / 16;
    const LAS f16* ap = As + fr * AS + 8 * fq;
    const int wq = wid / KS, kq = wid - wq * KS, nwq = 8 / KS;
    constexpr int KSTEPS = K / 32 / KS;
    for (int t0 = 0; t0 < nitem; t0 += nwq * nr) {
        const int t = t0 + wq * nr + r; const bool on = t < nitem;
        const int n0 = SWIGLU ? 32 * t : 16 * t;
        f32x4 acc0 = {0.f, 0.f, 0.f, 0.f}, acc1 = {0.f, 0.f, 0.f, 0.f};
        if (on) {
            const char* bp = (const char*)Bt + tiled_byte(n0 + fr, 8 * fq, K);
            const LAS f16* apk = ap + 32 * KSTEPS * kq;
#pragma unroll 8
            for (int ks = 0; ks < KSTEPS; ++ks) {
                const int kg = KSTEPS * kq + ks; const size_t ko = (size_t)(kg >> 1) * 32768 + (size_t)(kg & 1) * 1024;
                const f16x8 a = *(const LAS f16x8*)(apk + 32 * ks);
                const f16x8 b0 = *(const f16x8*)(bp + ko);
                acc0 = __builtin_amdgcn_mfma_f32_16x16x32_f16(b0, a, acc0, 0, 0, 0);
                if constexpr (SWIGLU) { const f16x8 b1 = *(const f16x8*)(bp + ko + 2048); acc1 = __builtin_amdgcn_mfma_f32_16x16x32_f16(b1, a, acc1, 0, 0, 0); }
            }
        }
        if constexpr (KS > 1) {
            *(LAS f32x4*)(red + (wid * 64 + lane) * 4) = acc0;
            __syncthreads();
            if (kq == 0) {
#pragma unroll
                for (int j = 1; j < KS; ++j) acc0 = acc0 + *(const LAS f32x4*)(red + ((wid + j) * 64 + lane) * 4);
            }
            __syncthreads();
        }
        const int row = MP + 16 * grp + fr;
        if (on && kq == 0) {
            if constexpr (SWIGLU) E.sk(row, t, 4 * fq, acc0, acc1);
            else E.sk(row, n0 + 4 * fq, acc0);
        }
    }
    __syncthreads();
}

struct Frame {
    ldsp_t lds; int tid, lane, wave, G, bid;
    float* out; unsigned char* ws;
};
#define FIN(i) (((const float* const __attribute__((address_space(4)))*)__builtin_amdgcn_kernarg_segment_ptr())[i])
#define WSP(T_, off) ((T_*)(F.ws + (off)))

__device__ __forceinline__ void tr_item(const float* W, int K, int Nsrc, int Ndst, int perm, f16* WT, LAS float* scr, int item, int lane) {
    const int nblk = Ndst / 64, kb = item / nblk, nb64 = item - kb * nblk, k0 = 32 * kb, n0 = 64 * nb64;
    const int kr = lane >> 4, c16 = lane & 15, nb = 2 * nb64 + (c16 >> 3), c4 = c16 & 7;
    int sc = 32 * nb + 4 * c4;
    if (perm == 2) sc = 32 * nb + 8 * (c4 & 3) + 4 * (c4 >> 2);
    else if (perm == 1) sc = (c4 >> 2) * FF + 128 * (nb64 >> 2) + 32 * (nb64 & 3) + 8 * (c4 & 3) + 4 * (c16 >> 3);
    const bool ok = sc < Nsrc;
    f32x4 v[8];
#pragma unroll
    for (int i = 0; i < 8; ++i) v[i] = ok ? __builtin_nontemporal_load((const f32x4*)(W + (size_t)(k0 + 4 * i + kr) * Nsrc + sc)) : (f32x4){0.f, 0.f, 0.f, 0.f};
#pragma unroll
    for (int i = 0; i < 8; ++i) { LAS float* d = scr + (4 * i + kr) * 65 + 4 * c16; d[0] = v[i][0]; d[1] = v[i][1]; d[2] = v[i][2]; d[3] = v[i][3]; }
    LDS_WAIT(); asm volatile("" ::: "memory");
    const int c = lane & 3;
#pragma unroll
    for (int j = 0; j < 4; ++j) { const int n = (lane >> 2) + 16 * j; const LAS float* sp = scr + (8 * c) * 65 + n;
        f16x8 o;
#pragma unroll
        for (int e = 0; e < 8; ++e) o[e] = (f16)sp[e * 65];
        const int row = perm == 1 ? 256 * (nb64 >> 2) + 128 * (n >> 5) + 32 * (nb64 & 3) + (n & 31) : n0 + n;
        *tiled_ptr<f16x8>(WT, row, k0 + 8 * c, K) = o; }
    LDS_WAIT(); asm volatile("" ::: "memory");
}
struct MatDesc { const float* src; int K, Nsrc, Ndst, perm; f16* dst; };
__device__ __forceinline__ void mat_desc(Frame& F, int mi, MatDesc& d) {
    if (mi < 8) { const int l = mi >> 1, i = mi & 1; d = {FIN(I_FWI) + (size_t)mi * D * FF2, D, FF2, FF2, 1, WSP(f16, WS_WIN) + (size_t)site_off(3 * l + 2 * i) * D}; }
    else if (mi < 10) { const int e = mi - 8; d = {FIN(I_EWI) + (size_t)e * D * NEVR, D, NEVR, NEV, 2, WSP(f16, WS_WIN) + (size_t)site_off(6 * e + 1) * D}; }
    else if (mi < 12) { const int o = mi - 10; d = {FIN(I_OWI) + (size_t)o * D * NOD, D, NOD, NOD, 2, WSP(f16, WS_WIN) + (size_t)site_off(6 * o + 4) * D}; }
    else if (mi < 20) { const int k = mi - 12; d = {FIN(I_FWO) + (size_t)k * FF * D, FF, D, D, 2, WSP(f16, WS_WFO) + (size_t)k * D * FF}; }
    else if (mi < 22) { const int e = mi - 20; d = {FIN(I_EWO) + (size_t)e * D * D, D, D, D, 2, WSP(f16, WS_WEO) + (size_t)e * D * D}; }
    else if (mi < 24) { const int o = mi - 22; d = {FIN(I_OWO) + (size_t)o * 512 * D, 512, D, D, 2, WSP(f16, WS_WOO) + (size_t)o * D * 512}; }
    else { const int l = mi - 24; d = {FIN(I_WMOD) + (size_t)l * D * NMODC, D, NMODC, NMODC, 0, WSP(f16, WS_WMOD) + (size_t)l * NMODC * D}; }
}
__device__ __forceinline__ void cache_shift(const float* in, float* out, int W, size_t gtid, size_t gstride) {
    const size_t per = (size_t)(W - 1) * 64, total = per * 256;
    for (size_t i = gtid; i < total; i += gstride) {
        const size_t es = i / per, off = i - es * per;
        const f32x4 v = __builtin_nontemporal_load((const f32x4*)(in + es * (size_t)W * 256 + 256) + off);
        __builtin_nontemporal_store(v, (f32x4*)(out + es * (size_t)W * 256) + off);
    }
}
__device__ __forceinline__ void phase_pr0(Frame& F, int mlo, int mhi, bool do_ac, unsigned* ctr) {
    LAS float* scr = (LAS float*)(F.lds + F.wave * 16384);
    const int gw = F.bid * 8 + F.wave, NGW = F.G * 8;
    if (ctr) {
        int total = 0;
        for (int mi = mlo; mi < mhi; ++mi) { MatDesc d; mat_desc(F, mi, d); total += (d.K / 64) * (d.Ndst / 32); }
        for (;;) {
            unsigned g0 = 0; if (F.lane == 0) g0 = xb_add(ctr, 4u);
            g0 = (unsigned)__builtin_amdgcn_readfirstlane((int)g0);
            if ((int)g0 >= total) break;
            for (int j = 0; j < 4 && (int)g0 + j < total; ++j) {
                int g = (int)g0 + j, mi = mlo; MatDesc d; mat_desc(F, mi, d); int items = (d.K / 64) * (d.Ndst / 32);
                while (g >= items) { g -= items; ++mi; mat_desc(F, mi, d); items = (d.K / 64) * (d.Ndst / 32); }
                tr_item(d.src, d.K, d.Nsrc, d.Ndst, d.perm, d.dst, scr, g, F.lane);
            }
        }
    } else {
    int base = 0;
    for (int mi = mlo; mi < mhi; ++mi) {
        MatDesc d; mat_desc(F, mi, d);
        const int items = (d.K / 64) * (d.Ndst / 32);
        int it = gw - (base % NGW); if (it < 0) it += NGW;
        for (; it < items; it += NGW) tr_item(d.src, d.K, d.Nsrc, d.Ndst, d.perm, d.dst, scr, it, F.lane);
        base += items;
    }
    }
    if (do_ac) { f16* AC = WSP(f16, WS_AC);
      for (int i = F.bid * 512 + F.tid; i < 256 * D; i += F.G * 512) { const int b = i >> 10, d = i & 1023; float v = 0.f;
          if (b < NBAT) { const float c = b < NB ? FIN(I_CP)[b * D + d] : FIN(I_CSMP)[(b - NB) * D + d]; v = c / (1.0f + __expf(-c)); }
          *tiled_ptr<f16>(AC, b, d, D) = (f16)v; } }
}
__device__ __forceinline__ void phase_pr2(Frame& F) {
    const float* CS0 = WSP(float, WS_CS);
    f16* X = WSP(f16, WS_X); f16* A = WSP(f16, WS_A); float* rowss = (float*)(F.ws + RSS_OFF);
    for (int m0 = (F.bid * 8 + F.wave) * 4; m0 < MALL; m0 += F.G * 32) {
        f32x4 xv[4][4];
#pragma unroll
        for (int r = 0; r < 4; ++r) { const int m = m0 + r; const float* xr = m < MP ? FIN(I_XP) + (size_t)m * D : FIN(I_XS) + (size_t)(m - MP) * D;
#pragma unroll
            for (int q = 0; q < 4; ++q) xv[r][q] = __builtin_nontemporal_load((const f32x4*)(xr + q * 256 + F.lane * 4)); }
#pragma unroll
        for (int r = 0; r < 4; ++r) { const int m = m0 + r; const float* cs = CS0 + (size_t)row_batch(m) * D; float ss = 0.f;
#pragma unroll
            for (int q = 0; q < 4; ++q) { const int d = q * 256 + F.lane * 4;
                const f32x4 x = xv[r][q];
                ss += (x[0] * x[0] + x[1] * x[1]) + (x[2] * x[2] + x[3] * x[3]);
                const f16x4 av = cvt4(x * *(const f32x4*)(cs + d));
                if (m < MP) *tiled_ptr<f16x4>(A, m, d, D) = av; else *(f16x4*)(A + (size_t)m * D + d) = av; }
            ss = wave_sum(ss);
            if (F.lane == 0) rowss[m] = ss; }
    }
}
template <int O0, int O1, int O2, int O3, int O4, int O5, int O6, int O7>
__device__ __forceinline__ void tr_read8(unsigned base, f16x4 (&r)[8]) {
    asm volatile("ds_read_b64_tr_b16 %0, %8 offset:%9\n\tds_read_b64_tr_b16 %1, %8 offset:%10\n\tds_read_b64_tr_b16 %2, %8 offset:%11\n\tds_read_b64_tr_b16 %3, %8 offset:%12\n\t"
                 "ds_read_b64_tr_b16 %4, %8 offset:%13\n\tds_read_b64_tr_b16 %5, %8 offset:%14\n\tds_read_b64_tr_b16 %6, %8 offset:%15\n\tds_read_b64_tr_b16 %7, %8 offset:%16\n\ts_waitcnt lgkmcnt(0)"
                 : "=&v"(r[0]), "=&v"(r[1]), "=&v"(r[2]), "=&v"(r[3]), "=&v"(r[4]), "=&v"(r[5]), "=&v"(r[6]), "=&v"(r[7])
                 : "v"(base), "n"(O0), "n"(O1), "n"(O2), "n"(O3), "n"(O4), "n"(O5), "n"(O6), "n"(O7) : "memory");
}
__device__ __forceinline__ unsigned lds_addr(const LAS void* p) { return (unsigned)(unsigned long long)p; }
struct BandAttn { const f16* Z; int ldz, qcol, kcol, vcol; f16* O; int ldo, ocol; float* LSE; const float* sinks; int tiledO; };
constexpr int KS_STR = 72, VS_STR = 96;
constexpr int ATT_KS = 0, ATT_VS = 256 * KS_STR * 2;
__device__ __forceinline__ void band_attn_unit(ldsp_t lds, const BandAttn& P, int tokbase, int stride, int blk, int kvh) {
    const int tid = opaque_v(threadIdx.x), w = __builtin_amdgcn_readfirstlane(tid >> 6), lane = tid & 63, c = lane & 31, hh = lane >> 5;
    LAS f16* Ks = (LAS f16*)(lds + ATT_KS); LAS f16* Vs = (LAS f16*)(lds + ATT_VS);
    f16x8 qfa[2][4];
    { const int head_ = kvh * 4 + (w >> 1);
#pragma unroll
      for (int qt = 0; qt < 2; ++qt) { const int mr_ = tokbase + stride * (128 * blk + 64 * (w & 1) + 32 * qt + c);
#pragma unroll
          for (int ks = 0; ks < 4; ++ks) qfa[qt][ks] = *(const f16x8*)(P.Z + (size_t)mr_ * P.ldz + P.qcol + head_ * 64 + 16 * ks + 8 * hh); } }
#pragma unroll
    for (int i = 0; i < 4; ++i) {
        const int cid = tid + 512 * i, key = cid >> 3, ch = cid & 7, p = 128 * blk - 128 + key;
        f16x8 kv = {0, 0, 0, 0, 0, 0, 0, 0}, vv = {0, 0, 0, 0, 0, 0, 0, 0};
        if (p >= 0) { const f16* zr = P.Z + (size_t)(tokbase + stride * p) * P.ldz + kvh * 64 + 8 * ch; kv = *(const f16x8*)(zr + P.kcol); vv = *(const f16x8*)(zr + P.vcol); }
        *(LAS f16x8*)(Ks + key * KS_STR + 8 * ch) = kv;
        *(LAS f16x8*)(Vs + key * VS_STR + 8 * ch) = vv;
    }
    __syncthreads();
    const int g = w >> 1, qh = w & 1, head = kvh * 4 + g;
    const unsigned vlane = lds_addr(Vs) + (unsigned)((4 * hh + ((lane & 15) >> 2)) * (VS_STR * 2) + (16 * ((lane >> 4) & 1) + 4 * (lane & 3)) * 2);
    const float sink = P.sinks ? P.sinks[head] : -INFINITY;
    constexpr float SC = 0.125f, L2E = 1.4426950408889634f;
#pragma unroll
    for (int qt = 0; qt < 2; ++qt) {
        const int i0 = 64 * qh + 32 * qt;
        const int mrow = tokbase + stride * (128 * blk + i0 + c);
        f16x8 qf[4];
#pragma unroll
        for (int ks = 0; ks < 4; ++ks) qf[ks] = qt ? qfa[1][ks] : qfa[0][ks];
        f32x16 s[5];
#pragma unroll
        for (int kt = 0; kt < 5; ++kt) {
#pragma unroll
            for (int i = 0; i < 16; ++i) s[kt][i] = 0.f;
#pragma unroll
            for (int ks = 0; ks < 4; ++ks) {
                const f16x8 a = *(const LAS f16x8*)(Ks + (i0 + 32 * kt + c) * KS_STR + 16 * ks + 8 * hh);
                s[kt] = __builtin_amdgcn_mfma_f32_32x32x16_f16(a, qf[ks], s[kt], 0, 0, 0);
            }
        }
        float mx = -INFINITY;
        const int cm = c - 4 * hh;
#pragma unroll
        for (int i = 0; i < 16; ++i) { const int kb = (i & 3) + 8 * (i >> 2);
            s[0][i] = (kb >= cm) ? s[0][i] : -INFINITY; s[4][i] = (kb <= cm) ? s[4][i] : -INFINITY; }
        if (blk == 0) {
            asm volatile("" ::: "memory");
#pragma unroll
            for (int kt = 0; kt < 5; ++kt)
#pragma unroll
                for (int i = 0; i < 16; ++i) { const int kr = (i & 3) + 8 * (i >> 2) + 4 * hh; s[kt][i] = (i0 + 32 * kt + kr >= 128) ? s[kt][i] : -INFINITY; }
        }
#pragma unroll
        for (int kt = 0; kt < 5; ++kt)
#pragma unroll
            for (int i = 0; i < 16; ++i) mx = fmaxf(mx, s[kt][i]);
        mx = fmaxf(mx, __shfl_xor(mx, 32));
        mx = fmaxf(mx * SC, sink);
        constexpr float CE = SC * L2E; const float moff = mx * L2E;
        float sum = 0.f; f16x8 pf[5][2];
#pragma unroll
        for (int kt = 0; kt < 5; ++kt)
#pragma unroll
            for (int i = 0; i < 16; ++i) { const float pv = __builtin_amdgcn_exp2f(__builtin_fmaf(s[kt][i], CE, -moff)); sum += pv; pf[kt][i >> 3][i & 7] = (f16)pv; }
        sum += __shfl_xor(sum, 32);
        sum += __builtin_amdgcn_exp2f((sink - mx) * L2E);
        const float inv = __builtin_amdgcn_rcpf(sum);
        f32x16 o[2];
#pragma unroll
        for (int i = 0; i < 16; ++i) { o[0][i] = 0.f; o[1][i] = 0.f; }
        const unsigned vb = vlane + (unsigned)(i0 * (VS_STR * 2));
#define BA_PV(KT) { f16x4 r[8]; constexpr int B_ = (KT) * 32 * VS_STR * 2, S_ = 16 * VS_STR * 2, H_ = 8 * VS_STR * 2; \
            tr_read8<B_, B_ + H_, B_ + S_, B_ + S_ + H_, B_ + 64, B_ + 64 + H_, B_ + 64 + S_, B_ + 64 + S_ + H_>(vb, r); \
            o[0] = __builtin_amdgcn_mfma_f32_32x32x16_f16(cat4(r[0], r[1]), pf[KT][0], o[0], 0, 0, 0); o[0] = __builtin_amdgcn_mfma_f32_32x32x16_f16(cat4(r[2], r[3]), pf[KT][1], o[0], 0, 0, 0); \
            o[1] = __builtin_amdgcn_mfma_f32_32x32x16_f16(cat4(r[4], r[5]), pf[KT][0], o[1], 0, 0, 0); o[1] = __builtin_amdgcn_mfma_f32_32x32x16_f16(cat4(r[6], r[7]), pf[KT][1], o[1], 0, 0, 0); }
        BA_PV(0) BA_PV(1) BA_PV(2) BA_PV(3) BA_PV(4)
#undef BA_PV
#pragma unroll
        for (int dt = 0; dt < 2; ++dt) {
            const int ocol = P.ocol + head * 64 + 32 * dt + 4 * hh;
#pragma unroll
            for (int rg = 0; rg < 4; ++rg) { f32x4 v = {o[dt][4 * rg] * inv, o[dt][4 * rg + 1] * inv, o[dt][4 * rg + 2] * inv, o[dt][4 * rg + 3] * inv};
                f16x4* op = P.tiledO ? tiled_ptr<f16x4>(P.O, mrow, ocol + 8 * rg, P.ldo) : (f16x4*)(P.O + (size_t)mrow * P.ldo + ocol + 8 * rg);
                *op = cvt4(v); }
        }
        if (P.LSE && hh == 0) P.LSE[(size_t)mrow * 8 + head] = mx + __logf(sum);
    }
    __syncthreads();
}
__device__ __forceinline__ void kv_export(const f16* Z, int ldz, int kcol, int vcol, int m0, int nrows, float* out, int tid0, int nthr) {
    for (int i = tid0; i < nrows * 32; i += nthr) {
        const int r = i >> 5, ch = i & 31, isv = ch >> 4, c8 = (ch & 15) * 8;
        const f16x8 v = *(const f16x8*)(Z + (size_t)(m0 + r) * ldz + (isv ? vcol : kcol) + c8);
        float* o = out + (size_t)r * 256 + isv * 128 + c8;
        *(f32x4*)o = (f32x4){(float)v[0], (float)v[1], (float)v[2], (float)v[3]}; *(f32x4*)(o + 4) = (f32x4){(float)v[4], (float)v[5], (float)v[6], (float)v[7]};
    }
}

__device__ __forceinline__ void gate_scan(const float* GATES, const float* bg, int m0, int h, int lane, LAS float* gb, LAS float* ga, LAS float* gcm, float& amax, float& bL, float& a0o, float& a1o) {
    const float* g0 = GATES + (size_t)(m0 + 2 * lane) * 16;
    const float ig0 = g0[h] + bg[h], ig1 = g0[16 + h] + bg[h];
    const float lf0 = logsigmoidf_(g0[8 + h] + bg[8 + h]), lf1 = logsigmoidf_(g0[24 + h] + bg[8 + h]);
    float s = lf0 + lf1;
#pragma unroll
    for (int o = 1; o < 64; o <<= 1) { const float t = __shfl_up(s, o); if (lane >= o) s += t; }
    const float b0 = (s - (lf0 + lf1)) + lf0, b1 = b0 + lf1;
    const float a0 = ig0 - b0, a1 = ig1 - b1;
    float mx = fmaxf(a0, a1);
#pragma unroll
    for (int o = 1; o < 64; o <<= 1) { const float t = __shfl_up(mx, o); if (lane >= o) mx = fmaxf(mx, t); }
    float ex = __shfl_up(mx, 1); if (lane == 0) ex = -INFINITY;
    const float c0 = fmaxf(ex, a0), c1 = fmaxf(c0, a1);
    gb[2 * lane] = b0; gb[2 * lane + 1] = b1; ga[2 * lane] = a0; ga[2 * lane + 1] = a1; gcm[2 * lane] = c0; gcm[2 * lane + 1] = c1;
    amax = __shfl(mx, 63); bL = __shfl(s, 63); a0o = a0; a1o = a1;
}
constexpr int X1_KS = 0, X1_VS = 18432, X1_G = 36864, X1_HEAD = 38912, X1_STR = 72;
__device__ __forceinline__ void mlstm_x1_unit(Frame& F, int e, int b, int ch, int hp) {
    const int tid = F.tid, w = F.wave, lane = F.lane, hg = w >> 2, wv = w & 3, gt = tid & 255, h = 2 * hp + hg;
    ldsp_t base = F.lds + hg * X1_HEAD;
    LAS f16* Ksm = (LAS f16*)(base + X1_KS); LAS f16* Vsm = (LAS f16*)(base + X1_VS);
    LAS float* gb = (LAS float*)(base + X1_G); LAS float* ga = gb + 128; LAS float* gcm = ga + 128; LAS float* gwk = gcm + 128;
    const f16* Z = WSP(f16, WS_Z); const float* GATES = WSP(float, WS_GATES); const float* bg = FIN(I_EBG) + e * 16;
    const int m0 = b * T + 128 * ch, idx = (b * 8 + h) * 64 + ch;
    float amax = 0.f, bL = 0.f;
    f16x8 kxa[4], vxa[4];
#pragma unroll
    for (int i = 0; i < 4; ++i) { const int cid = gt + 256 * i, s_ = cid >> 3, c8 = cid & 7; const f16* zr = Z + (size_t)(m0 + s_) * NEV + h * 64 + 8 * c8;
        kxa[i] = *(const f16x8*)(zr + 1280); vxa[i] = *(const f16x8*)(zr + 1792); }
    if (wv == 0) { float a0, a1; gate_scan(GATES, bg, m0, h, lane, gb, ga, gcm, amax, bL, a0, a1); gwk[2 * lane] = __expf(a0 - amax); gwk[2 * lane + 1] = __expf(a1 - amax); }
    __syncthreads();
#pragma unroll
    for (int i = 0; i < 4; ++i) {
        const int cid = gt + 256 * i, s_ = cid >> 3, c8 = cid & 7;
        const f16x8 kx = kxa[i], vx = vxa[i]; const float wk = gwk[s_];
        f16x8 ks;
#pragma unroll
        for (int q = 0; q < 8; ++q) ks[q] = (f16)((float)kx[q] * wk);
        *(LAS f16x8*)(Ksm + s_ * X1_STR + 8 * c8) = ks; *(LAS f16x8*)(Vsm + s_ * X1_STR + 8 * c8) = vx;
    }
    __syncthreads();
    const int fr = lane & 15, fq = lane >> 4;
    const unsigned lof = (unsigned)((8 * fq + (fr >> 2)) * (X1_STR * 2) + 4 * (fr & 3) * 2);
    const unsigned vaddr = lds_addr(Vsm) + lof + (unsigned)(16 * wv * 2), kaddr = lds_addr(Ksm) + lof;
    constexpr int R4 = 4 * X1_STR * 2, R32 = 32 * X1_STR * 2;
    f16x4 rv[8];
    tr_read8<0, R4, R32, R32 + R4, 2 * R32, 2 * R32 + R4, 3 * R32, 3 * R32 + R4>(vaddr, rv);
    float* DC = WSP(float, WS_DC) + (size_t)idx * 4096;
    f32x4 accn = {0.f, 0.f, 0.f, 0.f};
    f16x8 ones;
#pragma unroll
    for (int q = 0; q < 8; ++q) ones[q] = (fr == 0) ? (f16)1.0f : (f16)0.0f;
#define X1_TILE(DKT) { f16x4 rk[8]; tr_read8<(DKT) * 32, (DKT) * 32 + R4, (DKT) * 32 + R32, (DKT) * 32 + R32 + R4, (DKT) * 32 + 2 * R32, (DKT) * 32 + 2 * R32 + R4, (DKT) * 32 + 3 * R32, (DKT) * 32 + 3 * R32 + R4>(kaddr, rk); \
        f32x4 acc = {0.f, 0.f, 0.f, 0.f}; \
        _Pragma("unroll") for (int ks = 0; ks < 4; ++ks) { const f16x8 bf = cat4(rk[2 * ks], rk[2 * ks + 1]); acc = __builtin_amdgcn_mfma_f32_16x16x32_f16(cat4(rv[2 * ks], rv[2 * ks + 1]), bf, acc, 0, 0, 0); \
            if ((DKT) == wv) accn = __builtin_amdgcn_mfma_f32_16x16x32_f16(ones, bf, accn, 0, 0, 0); } \
        _Pragma("unroll") for (int r = 0; r < 4; ++r) DC[(16 * wv + 4 * fq + r) * 64 + 16 * (DKT) + fr] = acc[r]; }
    X1_TILE(0) X1_TILE(1) X1_TILE(2) X1_TILE(3)
#undef X1_TILE
    if (fq == 0) WSP(float, WS_DN)[(size_t)idx * 64 + 16 * wv + fr] = accn[0];
    if (gt == 0) { float* SC = WSP(float, WS_SC); SC[idx] = bL + amax; SC[1024 + idx] = bL; }
    __syncthreads();
}
__device__ __forceinline__ void mlstm_scan(Frame& F, int e) {
    const int gid = F.bid * 512 + F.tid; if (gid >= 16 * 4160) return;
    const int bh = gid / 4160, el = gid - bh * 4160; const bool isc = el < 4096;
    const float* SC = WSP(float, WS_SC); float* MPV = WSP(float, WS_SC) + 2048;
    const float* src = isc ? WSP(float, WS_DC) + (size_t)bh * 64 * 4096 + el : WSP(float, WS_DN) + (size_t)bh * 64 * 64 + (el - 4096);
    const int sstr = isc ? 4096 : 64;
    f16* cp = WSP(f16, WS_CP) + (size_t)bh * 64 * 4096 + el; float* np = WSP(float, WS_NP) + (size_t)bh * 64 * 64 + (el - 4096);
    float st = 0.f, mst = 0.f;
#pragma unroll 8
    for (int c = 0; c < 64; ++c) {
        const float dv = src[(size_t)c * sstr], mloc = SC[bh * 64 + c], bL = SC[1024 + bh * 64 + c];
        if (isc) cp[(size_t)c * 4096] = (f16)st; else np[c * 64] = st;
        if (el == 0) MPV[bh * 64 + c] = mst;
        const float mnew = fmaxf(bL + mst, mloc);
        st = __expf(bL + mst - mnew) * st + __expf(mloc - mnew) * dv; mst = mnew;
    }
    const int b = bh >> 3, h = bh & 7;
    if (isc) { const int dv = el >> 6, dk = el & 63; F.out[O_BCP + ((size_t)((e * 2 + b) * 8 + h) * 64 + dk) * 64 + dv] = st; }
    else F.out[O_BNP + (size_t)((e * 2 + b) * 8 + h) * 64 + (el - 4096)] = st;
    if (el == 0) F.out[O_BMP + (e * 2 + b) * 8 + h] = mst;
}
constexpr int X3_KR = 0, X3_VS = 18432, X3_G = 43008, X3_HEAD = 45056;
__device__ __forceinline__ void mlstm_x3_unit(Frame& F, int e, int b, int ch, int hp) {
    const int tid = F.tid, w = F.wave, lane = F.lane, hg = w >> 2, tt = w & 3, gt = tid & 255, h = 2 * hp + hg, c = lane & 31, hh = lane >> 5;
    ldsp_t base = F.lds + hg * X3_HEAD;
    LAS f16* Kr = (LAS f16*)(base + X3_KR); LAS f16* Vs = (LAS f16*)(base + X3_VS);
    LAS float* gb = (LAS float*)(base + X3_G); LAS float* ga = gb + 128; LAS float* gcm = ga + 128; LAS float* npv = gcm + 128;
    const f16* Z = WSP(f16, WS_Z); const float* GATES = WSP(float, WS_GATES); const float* bg = FIN(I_EBG) + e * 16;
    const int m0 = b * T + 128 * ch, idx = (b * 8 + h) * 64 + ch;
    f16x8 kxa[4], vxa[4];
#pragma unroll
    for (int i = 0; i < 4; ++i) { const int cid = gt + 256 * i, s = cid >> 3, c8 = cid & 7; const f16* zr = Z + (size_t)(m0 + s) * NEV + h * 64 + 8 * c8;
        kxa[i] = *(const f16x8*)(zr + 1280); vxa[i] = *(const f16x8*)(zr + 1792); }
    if (tt == 0) { float t0, t1, t2, t3; gate_scan(GATES, bg, m0, h, lane, gb, ga, gcm, t0, t1, t2, t3); }
#pragma unroll
    for (int i = 0; i < 4; ++i) {
        const int cid = gt + 256 * i, s = cid >> 3, c8 = cid & 7;
        const f16x8 kx = kxa[i], vx = vxa[i];
        *(LAS f16x8*)(Kr + s * KS_STR + 8 * c8) = kx;
        *(LAS f16x8*)(Vs + s * VS_STR + 8 * c8) = vx;
    }
    if (gt < 64) npv[gt] = WSP(float, WS_NP)[(size_t)idx * 64 + gt];
    __syncthreads();
    const float mst = WSP(float, WS_SC)[2048 + idx];
    const int t = 32 * tt + c, mrow = m0 + t;
    const float bt = gb[t], mm = fmaxf(mst, gcm[t]), mt = bt + mm;
    f16x8 qf[4];
#pragma unroll
    for (int ks = 0; ks < 4; ++ks) qf[ks] = *(const f16x8*)(Z + (size_t)mrow * NEV + 768 + h * 64 + 16 * ks + 8 * hh);
    f32x16 num[2];
#pragma unroll
    for (int i = 0; i < 16; ++i) { num[0][i] = 0.f; num[1][i] = 0.f; }
    float qsum = 0.f;
    const unsigned vlane = lds_addr(Vs) + (unsigned)((4 * hh + ((lane & 15) >> 2)) * (VS_STR * 2) + (16 * ((lane >> 4) & 1) + 4 * (lane & 3)) * 2);
    for (int st = 0; st <= tt; ++st) {
        f32x16 sa;
#pragma unroll
        for (int i = 0; i < 16; ++i) sa[i] = 0.f;
#pragma unroll
        for (int ks = 0; ks < 4; ++ks) { const f16x8 a = *(const LAS f16x8*)(Kr + (32 * st + c) * KS_STR + 16 * ks + 8 * hh); sa = __builtin_amdgcn_mfma_f32_32x32x16_f16(a, qf[ks], sa, 0, 0, 0); }
        f16x8 wf[2];
        const bool diag = (st == tt);
        constexpr float L2E_ = 1.4426950408889634f; const float mml = mm * L2E_;
#pragma unroll
        for (int rg = 0; rg < 4; ++rg) {
            const int s0 = 32 * st + 8 * rg + 4 * hh;
            const f32x4 g4 = *(const LAS f32x4*)(ga + s0);
#pragma unroll
            for (int q = 0; q < 4; ++q) {
                const int i = 4 * rg + q;
                float dd = __builtin_amdgcn_exp2f(__builtin_fmaf(g4[q], L2E_, -mml));
                if (diag) dd = (s0 + q <= t) ? dd : 0.f;
                const float wv_ = sa[i] * dd;
                qsum += wv_; wf[i >> 3][i & 7] = (f16)wv_;
            }
        }
        { f16x4 r[8]; constexpr int S_ = 16 * VS_STR * 2, H_ = 8 * VS_STR * 2;
          tr_read8<0, H_, S_, S_ + H_, 64, 64 + H_, 64 + S_, 64 + S_ + H_>(vlane + (unsigned)(st * 32 * VS_STR * 2), r);
          num[0] = __builtin_amdgcn_mfma_f32_32x32x16_f16(cat4(r[0], r[1]), wf[0], num[0], 0, 0, 0); num[0] = __builtin_amdgcn_mfma_f32_32x32x16_f16(cat4(r[2], r[3]), wf[1], num[0], 0, 0, 0);
          num[1] = __builtin_amdgcn_mfma_f32_32x32x16_f16(cat4(r[4], r[5]), wf[0], num[1], 0, 0, 0); num[1] = __builtin_amdgcn_mfma_f32_32x32x16_f16(cat4(r[6], r[7]), wf[1], num[1], 0, 0, 0); }
    }
    qsum += __shfl_xor(qsum, 32);
    f32x16 ni[2];
#pragma unroll
    for (int i = 0; i < 16; ++i) { ni[0][i] = 0.f; ni[1][i] = 0.f; }
    const f16* CP = WSP(f16, WS_CP) + (size_t)idx * 4096;
#pragma unroll
    for (int dt = 0; dt < 2; ++dt)
#pragma unroll
        for (int ks = 0; ks < 4; ++ks) { const f16x8 a = *(const f16x8*)(CP + (32 * dt + c) * 64 + 16 * ks + 8 * hh); ni[dt] = __builtin_amdgcn_mfma_f32_32x32x16_f16(a, qf[ks], ni[dt], 0, 0, 0); }
    float qni = 0.f;
#pragma unroll
    for (int ks = 0; ks < 4; ++ks)
#pragma unroll
        for (int j = 0; j < 8; ++j) qni += (float)qf[ks][j] * npv[16 * ks + 8 * hh + j];
    qni += __shfl_xor(qni, 32);
    const float inter = __expf(mst - mm);
    const float qn = qsum + inter * qni, invd = __builtin_amdgcn_rcpf(fmaxf(fabsf(qn), __expf(-mt)));
    float ssq = 0.f;
#pragma unroll
    for (int dt = 0; dt < 2; ++dt)
#pragma unroll
        for (int i = 0; i < 16; ++i) { const float hv = (num[dt][i] + inter * ni[dt][i]) * invd; num[dt][i] = hv; ssq += hv * hv; }
    ssq += __shfl_xor(ssq, 32);
    const float rinv = rsqrtf(ssq * (1.0f / 64.0f) + EPS);
    const float* hgain = FIN(I_EHG) + (e * 8 + h) * 64;
    f16* O = WSP(f16, WS_O);
#pragma unroll
    for (int dt = 0; dt < 2; ++dt)
#pragma unroll
        for (int rg = 0; rg < 4; ++rg) {
            const int dv0 = 32 * dt + 8 * rg + 4 * hh;
            const f16x4 bo = *(const f16x4*)(Z + (size_t)mrow * NEV + 2304 + h * 64 + dv0); const f32x4 gn = *(const f32x4*)(hgain + dv0);
            f32x4 y;
#pragma unroll
            for (int q = 0; q < 4; ++q) y[q] = num[dt][4 * rg + q] * rinv * gn[q] * sigmoidf_((float)bo[q]);
            *tiled_ptr<f16x4>(O, mrow, 512 + h * 64 + dv0, D) = cvt4(y);
        }
    __syncthreads();
}

constexpr int DA_QS = 0, DA_KC = 1024, DA_VC = 36352, DA_SC = 69376, DA_RD = 71488, DA_KSTR = 68;
__device__ __forceinline__ void dec_attn(Frame& F, const float* cache, int dil, int kvh, const f16* zrow, int qcol, int kcol, int vcol, const float* sinks, float& o_out, float& lse_out) {
    const int tid = F.tid, lane = F.lane, w = F.wave;
    LAS float* qs = (LAS float*)(F.lds + DA_QS); LAS float* Kc = (LAS float*)(F.lds + DA_KC); LAS float* Vc = (LAS float*)(F.lds + DA_VC);
    LAS float* sc = (LAS float*)(F.lds + DA_SC); LAS float* rd = (LAS float*)(F.lds + DA_RD);
#pragma unroll
    for (int i = 0; i < 4; ++i) {
        const int cid = tid + 512 * i, j = cid >> 4, c4 = cid & 15;
        const float* src = cache + (size_t)(dil * j) * 256 + kvh * 64 + 4 * c4;
        const f32x4 kk = *(const f32x4*)src, vv = *(const f32x4*)(src + 128);
        *(LAS f32x4*)(Kc + j * DA_KSTR + 4 * c4) = kk;
        *(LAS f32x4*)(Vc + j * 64 + 4 * c4) = vv;
    }
    if (tid < 64) { Kc[128 * DA_KSTR + tid] = (float)zrow[kcol + kvh * 64 + tid]; Vc[128 * 64 + tid] = (float)zrow[vcol + kvh * 64 + tid]; }
    if (tid < 256) qs[tid] = (float)zrow[qcol + kvh * 256 + tid];
    __syncthreads();
    for (int jj = tid; jj < 516; jj += 512) {
        const int j = jj >> 2, g = jj & 3; f32x4 s4 = {0.f, 0.f, 0.f, 0.f};
#pragma unroll
        for (int d = 0; d < 64; d += 4) s4 = s4 + *(const LAS f32x4*)(qs + g * 64 + d) * *(const LAS f32x4*)(Kc + j * DA_KSTR + d);
        sc[g * 132 + j] = ((s4[0] + s4[1]) + (s4[2] + s4[3])) * 0.125f;
    }
    __syncthreads();
    if (w < 4) {
        const float sk = sinks ? sinks[kvh * 4 + w] : -INFINITY;
        const float v0 = sc[w * 132 + lane], v1 = sc[w * 132 + 64 + lane], v2 = lane == 0 ? sc[w * 132 + 128] : -INFINITY;
        float mx = wave_max(fmaxf(fmaxf(v0, v1), v2)); mx = fmaxf(mx, sk);
        const float p0 = __expf(v0 - mx), p1 = __expf(v1 - mx), p2 = lane == 0 ? __expf(v2 - mx) : 0.f;
        const float sum = wave_sum(p0 + p1 + p2) + __expf(sk - mx);
        sc[w * 132 + lane] = p0; sc[w * 132 + 64 + lane] = p1; if (lane == 0) { sc[w * 132 + 128] = p2; rd[w] = sum; rd[4 + w] = mx; }
    }
    __syncthreads();
    if (tid < 256) {
        const int g = tid >> 6, d = tid & 63; float o = 0.f;
#pragma unroll 4
        for (int j = 0; j < 128; j += 4) { const f32x4 p4 = *(const LAS f32x4*)(sc + g * 132 + j);
            o += p4[0] * Vc[j * 64 + d]; o += p4[1] * Vc[(j + 1) * 64 + d]; o += p4[2] * Vc[(j + 2) * 64 + d]; o += p4[3] * Vc[(j + 3) * 64 + d]; }
        o += sc[g * 132 + 128] * Vc[128 * 64 + d];
        const float den = rd[g]; o_out = o * __builtin_amdgcn_rcpf(den); lse_out = rd[4 + g] + __logf(den);
    }
    __syncthreads();
}
__device__ __forceinline__ void sample_attn_even(Frame& F, int e, int s, int kvh) {
    const f16* zrow = WSP(f16, WS_Z) + (size_t)(MP + s) * NEV;
    float o = 0.f, lse = 0.f;
    dec_attn(F, FIN(I_CA) + ((size_t)e * NS + s) * 128 * 256, 1, kvh, zrow, 0, 512, 640, FIN(I_ESK) + e * 8, o, lse);
    if (F.tid < 256) WSP(f16, WS_O)[(size_t)(MP + s) * D + kvh * 256 + F.tid] = (f16)o;
    if (F.tid < 128) { const int isv = F.tid >> 6, d = F.tid & 63;
        F.out[O_AKVS + (((size_t)e * NS + s) * 128 + 127) * 256 + isv * 128 + kvh * 64 + d] = (float)zrow[(isv ? 640 : 512) + kvh * 64 + d]; }
}
__device__ __forceinline__ void sample_attn_odd(Frame& F, int oi, int s, int kvh) {
    const f16* zrow = WSP(f16, WS_Z) + (size_t)(MP + s) * NOD;
    float o[3] = {0.f, 0.f, 0.f}, lse[3] = {0.f, 0.f, 0.f};
    dec_attn(F, FIN(I_CC1) + ((size_t)oi * NS + s) * 128 * 256, 1, kvh, zrow, 0, 512, 640, nullptr, o[0], lse[0]);
    dec_attn(F, FIN(I_CC2) + ((size_t)oi * NS + s) * 512 * 256, 4, kvh, zrow, 768, 1280, 1408, nullptr, o[1], lse[1]);
    dec_attn(F, FIN(I_CC3) + ((size_t)oi * NS + s) * 2048 * 256, 16, kvh, zrow, 1536, 2048, 2176, nullptr, o[2], lse[2]);
    if (F.tid < 256) {
        const float mx = fmaxf(fmaxf(lse[0], lse[1]), lse[2]);
        const float w0 = __expf(lse[0] - mx), w1 = __expf(lse[1] - mx), w2 = __expf(lse[2] - mx);
        WSP(f16, WS_O)[(size_t)(MP + s) * 512 + kvh * 256 + F.tid] = (f16)((w0 * o[0] + w1 * o[1] + w2 * o[2]) / (w0 + w1 + w2));
    }
    if (F.tid < 384) { const int g = F.tid >> 7, r = F.tid & 127, isv = r >> 6, d = r & 63;
        const int W = g == 0 ? 128 : (g == 1 ? 512 : 2048); const size_t ob = g == 0 ? O_C1S : (g == 1 ? O_C2S : O_C3S);
        F.out[ob + (((size_t)oi * NS + s) * W + (W - 1)) * 256 + isv * 128 + kvh * 64 + d] = (float)zrow[768 * g + (isv ? 640 : 512) + kvh * 64 + d]; }
}
__device__ __forceinline__ void sample_mlstm(Frame& F, int e, int s) {
    const int h = F.wave, lane = F.lane, m = MP + s;
    const f16* zrow = WSP(f16, WS_Z) + (size_t)m * NEV; const float* gr = WSP(float, WS_GATES) + (size_t)m * 16; const float* bg = FIN(I_EBG) + e * 16;
    const float q = (float)zrow[768 + h * 64 + lane], k = (float)zrow[1280 + h * 64 + lane], v = (float)zrow[1792 + h * 64 + lane], bo = (float)zrow[2304 + h * 64 + lane];
    const float ig = gr[h] + bg[h], lf = logsigmoidf_(gr[8 + h] + bg[8 + h]);
    const size_t sh = ((size_t)e * NS + s) * 8 + h;
    const float mst = FIN(I_SBM)[sh], nst = FIN(I_SBN)[sh * 64 + lane];
    const float mt = fmaxf(lf + mst, ig), dsc = __expf(ig - mt), inter = __expf(lf + mst - mt);
    const float qk = wave_sum(q * k), qn_i = wave_sum(q * nst);
    const float* C = FIN(I_SBC) + sh * 4096; float* Co = F.out + O_BCS + sh * 4096;
    float qc = 0.f;
#pragma unroll 8
    for (int dk = 0; dk < 64; ++dk) {
        const float cv = C[dk * 64 + lane], qd = __shfl(q, dk), kd = __shfl(k, dk);
        qc += qd * cv; Co[dk * 64 + lane] = inter * cv + dsc * kd * v;
    }
    const float wgt = qk * dsc, num = wgt * v + inter * qc, qn = wgt + inter * qn_i;
    const float hv = num / fmaxf(fabsf(qn), __expf(-mt));
    const float rinv = rsqrtf(wave_sum(hv * hv) * (1.0f / 64.0f) + EPS);
    WSP(f16, WS_O)[(size_t)m * D + 512 + h * 64 + lane] = (f16)(hv * rinv * FIN(I_EHG)[(e * 8 + h) * 64 + lane] * sigmoidf_(bo));
    F.out[O_BNS + sh * 64 + lane] = inter * nst + dsc * k;
    if (lane == 0) F.out[O_BMS + sh] = mt;
}

__device__ __forceinline__ void phase_e1(Frame& F, int e, int tmask) {
    BandAttn P{WSP(f16, WS_Z), NEV, 0, 512, 640, WSP(f16, WS_O), D, 0, nullptr, FIN(I_ESK) + e * 8, 1};
    for (int u = F.bid; u < 1152; u += F.G) {
        if (u < 256) { if (!(tmask & 1)) continue; const int kvh = u & 1, blk = (u >> 1) & 63, b = u >> 7;
            band_attn_unit(F.lds, P, b * T, 1, blk, kvh);
            if (blk == 63 && kvh == 0) kv_export(P.Z, NEV, 512, 640, b * T + T - 128, 128, F.out + O_AKVP + (size_t)(e * 2 + b) * 128 * 256, F.tid, 512);
        } else if (u < 768) { if (!(tmask & 2)) continue; const int v = u - 256; mlstm_x1_unit(F, e, v >> 8, (v >> 2) & 63, v & 3); }
        else if (u < 1024) { if (!(tmask & 4)) continue; const int v = u - 768; sample_attn_even(F, e, v >> 1, v & 1); }
        else { if (!(tmask & 8)) continue; sample_mlstm(F, e, u - 1024); }
    }
}
__device__ __forceinline__ void phase_e3(Frame& F, int e) {
    for (int u = F.bid; u < 512; u += F.G) mlstm_x3_unit(F, e, u >> 8, (u >> 2) & 63, u & 3);
}
__device__ __forceinline__ void phase_o1(Frame& F, int oi, int tmask) {
    const f16* Z = WSP(f16, WS_Z);
    for (int u = F.bid; u < 768 + 256 + 42; u += F.G) {
        if (u < 768) {
            if (!(tmask & 1)) continue;
            const int g = u >> 8, v = u & 255, kvh = v & 1, r = v >> 1;
            const int dil = g == 0 ? 1 : (g == 1 ? 4 : 16), nblk = 64 / dil;
            const int b = r >> 6, rr = r & 63, res = rr / nblk, blk = rr % nblk;
            BandAttn P{Z, NOD, 768 * g, 768 * g + 512, 768 * g + 640, WSP(f16, WS_OG) + (size_t)g * MP * 512, 512, 0, WSP(float, WS_LSE) + (size_t)g * MP * 8, nullptr, 0};
            band_attn_unit(F.lds, P, b * T + res, dil, blk, kvh);
        } else if (u < 1024) { if (!(tmask & 4)) continue; const int v = u - 768; sample_attn_odd(F, oi, v >> 1, v & 1); }
        else {
            if (!(tmask & 16)) continue;
            const int v = u - 1024; int g, q; if (v < 2) { g = 0; q = v; } else if (v < 10) { g = 1; q = v - 2; } else { g = 2; q = v - 10; }
            const int W = 128 << (2 * g), per = W / 128, b = q / per, part = q % per;
            const size_t ob = g == 0 ? O_C1P : (g == 1 ? O_C2P : O_C3P);
            kv_export(Z, NOD, 768 * g + 512, 768 * g + 640, b * T + T - W + part * 128, 128, F.out + ob + ((size_t)(oi * 2 + b) * W + part * 128) * 256, F.tid, 512);
        }
    }
}
__device__ __forceinline__ void phase_o2(Frame& F) {
    const f16* OG = WSP(f16, WS_OG); const float* LSE = WSP(float, WS_LSE); f16* O = WSP(f16, WS_O);
    for (size_t i = (size_t)F.bid * 512 + F.tid; i < (size_t)MP * 64; i += (size_t)F.G * 512) {
        const size_t m = i >> 6; const int c8 = (int)(i & 63), hd = c8 >> 3;
        const float l0 = LSE[m * 8 + hd], l1 = LSE[(size_t)MP * 8 + m * 8 + hd], l2 = LSE[(size_t)2 * MP * 8 + m * 8 + hd];
        const float mx = fmaxf(fmaxf(l0, l1), l2); float w0 = __expf(l0 - mx), w1 = __expf(l1 - mx), w2 = __expf(l2 - mx); const float inv = 1.0f / (w0 + w1 + w2);
        w0 *= inv; w1 *= inv; w2 *= inv;
        const f16x8 a = *(const f16x8*)(OG + m * 512 + c8 * 8), b = *(const f16x8*)(OG + (size_t)MP * 512 + m * 512 + c8 * 8), c = *(const f16x8*)(OG + (size_t)2 * MP * 512 + m * 512 + c8 * 8);
        f16x8 o;
#pragma unroll
        for (int q = 0; q < 8; ++q) o[q] = (f16)(w0 * (float)a[q] + w1 * (float)b[q] + w2 * (float)c[q]);
        *tiled_ptr<f16x8>(O, (int)m, c8 * 8, 512) = o;
    }
}
__device__ __forceinline__ void phase_final(Frame& F) {
    const f16* X = WSP(f16, WS_X); const float* rss = (const float*)(F.ws + RSS_OFF) + (size_t)12 * MALL; const float* fg = FIN(I_FG);
    for (int m = F.bid * 8 + F.wave; m < MALL; m += F.G * 8) {
        const float r = rsqrtf(rss[m] * (1.0f / D) + EPS);
#pragma unroll
        for (int q = 0; q < 4; ++q) { const int d = q * 256 + F.lane * 4; const f16x4 xh = *(const f16x4*)(X + (size_t)m * D + d); const f32x4 x = {(float)xh[0], (float)xh[1], (float)xh[2], (float)xh[3]}, g = *(const f32x4*)(fg + d);
            *(f32x4*)(F.out + O_Y + (size_t)m * D + d) = x * r * g; }
    }
}

struct Args;
__device__ __forceinline__ bool phase_enter(Frame& F, const Args& args);
#define REP(bit) _Pragma("unroll 1") for (int rep_ = 0; rep_ < ((PROBE_DUP & (bit)) ? 2 : 1); ++rep_)
#ifndef P_MASK
#define P_MASK 0
#endif
constexpr bool P_SK = !(P_MASK & 1), P_MIX = !(P_MASK & 2), P_Z = !(P_MASK & 4), P_RES = !(P_MASK & 8), P_SW = !(P_MASK & 16), P_PR = !(P_MASK & 32), P_E1 = !(P_MASK & 64), P_E3 = !(P_MASK & 128), P_O1 = !(P_MASK & 256);
struct Args { const float* in[N_IN]; float* out; unsigned char* ws; int ph_lo, ph_hi; };
constexpr int PH_LAYER0 = 4, PH_PER_LAYER = 9, PH_FINAL = PH_LAYER0 + 4 * PH_PER_LAYER, N_PHASES = PH_FINAL + 1;

__device__ __forceinline__ bool phase_enter(Frame& F, const Args& args) {
    F.tid = opaque_v(threadIdx.x); F.lane = F.tid & 63; F.wave = __builtin_amdgcn_readfirstlane(F.tid >> 6);
    F.out = opaque_p(args.out); F.ws = opaque_p(args.ws);
    return true;
}
__global__ void __launch_bounds__(512, 2) fwd_kernel(Args args) {
    extern __shared__ __attribute__((aligned(16))) unsigned char lds_raw[];
    Frame F;
    F.lds = (ldsp_t)lds_raw; F.tid = threadIdx.x; F.lane = F.tid & 63; F.wave = __builtin_amdgcn_readfirstlane(F.tid >> 6); F.G = gridDim.x; F.bid = blockIdx.x;
    F.out = args.out; F.ws = args.ws;
    volatile LAS unsigned* MISC = (volatile LAS unsigned*)(F.lds + MISC_OFF);
    if (F.tid < 32) MISC[F.tid] = 0u;
    __syncthreads();
    XcdBarrier bar = xcd_barrier_post((unsigned*)(F.ws + WS_CTL) + CW_BAR, MISC + 8);
    const int lo = args.ph_lo, hi = args.ph_hi;
    const CopyQ CQ{args.in[I_CC3], args.in[I_CC2], args.in[I_CA], args.in[I_CC1], args.out, (unsigned*)(args.ws + WS_CTL) + CW_Q};
#define IN(k) (lo <= (k) && (k) < hi && phase_enter(F, args))
#define SEAM(k) do { if (IN((k) + 1)) { xcd_barrier(bar, CQ); if constexpr ((PROBE_DUP & 64) != 0) xcd_barrier(bar, CQ); } } while (0)
#define LSEAM(k) do { if (IN((k) + 1)) { if (fastp) xcc_barrier(bar, CQ); else xcd_barrier(bar, CQ); } } while (0)
    unsigned fastp = 0u;
    float* rowss = (float*)(F.ws + RSS_OFF);

    _Pragma("unroll 1") for (int prep_ = 0; prep_ < ((PROBE_DUP & 32) ? 2 : 1); ++prep_) {
    if (IN(0)) { REP(1) { if constexpr (P_PR) phase_pr0(F, 24, 28, true, nullptr); } SEAM(0);
        if (MK_N_LAUNCHES == 1 && hi == N_PHASES && MISC[8 + 10] != 0u) { fastp = 1u; F.bid = (int)(MISC[8 + 12] * 8u + bar.x); } }
    if (IN(1)) {
        pg8::Gemm g{WSP(f16, WS_AC), WSP(f16, WS_WMOD), 256, 4 * NMODC, D}; pg8::StaticOrder S; S.init(256, 4 * NMODC, F.G, F.bid);
        EpiMod E{WSP(float, WS_CS), WSP(float, WS_GT), WSP(f16, WS_SHA), FIN(I_BMOD), FIN(I_NG), WSP(float, WS_RCS)};
        if constexpr (P_PR) pg8::gemm_phase<EpiMod, pg8::StaticOrder>(F.lds, g, S, E);
        if constexpr (P_PR) { phase_enter(F, args); phase_pr0(F, 0, 24, false, (unsigned*)(F.ws + WS_CTL) + CW_Q + 128); }
        SEAM(1);
    }
    if (IN(3)) {
        pg8::Gemm g{WSP(f16, WS_SHA), WSP(f16, WS_WIN), 256 * NSITE, NWIN, D}; pg8::DiagOrder S{F.G, F.bid};
        EpiBias E{WSP(float, WS_BW)};
        if constexpr (P_PR) pg8::gemm_phase<EpiBias, pg8::DiagOrder>(F.lds, g, S, E);
        if constexpr (P_PR) { phase_enter(F, args); phase_pr2(F); }
        SEAM(3);
    }
    }
    for (int l = 0; l < 4; ++l) {
        const int pb = PH_LAYER0 + PH_PER_LAYER * l, s0 = 3 * l; const bool even = (l & 1) == 0; const int ei = l >> 1;
#pragma unroll 1
        for (int ffn = 0; ffn < 2; ++ffn) {
            if (ffn == 1) {
                if (IN(pb + 2)) {
                    const int so = site_off(s0 + 1), N = even ? NEV : NOD;
                    pg8::Gemm g{WSP(f16, WS_A), WSP(f16, WS_WIN) + (size_t)so * D, MP, N, D}; pg8::StaticOrder S; S.init(MP, N, F.G, F.bid);
                    if (even) { EpiZ<true> E{rowss + (size_t)(s0 + 1) * MALL, WSP(float, WS_BW) + so, WSP(f16, WS_Z), WSP(float, WS_GATES)};
                        if constexpr (P_Z) pg8::gemm_phase<EpiZ<true>, pg8::StaticOrder>(F.lds, g, S, E);
                        if constexpr ((PROBE_DUP & 128) != 0) { phase_enter(F, args); pg8::gemm_phase<EpiZ<true>, pg8::StaticOrder>(F.lds, g, S, E); }
                        if constexpr (P_SK) skinny_phase<false, D>(F.lds, g.A + (size_t)MP * D, g.Bt, N, E, F.G, F.bid, S.nwg); }
                    else { EpiZ<false> E{rowss + (size_t)(s0 + 1) * MALL, WSP(float, WS_BW) + so, WSP(f16, WS_Z), WSP(float, WS_GATES)};
                        if constexpr (P_Z) pg8::gemm_phase<EpiZ<false>, pg8::StaticOrder>(F.lds, g, S, E);
                        if constexpr ((PROBE_DUP & 128) != 0) { phase_enter(F, args); pg8::gemm_phase<EpiZ<false>, pg8::StaticOrder>(F.lds, g, S, E); }
                        if constexpr (P_SK) skinny_phase<false, D>(F.lds, g.A + (size_t)MP * D, g.Bt, N, E, F.G, F.bid, S.nwg); }
                    SEAM(pb + 2);
                }
                if (IN(pb + 3)) { REP(2) if constexpr (P_MIX) { const int tm = rep_ ? PROBE_TMASK : 31; if (even) { if constexpr (P_E1) phase_e1(F, ei, tm); } else { if constexpr (P_O1) phase_o1(F, ei, tm); } } SEAM(pb + 3); }
                if (IN(pb + 4)) { REP(4096) if constexpr (P_MIX) { if (even) mlstm_scan(F, ei); else phase_o2(F); } SEAM(pb + 4); }
                if (even && IN(pb + 5)) { REP(8192) if constexpr (P_MIX && P_E3) { phase_e3(F, ei); } SEAM(pb + 5); }
                if (IN(pb + 6)) {
                    const int K = even ? D : 512; const f16* Bt = even ? WSP(f16, WS_WEO) + (size_t)ei * D * D : WSP(f16, WS_WOO) + (size_t)ei * D * 512;
                    pg8::Gemm g{WSP(f16, WS_O), Bt, MP, D, K}; pg8::StaticOrder S; S.init(MP, D, F.G, F.bid);
                    EpiRes E{WSP(f16, WS_X), WSP(f16, WS_A), rowss + (size_t)(s0 + 2) * MALL, WSP(float, WS_GT) + (size_t)(s0 + 1) * NBAT * D, WSP(float, WS_CS) + (size_t)(s0 + 2) * NBAT * D, WSP(float, WS_RCS) + (size_t)(s0 + 1) * NBAT * D};
                    if constexpr ((PROBE_DUP & 256) != 0) { EpiRes E2{(f16*)(F.ws + WS_END), (f16*)(F.ws + WS_END + (size_t)MALL * D * 4), (float*)(F.ws + WS_END + (size_t)MALL * D * 6), E.GT, E.CS, E.RCS};
                        pg8::gemm_phase<EpiRes, pg8::StaticOrder>(F.lds, g, S, E2); phase_enter(F, args); }
                    if constexpr (P_RES) pg8::gemm_phase<EpiRes, pg8::StaticOrder>(F.lds, g, S, E);
                    if constexpr (P_SK) { if (even) skinny_phase<false, D>(F.lds, g.A + (size_t)MP * D, g.Bt, D, E, F.G, F.bid, S.nwg); else skinny_phase<false, 512>(F.lds, g.A + (size_t)MP * 512, g.Bt, D, E, F.G, F.bid, S.nwg); }
                    LSEAM(pb + 6);
                }
            }
            const int sf = s0 + 2 * ffn, pin = pb + (ffn ? 7 : 0);
            if (IN(pin)) {
                const int so = site_off(sf);
                pg8::Gemm g{WSP(f16, WS_A), WSP(f16, WS_WIN) + (size_t)so * D, MP, FF2, D}; pg8::StaticOrder S; S.init(MP, FF2, F.G, F.bid);
                EpiSwiglu E{rowss + (size_t)sf * MALL, WSP(float, WS_BW) + so, WSP(f16, WS_H)};
                if constexpr (P_SW) pg8::gemm_phase<EpiSwiglu, pg8::StaticOrder>(F.lds, g, S, E);
                if constexpr ((PROBE_DUP & 4) != 0) { phase_enter(F, args); pg8::gemm_phase<EpiSwiglu, pg8::StaticOrder>(F.lds, g, S, E); }
                REP(8) { if constexpr (P_SK) skinny_phase<true, D>(F.lds, g.A + (size_t)MP * D, g.Bt, FF2, E, F.G, F.bid, S.nwg); }
                LSEAM(pin);
            }
            if (IN(pin + 1)) {
                pg8::Gemm g{WSP(f16, WS_H), WSP(f16, WS_WFO) + (size_t)(2 * l + ffn) * D * FF, MP, D, FF}; pg8::StaticOrder S; S.init(MP, D, F.G, F.bid);
                EpiRes E{WSP(f16, WS_X), WSP(f16, WS_A), rowss + (size_t)(sf + 1) * MALL, WSP(float, WS_GT) + (size_t)sf * NBAT * D, (sf + 1 < NSITE) ? WSP(float, WS_CS) + (size_t)(sf + 1) * NBAT * D : nullptr, WSP(float, WS_RCS) + (size_t)sf * NBAT * D};
                if constexpr ((PROBE_DUP & 16) != 0) { EpiRes E2{(f16*)(F.ws + WS_END), (f16*)(F.ws + WS_END + (size_t)MALL * D * 4), (float*)(F.ws + WS_END + (size_t)MALL * D * 6), E.GT, E.CS, E.RCS};
                    pg8::gemm_phase<EpiRes, pg8::StaticOrder>(F.lds, g, S, E2); phase_enter(F, args); }
                if constexpr (P_RES) pg8::gemm_phase<EpiRes, pg8::StaticOrder>(F.lds, g, S, E);
                if constexpr (P_SK) skinny_phase<false, FF>(F.lds, g.A + (size_t)MP * FF, g.Bt, D, E, F.G, F.bid, S.nwg);
                if (pin + 1 == PH_FINAL - 1) SEAM(pin + 1); else LSEAM(pin + 1);
            }
        }
    }
    if (IN(PH_FINAL)) {
        phase_final(F);
        if constexpr ((PROBE_DUP & 512) != 0) { phase_enter(F, args); phase_final(F); }
        for (;;) {
            __syncthreads();
            if (F.tid == 0) MISC[24] = xb_add(CQ.head, 1u);
            __syncthreads();
            const unsigned ch = MISC[24];
            if (ch >= (unsigned)CQ_N) break;
            copy_chunk(CQ, (int)ch, F.tid);
        }
        if constexpr ((PROBE_DUP & 1024) != 0) {
            CopyQ CQ2 = CQ; CQ2.head = CQ.head + 64;
            for (;;) {
                __syncthreads();
                if (F.tid == 0) MISC[24] = xb_add(CQ2.head, 1u);
                __syncthreads();
                const unsigned ch = MISC[24];
                if (ch >= (unsigned)CQ_N) break;
                copy_chunk(CQ2, (int)ch, F.tid);
            }
        }
    }
#undef IN
#undef SEAM
}

extern "C" void kernel_launch(void* const* d_in, const int* in_sizes, int n_in, void* d_out, int out_size, void* d_ws, size_t ws_size, hipStream_t stream) {
    static int grid = 0;
    if (grid == 0) {
        if (n_in != N_IN || (size_t)out_size != O_END || ws_size < WS_END) { fprintf(stderr, "kernel_launch: unexpected shapes n_in %d out %d ws %zu (need %zu / %zu)\n", n_in, out_size, ws_size, (size_t)O_END, (size_t)WS_END); grid = -1; return; }
        int dev = 0, cus = 0, per_cu = 0;
        if (hipGetDevice(&dev) != hipSuccess || hipDeviceGetAttribute(&cus, hipDeviceAttributeMultiprocessorCount, dev) != hipSuccess) { grid = -1; return; }
        if (hipFuncSetAttribute((const void*)fwd_kernel, hipFuncAttributeMaxDynamicSharedMemorySize, LDS_BYTES) != hipSuccess) { fprintf(stderr, "kernel_launch: hipFuncSetAttribute failed\n"); grid = -1; return; }
        if (hipOccupancyMaxActiveBlocksPerMultiprocessor(&per_cu, (const void*)fwd_kernel, 512, LDS_BYTES) != hipSuccess || per_cu < 1) { fprintf(stderr, "kernel_launch: occupancy query says %d\n", per_cu); }
        (void)hipGetLastError();
        grid = cus;
    }
    if (grid < 0) return;
    (void)hipMemsetAsync((char*)d_ws + WS_CTL, 0, CTL_ZERO_BYTES, stream);
    Args a{};
    for (int i = 0; i < N_IN; ++i) a.in[i] = (const float*)d_in[i];
    a.out = (float*)d_out; a.ws = (unsigned char*)d_ws;
#if MK_N_LAUNCHES == 1
    a.ph_lo = 0; a.ph_hi = N_PHASES;
    hipLaunchKernelGGL(fwd_kernel, dim3(grid), dim3(512), LDS_BYTES, stream, a);
#else
    for (int p = 0; p < N_PHASES; ++p) { a.ph_lo = p; a.ph_hi = p + 1; hipLaunchKernelGGL(fwd_kernel, dim3(grid), dim3(512), LDS_BYTES, stream, a); }
#endif
}
```

```cpp
#include <hip/hip_runtime.h>
#include <cstdio>
#include <cstdint>

#ifndef PROBE_DUP
#define PROBE_DUP 0
#endif
#ifndef PROBE_TMASK
#define PROBE_TMASK 19
#endif
#ifndef MK_N_LAUNCHES
#define MK_N_LAUNCHES 1
#endif

#define GAS __attribute__((address_space(1)))
#define LAS __attribute__((address_space(3)))
typedef _Float16 f16;
typedef _Float16 f16x8 __attribute__((ext_vector_type(8)));
typedef _Float16 f16x4 __attribute__((ext_vector_type(4)));
typedef float f32x4 __attribute__((ext_vector_type(4)));
typedef float f32x16 __attribute__((ext_vector_type(16)));
typedef unsigned u32x4 __attribute__((ext_vector_type(4)));
typedef unsigned u32x2 __attribute__((ext_vector_type(2)));
typedef LAS unsigned char* ldsp_t;

constexpr int D = 1024, T = 8192, NB = 2, MP = NB * T, NS = 128, MALL = MP + NS, NBAT = NB + NS;
constexpr int FF = 2816, FF2 = 5632, NEV = 3072, NEVR = 2832, NOD = 2304, NMODC = 9216;
constexpr int NSITE = 12;
constexpr float EPS = 1e-6f;
__host__ __device__ __forceinline__ constexpr int site_N(int s) { return (s % 3 != 1) ? FF2 : (((s / 3) % 2 == 0) ? NEV : NOD); }
__host__ __device__ __forceinline__ constexpr int site_off(int s) { const int r = s % 6; return (s / 6) * 27904 + (r == 0 ? 0 : r == 1 ? 5632 : r == 2 ? 8704 : r == 3 ? 14336 : r == 4 ? 19968 : 22272); }
static_assert(site_off(1) == 5632 && site_off(2) == 8704 && site_off(3) == 14336 && site_off(4) == 19968 && site_off(5) == 22272 && site_off(6) == 27904 && site_off(7) == 27904 + 5632, "site_off");
constexpr int NWIN = site_off(NSITE);
static_assert(NWIN == 55808, "win rows");

constexpr size_t alignup(size_t x) { return (x + 4095) & ~(size_t)4095; }
constexpr size_t WS_CTL = 0, CTL_ZERO_BYTES = 1u << 20;
constexpr int CW_BAR = 1024;
constexpr size_t RSS_OFF = 65536;
static_assert(RSS_OFF + (size_t)13 * MALL * 4 <= CTL_ZERO_BYTES, "ctl");
constexpr size_t WS_WIN = alignup(CTL_ZERO_BYTES);
constexpr size_t WS_WFO = alignup(WS_WIN + (size_t)NWIN * D * 2);
constexpr size_t WS_WEO = alignup(WS_WFO + (size_t)8 * D * FF * 2);
constexpr size_t WS_WOO = alignup(WS_WEO + (size_t)2 * D * D * 2);
constexpr size_t WS_WMOD = alignup(WS_WOO + (size_t)2 * D * 512 * 2);
constexpr size_t WS_AC = alignup(WS_WMOD + (size_t)4 * NMODC * D * 2);
constexpr size_t WS_MOD = alignup(WS_AC + (size_t)256 * D * 2);
constexpr size_t WS_CS = alignup(WS_MOD + (size_t)NBAT * 4 * NMODC * 4);
constexpr size_t WS_GT = alignup(WS_CS + (size_t)NSITE * NBAT * D * 4);
constexpr size_t WS_RCS = alignup(WS_GT + (size_t)NSITE * NBAT * D * 4);
constexpr size_t WS_SHA = alignup(WS_RCS + (size_t)NSITE * NBAT * D * 4);
constexpr size_t WS_BW = alignup(WS_SHA + (size_t)NSITE * 256 * D * 2);
constexpr size_t WS_X = alignup(WS_BW + (size_t)NBAT * NWIN * 4);
constexpr size_t WS_A = alignup(WS_X + (size_t)MALL * D * 4);
constexpr size_t WS_H = alignup(WS_A + (size_t)MALL * D * 2);
constexpr size_t WS_Z = alignup(WS_H + (size_t)MALL * FF * 2);
constexpr size_t WS_GATES = alignup(WS_Z + (size_t)MALL * NEV * 2);
constexpr size_t WS_O = alignup(WS_GATES + (size_t)MALL * 16 * 4);
constexpr size_t WS_OG = alignup(WS_O + (size_t)MALL * D * 2);
constexpr size_t WS_LSE = alignup(WS_OG + (size_t)3 * MP * 512 * 2);
constexpr size_t WS_DC = alignup(WS_LSE + (size_t)3 * MP * 8 * 4);
constexpr size_t WS_DN = alignup(WS_DC + (size_t)16 * 64 * 4096 * 4);
constexpr size_t WS_CP = alignup(WS_DN + (size_t)16 * 64 * 64 * 4);
constexpr size_t WS_NP = alignup(WS_CP + (size_t)16 * 64 * 4096 * 2);
constexpr size_t WS_SC = alignup(WS_NP + (size_t)16 * 64 * 64 * 4);
constexpr size_t WS_END = alignup(WS_SC + (size_t)3 * 16 * 64 * 4);

constexpr size_t O_Y = 0;
constexpr size_t O_AKVP = O_Y + (size_t)MALL * D;
constexpr size_t O_AKVS = O_AKVP + (size_t)2 * 2 * 128 * 256;
constexpr size_t O_BCP = O_AKVS + (size_t)2 * 128 * 128 * 256;
constexpr size_t O_BCS = O_BCP + (size_t)2 * 2 * 8 * 4096;
constexpr size_t O_BNP = O_BCS + (size_t)2 * 128 * 8 * 4096;
constexpr size_t O_BNS = O_BNP + (size_t)2 * 2 * 8 * 64;
constexpr size_t O_BMP = O_BNS + (size_t)2 * 128 * 8 * 64;
constexpr size_t O_BMS = O_BMP + (size_t)2 * 2 * 8;
constexpr size_t O_C1P = O_BMS + (size_t)2 * 128 * 8;
constexpr size_t O_C1S = O_C1P + (size_t)2 * 2 * 128 * 256;
constexpr size_t O_C2P = O_C1S + (size_t)2 * 128 * 128 * 256;
constexpr size_t O_C2S = O_C2P + (size_t)2 * 2 * 512 * 256;
constexpr size_t O_C3P = O_C2S + (size_t)2 * 128 * 512 * 256;
constexpr size_t O_C3S = O_C3P + (size_t)2 * 2 * 2048 * 256;
constexpr size_t O_END = O_C3S + (size_t)2 * 128 * 2048 * 256;

enum { I_XP = 0, I_XS, I_CA, I_SBC, I_SBN, I_SBM, I_CC1, I_CC2, I_CC3, I_CP, I_CSMP, I_WMOD, I_BMOD, I_NG, I_FWI, I_FWO, I_EWI, I_EBG, I_ESK, I_EHG, I_EWO, I_OWI, I_OWO, I_FG, N_IN };

constexpr int RING_BYTES = 131072;
constexpr int MISC_OFF = RING_BYTES + 320;
constexpr int PF_OFF = 139264;
constexpr int EPI_OFF = 133120, EPI_STRIDE = 4096;
constexpr int LDS_BYTES = 147456;

#define RLX_AGENT __ATOMIC_RELAXED, __HIP_MEMORY_SCOPE_AGENT
#define LDS_WAIT() asm volatile("s_waitcnt lgkmcnt(0)" ::: "memory")
#define VM_WAIT() asm volatile("s_waitcnt vmcnt(0)" ::: "memory")

#define XB_TMO      128
#define XB_XCNT(j)  (256  + 64 * (j))
#define XB_XSUB(j)  (1280 + 64 * (j))
#define XB_XGEN(j)  (2304 + 64 * (j))
#define XB_TOP      3328
#define XB_TOPGEN   3392
#define XB_LSUB(j)  (3456 + 64 * (j))
#define XCD_BAR_WORDS 4480
#define XB_SPIN_CAP (1u << 21)
__device__ __forceinline__ unsigned xb_ld(unsigned* p)              { return __hip_atomic_load(p, __ATOMIC_RELAXED, __HIP_MEMORY_SCOPE_AGENT); }
__device__ __forceinline__ unsigned xb_add(unsigned* p, unsigned v) { return __hip_atomic_fetch_add(p, v, __ATOMIC_RELAXED, __HIP_MEMORY_SCOPE_AGENT); }
__device__ __forceinline__ unsigned xb_xcc_id() { return (unsigned)__builtin_amdgcn_s_getreg((3 << 11) | 20) & 0xFu; }
#define XB_SPIN(cond, bar) do { unsigned _sp = 0; while (cond) { __builtin_amdgcn_s_sleep(1); \
    if ((++_sp & 255u) == 0u) { if (xb_ld(&(bar)[XB_TMO])) break; if (_sp > XB_SPIN_CAP) { atomicAdd(&(bar)[XB_TMO], 1u); break; } } } } while (0)
struct XcdBarrier { unsigned* bar; unsigned x; volatile LAS unsigned* st; };
__device__ __forceinline__ XcdBarrier xcd_barrier_post(unsigned* bar, volatile LAS unsigned* st) {
    XcdBarrier b; b.bar = bar; b.x = xb_xcc_id(); b.st = st;
    if (threadIdx.x == 0) st[12] = xb_add(&bar[XB_XCNT(b.x)], 1u);
    return b;
}
__device__ __forceinline__ void xcd_barrier_complete(unsigned* bar, unsigned x, unsigned& nloc, unsigned& nx) {
    const unsigned G = gridDim.x * gridDim.y * gridDim.z;
    unsigned sum, cnt, mine, sp = 0u;
    for (;;) {
        sum = 0u; cnt = 0u; mine = 0u;
#pragma unroll
        for (unsigned j = 0; j < 16; ++j) { const unsigned c = xb_ld(&bar[XB_XCNT(j)]); sum += c; cnt += (c > 0u) ? 1u : 0u; mine = (j == x) ? c : mine; }
        if (sum == G) break;
        __builtin_amdgcn_s_sleep(1);
        if ((++sp & 255u) == 0u) { if (xb_ld(&bar[XB_TMO])) break; if (sp > XB_SPIN_CAP) { atomicAdd(&bar[XB_TMO], 1u); break; } }
    }
    nloc = mine > 0u ? mine : 1u; nx = cnt > 0u ? cnt : 1u;
}
__device__ __forceinline__ unsigned xcd_census_even(unsigned* bar) {
    const unsigned G = gridDim.x; if (G % 8u) return 0u;
    unsigned ok = 1u;
#pragma unroll
    for (unsigned j = 0; j < 16; ++j) { const unsigned c = xb_ld(&bar[XB_XCNT(j)]); ok &= (c == (j < 8u ? G / 8u : 0u)) ? 1u : 0u; }
    return ok;
}
constexpr int CQ_CH = 4096;
constexpr int CQ_N3 = 2047 * 16384 / CQ_CH, CQ_N2 = 511 * 16384 / CQ_CH, CQ_NA = 127 * 16384 / CQ_CH, CQ_N = CQ_N3 + CQ_N2 + 2 * CQ_NA;
constexpr int CW_Q = 512;
struct CopyQ { const float* c3; const float* c2; const float* ca; const float* c1; float* out; unsigned* head; };
__device__ __forceinline__ void copy_chunk(const CopyQ& Q, int chunk, int tid) {
    const float* in; float* out; int W;
    if (chunk < CQ_N3) { in = Q.c3; out = Q.out + O_C3S; W = 2048; }
    else if (chunk < CQ_N3 + CQ_N2) { chunk -= CQ_N3; in = Q.c2; out = Q.out + O_C2S; W = 512; }
    else if (chunk < CQ_N3 + CQ_N2 + CQ_NA) { chunk -= CQ_N3 + CQ_N2; in = Q.ca; out = Q.out + O_AKVS; W = 128; }
    else { chunk -= CQ_N3 + CQ_N2 + CQ_NA; in = Q.c1; out = Q.out + O_C1S; W = 128; }
    const unsigned wm1 = (unsigned)(W - 1);
    f32x4 v[8]; size_t doff[8];
#pragma unroll
    for (int j = 0; j < 8; ++j) {
        const unsigned i = (unsigned)chunk * CQ_CH + j * 512 + tid, r = i >> 6, es = r / wm1, rr = r - es * wm1;
        const size_t o = ((size_t)es * W + rr) * 256 + (i & 63) * 4; doff[j] = o;
        v[j] = __builtin_nontemporal_load((const f32x4*)(in + o + 256));
    }
#pragma unroll
    for (int j = 0; j < 8; ++j) __builtin_nontemporal_store(v[j], (f32x4*)(out + doff[j]));
}
template <int MODE  >
__device__ __forceinline__ void xb_wait_work(unsigned* bar, unsigned* pw, unsigned same, bool need_wait, volatile LAS unsigned* W, const CopyQ& Q) {
    const int tid = threadIdx.x;
    for (unsigned it = 0;; ++it) {
        const unsigned par = (it & 1u) * 2u;
        if (tid == 0) {
            unsigned rel = need_wait ? 0u : 1u;
            if (!rel) { for (int sp = 0; sp < 12; ++sp) { const unsigned v_ = xb_ld(pw); if (MODE == 0 ? (v_ != same) : (v_ >= same)) { rel = 1u; break; } __builtin_amdgcn_s_sleep(1); } }
            if (!rel && (it & 255u) == 255u) { if (xb_ld(&bar[XB_TMO])) rel = 1u; else if (it > (1u << 16)) { atomicAdd(&bar[XB_TMO], 1u); rel = 1u; } }
            unsigned ch = 0xffffffffu;
            if ((PROBE_DUP & 2048) == 0 && !rel && xb_ld(Q.head) < (unsigned)CQ_N) ch = xb_add(Q.head, 1u);
            W[par] = rel; W[par + 1] = ch;
        }
        __syncthreads();
        const unsigned rel = W[par], ch = W[par + 1];
        if (rel) break;
        if (ch < (unsigned)CQ_N) copy_chunk(Q, (int)ch, tid);
    }
}
__device__ __forceinline__ void xcd_barrier(const XcdBarrier& b, const CopyQ& Q) {
    asm volatile("s_waitcnt vmcnt(0)" ::: "memory");
    __syncthreads();
    unsigned* bar = b.bar;
    volatile LAS unsigned* W = b.st + 4;
    if (threadIdx.x == 0) {
        __builtin_amdgcn_s_waitcnt(0);
        unsigned nloc = b.st[0], nx = b.st[1];
        if (nloc == 0u) { xcd_barrier_complete(bar, b.x, nloc, nx); b.st[0] = nloc; b.st[1] = nx; b.st[10] = xcd_census_even(bar); }
        const unsigned old = xb_add(&bar[XB_XSUB(b.x)], 1u);
        const unsigned gen = old / nloc;
        unsigned role, val;
        if (old + 1u == (gen + 1u) * nloc) {
            __builtin_amdgcn_fence(__ATOMIC_RELEASE, "agent");
            asm volatile("s_waitcnt vmcnt(0)" ::: "memory");
            const unsigned og = xb_add(&bar[XB_TOP], 1u);
            const unsigned tg = og / nx;
            if (og + 1u == (tg + 1u) * nx) { xb_add(&bar[XB_TOPGEN], 1u); role = 2u; val = 0u; }
            else { role = 1u; val = tg; }
        } else { role = 0u; val = gen; }
        b.st[8] = role; b.st[9] = val;
    }
    __syncthreads();
    const unsigned role = b.st[8], val = b.st[9];
    xb_wait_work<0>(bar, role == 1u ? &bar[XB_TOPGEN] : &bar[XB_XGEN(b.x)], val, role != 2u, W, Q);
    if (threadIdx.x == 0) {
        __builtin_amdgcn_fence(__ATOMIC_ACQUIRE, "agent");
        if (role != 0u) xb_add(&bar[XB_XGEN(b.x)], 1u);
        asm volatile("s_waitcnt vmcnt(0)" ::: "memory");
    }
    __syncthreads();
}

__device__ __forceinline__ void xcc_barrier(const XcdBarrier& b, const CopyQ& Q) {
    asm volatile("s_waitcnt vmcnt(0)" ::: "memory");
    __syncthreads();
    unsigned* bar = b.bar;
    if (threadIdx.x == 0) {
        __builtin_amdgcn_s_waitcnt(0);
        const unsigned gen = b.st[11]; b.st[11] = gen + 1u;
        (void)xb_add(&bar[XB_LSUB(b.x)], 1u);
        b.st[9] = (gen + 1u) * b.st[0];
    }
    __syncthreads();
    const unsigned target = b.st[9];
    xb_wait_work<1>(bar, &bar[XB_LSUB(b.x)], target, true, b.st + 4, Q);
    asm volatile("" ::: "memory");
    __syncthreads();
}

__device__ __forceinline__ int opaque_v(int x) { asm volatile("" : "+v"(x)); return x; }
template <class P> __device__ __forceinline__ P* opaque_p(P* p) { asm volatile("" : "+s"(p)); return p; }
__device__ __forceinline__ float wave_sum(float v) {
#pragma unroll
    for (int o = 1; o < 64; o <<= 1) v += __shfl_xor(v, o);
    return v;
}
__device__ __forceinline__ float wave_max(float v) {
#pragma unroll
    for (int o = 1; o < 64; o <<= 1) v = fmaxf(v, __shfl_xor(v, o));
    return v;
}
__device__ __forceinline__ f16x4 cvt4(f32x4 v) { f16x4 r; r[0] = (f16)v[0]; r[1] = (f16)v[1]; r[2] = (f16)v[2]; r[3] = (f16)v[3]; return r; }
__device__ __forceinline__ f16x8 cat4(f16x4 lo, f16x4 hi) { f16x8 a; a[0] = lo[0]; a[1] = lo[1]; a[2] = lo[2]; a[3] = lo[3]; a[4] = hi[0]; a[5] = hi[1]; a[6] = hi[2]; a[7] = hi[3]; return a; }
__device__ __forceinline__ float sigmoidf_(float x) { return __builtin_amdgcn_rcpf(1.0f + __expf(-x)); }
__device__ __forceinline__ float logsigmoidf_(float x) { return fminf(x, 0.f) - log1pf(__expf(-fabsf(x))); }
__device__ __forceinline__ int row_batch(int m) { return m < MP ? (m >> 13) : (NB + m - MP); }

namespace pg8 {
constexpr int BM = 256, BK = 64, HALF = 128, HTB = HALF * BK * 2, STAGE_BYTES = 8 * HTB, NXCD = 8, WGM = 8;
__host__ __device__ __forceinline__ int lds_byte(int r, int c) { const int st = (r >> 4) * 2 + (c >> 5), rr = r & 15, cc = c & 31, ob = rr * 64 + cc * 2; return st * 1024 + (ob ^ (((ob >> 9) & 1) << 5)); }
__host__ __device__ __forceinline__ void stage_rc(int b, int& R, int& C) { const int st = b / 1024, sb = b % 1024, swz = sb ^ (((sb >> 9) & 1) << 5); R = (st >> 1) * 16 + swz / 64; C = (st & 1) * 32 + (swz % 64) / 2; }
struct Unit { int pm, pn; };
struct Gemm { const f16* A; const f16* Bt; int M, N, K; };
struct StaticOrder {
    int nM, nN, nwg, G, c;
    __host__ __device__ void init(int M, int N, int G_, int c_) { nM = M / BM; nN = N / BM; nwg = nM * nN; G = G_; c = c_; }
    __host__ __device__ bool next(int i, Unit& u) const {
        const long L = (long)i * G + c; if (L >= nwg) return false;
        int wgid = (int)L; { const int q = nwg / NXCD, r = nwg % NXCD, xcd = wgid % NXCD, off = wgid / NXCD; wgid = (xcd < r ? xcd * (q + 1) : r * (q + 1) + (xcd - r) * q) + off; }
        const int nig = WGM * nN, gid = wgid / nig, fm = gid * WGM, gsz = (nM - fm) < WGM ? (nM - fm) : WGM;
        u.pm = fm + ((wgid % nig) % gsz); u.pn = (wgid % nig) / gsz; return true;
    }
    __device__ __forceinline__ void a_ready(const Unit&) const {}
    __device__ __forceinline__ void done(const Unit&) const {}
};
struct DiagOrder {
    int G, c;
    __device__ bool next(int i, Unit& u) const {
        const int L = i * G + c; if (L >= NWIN / BM) return false;
        int s = 0, acc = 0;
#pragma unroll
        for (int k = 0; k < NSITE; ++k) { const int n = site_N(k) / BM; if (L >= acc + n) { s = k + 1; } acc += n; }
        u.pm = s; u.pn = L; return true;
    }
    __device__ __forceinline__ void a_ready(const Unit&) const {}
    __device__ __forceinline__ void done(const Unit&) const {}
};

template <class Epi, class Sched, bool ALIGN_EPI = true>
__device__ __forceinline__ void gemm_phase(ldsp_t lds, const Gemm g, const Sched& S, const Epi& E) {
    const int tid = opaque_v(threadIdx.x), wid = __builtin_amdgcn_readfirstlane(tid >> 6), lane = tid & 63, wr = wid >> 2, wc = wid & 3, fr = lane & 15, fq = lane >> 4;
    const int K = g.K, nt = K / BK;
    const int rot = (((S.c & 7) * nt) >> 3) & ~1;
    unsigned voffA[2];
#pragma unroll
    for (int i = 0; i < 2; ++i) voffA[i] = (unsigned)(tid * 16 + i * 8192);
#define voffB voffA
    const size_t kstep = (size_t)(2 * HTB);
    const size_t hstep = (size_t)HTB;
    const size_t tstep = (size_t)nt * kstep;
    const unsigned ldsw = (unsigned)wid * 1024u;
    const int aoff = lds_byte(wr * 64 + fr, fq * 8), boff = lds_byte(wc * 32 + fr, fq * 8);
#define PG8_SA(b, h) (((b) * 2 + (h)) * HTB)
#define PG8_SB(b, h) ((4 + (b) * 2 + (h)) * HTB)
#define PG8_STAGE_X(bufoff, gbase, voff, AUX) do { _Pragma("unroll") for (int _i = 0; _i < 2; ++_i) \
        __builtin_amdgcn_global_load_lds((const unsigned*)((const char*)(gbase) + (voff)[_i]), (LAS unsigned*)(lds + (bufoff) + ldsw + _i * 8192), 16, 0, AUX); } while (0)
#define PG8_STAGE(bufoff, gbase, voff) PG8_STAGE_X(bufoff, gbase, voff, 0)
#define PG8_STAGEA(bufoff, gbase, voff) PG8_STAGE_X(bufoff, gbase, voff, 16)
#define PG8_LDA(dst, b, h) do { _Pragma("unroll") for (int m = 0; m < 4; ++m) _Pragma("unroll") for (int k = 0; k < 2; ++k) dst[m][k] = *(const LAS f16x8*)(lds + PG8_SA(b, h) + aoff + m * 2048 + k * 1024); } while (0)
#define PG8_LDB(dst, b, h) do { _Pragma("unroll") for (int n = 0; n < 2; ++n) _Pragma("unroll") for (int k = 0; k < 2; ++k) dst[n][k] = *(const LAS f16x8*)(lds + PG8_SB(b, h) + boff + n * 2048 + k * 1024); } while (0)
#define PG8_MMA(ai, bj, At, Bt) do { __builtin_amdgcn_s_setprio(1); _Pragma("unroll") for (int m = 0; m < 4; ++m) _Pragma("unroll") for (int n = 0; n < 2; ++n) _Pragma("unroll") for (int k = 0; k < 2; ++k) \
        acc[ai][bj][m][n] = __builtin_amdgcn_mfma_f32_16x16x32_f16(Bt[n][k], At[m][k], acc[ai][bj][m][n], 0, 0, 0); __builtin_amdgcn_s_setprio(0); } while (0)
#define PG8_WAIT_V(n) asm volatile("s_waitcnt vmcnt(" #n ")" ::: "memory")
#define PG8_WAIT_L(n) asm volatile("s_waitcnt lgkmcnt(" #n ")" ::: "memory")
#define PG8_BAR __builtin_amdgcn_s_barrier()
#define PG8_SCHED __builtin_amdgcn_sched_barrier(0)
    Unit cur, nxt; int ui = 0;
    if (!S.next(0, cur)) return;
    f32x4 acc[2][2][4][2];
#pragma unroll
    for (int a = 0; a < 2; ++a)
#pragma unroll
        for (int b = 0; b < 2; ++b)
#pragma unroll
            for (int m = 0; m < 4; ++m)
#pragma unroll
                for (int n = 0; n < 2; ++n) acc[a][b][m][n] = (f32x4){0.f, 0.f, 0.f, 0.f};
    f16x8 At[4][2], B0[2][2], B1[2][2];
    const char* cA = (const char*)g.A + (size_t)cur.pm * tstep; const char* cB = (const char*)g.Bt + (size_t)cur.pn * tstep;
    S.a_ready(cur);
    const size_t rstep = (size_t)rot * kstep;
    PG8_STAGE(PG8_SB(0, 0), cB + rstep, voffB); PG8_STAGE(PG8_SB(0, 1), cB + rstep + hstep, voffB); PG8_STAGEA(PG8_SA(0, 0), cA + rstep, voffA); PG8_STAGEA(PG8_SA(0, 1), cA + rstep + hstep, voffA);
    if (wr == 1) PG8_BAR;
    PG8_WAIT_V(2); PG8_BAR;
    PG8_STAGE(PG8_SB(1, 0), cB + rstep + kstep, voffB); PG8_STAGEA(PG8_SA(1, 0), cA + rstep + kstep, voffA); PG8_STAGE(PG8_SB(1, 1), cB + rstep + hstep + kstep, voffB);
    PG8_WAIT_V(6); PG8_BAR;
    if constexpr (Epi::HAS_PRE) E.pre(cur, (LAS float*)(lds + EPI_OFF), wid, opaque_v(lane));
    for (;;) {
        const bool has_next = S.next(ui + 1, nxt);
        const char* nA = has_next ? (const char*)g.A + (size_t)nxt.pm * tstep : cA; const char* nB = has_next ? (const char*)g.Bt + (size_t)nxt.pn * tstep : cB;
        for (int t = 0; t < nt; t += 2) {
            const bool last = (t == nt - 2);
            int t1 = t + 1 + rot, t2 = t + 2 + rot; t1 -= (t1 >= nt) ? nt : 0; t2 -= (t2 >= nt) ? nt : 0;
            const char* a1 = cA + (size_t)t1 * kstep;
            const size_t nxoff = has_next ? rstep : (size_t)((nt - 2 + rot) % nt) * kstep;
            const char* a2 = last ? nA + nxoff : cA + (size_t)t2 * kstep; const char* b2 = last ? nB + nxoff : cB + (size_t)t2 * kstep;
            const char* a3 = a2 + kstep; const char* b3 = b2 + kstep;
            if (last && has_next) S.a_ready(nxt);
            PG8_LDB(B0, 0, 0); PG8_LDB(B1, 0, 1); PG8_SCHED; PG8_LDA(At, 0, 0); PG8_STAGEA(PG8_SA(1, 1), a1 + hstep, voffA);
            PG8_WAIT_V(8); PG8_WAIT_L(0); PG8_BAR; PG8_MMA(0, 0, At, B0); PG8_MMA(0, 1, At, B1); PG8_BAR; PG8_SCHED;
            PG8_LDA(At, 0, 1); PG8_STAGE(PG8_SB(0, 0), b2, voffB); PG8_STAGE(PG8_SB(0, 1), b2 + hstep, voffB); PG8_STAGEA(PG8_SA(0, 0), a2, voffA);
            PG8_WAIT_V(8); PG8_WAIT_L(0); PG8_BAR; PG8_MMA(1, 0, At, B0); PG8_MMA(1, 1, At, B1); PG8_BAR; PG8_SCHED;
            PG8_LDB(B0, 1, 0); PG8_LDB(B1, 1, 1); PG8_SCHED; PG8_LDA(At, 1, 0); PG8_STAGEA(PG8_SA(0, 1), a2 + hstep, voffA);
            PG8_WAIT_V(8); PG8_WAIT_L(0); PG8_BAR; PG8_MMA(0, 0, At, B0); PG8_MMA(0, 1, At, B1); PG8_BAR; PG8_SCHED;
            PG8_LDA(At, 1, 1); PG8_STAGE(PG8_SB(1, 0), b3, voffB); PG8_STAGE(PG8_SB(1, 1), b3 + hstep, voffB); PG8_STAGEA(PG8_SA(1, 0), a3, voffA);
            PG8_WAIT_V(8); PG8_WAIT_L(0); PG8_BAR; PG8_MMA(1, 0, At, B0); PG8_MMA(1, 1, At, B1); PG8_BAR; PG8_SCHED;
        }
        if constexpr (ALIGN_EPI) { if (wr == 0) PG8_BAR; }
        E(acc, cur, wr, wc, fr, fq, (const LAS float*)(lds + EPI_OFF + (ui & 1) * EPI_STRIDE)); S.done(cur);
        if (!has_next) break;
#pragma unroll
        for (int a = 0; a < 2; ++a)
#pragma unroll
            for (int b = 0; b < 2; ++b)
#pragma unroll
                for (int m = 0; m < 4; ++m)
#pragma unroll
                    for (int n = 0; n < 2; ++n) acc[a][b][m][n] = (f32x4){0.f, 0.f, 0.f, 0.f};
        cur = nxt; cA = nA; cB = nB; ++ui;
        if constexpr (Epi::HAS_PRE) E.pre(cur, (LAS float*)(lds + EPI_OFF + (ui & 1) * EPI_STRIDE), wid, opaque_v(lane));
        if constexpr (ALIGN_EPI) { if (wr == 1) PG8_BAR; }
    }
    PG8_WAIT_V(0);
    if constexpr (!ALIGN_EPI) { if (wr == 0) PG8_BAR; }
    PG8_BAR;
#undef PG8_SA
#undef PG8_SB
#undef PG8_STAGE
#undef voffB
#undef PG8_STAGEA
#undef PG8_STAGE_X
#undef PG8_LDA
#undef PG8_LDB
#undef PG8_MMA
#undef PG8_WAIT_V
#undef PG8_WAIT_L
#undef PG8_BAR
#undef PG8_SCHED
}
}
__host__ __device__ __forceinline__ size_t tiled_byte(int row, int col, int K) {
    return ((size_t)((row >> 8) * (K >> 6) + (col >> 6)) * 2 + ((row >> 7) & 1)) * 16384 + (size_t)pg8::lds_byte(row & 127, col & 63);
}
template <class V> __device__ __forceinline__ V* tiled_ptr(f16* base, int row, int col, int K) { return (V*)((char*)base + tiled_byte(row, col, K)); }

using pg8::Unit;
struct EpiSwiglu {
    static constexpr bool HAS_PRE = true;
    const float* rowss; const float* BW; f16* H;
    __device__ __forceinline__ void pre(const Unit& u, LAS float* ev, int wid, int lane) const {
        const int i = (wid & 3) * 64 + lane;
        const float* src = (wid < 4) ? rowss + u.pm * 256 + i : BW + (size_t)(u.pm >> 5) * NWIN + u.pn * 256 + i;
        __builtin_amdgcn_global_load_lds((const unsigned*)src, (LAS unsigned*)(ev + (wid < 4 ? 0 : 256) + (wid & 3) * 64), 4, 0, 0);
    }
    __device__ __forceinline__ static f16x4 act(f32x4 g, f32x4 u, float r, f32x4 bg, f32x4 bu) {
        f32x4 o;
#pragma unroll
        for (int e = 0; e < 4; ++e) { const float gg = g[e] * r + bg[e], uu = u[e] * r + bu[e]; o[e] = gg * uu * __builtin_amdgcn_rcpf(1.0f + __expf(-gg)); }
        return cvt4(o);
    }
    __device__ __forceinline__ void operator()(const f32x4 (&acc)[2][2][4][2], const Unit& u, int wr, int wc, int fr_in, int fq_in, const LAS float* ev) const {
        const int fr = opaque_v(fr_in), fq = opaque_v(fq_in);
        f32x4 bg[2], bu[2];
#pragma unroll
        for (int bj = 0; bj < 2; ++bj) { const int cg = 256 + bj * 128 + wc * 32 + 4 * fq; bg[bj] = *(const LAS f32x4*)(ev + cg); bu[bj] = *(const LAS f32x4*)(ev + cg + 16); }
        char* hb = (char*)H + (size_t)(u.pm * (FF / 64) + 2 * u.pn + (wc >> 1)) * 32768 + (size_t)(8 * wr + (wc & 1)) * 1024;
        const unsigned lo = (unsigned)(fr * 64 + ((16 * fq) ^ (32 * (fr >> 3))));
#pragma unroll
        for (int ai = 0; ai < 2; ++ai)
#pragma unroll
            for (int m = 0; m < 4; ++m) {
                const float r = rsqrtf(ev[ai * 128 + wr * 64 + m * 16 + fr] * (1.0f / D) + EPS);
                const f16x4 h0 = act(acc[ai][0][m][0], acc[ai][0][m][1], r, bg[0], bu[0]), h1 = act(acc[ai][1][m][0], acc[ai][1][m][1], r, bg[1], bu[1]);
                *(f16x8*)(hb + lo + (ai * 16384 + m * 2048)) = cat4(h0, h1);
            }
    }
    __device__ __forceinline__ void sk(int row, int q32, int e4, f32x4 g, f32x4 u) const {
        const int b = row_batch(row); const float* bias = BW + (size_t)b * NWIN + q32 * 32 + e4;
        const float r = rsqrtf(rowss[row] * (1.0f / D) + EPS);
        *(f16x4*)(H + (size_t)row * FF + 128 * (q32 >> 3) + 32 * (q32 & 3) + 2 * e4 + 4 * ((q32 >> 2) & 1)) = act(g, u, r, *(const f32x4*)bias, *(const f32x4*)(bias + 16));
    }
};
struct EpiRes {
    static constexpr bool HAS_PRE = true;
    f16* X; f16* A; float* rowss_next; const float* GT; const float* CS; const float* RCS;
    __device__ __forceinline__ void pre(const Unit& u, LAS float* ev, int wid, int lane) const {
        const int i = (wid & 3) * 64 + lane; const size_t o = (size_t)(u.pm >> 5) * D + u.pn * 256 + i;
        if (wid < 4) { __builtin_amdgcn_global_load_lds((const unsigned*)(GT + o), (LAS unsigned*)(ev + (wid & 3) * 64), 4, 0, 0);
                       __builtin_amdgcn_global_load_lds((const unsigned*)(RCS + o), (LAS unsigned*)(ev + 512 + (wid & 3) * 64), 4, 0, 0); }
        else if (CS) __builtin_amdgcn_global_load_lds((const unsigned*)(CS + o), (LAS unsigned*)(ev + 256 + (wid & 3) * 64), 4, 0, 0);
    }
    __device__ __forceinline__ void operator()(const f32x4 (&acc)[2][2][4][2], const Unit& u, int wr, int wc, int fr_in, int fq_in, const LAS float* ev) const {
        const int fr = opaque_v(fr_in), fq = opaque_v(fq_in);
        const int col0 = u.pn * 256 + wc * 32 + 8 * fq;
        const LAS float* gt = ev + wc * 32 + 8 * fq; const LAS float* cs = ev + 256 + wc * 32 + 8 * fq; const LAS float* rc = ev + 512 + wc * 32 + 8 * fq;
        char* ab = (char*)A + (size_t)(u.pm * (D / 64) + 4 * u.pn + (wc >> 1)) * 32768 + (size_t)(8 * wr + (wc & 1)) * 1024;
        const unsigned lo = (unsigned)(fr * 64 + ((16 * fq) ^ (32 * (fr >> 3))));
        const bool lastsite = (CS == nullptr);
        f32x4 gv[2][2], rv[2][2], cv[2][2];
#pragma unroll
        for (int bj = 0; bj < 2; ++bj)
#pragma unroll
            for (int n = 0; n < 2; ++n) { gv[bj][n] = *(const LAS f32x4*)(gt + bj * 128 + 4 * n); rv[bj][n] = *(const LAS f32x4*)(rc + bj * 128 + 4 * n); cv[bj][n] = *(const LAS f32x4*)(cs + bj * 128 + 4 * n); }
#pragma unroll
        for (int ai = 0; ai < 2; ++ai)
#pragma unroll
            for (int m = 0; m < 4; ++m) {
                const int row = u.pm * 256 + ai * 128 + wr * 64 + m * 16 + fr;
                float ss = 0.f;
#pragma unroll
                for (int bj = 0; bj < 2; ++bj) {
                    const int off = bj * 128;
                    f16x8* ap = (f16x8*)(ab + lo + (bj * 65536 + ai * 16384 + m * 2048));
                    const f16x8 ah = *ap;
                    f16x4 ao[2];
#pragma unroll
                    for (int n = 0; n < 2; ++n) {
                        f32x4 x = {(float)ah[4 * n], (float)ah[4 * n + 1], (float)ah[4 * n + 2], (float)ah[4 * n + 3]}; x = x * rv[bj][n] + gv[bj][n] * acc[ai][bj][m][n];
                        ss += (x[0] * x[0] + x[1] * x[1]) + (x[2] * x[2] + x[3] * x[3]);
                        ao[n] = cvt4(lastsite ? x : x * cv[bj][n]);
                    }
                    if (lastsite) *(f16x8*)(X + (size_t)row * D + col0 + off) = cat4(ao[0], ao[1]);
                    else *ap = cat4(ao[0], ao[1]);
                }
                ss += __shfl_xor(ss, 16); ss += __shfl_xor(ss, 32);
                if (fq == 0) atomicAdd(rowss_next + row, ss);
            }
    }
    __device__ __forceinline__ static int slot2col(int slot) { return (slot & ~31) + 8 * ((slot & 15) >> 2) + 4 * ((slot >> 4) & 1); }
    __device__ __forceinline__ void sk(int row, int slot, f32x4 v) const {
        const int col = slot2col(slot);
        const int b = row_batch(row);
        const f32x4 g4 = *(const f32x4*)(GT + (size_t)b * D + col), r4 = *(const f32x4*)(RCS + (size_t)b * D + col);
        f16* ar = A + (size_t)row * D + col; const f16x4 ah = *(const f16x4*)ar;
        f32x4 x = {(float)ah[0], (float)ah[1], (float)ah[2], (float)ah[3]}; x = x * r4 + g4 * v;
        if (CS) *(f16x4*)ar = cvt4(x * *(const f32x4*)(CS + (size_t)b * D + col));
        else *(f16x4*)(X + (size_t)row * D + col) = cvt4(x);
        atomicAdd(rowss_next + row, (x[0] * x[0] + x[1] * x[1]) + (x[2] * x[2] + x[3] * x[3]));
    }
};
template <bool EVEN> struct EpiZ {
    static constexpr bool HAS_PRE = true;
    const float* rowss; const float* BW; f16* Z; float* GATES;
    __device__ __forceinline__ void pre(const Unit& u, LAS float* ev, int wid, int lane) const {
        const int i = (wid & 3) * 64 + lane;
        const float* src = (wid < 4) ? rowss + u.pm * 256 + i : BW + (size_t)(u.pm >> 5) * NWIN + u.pn * 256 + i;
        __builtin_amdgcn_global_load_lds((const unsigned*)src, (LAS unsigned*)(ev + (wid < 4 ? 0 : 256) + (wid & 3) * 64), 4, 0, 0);
    }
    static constexpr int LDZ = EVEN ? NEV : NOD;
    __device__ __forceinline__ void put(int row, int col, f32x4 z) const {
        if (EVEN) {
            if (col < 2816) { if (col >= 1280 && col < 1792) z = z * 0.125f; *(f16x4*)(Z + (size_t)row * LDZ + col) = cvt4(z); }
            else if (col < NEVR) *(f32x4*)(GATES + (size_t)row * 16 + (col - 2816)) = z;
        } else *(f16x4*)(Z + (size_t)row * LDZ + col) = cvt4(z);
    }
    __device__ __forceinline__ void put8(int row, int col, f32x4 z0, f32x4 z1) const {
        if (EVEN) {
            if (col < 2816) { if (col >= 1280 && col < 1792) { z0 = z0 * 0.125f; z1 = z1 * 0.125f; } *(f16x8*)(Z + (size_t)row * LDZ + col) = cat4(cvt4(z0), cvt4(z1)); }
            else if (col < NEVR) { float* gp = GATES + (size_t)row * 16 + (col - 2816); *(f32x4*)gp = z0; *(f32x4*)(gp + 4) = z1; }
        } else *(f16x8*)(Z + (size_t)row * LDZ + col) = cat4(cvt4(z0), cvt4(z1));
    }
    __device__ __forceinline__ static int slot2col(int slot) { return (slot & ~31) + 8 * ((slot & 15) >> 2) + 4 * ((slot >> 4) & 1); }
    __device__ __forceinline__ void operator()(const f32x4 (&acc)[2][2][4][2], const Unit& u, int wr, int wc, int fr_in, int fq_in, const LAS float* ev) const {
        const int fr = opaque_v(fr_in), fq = opaque_v(fq_in);
        const int col0 = u.pn * 256 + wc * 32 + 8 * fq;
        f32x4 bv[2][2];
#pragma unroll
        for (int bj = 0; bj < 2; ++bj)
#pragma unroll
            for (int n = 0; n < 2; ++n) bv[bj][n] = *(const LAS f32x4*)(ev + 256 + wc * 32 + 4 * fq + bj * 128 + n * 16);
#pragma unroll
        for (int ai = 0; ai < 2; ++ai)
#pragma unroll
            for (int m = 0; m < 4; ++m) {
                const int row = u.pm * 256 + ai * 128 + wr * 64 + m * 16 + fr;
                const float r = rsqrtf(ev[ai * 128 + wr * 64 + m * 16 + fr] * (1.0f / D) + EPS);
#pragma unroll
                for (int bj = 0; bj < 2; ++bj) put8(row, col0 + bj * 128, acc[ai][bj][m][0] * r + bv[bj][0], acc[ai][bj][m][1] * r + bv[bj][1]);
            }
    }
    __device__ __forceinline__ void sk(int row, int slot, f32x4 v) const {
        const int b = row_batch(row); const float r = rsqrtf(rowss[row] * (1.0f / D) + EPS);
        put(row, slot2col(slot), v * r + *(const f32x4*)(BW + (size_t)b * NWIN + slot));
    }
};
struct EpiMod {
    static constexpr bool HAS_PRE = false;
    float* CS; float* GT; f16* SHA; const float* bmod; const float* NG; float* RCS;
    __device__ __forceinline__ void operator()(const f32x4 (&acc)[2][2][4][2], const Unit& u, int wr, int wc, int fr_in, int fq_in, const LAS float* ev) const {
        const int fr = opaque_v(fr_in), fq = opaque_v(fq_in);
        const int cu = u.pn * 256, l = cu / NMODC, jj = (cu - l * NMODC) >> 10, j = jj / 3, kind = jj - 3 * j, s = 3 * l + j;
        const int d0 = (cu & 1023) + wc * 32 + 4 * fq;
#pragma unroll
        for (int ai = 0; ai < 2; ++ai)
#pragma unroll
            for (int m = 0; m < 4; ++m) {
                const int row = ai * 128 + wr * 64 + m * 16 + fr;
#pragma unroll
                for (int bj = 0; bj < 2; ++bj)
#pragma unroll
                    for (int n = 0; n < 2; ++n) {
                        const int d = d0 + bj * 128 + n * 16;
                        const f32x4 v = acc[ai][bj][m][n] + *(const f32x4*)(bmod + cu - (cu & 1023) + d);
                        if (kind == 0) *tiled_ptr<f16x4>(SHA, s * 256 + row, d, D) = row < NBAT ? cvt4(v) : (f16x4){0, 0, 0, 0};
                        else if (row < NBAT) {
                            if (kind == 1) { const f32x4 c4 = *(const f32x4*)(NG + (l * 3 + j) * D + d) * (v + 1.0f); *(f32x4*)(CS + ((size_t)s * NBAT + row) * D + d) = c4;
                                *(f32x4*)(RCS + ((size_t)s * NBAT + row) * D + d) = (f32x4){1.0f / c4[0], 1.0f / c4[1], 1.0f / c4[2], 1.0f / c4[3]}; }
                            else *(f32x4*)(GT + ((size_t)s * NBAT + row) * D + d) = v * (j == 1 ? 1.0f : 0.5f);
                        }
                    }
            }
    }
};
struct EpiBias {
    static constexpr bool HAS_PRE = false;
    float* BW;
    __device__ __forceinline__ void operator()(const f32x4 (&acc)[2][2][4][2], const Unit& u, int wr, int wc, int fr_in, int fq_in, const LAS float* ev) const {
        const int fr = opaque_v(fr_in), fq = opaque_v(fq_in);
        const int col0 = u.pn * 256 + wc * 32 + 4 * fq;
#pragma unroll
        for (int ai = 0; ai < 2; ++ai)
#pragma unroll
            for (int m = 0; m < 4; ++m) {
                const int row = ai * 128 + wr * 64 + m * 16 + fr;
                if (row < NBAT) {
#pragma unroll
                    for (int bj = 0; bj < 2; ++bj)
#pragma unroll
                        for (int n = 0; n < 2; ++n) *(f32x4*)(BW + (size_t)row * NWIN + col0 + bj * 128 + n * 16) = acc[ai][bj][m][n];
                }
            }
    }
};

template <bool SWIGLU, int K, class Epi>
__device__ __forceinline__ void skinny_phase(ldsp_t lds, const f16* A, const f16* Bt, int N, const Epi& E, int G, int c, int nunits) {
    const int tid = opaque_v(threadIdx.x), wid = __builtin_amdgcn_readfirstlane(tid >> 6), lane = tid & 63, fr = lane & 15, fq = lane >> 4;
    const int grp = c & 7, rem = nunits % G, r0 = (rem + 7 - grp) >> 3;
    int r = (c >> 3) - r0, nr = ((G - grp + 7) >> 3) - r0;
    if (r < 0 || nr <= 0) { if (nr > 0) return; r = c >> 3; nr = (G - grp + 7) >> 3; }
    constexpr int AS = K + 8;
    constexpr int KS = (!SWIGLU && K > 2048) ? 4 : 1;
    LAS f16* As = (LAS f16*)lds;
    LAS float* red = (LAS float*)(lds + 16 * AS * 2);
    const f16* Ag = A + (size_t)(16 * grp) * K;
    for (int i = tid; i < 16 * (K / 8); i += 512) { const int row = i / (K / 8), ch = i - row * (K / 8);
        const unsigned long long* gp = (const unsigned long long*)(Ag + (size_t)row * K + 8 * ch);
        const unsigned long long lo = __hip_atomic_load(gp, __ATOMIC_RELAXED, __HIP_MEMORY_SCOPE_AGENT), hi = __hip_atomic_load(gp + 1, __ATOMIC_RELAXED, __HIP_MEMORY_SCOPE_AGENT);
        LAS unsigned long long* lp = (LAS unsigned long long*)(As + row * AS + 8 * ch); lp[0] = lo; lp[1] = hi; }
    __syncthreads();
    const int nitem = SWIGLU ? N / 32 : N / 16;
    const LAS f16* ap = As + fr * AS + 8 * fq;
    const int wq = wid / KS, kq = wid - wq * KS, nwq = 8 / KS;
    constexpr int KSTEPS = K / 32 / KS;
    for (int t0 = 0; t0 < nitem; t0 += nwq * nr) {
        const int t = t0 + wq * nr + r; const bool on = t < nitem;
        const int n0 = SWIGLU ? 32 * t : 16 * t;
        f32x4 acc0 = {0.f, 0.f, 0.f, 0.f}, acc1 = {0.f, 0.f, 0.f, 0.f};
        if (on) {
            const char* bp = (const char*)Bt + tiled_byte(n0 + fr, 8 * fq, K);
            const LAS f16* apk = ap + 32 * KSTEPS * kq;
#pragma unroll 8
            for (int ks = 0; ks < KSTEPS; ++ks) {
                const int kg = KSTEPS * kq + ks; const size_t ko = (size_t)(kg >> 1) * 32768 + (size_t)(kg & 1) * 1024;
                const f16x8 a = *(const LAS f16x8*)(apk + 32 * ks);
                const f16x8 b0 = *(const f16x8*)(bp + ko);
                acc0 = __builtin_amdgcn_mfma_f32_16x16x32_f16(b0, a, acc0, 0, 0, 0);
                if constexpr (SWIGLU) { const f16x8 b1 = *(const f16x8*)(bp + ko + 2048); acc1 = __builtin_amdgcn_mfma_f32_16x16x32_f16(b1, a, acc1, 0, 0, 0); }
            }
        }
        if constexpr (KS > 1) {
            *(LAS f32x4*)(red + (wid * 64 + lane) * 4) = acc0;
            __syncthreads();
            if (kq == 0) {
#pragma unroll
                for (int j = 1; j < KS; ++j) acc0 = acc0 + *(const LAS f32x4*)(red + ((wid + j) * 64 + lane) * 4);
            }
            __syncthreads();
        }
        const int row = MP + 16 * grp + fr;
        if (on && kq == 0) {
            if constexpr (SWIGLU) E.sk(row, t, 4 * fq, acc0, acc1);
            else E.sk(row, n0 + 4 * fq, acc0);
        }
    }
    __syncthreads();
}

struct Frame {
    ldsp_t lds; int tid, lane, wave, G, bid;
    float* out; unsigned char* ws;
};
#define FIN(i) (((const float* const __attribute__((address_space(4)))*)__builtin_amdgcn_kernarg_segment_ptr())[i])
#define WSP(T_, off) ((T_*)(F.ws + (off)))

__device__ __forceinline__ void tr_item(const float* W, int K, int Nsrc, int Ndst, int perm, f16* WT, LAS float* scr, int item, int lane) {
    const int nblk = Ndst / 64, kb = item / nblk, nb64 = item - kb * nblk, k0 = 32 * kb, n0 = 64 * nb64;
    const int kr = lane >> 4, c16 = lane & 15, nb = 2 * nb64 + (c16 >> 3), c4 = c16 & 7;
    int sc = 32 * nb + 4 * c4;
    if (perm == 2) sc = 32 * nb + 8 * (c4 & 3) + 4 * (c4 >> 2);
    else if (perm == 1) sc = (c4 >> 2) * FF + 128 * (nb64 >> 2) + 32 * (nb64 & 3) + 8 * (c4 & 3) + 4 * (c16 >> 3);
    const bool ok = sc < Nsrc;
    f32x4 v[8];
#pragma unroll
    for (int i = 0; i < 8; ++i) v[i] = ok ? __builtin_nontemporal_load((const f32x4*)(W + (size_t)(k0 + 4 * i + kr) * Nsrc + sc)) : (f32x4){0.f, 0.f, 0.f, 0.f};
#pragma unroll
    for (int i = 0; i < 8; ++i) { LAS float* d = scr + (4 * i + kr) * 65 + 4 * c16; d[0] = v[i][0]; d[1] = v[i][1]; d[2] = v[i][2]; d[3] = v[i][3]; }
    LDS_WAIT(); asm volatile("" ::: "memory");
    const int c = lane & 3;
#pragma unroll
    for (int j = 0; j < 4; ++j) { const int n = (lane >> 2) + 16 * j; const LAS float* sp = scr + (8 * c) * 65 + n;
        f16x8 o;
#pragma unroll
        for (int e = 0; e < 8; ++e) o[e] = (f16)sp[e * 65];
        const int row = perm == 1 ? 256 * (nb64 >> 2) + 128 * (n >> 5) + 32 * (nb64 & 3) + (n & 31) : n0 + n;
        *tiled_ptr<f16x8>(WT, row, k0 + 8 * c, K) = o; }
    LDS_WAIT(); asm volatile("" ::: "memory");
}
struct MatDesc { const float* src; int K, Nsrc, Ndst, perm; f16* dst; };
__device__ __forceinline__ void mat_desc(Frame& F, int mi, MatDesc& d) {
    if (mi < 8) { const int l = mi >> 1, i = mi & 1; d = {FIN(I_FWI) + (size_t)mi * D * FF2, D, FF2, FF2, 1, WSP(f16, WS_WIN) + (size_t)site_off(3 * l + 2 * i) * D}; }
    else if (mi < 10) { const int e = mi - 8; d = {FIN(I_EWI) + (size_t)e * D * NEVR, D, NEVR, NEV, 2, WSP(f16, WS_WIN) + (size_t)site_off(6 * e + 1) * D}; }
    else if (mi < 12) { const int o = mi - 10; d = {FIN(I_OWI) + (size_t)o * D * NOD, D, NOD, NOD, 2, WSP(f16, WS_WIN) + (size_t)site_off(6 * o + 4) * D}; }
    else if (mi < 20) { const int k = mi - 12; d = {FIN(I_FWO) + (size_t)k * FF * D, FF, D, D, 2, WSP(f16, WS_WFO) + (size_t)k * D * FF}; }
    else if (mi < 22) { const int e = mi - 20; d = {FIN(I_EWO) + (size_t)e * D * D, D, D, D, 2, WSP(f16, WS_WEO) + (size_t)e * D * D}; }
    else if (mi < 24) { const int o = mi - 22; d = {FIN(I_OWO) + (size_t)o * 512 * D, 512, D, D, 2, WSP(f16, WS_WOO) + (size_t)o * D * 512}; }
    else { const int l = mi - 24; d = {FIN(I_WMOD) + (size_t)l * D * NMODC, D, NMODC, NMODC, 0, WSP(f16, WS_WMOD) + (size_t)l * NMODC * D}; }
}
__device__ __forceinline__ void cache_shift(const float* in, float* out, int W, size_t gtid, size_t gstride) {
    const size_t per = (size_t)(W - 1) * 64, total = per * 256;
    for (size_t i = gtid; i < total; i += gstride) {
        const size_t es = i / per, off = i - es * per;
        const f32x4 v = __builtin_nontemporal_load((const f32x4*)(in + es * (size_t)W * 256 + 256) + off);
        __builtin_nontemporal_store(v, (f32x4*)(out + es * (size_t)W * 256) + off);
    }
}
__device__ __forceinline__ void phase_pr0(Frame& F, int mlo, int mhi, bool do_ac, unsigned* ctr) {
    LAS float* scr = (LAS float*)(F.lds + F.wave * 16384);
    const int gw = F.bid * 8 + F.wave, NGW = F.G * 8;
    if (ctr) {
        int total = 0;
        for (int mi = mlo; mi < mhi; ++mi) { MatDesc d; mat_desc(F, mi, d); total += (d.K / 64) * (d.Ndst / 32); }
        for (;;) {
            unsigned g0 = 0; if (F.lane == 0) g0 = xb_add(ctr, 4u);
            g0 = (unsigned)__builtin_amdgcn_readfirstlane((int)g0);
            if ((int)g0 >= total) break;
            for (int j = 0; j < 4 && (int)g0 + j < total; ++j) {
                int g = (int)g0 + j, mi = mlo; MatDesc d; mat_desc(F, mi, d); int items = (d.K / 64) * (d.Ndst / 32);
                while (g >= items) { g -= items; ++mi; mat_desc(F, mi, d); items = (d.K / 64) * (d.Ndst / 32); }
                tr_item(d.src, d.K, d.Nsrc, d.Ndst, d.perm, d.dst, scr, g, F.lane);
            }
        }
    } else {
    int base = 0;
    for (int mi = mlo; mi < mhi; ++mi) {
        MatDesc d; mat_desc(F, mi, d);
        const int items = (d.K / 64) * (d.Ndst / 32);
        int it = gw - (base % NGW); if (it < 0) it += NGW;
        for (; it < items; it += NGW) tr_item(d.src, d.K, d.Nsrc, d.Ndst, d.perm, d.dst, scr, it, F.lane);
        base += items;
    }
    }
    if (do_ac) { f16* AC = WSP(f16, WS_AC);
      for (int i = F.bid * 512 + F.tid; i < 256 * D; i += F.G * 512) { const int b = i >> 10, d = i & 1023; float v = 0.f;
          if (b < NBAT) { const float c = b < NB ? FIN(I_CP)[b * D + d] : FIN(I_CSMP)[(b - NB) * D + d]; v = c / (1.0f + __expf(-c)); }
          *tiled_ptr<f16>(AC, b, d, D) = (f16)v; } }
}
__device__ __forceinline__ void phase_pr2(Frame& F) {
    const float* CS0 = WSP(float, WS_CS);
    f16* X = WSP(f16, WS_X); f16* A = WSP(f16, WS_A); float* rowss = (float*)(F.ws + RSS_OFF);
    constexpr int NU = NWIN / 256, NIT = MALL / 4;
    const int nbw = (F.G < NU ? F.G : NU) * 8, nfw = F.G * 8 - nbw;
    int it_lo = 0, it_hi = NIT, it_idx = F.bid * 8 + F.wave, it_st = F.G * 8;
    if (nfw > 0) { const int ib = NIT < nbw ? NIT : nbw;
        if (F.bid < NU) { it_hi = ib; it_st = nbw; } else { it_lo = ib; it_idx = (F.bid - NU) * 8 + F.wave; it_st = nfw; } }
    for (int it = it_lo + it_idx; it < it_hi; it += it_st) { const int m0 = it * 4;
        f32x4 xv[4][4];
#pragma unroll
        for (int r = 0; r < 4; ++r) { const int m = m0 + r; const float* xr = m < MP ? FIN(I_XP) + (size_t)m * D : FIN(I_XS) + (size_t)(m - MP) * D;
#pragma unroll
            for (int q = 0; q < 4; ++q) xv[r][q] = __builtin_nontemporal_load((const f32x4*)(xr + q * 256 + F.lane * 4)); }
#pragma unroll
        for (int r = 0; r < 4; ++r) { const int m = m0 + r; const float* cs = CS0 + (size_t)row_batch(m) * D; float ss = 0.f;
#pragma unroll
            for (int q = 0; q < 4; ++q) { const int d = q * 256 + F.lane * 4;
                const f32x4 x = xv[r][q];
                ss += (x[0] * x[0] + x[1] * x[1]) + (x[2] * x[2] + x[3] * x[3]);
                const f16x4 av = cvt4(x * *(const f32x4*)(cs + d));
                if (m < MP) *tiled_ptr<f16x4>(A, m, d, D) = av; else *(f16x4*)(A + (size_t)m * D + d) = av; }
            ss = wave_sum(ss);
            if (F.lane == 0) rowss[m] = ss; }
    }
}
template <int O0, int O1, int O2, int O3, int O4, int O5, int O6, int O7>
__device__ __forceinline__ void tr_read8(unsigned base, f16x4 (&r)[8]) {
    asm volatile("ds_read_b64_tr_b16 %0, %8 offset:%9\n\tds_read_b64_tr_b16 %1, %8 offset:%10\n\tds_read_b64_tr_b16 %2, %8 offset:%11\n\tds_read_b64_tr_b16 %3, %8 offset:%12\n\t"
                 "ds_read_b64_tr_b16 %4, %8 offset:%13\n\tds_read_b64_tr_b16 %5, %8 offset:%14\n\tds_read_b64_tr_b16 %6, %8 offset:%15\n\tds_read_b64_tr_b16 %7, %8 offset:%16\n\ts_waitcnt lgkmcnt(0)"
                 : "=&v"(r[0]), "=&v"(r[1]), "=&v"(r[2]), "=&v"(r[3]), "=&v"(r[4]), "=&v"(r[5]), "=&v"(r[6]), "=&v"(r[7])
                 : "v"(base), "n"(O0), "n"(O1), "n"(O2), "n"(O3), "n"(O4), "n"(O5), "n"(O6), "n"(O7) : "memory");
}
__device__ __forceinline__ unsigned lds_addr(const LAS void* p) { return (unsigned)(unsigned long long)p; }
struct BandAttn { const f16* Z; int ldz, qcol, kcol, vcol; f16* O; int ldo, ocol; float* LSE; const float* sinks; int tiledO; };
constexpr int KS_STR = 72, VS_STR = 96;
constexpr int ATT_KS = 0, ATT_VS = 256 * KS_STR * 2;
__device__ __forceinline__ void band_attn_unit(ldsp_t lds, const BandAttn& P, int tokbase, int stride, int blk, int kvh) {
    const int tid = opaque_v(threadIdx.x), w = __builtin_amdgcn_readfirstlane(tid >> 6), lane = tid & 63, c = lane & 31, hh = lane >> 5;
    LAS f16* Ks = (LAS f16*)(lds + ATT_KS); LAS f16* Vs = (LAS f16*)(lds + ATT_VS);
    f16x8 qfa[2][4];
    { const int head_ = kvh * 4 + (w >> 1);
#pragma unroll
      for (int qt = 0; qt < 2; ++qt) { const int mr_ = tokbase + stride * (128 * blk + 64 * (w & 1) + 32 * qt + c);
#pragma unroll
          for (int ks = 0; ks < 4; ++ks) qfa[qt][ks] = *(const f16x8*)(P.Z + (size_t)mr_ * P.ldz + P.qcol + head_ * 64 + 16 * ks + 8 * hh); } }
#pragma unroll
    for (int i = 0; i < 4; ++i) {
        const int cid = tid + 512 * i, key = cid >> 3, ch = cid & 7, p = 128 * blk - 128 + key;
        f16x8 kv = {0, 0, 0, 0, 0, 0, 0, 0}, vv = {0, 0, 0, 0, 0, 0, 0, 0};
        if (p >= 0) { const f16* zr = P.Z + (size_t)(tokbase + stride * p) * P.ldz + kvh * 64 + 8 * ch; kv = *(const f16x8*)(zr + P.kcol); vv = *(const f16x8*)(zr + P.vcol); }
        *(LAS f16x8*)(Ks + key * KS_STR + 8 * ch) = kv;
        *(LAS f16x8*)(Vs + key * VS_STR + 8 * ch) = vv;
    }
    __syncthreads();
    const int g = w >> 1, qh = w & 1, head = kvh * 4 + g;
    const unsigned vlane = lds_addr(Vs) + (unsigned)((4 * hh + ((lane & 15) >> 2)) * (VS_STR * 2) + (16 * ((lane >> 4) & 1) + 4 * (lane & 3)) * 2);
    const float sink = P.sinks ? P.sinks[head] : -INFINITY;
    constexpr float SC = 0.125f, L2E = 1.4426950408889634f;
#pragma unroll
    for (int qt = 0; qt < 2; ++qt) {
        const int i0 = 64 * qh + 32 * qt;
        const int mrow = tokbase + stride * (128 * blk + i0 + c);
        f16x8 qf[4];
#pragma unroll
        for (int ks = 0; ks < 4; ++ks) qf[ks] = qt ? qfa[1][ks] : qfa[0][ks];
        f32x16 s[5];
#pragma unroll
        for (int kt = 0; kt < 5; ++kt) {
#pragma unroll
            for (int i = 0; i < 16; ++i) s[kt][i] = 0.f;
#pragma unroll
            for (int ks = 0; ks < 4; ++ks) {
                const f16x8 a = *(const LAS f16x8*)(Ks + (i0 + 32 * kt + c) * KS_STR + 16 * ks + 8 * hh);
                s[kt] = __builtin_amdgcn_mfma_f32_32x32x16_f16(a, qf[ks], s[kt], 0, 0, 0);
            }
        }
        float mx = -INFINITY;
        const int cm = c - 4 * hh;
#pragma unroll
        for (int i = 0; i < 16; ++i) { const int kb = (i & 3) + 8 * (i >> 2);
            s[0][i] = (kb >= cm) ? s[0][i] : -INFINITY; s[4][i] = (kb <= cm) ? s[4][i] : -INFINITY; }
        if (blk == 0) {
            asm volatile("" ::: "memory");
#pragma unroll
            for (int kt = 0; kt < 5; ++kt)
#pragma unroll
                for (int i = 0; i < 16; ++i) { const int kr = (i & 3) + 8 * (i >> 2) + 4 * hh; s[kt][i] = (i0 + 32 * kt + kr >= 128) ? s[kt][i] : -INFINITY; }
        }
#pragma unroll
        for (int kt = 0; kt < 5; ++kt)
#pragma unroll
            for (int i = 0; i < 16; ++i) mx = fmaxf(mx, s[kt][i]);
        mx = fmaxf(mx, __shfl_xor(mx, 32));
        mx = fmaxf(mx * SC, sink);
        constexpr float CE = SC * L2E; const float moff = mx * L2E;
        float sum = 0.f; f16x8 pf[5][2];
#pragma unroll
        for (int kt = 0; kt < 5; ++kt)
#pragma unroll
            for (int i = 0; i < 16; ++i) { const float pv = __builtin_amdgcn_exp2f(__builtin_fmaf(s[kt][i], CE, -moff)); sum += pv; pf[kt][i >> 3][i & 7] = (f16)pv; }
        sum += __shfl_xor(sum, 32);
        sum += __builtin_amdgcn_exp2f((sink - mx) * L2E);
        const float inv = __builtin_amdgcn_rcpf(sum);
        f32x16 o[2];
#pragma unroll
        for (int i = 0; i < 16; ++i) { o[0][i] = 0.f; o[1][i] = 0.f; }
        const unsigned vb = vlane + (unsigned)(i0 * (VS_STR * 2));
#define BA_PV(KT) { f16x4 r[8]; constexpr int B_ = (KT) * 32 * VS_STR * 2, S_ = 16 * VS_STR * 2, H_ = 8 * VS_STR * 2; \
            tr_read8<B_, B_ + H_, B_ + S_, B_ + S_ + H_, B_ + 64, B_ + 64 + H_, B_ + 64 + S_, B_ + 64 + S_ + H_>(vb, r); \
            o[0] = __builtin_amdgcn_mfma_f32_32x32x16_f16(cat4(r[0], r[1]), pf[KT][0], o[0], 0, 0, 0); o[0] = __builtin_amdgcn_mfma_f32_32x32x16_f16(cat4(r[2], r[3]), pf[KT][1], o[0], 0, 0, 0); \
            o[1] = __builtin_amdgcn_mfma_f32_32x32x16_f16(cat4(r[4], r[5]), pf[KT][0], o[1], 0, 0, 0); o[1] = __builtin_amdgcn_mfma_f32_32x32x16_f16(cat4(r[6], r[7]), pf[KT][1], o[1], 0, 0, 0); }
        BA_PV(0) BA_PV(1) BA_PV(2) BA_PV(3) BA_PV(4)
#undef BA_PV
#pragma unroll
        for (int dt = 0; dt < 2; ++dt) {
            const int ocol = P.ocol + head * 64 + 32 * dt + 4 * hh;
#pragma unroll
            for (int rg = 0; rg < 4; ++rg) { f32x4 v = {o[dt][4 * rg] * inv, o[dt][4 * rg + 1] * inv, o[dt][4 * rg + 2] * inv, o[dt][4 * rg + 3] * inv};
                f16x4* op = P.tiledO ? tiled_ptr<f16x4>(P.O, mrow, ocol + 8 * rg, P.ldo) : (f16x4*)(P.O + (size_t)mrow * P.ldo + ocol + 8 * rg);
                *op = cvt4(v); }
        }
        if (P.LSE && hh == 0) P.LSE[(size_t)mrow * 8 + head] = mx + __logf(sum);
    }
    __syncthreads();
}
__device__ __forceinline__ void kv_export(const f16* Z, int ldz, int kcol, int vcol, int m0, int nrows, float* out, int tid0, int nthr) {
    for (int i = tid0; i < nrows * 32; i += nthr) {
        const int r = i >> 5, ch = i & 31, isv = ch >> 4, c8 = (ch & 15) * 8;
        const f16x8 v = *(const f16x8*)(Z + (size_t)(m0 + r) * ldz + (isv ? vcol : kcol) + c8);
        float* o = out + (size_t)r * 256 + isv * 128 + c8;
        *(f32x4*)o = (f32x4){(float)v[0], (float)v[1], (float)v[2], (float)v[3]}; *(f32x4*)(o + 4) = (f32x4){(float)v[4], (float)v[5], (float)v[6], (float)v[7]};
    }
}

__device__ __forceinline__ void gate_scan(const float* GATES, const float* bg, int m0, int h, int lane, LAS float* gb, LAS float* ga, LAS float* gcm, float& amax, float& bL, float& a0o, float& a1o) {
    const float* g0 = GATES + (size_t)(m0 + 2 * lane) * 16;
    const float ig0 = g0[h] + bg[h], ig1 = g0[16 + h] + bg[h];
    const float lf0 = logsigmoidf_(g0[8 + h] + bg[8 + h]), lf1 = logsigmoidf_(g0[24 + h] + bg[8 + h]);
    float s = lf0 + lf1;
#pragma unroll
    for (int o = 1; o < 64; o <<= 1) { const float t = __shfl_up(s, o); if (lane >= o) s += t; }
    const float b0 = (s - (lf0 + lf1)) + lf0, b1 = b0 + lf1;
    const float a0 = ig0 - b0, a1 = ig1 - b1;
    float mx = fmaxf(a0, a1);
#pragma unroll
    for (int o = 1; o < 64; o <<= 1) { const float t = __shfl_up(mx, o); if (lane >= o) mx = fmaxf(mx, t); }
    float ex = __shfl_up(mx, 1); if (lane == 0) ex = -INFINITY;
    const float c0 = fmaxf(ex, a0), c1 = fmaxf(c0, a1);
    gb[2 * lane] = b0; gb[2 * lane + 1] = b1; ga[2 * lane] = a0; ga[2 * lane + 1] = a1; gcm[2 * lane] = c0; gcm[2 * lane + 1] = c1;
    amax = __shfl(mx, 63); bL = __shfl(s, 63); a0o = a0; a1o = a1;
}
constexpr int X1_KS = 0, X1_VS = 18432, X1_G = 36864, X1_HEAD = 38912, X1_STR = 72;
__device__ __forceinline__ void mlstm_x1_unit(Frame& F, int e, int b, int ch, int hp) {
    const int tid = F.tid, w = F.wave, lane = F.lane, hg = w >> 2, wv = w & 3, gt = tid & 255, h = 2 * hp + hg;
    ldsp_t base = F.lds + hg * X1_HEAD;
    LAS f16* Ksm = (LAS f16*)(base + X1_KS); LAS f16* Vsm = (LAS f16*)(base + X1_VS);
    LAS float* gb = (LAS float*)(base + X1_G); LAS float* ga = gb + 128; LAS float* gcm = ga + 128; LAS float* gwk = gcm + 128;
    const f16* Z = WSP(f16, WS_Z); const float* GATES = WSP(float, WS_GATES); const float* bg = FIN(I_EBG) + e * 16;
    const int m0 = b * T + 128 * ch, idx = (b * 8 + h) * 64 + ch;
    float amax = 0.f, bL = 0.f;
    f16x8 kxa[4], vxa[4];
#pragma unroll
    for (int i = 0; i < 4; ++i) { const int cid = gt + 256 * i, s_ = cid >> 3, c8 = cid & 7; const f16* zr = Z + (size_t)(m0 + s_) * NEV + h * 64 + 8 * c8;
        kxa[i] = *(const f16x8*)(zr + 1280); vxa[i] = *(const f16x8*)(zr + 1792); }
    if (wv == 0) { float a0, a1; gate_scan(GATES, bg, m0, h, lane, gb, ga, gcm, amax, bL, a0, a1); gwk[2 * lane] = __expf(a0 - amax); gwk[2 * lane + 1] = __expf(a1 - amax); }
    __syncthreads();
#pragma unroll
    for (int i = 0; i < 4; ++i) {
        const int cid = gt + 256 * i, s_ = cid >> 3, c8 = cid & 7;
        const f16x8 kx = kxa[i], vx = vxa[i]; const float wk = gwk[s_];
        f16x8 ks;
#pragma unroll
        for (int q = 0; q < 8; ++q) ks[q] = (f16)((float)kx[q] * wk);
        *(LAS f16x8*)(Ksm + s_ * X1_STR + 8 * c8) = ks; *(LAS f16x8*)(Vsm + s_ * X1_STR + 8 * c8) = vx;
    }
    __syncthreads();
    const int fr = lane & 15, fq = lane >> 4;
    const unsigned lof = (unsigned)((8 * fq + (fr >> 2)) * (X1_STR * 2) + 4 * (fr & 3) * 2);
    const unsigned vaddr = lds_addr(Vsm) + lof + (unsigned)(16 * wv * 2), kaddr = lds_addr(Ksm) + lof;
    constexpr int R4 = 4 * X1_STR * 2, R32 = 32 * X1_STR * 2;
    f16x4 rv[8];
    tr_read8<0, R4, R32, R32 + R4, 2 * R32, 2 * R32 + R4, 3 * R32, 3 * R32 + R4>(vaddr, rv);
    float* DC = WSP(float, WS_DC) + (size_t)idx * 4096;
    f32x4 accn = {0.f, 0.f, 0.f, 0.f};
    f16x8 ones;
#pragma unroll
    for (int q = 0; q < 8; ++q) ones[q] = (fr == 0) ? (f16)1.0f : (f16)0.0f;
#define X1_TILE(DKT) { f16x4 rk[8]; tr_read8<(DKT) * 32, (DKT) * 32 + R4, (DKT) * 32 + R32, (DKT) * 32 + R32 + R4, (DKT) * 32 + 2 * R32, (DKT) * 32 + 2 * R32 + R4, (DKT) * 32 + 3 * R32, (DKT) * 32 + 3 * R32 + R4>(kaddr, rk); \
        f32x4 acc = {0.f, 0.f, 0.f, 0.f}; \
        _Pragma("unroll") for (int ks = 0; ks < 4; ++ks) { const f16x8 bf = cat4(rk[2 * ks], rk[2 * ks + 1]); acc = __builtin_amdgcn_mfma_f32_16x16x32_f16(cat4(rv[2 * ks], rv[2 * ks + 1]), bf, acc, 0, 0, 0); \
            if ((DKT) == wv) accn = __builtin_amdgcn_mfma_f32_16x16x32_f16(ones, bf, accn, 0, 0, 0); } \
        _Pragma("unroll") for (int r = 0; r < 4; ++r) DC[(16 * wv + 4 * fq + r) * 64 + 16 * (DKT) + fr] = acc[r]; }
    X1_TILE(0) X1_TILE(1) X1_TILE(2) X1_TILE(3)
#undef X1_TILE
    if (fq == 0) WSP(float, WS_DN)[(size_t)idx * 64 + 16 * wv + fr] = accn[0];
    if (gt == 0) { float* SC = WSP(float, WS_SC); SC[idx] = bL + amax; SC[1024 + idx] = bL; }
    __syncthreads();
}
__device__ __forceinline__ void mlstm_scan(Frame& F, int e) {
    const int gid = F.bid * 512 + F.tid; if (gid >= 16 * 4160) return;
    const int bh = gid / 4160, el = gid - bh * 4160; const bool isc = el < 4096;
    const float* SC = WSP(float, WS_SC); float* MPV = WSP(float, WS_SC) + 2048;
    const float* src = isc ? WSP(float, WS_DC) + (size_t)bh * 64 * 4096 + el : WSP(float, WS_DN) + (size_t)bh * 64 * 64 + (el - 4096);
    const int sstr = isc ? 4096 : 64;
    f16* cp = WSP(f16, WS_CP) + (size_t)bh * 64 * 4096 + el; float* np = WSP(float, WS_NP) + (size_t)bh * 64 * 64 + (el - 4096);
    float st = 0.f, mst = 0.f;
#pragma unroll 8
    for (int c = 0; c < 64; ++c) {
        const float dv = src[(size_t)c * sstr], mloc = SC[bh * 64 + c], bL = SC[1024 + bh * 64 + c];
        if (isc) cp[(size_t)c * 4096] = (f16)st; else np[c * 64] = st;
        if (el == 0) MPV[bh * 64 + c] = mst;
        const float mnew = fmaxf(bL + mst, mloc);
        st = __expf(bL + mst - mnew) * st + __expf(mloc - mnew) * dv; mst = mnew;
    }
    const int b = bh >> 3, h = bh & 7;
    if (isc) { const int dv = el >> 6, dk = el & 63; F.out[O_BCP + ((size_t)((e * 2 + b) * 8 + h) * 64 + dk) * 64 + dv] = st; }
    else F.out[O_BNP + (size_t)((e * 2 + b) * 8 + h) * 64 + (el - 4096)] = st;
    if (el == 0) F.out[O_BMP + (e * 2 + b) * 8 + h] = mst;
}
constexpr int X3_KR = 0, X3_VS = 18432, X3_G = 43008, X3_HEAD = 45056;
__device__ __forceinline__ void mlstm_x3_unit(Frame& F, int e, int b, int ch, int hp) {
    const int tid = F.tid, w = F.wave, lane = F.lane, hg = w >> 2, tt = w & 3, gt = tid & 255, h = 2 * hp + hg, c = lane & 31, hh = lane >> 5;
    ldsp_t base = F.lds + hg * X3_HEAD;
    LAS f16* Kr = (LAS f16*)(base + X3_KR); LAS f16* Vs = (LAS f16*)(base + X3_VS);
    LAS float* gb = (LAS float*)(base + X3_G); LAS float* ga = gb + 128; LAS float* gcm = ga + 128; LAS float* npv = gcm + 128;
    const f16* Z = WSP(f16, WS_Z); const float* GATES = WSP(float, WS_GATES); const float* bg = FIN(I_EBG) + e * 16;
    const int m0 = b * T + 128 * ch, idx = (b * 8 + h) * 64 + ch;
    f16x8 kxa[4], vxa[4];
#pragma unroll
    for (int i = 0; i < 4; ++i) { const int cid = gt + 256 * i, s = cid >> 3, c8 = cid & 7; const f16* zr = Z + (size_t)(m0 + s) * NEV + h * 64 + 8 * c8;
        kxa[i] = *(const f16x8*)(zr + 1280); vxa[i] = *(const f16x8*)(zr + 1792); }
    if (tt == 0) { float t0, t1, t2, t3; gate_scan(GATES, bg, m0, h, lane, gb, ga, gcm, t0, t1, t2, t3); }
#pragma unroll
    for (int i = 0; i < 4; ++i) {
        const int cid = gt + 256 * i, s = cid >> 3, c8 = cid & 7;
        const f16x8 kx = kxa[i], vx = vxa[i];
        *(LAS f16x8*)(Kr + s * KS_STR + 8 * c8) = kx;
        *(LAS f16x8*)(Vs + s * VS_STR + 8 * c8) = vx;
    }
    if (gt < 64) npv[gt] = WSP(float, WS_NP)[(size_t)idx * 64 + gt];
    __syncthreads();
    const float mst = WSP(float, WS_SC)[2048 + idx];
    const int t = 32 * tt + c, mrow = m0 + t;
    const float bt = gb[t], mm = fmaxf(mst, gcm[t]), mt = bt + mm;
    f16x8 qf[4];
#pragma unroll
    for (int ks = 0; ks < 4; ++ks) qf[ks] = *(const f16x8*)(Z + (size_t)mrow * NEV + 768 + h * 64 + 16 * ks + 8 * hh);
    f32x16 num[2];
#pragma unroll
    for (int i = 0; i < 16; ++i) { num[0][i] = 0.f; num[1][i] = 0.f; }
    float qsum = 0.f;
    const unsigned vlane = lds_addr(Vs) + (unsigned)((4 * hh + ((lane & 15) >> 2)) * (VS_STR * 2) + (16 * ((lane >> 4) & 1) + 4 * (lane & 3)) * 2);
    for (int st = 0; st <= tt; ++st) {
        f32x16 sa;
#pragma unroll
        for (int i = 0; i < 16; ++i) sa[i] = 0.f;
#pragma unroll
        for (int ks = 0; ks < 4; ++ks) { const f16x8 a = *(const LAS f16x8*)(Kr + (32 * st + c) * KS_STR + 16 * ks + 8 * hh); sa = __builtin_amdgcn_mfma_f32_32x32x16_f16(a, qf[ks], sa, 0, 0, 0); }
        f16x8 wf[2];
        const bool diag = (st == tt);
        constexpr float L2E_ = 1.4426950408889634f; const float mml = mm * L2E_;
#pragma unroll
        for (int rg = 0; rg < 4; ++rg) {
            const int s0 = 32 * st + 8 * rg + 4 * hh;
            const f32x4 g4 = *(const LAS f32x4*)(ga + s0);
#pragma unroll
            for (int q = 0; q < 4; ++q) {
                const int i = 4 * rg + q;
                float dd = __builtin_amdgcn_exp2f(__builtin_fmaf(g4[q], L2E_, -mml));
                if (diag) dd = (s0 + q <= t) ? dd : 0.f;
                const float wv_ = sa[i] * dd;
                qsum += wv_; wf[i >> 3][i & 7] = (f16)wv_;
            }
        }
        { f16x4 r[8]; constexpr int S_ = 16 * VS_STR * 2, H_ = 8 * VS_STR * 2;
          tr_read8<0, H_, S_, S_ + H_, 64, 64 + H_, 64 + S_, 64 + S_ + H_>(vlane + (unsigned)(st * 32 * VS_STR * 2), r);
          num[0] = __builtin_amdgcn_mfma_f32_32x32x16_f16(cat4(r[0], r[1]), wf[0], num[0], 0, 0, 0); num[0] = __builtin_amdgcn_mfma_f32_32x32x16_f16(cat4(r[2], r[3]), wf[1], num[0], 0, 0, 0);
          num[1] = __builtin_amdgcn_mfma_f32_32x32x16_f16(cat4(r[4], r[5]), wf[0], num[1], 0, 0, 0); num[1] = __builtin_amdgcn_mfma_f32_32x32x16_f16(cat4(r[6], r[7]), wf[1], num[1], 0, 0, 0); }
    }
    qsum += __shfl_xor(qsum, 32);
    f32x16 ni[2];
#pragma unroll
    for (int i = 0; i < 16; ++i) { ni[0][i] = 0.f; ni[1][i] = 0.f; }
    const f16* CP = WSP(f16, WS_CP) + (size_t)idx * 4096;
#pragma unroll
    for (int dt = 0; dt < 2; ++dt)
#pragma unroll
        for (int ks = 0; ks < 4; ++ks) { const f16x8 a = *(const f16x8*)(CP + (32 * dt + c) * 64 + 16 * ks + 8 * hh); ni[dt] = __builtin_amdgcn_mfma_f32_32x32x16_f16(a, qf[ks], ni[dt], 0, 0, 0); }
    float qni = 0.f;
#pragma unroll
    for (int ks = 0; ks < 4; ++ks)
#pragma unroll
        for (int j = 0; j < 8; ++j) qni += (float)qf[ks][j] * npv[16 * ks + 8 * hh + j];
    qni += __shfl_xor(qni, 32);
    const float inter = __expf(mst - mm);
    const float qn = qsum + inter * qni, invd = __builtin_amdgcn_rcpf(fmaxf(fabsf(qn), __expf(-mt)));
    float ssq = 0.f;
#pragma unroll
    for (int dt = 0; dt < 2; ++dt)
#pragma unroll
        for (int i = 0; i < 16; ++i) { const float hv = (num[dt][i] + inter * ni[dt][i]) * invd; num[dt][i] = hv; ssq += hv * hv; }
    ssq += __shfl_xor(ssq, 32);
    const float rinv = rsqrtf(ssq * (1.0f / 64.0f) + EPS);
    const float* hgain = FIN(I_EHG) + (e * 8 + h) * 64;
    f16* O = WSP(f16, WS_O);
#pragma unroll
    for (int dt = 0; dt < 2; ++dt)
#pragma unroll
        for (int rg = 0; rg < 4; ++rg) {
            const int dv0 = 32 * dt + 8 * rg + 4 * hh;
            const f16x4 bo = *(const f16x4*)(Z + (size_t)mrow * NEV + 2304 + h * 64 + dv0); const f32x4 gn = *(const f32x4*)(hgain + dv0);
            f32x4 y;
#pragma unroll
            for (int q = 0; q < 4; ++q) y[q] = num[dt][4 * rg + q] * rinv * gn[q] * sigmoidf_((float)bo[q]);
            *tiled_ptr<f16x4>(O, mrow, 512 + h * 64 + dv0, D) = cvt4(y);
        }
    __syncthreads();
}

constexpr int DA_QS = 0, DA_KC = 1024, DA_VC = 36352, DA_SC = 69376, DA_RD = 71488, DA_KSTR = 68;
__device__ __forceinline__ void dec_attn(Frame& F, const float* cache, int dil, int kvh, const f16* zrow, int qcol, int kcol, int vcol, const float* sinks, float& o_out, float& lse_out) {
    const int tid = F.tid, lane = F.lane, w = F.wave;
    LAS float* qs = (LAS float*)(F.lds + DA_QS); LAS float* Kc = (LAS float*)(F.lds + DA_KC); LAS float* Vc = (LAS float*)(F.lds + DA_VC);
    LAS float* sc = (LAS float*)(F.lds + DA_SC); LAS float* rd = (LAS float*)(F.lds + DA_RD);
#pragma unroll
    for (int i = 0; i < 4; ++i) {
        const int cid = tid + 512 * i, j = cid >> 4, c4 = cid & 15;
        const float* src = cache + (size_t)(dil * j) * 256 + kvh * 64 + 4 * c4;
        const f32x4 kk = *(const f32x4*)src, vv = *(const f32x4*)(src + 128);
        *(LAS f32x4*)(Kc + j * DA_KSTR + 4 * c4) = kk;
        *(LAS f32x4*)(Vc + j * 64 + 4 * c4) = vv;
    }
    if (tid < 64) { Kc[128 * DA_KSTR + tid] = (float)zrow[kcol + kvh * 64 + tid]; Vc[128 * 64 + tid] = (float)zrow[vcol + kvh * 64 + tid]; }
    if (tid < 256) qs[tid] = (float)zrow[qcol + kvh * 256 + tid];
    __syncthreads();
    for (int jj = tid; jj < 516; jj += 512) {
        const int j = jj >> 2, g = jj & 3; f32x4 s4 = {0.f, 0.f, 0.f, 0.f};
#pragma unroll
        for (int d = 0; d < 64; d += 4) s4 = s4 + *(const LAS f32x4*)(qs + g * 64 + d) * *(const LAS f32x4*)(Kc + j * DA_KSTR + d);
        sc[g * 132 + j] = ((s4[0] + s4[1]) + (s4[2] + s4[3])) * 0.125f;
    }
    __syncthreads();
    if (w < 4) {
        const float sk = sinks ? sinks[kvh * 4 + w] : -INFINITY;
        const float v0 = sc[w * 132 + lane], v1 = sc[w * 132 + 64 + lane], v2 = lane == 0 ? sc[w * 132 + 128] : -INFINITY;
        float mx = wave_max(fmaxf(fmaxf(v0, v1), v2)); mx = fmaxf(mx, sk);
        const float p0 = __expf(v0 - mx), p1 = __expf(v1 - mx), p2 = lane == 0 ? __expf(v2 - mx) : 0.f;
        const float sum = wave_sum(p0 + p1 + p2) + __expf(sk - mx);
        sc[w * 132 + lane] = p0; sc[w * 132 + 64 + lane] = p1; if (lane == 0) { sc[w * 132 + 128] = p2; rd[w] = sum; rd[4 + w] = mx; }
    }
    __syncthreads();
    if (tid < 256) {
        const int g = tid >> 6, d = tid & 63; float o = 0.f;
#pragma unroll 4
        for (int j = 0; j < 128; j += 4) { const f32x4 p4 = *(const LAS f32x4*)(sc + g * 132 + j);
            o += p4[0] * Vc[j * 64 + d]; o += p4[1] * Vc[(j + 1) * 64 + d]; o += p4[2] * Vc[(j + 2) * 64 + d]; o += p4[3] * Vc[(j + 3) * 64 + d]; }
        o += sc[g * 132 + 128] * Vc[128 * 64 + d];
        const float den = rd[g]; o_out = o * __builtin_amdgcn_rcpf(den); lse_out = rd[4 + g] + __logf(den);
    }
    __syncthreads();
}
__device__ __forceinline__ void sample_attn_even(Frame& F, int e, int s, int kvh) {
    const f16* zrow = WSP(f16, WS_Z) + (size_t)(MP + s) * NEV;
    float o = 0.f, lse = 0.f;
    dec_attn(F, FIN(I_CA) + ((size_t)e * NS + s) * 128 * 256, 1, kvh, zrow, 0, 512, 640, FIN(I_ESK) + e * 8, o, lse);
    if (F.tid < 256) WSP(f16, WS_O)[(size_t)(MP + s) * D + kvh * 256 + F.tid] = (f16)o;
    if (F.tid < 128) { const int isv = F.tid >> 6, d = F.tid & 63;
        F.out[O_AKVS + (((size_t)e * NS + s) * 128 + 127) * 256 + isv * 128 + kvh * 64 + d] = (float)zrow[(isv ? 640 : 512) + kvh * 64 + d]; }
}
__device__ __forceinline__ void sample_attn_odd(Frame& F, int oi, int s, int kvh) {
    const f16* zrow = WSP(f16, WS_Z) + (size_t)(MP + s) * NOD;
    float o[3] = {0.f, 0.f, 0.f}, lse[3] = {0.f, 0.f, 0.f};
    dec_attn(F, FIN(I_CC1) + ((size_t)oi * NS + s) * 128 * 256, 1, kvh, zrow, 0, 512, 640, nullptr, o[0], lse[0]);
    dec_attn(F, FIN(I_CC2) + ((size_t)oi * NS + s) * 512 * 256, 4, kvh, zrow, 768, 1280, 1408, nullptr, o[1], lse[1]);
    dec_attn(F, FIN(I_CC3) + ((size_t)oi * NS + s) * 2048 * 256, 16, kvh, zrow, 1536, 2048, 2176, nullptr, o[2], lse[2]);
    if (F.tid < 256) {
        const float mx = fmaxf(fmaxf(lse[0], lse[1]), lse[2]);
        const float w0 = __expf(lse[0] - mx), w1 = __expf(lse[1] - mx), w2 = __expf(lse[2] - mx);
        WSP(f16, WS_O)[(size_t)(MP + s) * 512 + kvh * 256 + F.tid] = (f16)((w0 * o[0] + w1 * o[1] + w2 * o[2]) / (w0 + w1 + w2));
    }
    if (F.tid < 384) { const int g = F.tid >> 7, r = F.tid & 127, isv = r >> 6, d = r & 63;
        const int W = g == 0 ? 128 : (g == 1 ? 512 : 2048); const size_t ob = g == 0 ? O_C1S : (g == 1 ? O_C2S : O_C3S);
        F.out[ob + (((size_t)oi * NS + s) * W + (W - 1)) * 256 + isv * 128 + kvh * 64 + d] = (float)zrow[768 * g + (isv ? 640 : 512) + kvh * 64 + d]; }
}
__device__ __forceinline__ void sample_mlstm(Frame& F, int e, int s) {
    const int h = F.wave, lane = F.lane, m = MP + s;
    const f16* zrow = WSP(f16, WS_Z) + (size_t)m * NEV; const float* gr = WSP(float, WS_GATES) + (size_t)m * 16; const float* bg = FIN(I_EBG) + e * 16;
    const float q = (float)zrow[768 + h * 64 + lane], k = (float)zrow[1280 + h * 64 + lane], v = (float)zrow[1792 + h * 64 + lane], bo = (float)zrow[2304 + h * 64 + lane];
    const float ig = gr[h] + bg[h], lf = logsigmoidf_(gr[8 + h] + bg[8 + h]);
    const size_t sh = ((size_t)e * NS + s) * 8 + h;
    const float mst = FIN(I_SBM)[sh], nst = FIN(I_SBN)[sh * 64 + lane];
    const float mt = fmaxf(lf + mst, ig), dsc = __expf(ig - mt), inter = __expf(lf + mst - mt);
    const float qk = wave_sum(q * k), qn_i = wave_sum(q * nst);
    const float* C = FIN(I_SBC) + sh * 4096; float* Co = F.out + O_BCS + sh * 4096;
    float qc = 0.f;
#pragma unroll 8
    for (int dk = 0; dk < 64; ++dk) {
        const float cv = C[dk * 64 + lane], qd = __shfl(q, dk), kd = __shfl(k, dk);
        qc += qd * cv; Co[dk * 64 + lane] = inter * cv + dsc * kd * v;
    }
    const float wgt = qk * dsc, num = wgt * v + inter * qc, qn = wgt + inter * qn_i;
    const float hv = num / fmaxf(fabsf(qn), __expf(-mt));
    const float rinv = rsqrtf(wave_sum(hv * hv) * (1.0f / 64.0f) + EPS);
    WSP(f16, WS_O)[(size_t)m * D + 512 + h * 64 + lane] = (f16)(hv * rinv * FIN(I_EHG)[(e * 8 + h) * 64 + lane] * sigmoidf_(bo));
    F.out[O_BNS + sh * 64 + lane] = inter * nst + dsc * k;
    if (lane == 0) F.out[O_BMS + sh] = mt;
}

__device__ __forceinline__ void phase_e1(Frame& F, int e, int tmask) {
    BandAttn P{WSP(f16, WS_Z), NEV, 0, 512, 640, WSP(f16, WS_O), D, 0, nullptr, FIN(I_ESK) + e * 8, 1};
    for (int u = F.bid; u < 1152; u += F.G) {
        if (u < 256) { if (!(tmask & 1)) continue; const int kvh = u & 1, blk = (u >> 1) & 63, b = u >> 7;
            band_attn_unit(F.lds, P, b * T, 1, blk, kvh);
            if (blk == 63 && kvh == 0) kv_export(P.Z, NEV, 512, 640, b * T + T - 128, 128, F.out + O_AKVP + (size_t)(e * 2 + b) * 128 * 256, F.tid, 512);
        } else if (u < 768) { if (!(tmask & 2)) continue; const int v = u - 256; mlstm_x1_unit(F, e, v >> 8, (v >> 2) & 63, v & 3); }
        else if (u < 1024) { if (!(tmask & 4)) continue; const int v = u - 768; sample_attn_even(F, e, v >> 1, v & 1); }
        else { if (!(tmask & 8)) continue; sample_mlstm(F, e, u - 1024); }
    }
}
__device__ __forceinline__ void phase_e3(Frame& F, int e) {
    for (int u = F.bid; u < 512; u += F.G) mlstm_x3_unit(F, e, u >> 8, (u >> 2) & 63, u & 3);
}
__device__ __forceinline__ void phase_o1(Frame& F, int oi, int tmask) {
    const f16* Z = WSP(f16, WS_Z);
    for (int u = F.bid; u < 768 + 256 + 42; u += F.G) {
        if (u < 768) {
            if (!(tmask & 1)) continue;
            const int g = u >> 8, v = u & 255, kvh = v & 1, r = v >> 1;
            const int dil = g == 0 ? 1 : (g == 1 ? 4 : 16), nblk = 64 / dil;
            const int b = r >> 6, rr = r & 63, res = rr / nblk, blk = rr % nblk;
            BandAttn P{Z, NOD, 768 * g, 768 * g + 512, 768 * g + 640, WSP(f16, WS_OG) + (size_t)g * MP * 512, 512, 0, WSP(float, WS_LSE) + (size_t)g * MP * 8, nullptr, 0};
            band_attn_unit(F.lds, P, b * T + res, dil, blk, kvh);
        } else if (u < 1024) { if (!(tmask & 4)) continue; const int v = u - 768; sample_attn_odd(F, oi, v >> 1, v & 1); }
        else {
            if (!(tmask & 16)) continue;
            const int v = u - 1024; int g, q; if (v < 2) { g = 0; q = v; } else if (v < 10) { g = 1; q = v - 2; } else { g = 2; q = v - 10; }
            const int W = 128 << (2 * g), per = W / 128, b = q / per, part = q % per;
            const size_t ob = g == 0 ? O_C1P : (g == 1 ? O_C2P : O_C3P);
            kv_export(Z, NOD, 768 * g + 512, 768 * g + 640, b * T + T - W + part * 128, 128, F.out + ob + ((size_t)(oi * 2 + b) * W + part * 128) * 256, F.tid, 512);
        }
    }
}
__device__ __forceinline__ void phase_o2(Frame& F) {
    const f16* OG = WSP(f16, WS_OG); const float* LSE = WSP(float, WS_LSE); f16* O = WSP(f16, WS_O);
    for (int i0 = F.bid; i0 < MP / 8; i0 += F.G) {
        const size_t m = (size_t)((i0 & 7) * (MP / 64) + (i0 >> 3)) * 8 + (F.tid >> 6); const int c8 = F.tid & 63, hd = c8 >> 3;
        const float l0 = LSE[m * 8 + hd], l1 = LSE[(size_t)MP * 8 + m * 8 + hd], l2 = LSE[(size_t)2 * MP * 8 + m * 8 + hd];
        const float mx = fmaxf(fmaxf(l0, l1), l2); float w0 = __expf(l0 - mx), w1 = __expf(l1 - mx), w2 = __expf(l2 - mx); const float inv = 1.0f / (w0 + w1 + w2);
        w0 *= inv; w1 *= inv; w2 *= inv;
        const f16x8 a = *(const f16x8*)(OG + m * 512 + c8 * 8), b = *(const f16x8*)(OG + (size_t)MP * 512 + m * 512 + c8 * 8), c = *(const f16x8*)(OG + (size_t)2 * MP * 512 + m * 512 + c8 * 8);
        f16x8 o;
#pragma unroll
        for (int q = 0; q < 8; ++q) o[q] = (f16)(w0 * (float)a[q] + w1 * (float)b[q] + w2 * (float)c[q]);
        *tiled_ptr<f16x8>(O, (int)m, c8 * 8, 512) = o;
    }
}
__device__ __forceinline__ void phase_final(Frame& F) {
    const f16* X = WSP(f16, WS_X); const float* rss = (const float*)(F.ws + RSS_OFF) + (size_t)12 * MALL; const float* fg = FIN(I_FG);
    for (int m = F.bid * 8 + F.wave; m < MALL; m += F.G * 8) {
        const float r = rsqrtf(rss[m] * (1.0f / D) + EPS);
#pragma unroll
        for (int q = 0; q < 4; ++q) { const int d = q * 256 + F.lane * 4; const f16x4 xh = *(const f16x4*)(X + (size_t)m * D + d); const f32x4 x = {(float)xh[0], (float)xh[1], (float)xh[2], (float)xh[3]}, g = *(const f32x4*)(fg + d);
            *(f32x4*)(F.out + O_Y + (size_t)m * D + d) = x * r * g; }
    }
}

struct Args;
__device__ __forceinline__ bool phase_enter(Frame& F, const Args& args);
#define REP(bit) _Pragma("unroll 1") for (int rep_ = 0; rep_ < ((PROBE_DUP & (bit)) ? 2 : 1); ++rep_)
#ifndef P_MASK
#define P_MASK 0
#endif
constexpr bool P_SK = !(P_MASK & 1), P_MIX = !(P_MASK & 2), P_Z = !(P_MASK & 4), P_RES = !(P_MASK & 8), P_SW = !(P_MASK & 16), P_PR = !(P_MASK & 32), P_E1 = !(P_MASK & 64), P_E3 = !(P_MASK & 128), P_O1 = !(P_MASK & 256);
struct Args { const float* in[N_IN]; float* out; unsigned char* ws; int ph_lo, ph_hi; };
constexpr int PH_LAYER0 = 4, PH_PER_LAYER = 9, PH_FINAL = PH_LAYER0 + 4 * PH_PER_LAYER, N_PHASES = PH_FINAL + 1;

__device__ __forceinline__ bool phase_enter(Frame& F, const Args& args) {
    F.tid = opaque_v(threadIdx.x); F.lane = F.tid & 63; F.wave = __builtin_amdgcn_readfirstlane(F.tid >> 6);
    F.out = opaque_p(args.out); F.ws = opaque_p(args.ws);
    return true;
}
__global__ void __launch_bounds__(512, 2) fwd_kernel(Args args) {
    extern __shared__ __attribute__((aligned(16))) unsigned char lds_raw[];
    Frame F;
    F.lds = (ldsp_t)lds_raw; F.tid = threadIdx.x; F.lane = F.tid & 63; F.wave = __builtin_amdgcn_readfirstlane(F.tid >> 6); F.G = gridDim.x; F.bid = blockIdx.x;
    F.out = args.out; F.ws = args.ws;
    volatile LAS unsigned* MISC = (volatile LAS unsigned*)(F.lds + MISC_OFF);
    if (F.tid < 32) MISC[F.tid] = 0u;
    __syncthreads();
    XcdBarrier bar = xcd_barrier_post((unsigned*)(F.ws + WS_CTL) + CW_BAR, MISC + 8);
    const int lo = args.ph_lo, hi = args.ph_hi;
    const CopyQ CQ{args.in[I_CC3], args.in[I_CC2], args.in[I_CA], args.in[I_CC1], args.out, (unsigned*)(args.ws + WS_CTL) + CW_Q};
#define IN(k) (lo <= (k) && (k) < hi && phase_enter(F, args))
#define SEAM(k) do { if (IN((k) + 1)) { xcd_barrier(bar, CQ); if constexpr ((PROBE_DUP & 64) != 0) xcd_barrier(bar, CQ); } } while (0)
#define LSEAM(k) do { if (IN((k) + 1)) { if (fastp) xcc_barrier(bar, CQ); else xcd_barrier(bar, CQ); } } while (0)
    unsigned fastp = 0u;
    float* rowss = (float*)(F.ws + RSS_OFF);

    _Pragma("unroll 1") for (int prep_ = 0; prep_ < ((PROBE_DUP & 32) ? 2 : 1); ++prep_) {
    if (IN(0)) { REP(1) { if constexpr (P_PR) phase_pr0(F, 24, 28, true, nullptr); } SEAM(0);
        if (MK_N_LAUNCHES == 1 && hi == N_PHASES && MISC[8 + 10] != 0u) { fastp = 1u; F.bid = (int)(MISC[8 + 12] * 8u + bar.x); } }
    if (IN(1)) {
        pg8::Gemm g{WSP(f16, WS_AC), WSP(f16, WS_WMOD), 256, 4 * NMODC, D}; pg8::StaticOrder S; S.init(256, 4 * NMODC, F.G, F.bid);
        EpiMod E{WSP(float, WS_CS), WSP(float, WS_GT), WSP(f16, WS_SHA), FIN(I_BMOD), FIN(I_NG), WSP(float, WS_RCS)};
        if constexpr (P_PR) pg8::gemm_phase<EpiMod, pg8::StaticOrder>(F.lds, g, S, E);
        if constexpr (P_PR) { phase_enter(F, args); phase_pr0(F, 0, 24, false, (unsigned*)(F.ws + WS_CTL) + CW_Q + 128); }
        SEAM(1);
    }
    if (IN(3)) {
        pg8::Gemm g{WSP(f16, WS_SHA), WSP(f16, WS_WIN), 256 * NSITE, NWIN, D}; pg8::DiagOrder S{F.G, F.bid};
        EpiBias E{WSP(float, WS_BW)};
        if constexpr (P_PR) pg8::gemm_phase<EpiBias, pg8::DiagOrder>(F.lds, g, S, E);
        if constexpr (P_PR) { phase_enter(F, args); phase_pr2(F); }
        SEAM(3);
    }
    }
    for (int l = 0; l < 4; ++l) {
        const int pb = PH_LAYER0 + PH_PER_LAYER * l, s0 = 3 * l; const bool even = (l & 1) == 0; const int ei = l >> 1;
#pragma unroll 1
        for (int ffn = 0; ffn < 2; ++ffn) {
            if (ffn == 1) {
                if (IN(pb + 2)) {
                    const int so = site_off(s0 + 1), N = even ? NEV : NOD;
                    pg8::Gemm g{WSP(f16, WS_A), WSP(f16, WS_WIN) + (size_t)so * D, MP, N, D}; pg8::StaticOrder S; S.init(MP, N, F.G, F.bid);
                    if (even) { EpiZ<true> E{rowss + (size_t)(s0 + 1) * MALL, WSP(float, WS_BW) + so, WSP(f16, WS_Z), WSP(float, WS_GATES)};
                        if constexpr (P_Z) pg8::gemm_phase<EpiZ<true>, pg8::StaticOrder>(F.lds, g, S, E);
                        if constexpr ((PROBE_DUP & 128) != 0) { phase_enter(F, args); pg8::gemm_phase<EpiZ<true>, pg8::StaticOrder>(F.lds, g, S, E); }
                        if constexpr (P_SK) skinny_phase<false, D>(F.lds, g.A + (size_t)MP * D, g.Bt, N, E, F.G, F.bid, S.nwg); }
                    else { EpiZ<false> E{rowss + (size_t)(s0 + 1) * MALL, WSP(float, WS_BW) + so, WSP(f16, WS_Z), WSP(float, WS_GATES)};
                        if constexpr (P_Z) pg8::gemm_phase<EpiZ<false>, pg8::StaticOrder>(F.lds, g, S, E);
                        if constexpr ((PROBE_DUP & 128) != 0) { phase_enter(F, args); pg8::gemm_phase<EpiZ<false>, pg8::StaticOrder>(F.lds, g, S, E); }
                        if constexpr (P_SK) skinny_phase<false, D>(F.lds, g.A + (size_t)MP * D, g.Bt, N, E, F.G, F.bid, S.nwg); }
                    SEAM(pb + 2);
                }
                if (IN(pb + 3)) { REP(2) if constexpr (P_MIX) { const int tm = rep_ ? PROBE_TMASK : 31; if (even) { if constexpr (P_E1) phase_e1(F, ei, tm); } else { if constexpr (P_O1) phase_o1(F, ei, tm); } } SEAM(pb + 3); }
                if (IN(pb + 4)) { REP(4096) if constexpr (P_MIX) { if (even) mlstm_scan(F, ei); else phase_o2(F); } if (even) SEAM(pb + 4); else LSEAM(pb + 4); }
                if (even && IN(pb + 5)) { REP(8192) if constexpr (P_MIX && P_E3) { phase_e3(F, ei); } SEAM(pb + 5); }
                if (IN(pb + 6)) {
                    const int K = even ? D : 512; const f16* Bt = even ? WSP(f16, WS_WEO) + (size_t)ei * D * D : WSP(f16, WS_WOO) + (size_t)ei * D * 512;
                    pg8::Gemm g{WSP(f16, WS_O), Bt, MP, D, K}; pg8::StaticOrder S; S.init(MP, D, F.G, F.bid);
                    EpiRes E{WSP(f16, WS_X), WSP(f16, WS_A), rowss + (size_t)(s0 + 2) * MALL, WSP(float, WS_GT) + (size_t)(s0 + 1) * NBAT * D, WSP(float, WS_CS) + (size_t)(s0 + 2) * NBAT * D, WSP(float, WS_RCS) + (size_t)(s0 + 1) * NBAT * D};
                    if constexpr ((PROBE_DUP & 256) != 0) { EpiRes E2{(f16*)(F.ws + WS_END), (f16*)(F.ws + WS_END + (size_t)MALL * D * 4), (float*)(F.ws + WS_END + (size_t)MALL * D * 6), E.GT, E.CS, E.RCS};
                        pg8::gemm_phase<EpiRes, pg8::StaticOrder>(F.lds, g, S, E2); phase_enter(F, args); }
                    if constexpr (P_RES) pg8::gemm_phase<EpiRes, pg8::StaticOrder>(F.lds, g, S, E);
                    if constexpr (P_SK) { if (even) skinny_phase<false, D>(F.lds, g.A + (size_t)MP * D, g.Bt, D, E, F.G, F.bid, S.nwg); else skinny_phase<false, 512>(F.lds, g.A + (size_t)MP * 512, g.Bt, D, E, F.G, F.bid, S.nwg); }
                    LSEAM(pb + 6);
                }
            }
            const int sf = s0 + 2 * ffn, pin = pb + (ffn ? 7 : 0);
            if (IN(pin)) {
                const int so = site_off(sf);
                pg8::Gemm g{WSP(f16, WS_A), WSP(f16, WS_WIN) + (size_t)so * D, MP, FF2, D}; pg8::StaticOrder S; S.init(MP, FF2, F.G, F.bid);
                EpiSwiglu E{rowss + (size_t)sf * MALL, WSP(float, WS_BW) + so, WSP(f16, WS_H)};
                if constexpr (P_SW) pg8::gemm_phase<EpiSwiglu, pg8::StaticOrder>(F.lds, g, S, E);
                if constexpr ((PROBE_DUP & 4) != 0) { phase_enter(F, args); pg8::gemm_phase<EpiSwiglu, pg8::StaticOrder>(F.lds, g, S, E); }
                REP(8) { if constexpr (P_SK) skinny_phase<true, D>(F.lds, g.A + (size_t)MP * D, g.Bt, FF2, E, F.G, F.bid, S.nwg); }
                LSEAM(pin);
            }
            if (IN(pin + 1)) {
                pg8::Gemm g{WSP(f16, WS_H), WSP(f16, WS_WFO) + (size_t)(2 * l + ffn) * D * FF, MP, D, FF}; pg8::StaticOrder S; S.init(MP, D, F.G, F.bid);
                EpiRes E{WSP(f16, WS_X), WSP(f16, WS_A), rowss + (size_t)(sf + 1) * MALL, WSP(float, WS_GT) + (size_t)sf * NBAT * D, (sf + 1 < NSITE) ? WSP(float, WS_CS) + (size_t)(sf + 1) * NBAT * D : nullptr, WSP(float, WS_RCS) + (size_t)sf * NBAT * D};
                if constexpr ((PROBE_DUP & 16) != 0) { EpiRes E2{(f16*)(F.ws + WS_END), (f16*)(F.ws + WS_END + (size_t)MALL * D * 4), (float*)(F.ws + WS_END + (size_t)MALL * D * 6), E.GT, E.CS, E.RCS};
                    pg8::gemm_phase<EpiRes, pg8::StaticOrder>(F.lds, g, S, E2); phase_enter(F, args); }
                if constexpr (P_RES) pg8::gemm_phase<EpiRes, pg8::StaticOrder>(F.lds, g, S, E);
                if constexpr (P_SK) skinny_phase<false, FF>(F.lds, g.A + (size_t)MP * FF, g.Bt, D, E, F.G, F.bid, S.nwg);
                if (pin + 1 == PH_FINAL - 1) SEAM(pin + 1); else LSEAM(pin + 1);
            }
        }
    }
    if (IN(PH_FINAL)) {
        phase_final(F);
        if constexpr ((PROBE_DUP & 512) != 0) { phase_enter(F, args); phase_final(F); }
        for (;;) {
            __syncthreads();
            if (F.tid == 0) MISC[24] = xb_add(CQ.head, 1u);
            __syncthreads();
            const unsigned ch = MISC[24];
            if (ch >= (unsigned)CQ_N) break;
            copy_chunk(CQ, (int)ch, F.tid);
        }
        if constexpr ((PROBE_DUP & 1024) != 0) {
            CopyQ CQ2 = CQ; CQ2.head = CQ.head + 64;
            for (;;) {
                __syncthreads();
                if (F.tid == 0) MISC[24] = xb_add(CQ2.head, 1u);
                __syncthreads();
                const unsigned ch = MISC[24];
                if (ch >= (unsigned)CQ_N) break;
                copy_chunk(CQ2, (int)ch, F.tid);
            }
        }
    }
#undef IN
#undef SEAM
}

extern "C" void kernel_launch(void* const* d_in, const int* in_sizes, int n_in, void* d_out, int out_size, void* d_ws, size_t ws_size, hipStream_t stream) {
    static int grid = 0;
    if (grid == 0) {
        if (n_in != N_IN || (size_t)out_size != O_END || ws_size < WS_END) { fprintf(stderr, "kernel_launch: unexpected shapes n_in %d out %d ws %zu (need %zu / %zu)\n", n_in, out_size, ws_size, (size_t)O_END, (size_t)WS_END); grid = -1; return; }
        int dev = 0, cus = 0, per_cu = 0;
        if (hipGetDevice(&dev) != hipSuccess || hipDeviceGetAttribute(&cus, hipDeviceAttributeMultiprocessorCount, dev) != hipSuccess) { grid = -1; return; }
        if (hipFuncSetAttribute((const void*)fwd_kernel, hipFuncAttributeMaxDynamicSharedMemorySize, LDS_BYTES) != hipSuccess) { fprintf(stderr, "kernel_launch: hipFuncSetAttribute failed\n"); grid = -1; return; }
        if (hipOccupancyMaxActiveBlocksPerMultiprocessor(&per_cu, (const void*)fwd_kernel, 512, LDS_BYTES) != hipSuccess || per_cu < 1) { fprintf(stderr, "kernel_launch: occupancy query says %d\n", per_cu); }
        (void)hipGetLastError();
        grid = cus;
    }
    if (grid < 0) return;
    (void)hipMemsetAsync((char*)d_ws + WS_CTL, 0, CTL_ZERO_BYTES, stream);
    Args a{};
    for (int i = 0; i < N_IN; ++i) a.in[i] = (const float*)d_in[i];
    a.out = (float*)d_out; a.ws = (unsigned char*)d_ws;
#if MK_N_LAUNCHES == 1
    a.ph_lo = 0; a.ph_hi = N_PHASES;
    hipLaunchKernelGGL(fwd_kernel, dim3(grid), dim3(512), LDS_BYTES, stream, a);
#else
    for (int p = 0; p < N_PHASES; ++p) { a.ph_lo = p; a.ph_hi = p + 1; hipLaunchKernelGGL(fwd_kernel, dim3(grid), dim3(512), LDS_BYTES, stream, a); }
#endif
}
```

```cpp
#include <hip/hip_runtime.h>
#include <cstdio>
#include <cstdint>

#ifndef PROBE_DUP
#define PROBE_DUP 0
#endif
#ifndef PROBE_TMASK
#define PROBE_TMASK 19
#endif
#ifndef MK_N_LAUNCHES
#define MK_N_LAUNCHES 1
#endif

#define GAS __attribute__((address_space(1)))
#define LAS __attribute__((address_space(3)))
typedef _Float16 f16;
typedef _Float16 f16x8 __attribute__((ext_vector_type(8)));
typedef _Float16 f16x4 __attribute__((ext_vector_type(4)));
typedef float f32x4 __attribute__((ext_vector_type(4)));
typedef float f32x16 __attribute__((ext_vector_type(16)));
typedef unsigned u32x4 __attribute__((ext_vector_type(4)));
typedef unsigned u32x2 __attribute__((ext_vector_type(2)));
typedef LAS unsigned char* ldsp_t;

constexpr int D = 1024, T = 8192, NB = 2, MP = NB * T, NS = 128, MALL = MP + NS, NBAT = NB + NS;
constexpr int FF = 2816, FF2 = 5632, NEV = 3072, NEVR = 2832, NOD = 2304, NMODC = 9216;
constexpr int NSITE = 12;
constexpr float EPS = 1e-6f;
__host__ __device__ __forceinline__ constexpr int site_N(int s) { return (s % 3 != 1) ? FF2 : (((s / 3) % 2 == 0) ? NEV : NOD); }
__host__ __device__ __forceinline__ constexpr int site_off(int s) { const int r = s % 6; return (s / 6) * 27904 + (r == 0 ? 0 : r == 1 ? 5632 : r == 2 ? 8704 : r == 3 ? 14336 : r == 4 ? 19968 : 22272); }
static_assert(site_off(1) == 5632 && site_off(2) == 8704 && site_off(3) == 14336 && site_off(4) == 19968 && site_off(5) == 22272 && site_off(6) == 27904 && site_off(7) == 27904 + 5632, "site_off");
constexpr int NWIN = site_off(NSITE);
static_assert(NWIN == 55808, "win rows");

constexpr size_t alignup(size_t x) { return (x + 4095) & ~(size_t)4095; }
constexpr size_t WS_CTL = 0, CTL_ZERO_BYTES = 1u << 20;
constexpr int CW_BAR = 1024;
constexpr size_t RSS_OFF = 65536;
static_assert(RSS_OFF + (size_t)13 * MALL * 4 <= CTL_ZERO_BYTES, "ctl");
constexpr size_t WS_WIN = alignup(CTL_ZERO_BYTES);
constexpr size_t WS_WFO = alignup(WS_WIN + (size_t)NWIN * D * 2);
constexpr size_t WS_WEO = alignup(WS_WFO + (size_t)8 * D * FF * 2);
constexpr size_t WS_WOO = alignup(WS_WEO + (size_t)2 * D * D * 2);
constexpr size_t WS_WMOD = alignup(WS_WOO + (size_t)2 * D * 512 * 2);
constexpr size_t WS_AC = alignup(WS_WMOD + (size_t)4 * NMODC * D * 2);
constexpr size_t WS_MOD = alignup(WS_AC + (size_t)256 * D * 2);
constexpr size_t WS_CS = alignup(WS_MOD + (size_t)NBAT * 4 * NMODC * 4);
constexpr size_t WS_GT = alignup(WS_CS + (size_t)NSITE * NBAT * D * 4);
constexpr size_t WS_RCS = alignup(WS_GT + (size_t)NSITE * NBAT * D * 4);
constexpr size_t WS_SHA = alignup(WS_RCS + (size_t)NSITE * NBAT * D * 4);
constexpr size_t WS_BW = alignup(WS_SHA + (size_t)NSITE * 256 * D * 2);
constexpr size_t WS_X = alignup(WS_BW + (size_t)NBAT * NWIN * 4);
constexpr size_t WS_A = alignup(WS_X + (size_t)MALL * D * 4);
constexpr size_t WS_H = alignup(WS_A + (size_t)MALL * D * 2);
constexpr size_t WS_Z = alignup(WS_H + (size_t)MALL * FF * 2);
constexpr size_t WS_GATES = alignup(WS_Z + (size_t)MALL * NEV * 2);
constexpr size_t WS_O = alignup(WS_GATES + (size_t)MALL * 16 * 4);
constexpr size_t WS_OG = alignup(WS_O + (size_t)MALL * D * 2);
constexpr size_t WS_LSE = alignup(WS_OG + (size_t)3 * MP * 512 * 2);
constexpr size_t WS_DC = alignup(WS_LSE + (size_t)3 * MP * 8 * 4);
constexpr size_t WS_DN = alignup(WS_DC + (size_t)16 * 64 * 4096 * 4);
constexpr size_t WS_CP = alignup(WS_DN + (size_t)16 * 64 * 64 * 4);
constexpr size_t WS_NP = alignup(WS_CP + (size_t)16 * 64 * 4096 * 2);
constexpr size_t WS_SC = alignup(WS_NP + (size_t)16 * 64 * 64 * 4);
constexpr size_t WS_END = alignup(WS_SC + (size_t)3 * 16 * 64 * 4);

constexpr size_t O_Y = 0;
constexpr size_t O_AKVP = O_Y + (size_t)MALL * D;
constexpr size_t O_AKVS = O_AKVP + (size_t)2 * 2 * 128 * 256;
constexpr size_t O_BCP = O_AKVS + (size_t)2 * 128 * 128 * 256;
constexpr size_t O_BCS = O_BCP + (size_t)2 * 2 * 8 * 4096;
constexpr size_t O_BNP = O_BCS + (size_t)2 * 128 * 8 * 4096;
constexpr size_t O_BNS = O_BNP + (size_t)2 * 2 * 8 * 64;
constexpr size_t O_BMP = O_BNS + (size_t)2 * 128 * 8 * 64;
constexpr size_t O_BMS = O_BMP + (size_t)2 * 2 * 8;
constexpr size_t O_C1P = O_BMS + (size_t)2 * 128 * 8;
constexpr size_t O_C1S = O_C1P + (size_t)2 * 2 * 128 * 256;
constexpr size_t O_C2P = O_C1S + (size_t)2 * 128 * 128 * 256;
constexpr size_t O_C2S = O_C2P + (size_t)2 * 2 * 512 * 256;
constexpr size_t O_C3P = O_C2S + (size_t)2 * 128 * 512 * 256;
constexpr size_t O_C3S = O_C3P + (size_t)2 * 2 * 2048 * 256;
constexpr size_t O_END = O_C3S + (size_t)2 * 128 * 2048 * 256;

enum { I_XP = 0, I_XS, I_CA, I_SBC, I_SBN, I_SBM, I_CC1, I_CC2, I_CC3, I_CP, I_CSMP, I_WMOD, I_BMOD, I_NG, I_FWI, I_FWO, I_EWI, I_EBG, I_ESK, I_EHG, I_EWO, I_OWI, I_OWO, I_FG, N_IN };

constexpr int RING_BYTES = 131072;
constexpr int MISC_OFF = RING_BYTES + 320;
constexpr int PF_OFF = 139264;
constexpr int EPI_OFF = 133120, EPI_STRIDE = 4096;
constexpr int LDS_BYTES = 147456;

#define RLX_AGENT __ATOMIC_RELAXED, __HIP_MEMORY_SCOPE_AGENT
#define LDS_WAIT() asm volatile("s_waitcnt lgkmcnt(0)" ::: "memory")
#define VM_WAIT() asm volatile("s_waitcnt vmcnt(0)" ::: "memory")

#define XB_TMO      128
#define XB_XCNT(j)  (256  + 64 * (j))
#define XB_XSUB(j)  (1280 + 64 * (j))
#define XB_XGEN(j)  (2304 + 64 * (j))
#define XB_TOP      3328
#define XB_TOPGEN   3392
#define XB_LSUB(j)  (3456 + 64 * (j))
#define XCD_BAR_WORDS 4480
#define XB_SPIN_CAP (1u << 21)
__device__ __forceinline__ unsigned xb_ld(unsigned* p)              { return __hip_atomic_load(p, __ATOMIC_RELAXED, __HIP_MEMORY_SCOPE_AGENT); }
__device__ __forceinline__ unsigned xb_add(unsigned* p, unsigned v) { return __hip_atomic_fetch_add(p, v, __ATOMIC_RELAXED, __HIP_MEMORY_SCOPE_AGENT); }
__device__ __forceinline__ unsigned xb_xcc_id() { return (unsigned)__builtin_amdgcn_s_getreg((3 << 11) | 20) & 0xFu; }
#define XB_SPIN(cond, bar) do { unsigned _sp = 0; while (cond) { __builtin_amdgcn_s_sleep(1); \
    if ((++_sp & 255u) == 0u) { if (xb_ld(&(bar)[XB_TMO])) break; if (_sp > XB_SPIN_CAP) { atomicAdd(&(bar)[XB_TMO], 1u); break; } } } } while (0)
struct XcdBarrier { unsigned* bar; unsigned x; volatile LAS unsigned* st; };
__device__ __forceinline__ XcdBarrier xcd_barrier_post(unsigned* bar, volatile LAS unsigned* st) {
    XcdBarrier b; b.bar = bar; b.x = xb_xcc_id(); b.st = st;
    if (threadIdx.x == 0) st[12] = xb_add(&bar[XB_XCNT(b.x)], 1u);
    return b;
}
__device__ __forceinline__ void xcd_barrier_complete(unsigned* bar, unsigned x, unsigned& nloc, unsigned& nx) {
    const unsigned G = gridDim.x * gridDim.y * gridDim.z;
    unsigned sum, cnt, mine, sp = 0u;
    for (;;) {
        sum = 0u; cnt = 0u; mine = 0u;
#pragma unroll
        for (unsigned j = 0; j < 16; ++j) { const unsigned c = xb_ld(&bar[XB_XCNT(j)]); sum += c; cnt += (c > 0u) ? 1u : 0u; mine = (j == x) ? c : mine; }
        if (sum == G) break;
        __builtin_amdgcn_s_sleep(1);
        if ((++sp & 255u) == 0u) { if (xb_ld(&bar[XB_TMO])) break; if (sp > XB_SPIN_CAP) { atomicAdd(&bar[XB_TMO], 1u); break; } }
    }
    nloc = mine > 0u ? mine : 1u; nx = cnt > 0u ? cnt : 1u;
}
__device__ __forceinline__ unsigned xcd_census_even(unsigned* bar) {
    const unsigned G = gridDim.x; if (G % 8u) return 0u;
    unsigned ok = 1u;
#pragma unroll
    for (unsigned j = 0; j < 16; ++j) { const unsigned c = xb_ld(&bar[XB_XCNT(j)]); ok &= (c == (j < 8u ? G / 8u : 0u)) ? 1u : 0u; }
    return ok;
}
constexpr int CQ_CH = 4096;
constexpr int CQ_N3 = 2047 * 16384 / CQ_CH, CQ_N2 = 511 * 16384 / CQ_CH, CQ_NA = 127 * 16384 / CQ_CH, CQ_N = CQ_N3 + CQ_N2 + 2 * CQ_NA;
constexpr int CW_Q = 512;
struct CopyQ { const float* c3; const float* c2; const float* ca; const float* c1; float* out; unsigned* head; };
__device__ __forceinline__ void copy_chunk(const CopyQ& Q, int chunk, int tid) {
    const float* in; float* out; int W;
    if (chunk < CQ_N3) { in = Q.c3; out = Q.out + O_C3S; W = 2048; }
    else if (chunk < CQ_N3 + CQ_N2) { chunk -= CQ_N3; in = Q.c2; out = Q.out + O_C2S; W = 512; }
    else if (chunk < CQ_N3 + CQ_N2 + CQ_NA) { chunk -= CQ_N3 + CQ_N2; in = Q.ca; out = Q.out + O_AKVS; W = 128; }
    else { chunk -= CQ_N3 + CQ_N2 + CQ_NA; in = Q.c1; out = Q.out + O_C1S; W = 128; }
    const unsigned wm1 = (unsigned)(W - 1);
    f32x4 v[8]; size_t doff[8];
#pragma unroll
    for (int j = 0; j < 8; ++j) {
        const unsigned i = (unsigned)chunk * CQ_CH + j * 512 + tid, r = i >> 6, es = r / wm1, rr = r - es * wm1;
        const size_t o = ((size_t)es * W + rr) * 256 + (i & 63) * 4; doff[j] = o;
        v[j] = __builtin_nontemporal_load((const f32x4*)(in + o + 256));
    }
#pragma unroll
    for (int j = 0; j < 8; ++j) __builtin_nontemporal_store(v[j], (f32x4*)(out + doff[j]));
}
template <int MODE  >
__device__ __forceinline__ void xb_wait_work(unsigned* bar, unsigned* pw, unsigned same, bool need_wait, volatile LAS unsigned* W, const CopyQ& Q) {
    const int tid = threadIdx.x;
    for (unsigned it = 0;; ++it) {
        const unsigned par = (it & 1u) * 2u;
        if (tid == 0) {
            unsigned rel = need_wait ? 0u : 1u;
            if (!rel) { for (int sp = 0; sp < 12; ++sp) { const unsigned v_ = xb_ld(pw); if (MODE == 0 ? (v_ != same) : (v_ >= same)) { rel = 1u; break; } __builtin_amdgcn_s_sleep(1); } }
            if (!rel && (it & 255u) == 255u) { if (xb_ld(&bar[XB_TMO])) rel = 1u; else if (it > (1u << 16)) { atomicAdd(&bar[XB_TMO], 1u); rel = 1u; } }
            unsigned ch = 0xffffffffu;
            if ((PROBE_DUP & 2048) == 0 && !rel && xb_ld(Q.head) < (unsigned)CQ_N) ch = xb_add(Q.head, 1u);
            W[par] = rel; W[par + 1] = ch;
        }
        __syncthreads();
        const unsigned rel = W[par], ch = W[par + 1];
        if (rel) break;
        if (ch < (unsigned)CQ_N) copy_chunk(Q, (int)ch, tid);
    }
}
__device__ __forceinline__ void xcd_barrier(const XcdBarrier& b, const CopyQ& Q) {
    asm volatile("s_waitcnt vmcnt(0)" ::: "memory");
    __syncthreads();
    unsigned* bar = b.bar;
    volatile LAS unsigned* W = b.st + 4;
    if (threadIdx.x == 0) {
        __builtin_amdgcn_s_waitcnt(0);
        unsigned nloc = b.st[0], nx = b.st[1];
        if (nloc == 0u) { xcd_barrier_complete(bar, b.x, nloc, nx); b.st[0] = nloc; b.st[1] = nx; b.st[10] = xcd_census_even(bar); }
        const unsigned old = xb_add(&bar[XB_XSUB(b.x)], 1u);
        const unsigned gen = old / nloc;
        unsigned role, val;
        if (old + 1u == (gen + 1u) * nloc) {
            __builtin_amdgcn_fence(__ATOMIC_RELEASE, "agent");
            asm volatile("s_waitcnt vmcnt(0)" ::: "memory");
            const unsigned og = xb_add(&bar[XB_TOP], 1u);
            const unsigned tg = og / nx;
            if (og + 1u == (tg + 1u) * nx) { xb_add(&bar[XB_TOPGEN], 1u); role = 2u; val = 0u; }
            else { role = 1u; val = tg; }
        } else { role = 0u; val = gen; }
        b.st[8] = role; b.st[9] = val;
    }
    __syncthreads();
    const unsigned role = b.st[8], val = b.st[9];
    xb_wait_work<0>(bar, role == 1u ? &bar[XB_TOPGEN] : &bar[XB_XGEN(b.x)], val, role != 2u, W, Q);
    if (threadIdx.x == 0) {
        __builtin_amdgcn_fence(__ATOMIC_ACQUIRE, "agent");
        if (role != 0u) xb_add(&bar[XB_XGEN(b.x)], 1u);
        asm volatile("s_waitcnt vmcnt(0)" ::: "memory");
    }
    __syncthreads();
}

__device__ __forceinline__ void xcc_barrier(const XcdBarrier& b, const CopyQ& Q) {
    asm volatile("s_waitcnt vmcnt(0)" ::: "memory");
    __syncthreads();
    unsigned* bar = b.bar;
    if (threadIdx.x == 0) {
        __builtin_amdgcn_s_waitcnt(0);
        const unsigned gen = b.st[11]; b.st[11] = gen + 1u;
        (void)xb_add(&bar[XB_LSUB(b.x)], 1u);
        b.st[9] = (gen + 1u) * b.st[0];
    }
    __syncthreads();
    const unsigned target = b.st[9];
    xb_wait_work<1>(bar, &bar[XB_LSUB(b.x)], target, true, b.st + 4, Q);
    asm volatile("" ::: "memory");
    __syncthreads();
}

__device__ __forceinline__ int opaque_v(int x) { asm volatile("" : "+v"(x)); return x; }
template <class P> __device__ __forceinline__ P* opaque_p(P* p) { asm volatile("" : "+s"(p)); return p; }
__device__ __forceinline__ float wave_sum(float v) {
#pragma unroll
    for (int o = 1; o < 64; o <<= 1) v += __shfl_xor(v, o);
    return v;
}
__device__ __forceinline__ float wave_max(float v) {
#pragma unroll
    for (int o = 1; o < 64; o <<= 1) v = fmaxf(v, __shfl_xor(v, o));
    return v;
}
__device__ __forceinline__ f16x4 cvt4(f32x4 v) { f16x4 r; r[0] = (f16)v[0]; r[1] = (f16)v[1]; r[2] = (f16)v[2]; r[3] = (f16)v[3]; return r; }
__device__ __forceinline__ f16x8 cat4(f16x4 lo, f16x4 hi) { f16x8 a; a[0] = lo[0]; a[1] = lo[1]; a[2] = lo[2]; a[3] = lo[3]; a[4] = hi[0]; a[5] = hi[1]; a[6] = hi[2]; a[7] = hi[3]; return a; }
__device__ __forceinline__ float sigmoidf_(float x) { return __builtin_amdgcn_rcpf(1.0f + __expf(-x)); }
__device__ __forceinline__ float logsigmoidf_(float x) { return fminf(x, 0.f) - log1pf(__expf(-fabsf(x))); }
__device__ __forceinline__ int row_batch(int m) { return m < MP ? (m >> 13) : (NB + m - MP); }

namespace pg8 {
constexpr int BM = 256, BK = 64, HALF = 128, HTB = HALF * BK * 2, STAGE_BYTES = 8 * HTB, NXCD = 8, WGM = 8;
__host__ __device__ __forceinline__ int lds_byte(int r, int c) { const int st = (r >> 4) * 2 + (c >> 5), rr = r & 15, cc = c & 31, ob = rr * 64 + cc * 2; return st * 1024 + (ob ^ (((ob >> 9) & 1) << 5)); }
__host__ __device__ __forceinline__ void stage_rc(int b, int& R, int& C) { const int st = b / 1024, sb = b % 1024, swz = sb ^ (((sb >> 9) & 1) << 5); R = (st >> 1) * 16 + swz / 64; C = (st & 1) * 32 + (swz % 64) / 2; }
struct Unit { int pm, pn; };
struct Gemm { const f16* A; const f16* Bt; int M, N, K; };
struct StaticOrder {
    int nM, nN, nwg, G, c;
    __host__ __device__ void init(int M, int N, int G_, int c_) { nM = M / BM; nN = N / BM; nwg = nM * nN; G = G_; c = c_; }
    __host__ __device__ bool next(int i, Unit& u) const {
        const long L = (long)i * G + c; if (L >= nwg) return false;
        int wgid = (int)L; { const int q = nwg / NXCD, r = nwg % NXCD, xcd = wgid % NXCD, off = wgid / NXCD; wgid = (xcd < r ? xcd * (q + 1) : r * (q + 1) + (xcd - r) * q) + off; }
        const int nig = WGM * nN, gid = wgid / nig, fm = gid * WGM, gsz = (nM - fm) < WGM ? (nM - fm) : WGM;
        u.pm = fm + ((wgid % nig) % gsz); u.pn = (wgid % nig) / gsz; return true;
    }
    __device__ __forceinline__ void a_ready(const Unit&) const {}
    __device__ __forceinline__ void done(const Unit&) const {}
};
struct DiagOrder {
    int G, c;
    __device__ bool next(int i, Unit& u) const {
        const int L = i * G + c; if (L >= NWIN / BM) return false;
        int s = 0, acc = 0;
#pragma unroll
        for (int k = 0; k < NSITE; ++k) { const int n = site_N(k) / BM; if (L >= acc + n) { s = k + 1; } acc += n; }
        u.pm = s; u.pn = L; return true;
    }
    __device__ __forceinline__ void a_ready(const Unit&) const {}
    __device__ __forceinline__ void done(const Unit&) const {}
};

template <class Epi, class Sched, bool ALIGN_EPI = true>
__device__ __forceinline__ void gemm_phase(ldsp_t lds, const Gemm g, const Sched& S, const Epi& E) {
    const int tid = opaque_v(threadIdx.x), wid = __builtin_amdgcn_readfirstlane(tid >> 6), lane = tid & 63, wr = wid >> 2, wc = wid & 3, fr = lane & 15, fq = lane >> 4;
    const int K = g.K, nt = K / BK;
    const int rot = (((S.c & 7) * nt) >> 3) & ~1;
    unsigned voffA[2];
#pragma unroll
    for (int i = 0; i < 2; ++i) voffA[i] = (unsigned)(tid * 16 + i * 8192);
#define voffB voffA
    const size_t kstep = (size_t)(2 * HTB);
    const size_t hstep = (size_t)HTB;
    const size_t tstep = (size_t)nt * kstep;
    const unsigned ldsw = (unsigned)wid * 1024u;
    const int aoff = lds_byte(wr * 64 + fr, fq * 8), boff = lds_byte(wc * 32 + fr, fq * 8);
#define PG8_SA(b, h) (((b) * 2 + (h)) * HTB)
#define PG8_SB(b, h) ((4 + (b) * 2 + (h)) * HTB)
#define PG8_STAGE_X(bufoff, gbase, voff, AUX) do { _Pragma("unroll") for (int _i = 0; _i < 2; ++_i) \
        __builtin_amdgcn_global_load_lds((const unsigned*)((const char*)(gbase) + (voff)[_i]), (LAS unsigned*)(lds + (bufoff) + ldsw + _i * 8192), 16, 0, AUX); } while (0)
#define PG8_STAGE(bufoff, gbase, voff) PG8_STAGE_X(bufoff, gbase, voff, 0)
#define PG8_STAGEA(bufoff, gbase, voff) PG8_STAGE_X(bufoff, gbase, voff, 16)
#define PG8_LDA(dst, b, h) do { _Pragma("unroll") for (int m = 0; m < 4; ++m) _Pragma("unroll") for (int k = 0; k < 2; ++k) dst[m][k] = *(const LAS f16x8*)(lds + PG8_SA(b, h) + aoff + m * 2048 + k * 1024); } while (0)
#define PG8_LDB(dst, b, h) do { _Pragma("unroll") for (int n = 0; n < 2; ++n) _Pragma("unroll") for (int k = 0; k < 2; ++k) dst[n][k] = *(const LAS f16x8*)(lds + PG8_SB(b, h) + boff + n * 2048 + k * 1024); } while (0)
#define PG8_MMA(ai, bj, At, Bt) do { __builtin_amdgcn_s_setprio(1); _Pragma("unroll") for (int m = 0; m < 4; ++m) _Pragma("unroll") for (int n = 0; n < 2; ++n) _Pragma("unroll") for (int k = 0; k < 2; ++k) \
        acc[ai][bj][m][n] = __builtin_amdgcn_mfma_f32_16x16x32_f16(Bt[n][k], At[m][k], acc[ai][bj][m][n], 0, 0, 0); __builtin_amdgcn_s_setprio(0); } while (0)
#define PG8_WAIT_V(n) asm volatile("s_waitcnt vmcnt(" #n ")" ::: "memory")
#define PG8_WAIT_L(n) asm volatile("s_waitcnt lgkmcnt(" #n ")" ::: "memory")
#define PG8_BAR __builtin_amdgcn_s_barrier()
#define PG8_SCHED __builtin_amdgcn_sched_barrier(0)
    Unit cur, nxt; int ui = 0;
    if (!S.next(0, cur)) return;
    f32x4 acc[2][2][4][2];
#pragma unroll
    for (int a = 0; a < 2; ++a)
#pragma unroll
        for (int b = 0; b < 2; ++b)
#pragma unroll
            for (int m = 0; m < 4; ++m)
#pragma unroll
                for (int n = 0; n < 2; ++n) acc[a][b][m][n] = (f32x4){0.f, 0.f, 0.f, 0.f};
    f16x8 At[4][2], B0[2][2], B1[2][2];
    const char* cA = (const char*)g.A + (size_t)cur.pm * tstep; const char* cB = (const char*)g.Bt + (size_t)cur.pn * tstep;
    S.a_ready(cur);
    const size_t rstep = (size_t)rot * kstep;
    PG8_STAGE(PG8_SB(0, 0), cB + rstep, voffB); PG8_STAGE(PG8_SB(0, 1), cB + rstep + hstep, voffB); PG8_STAGEA(PG8_SA(0, 0), cA + rstep, voffA); PG8_STAGEA(PG8_SA(0, 1), cA + rstep + hstep, voffA);
    if (wr == 1) PG8_BAR;
    PG8_WAIT_V(2); PG8_BAR;
    PG8_STAGE(PG8_SB(1, 0), cB + rstep + kstep, voffB); PG8_STAGEA(PG8_SA(1, 0), cA + rstep + kstep, voffA); PG8_STAGE(PG8_SB(1, 1), cB + rstep + hstep + kstep, voffB);
    PG8_WAIT_V(6); PG8_BAR;
    if constexpr (Epi::HAS_PRE) E.pre(cur, (LAS float*)(lds + EPI_OFF), wid, opaque_v(lane));
    for (;;) {
        const bool has_next = S.next(ui + 1, nxt);
        const char* nA = has_next ? (const char*)g.A + (size_t)nxt.pm * tstep : cA; const char* nB = has_next ? (const char*)g.Bt + (size_t)nxt.pn * tstep : cB;
        for (int t = 0; t < nt; t += 2) {
            const bool last = (t == nt - 2);
            int t1 = t + 1 + rot, t2 = t + 2 + rot; t1 -= (t1 >= nt) ? nt : 0; t2 -= (t2 >= nt) ? nt : 0;
            const char* a1 = cA + (size_t)t1 * kstep;
            const size_t nxoff = has_next ? rstep : (size_t)((nt - 2 + rot) % nt) * kstep;
            const char* a2 = last ? nA + nxoff : cA + (size_t)t2 * kstep; const char* b2 = last ? nB + nxoff : cB + (size_t)t2 * kstep;
            const char* a3 = a2 + kstep; const char* b3 = b2 + kstep;
            if (last && has_next) S.a_ready(nxt);
            PG8_LDB(B0, 0, 0); PG8_LDB(B1, 0, 1); PG8_SCHED; PG8_LDA(At, 0, 0); PG8_STAGEA(PG8_SA(1, 1), a1 + hstep, voffA);
            PG8_WAIT_V(8); PG8_WAIT_L(0); PG8_BAR; PG8_MMA(0, 0, At, B0); PG8_MMA(0, 1, At, B1); PG8_BAR; PG8_SCHED;
            PG8_LDA(At, 0, 1); PG8_STAGE(PG8_SB(0, 0), b2, voffB); PG8_STAGE(PG8_SB(0, 1), b2 + hstep, voffB); PG8_STAGEA(PG8_SA(0, 0), a2, voffA);
            PG8_WAIT_V(8); PG8_WAIT_L(0); PG8_BAR; PG8_MMA(1, 0, At, B0); PG8_MMA(1, 1, At, B1); PG8_BAR; PG8_SCHED;
            PG8_LDB(B0, 1, 0); PG8_LDB(B1, 1, 1); PG8_SCHED; PG8_LDA(At, 1, 0); PG8_STAGEA(PG8_SA(0, 1), a2 + hstep, voffA);
            PG8_WAIT_V(8); PG8_WAIT_L(0); PG8_BAR; PG8_MMA(0, 0, At, B0); PG8_MMA(0, 1, At, B1); PG8_BAR; PG8_SCHED;
            PG8_LDA(At, 1, 1); PG8_STAGE(PG8_SB(1, 0), b3, voffB); PG8_STAGE(PG8_SB(1, 1), b3 + hstep, voffB); PG8_STAGEA(PG8_SA(1, 0), a3, voffA);
            PG8_WAIT_V(8); PG8_WAIT_L(0); PG8_BAR; PG8_MMA(1, 0, At, B0); PG8_MMA(1, 1, At, B1); PG8_BAR; PG8_SCHED;
        }
        if constexpr (ALIGN_EPI) { if (wr == 0) PG8_BAR; }
        E(acc, cur, wr, wc, fr, fq, (const LAS float*)(lds + EPI_OFF + (ui & 1) * EPI_STRIDE)); S.done(cur);
        if (!has_next) break;
#pragma unroll
        for (int a = 0; a < 2; ++a)
#pragma unroll
            for (int b = 0; b < 2; ++b)
#pragma unroll
                for (int m = 0; m < 4; ++m)
#pragma unroll
                    for (int n = 0; n < 2; ++n) acc[a][b][m][n] = (f32x4){0.f, 0.f, 0.f, 0.f};
        cur = nxt; cA = nA; cB = nB; ++ui;
        if constexpr (Epi::HAS_PRE) E.pre(cur, (LAS float*)(lds + EPI_OFF + (ui & 1) * EPI_STRIDE), wid, opaque_v(lane));
        if constexpr (ALIGN_EPI) { if (wr == 1) PG8_BAR; }
    }
    PG8_WAIT_V(0);
    if constexpr (!ALIGN_EPI) { if (wr == 0) PG8_BAR; }
    PG8_BAR;
#undef PG8_SA
#undef PG8_SB
#undef PG8_STAGE
#undef voffB
#undef PG8_STAGEA
#undef PG8_STAGE_X
#undef PG8_LDA
#undef PG8_LDB
#undef PG8_MMA
#undef PG8_WAIT_V
#undef PG8_WAIT_L
#undef PG8_BAR
#undef PG8_SCHED
}
}
__host__ __device__ __forceinline__ size_t tiled_byte(int row, int col, int K) {
    return ((size_t)((row >> 8) * (K >> 6) + (col >> 6)) * 2 + ((row >> 7) & 1)) * 16384 + (size_t)pg8::lds_byte(row & 127, col & 63);
}
template <class V> __device__ __forceinline__ V* tiled_ptr(f16* base, int row, int col, int K) { return (V*)((char*)base + tiled_byte(row, col, K)); }

using pg8::Unit;
struct EpiSwiglu {
    static constexpr bool HAS_PRE = true;
    const float* rowss; const float* BW; f16* H;
    __device__ __forceinline__ void pre(const Unit& u, LAS float* ev, int wid, int lane) const {
        const int i = (wid & 3) * 64 + lane;
        const float* src = (wid < 4) ? rowss + u.pm * 256 + i : BW + (size_t)(u.pm >> 5) * NWIN + u.pn * 256 + i;
        __builtin_amdgcn_global_load_lds((const unsigned*)src, (LAS unsigned*)(ev + (wid < 4 ? 0 : 256) + (wid & 3) * 64), 4, 0, 0);
    }
    __device__ __forceinline__ static f16x4 act(f32x4 g, f32x4 u, float r, f32x4 bg, f32x4 bu) {
        f32x4 o;
#pragma unroll
        for (int e = 0; e < 4; ++e) { const float gg = g[e] * r + bg[e], uu = u[e] * r + bu[e]; o[e] = gg * uu * __builtin_amdgcn_rcpf(1.0f + __expf(-gg)); }
        return cvt4(o);
    }
    __device__ __forceinline__ void operator()(const f32x4 (&acc)[2][2][4][2], const Unit& u, int wr, int wc, int fr_in, int fq_in, const LAS float* ev) const {
        const int fr = opaque_v(fr_in), fq = opaque_v(fq_in);
        f32x4 bg[2], bu[2];
#pragma unroll
        for (int bj = 0; bj < 2; ++bj) { const int cg = 256 + bj * 128 + wc * 32 + 4 * fq; bg[bj] = *(const LAS f32x4*)(ev + cg); bu[bj] = *(const LAS f32x4*)(ev + cg + 16); }
        char* hb = (char*)H + (size_t)(u.pm * (FF / 64) + 2 * u.pn + (wc >> 1)) * 32768 + (size_t)(8 * wr + (wc & 1)) * 1024;
        const unsigned lo = (unsigned)(fr * 64 + ((16 * fq) ^ (32 * (fr >> 3))));
#pragma unroll
        for (int ai = 0; ai < 2; ++ai)
#pragma unroll
            for (int m = 0; m < 4; ++m) {
                const float r = rsqrtf(ev[ai * 128 + wr * 64 + m * 16 + fr] * (1.0f / D) + EPS);
                const f16x4 h0 = act(acc[ai][0][m][0], acc[ai][0][m][1], r, bg[0], bu[0]), h1 = act(acc[ai][1][m][0], acc[ai][1][m][1], r, bg[1], bu[1]);
                *(f16x8*)(hb + lo + (ai * 16384 + m * 2048)) = cat4(h0, h1);
            }
    }
    __device__ __forceinline__ void sk(int row, int q32, int e4, f32x4 g, f32x4 u) const {
        const int b = row_batch(row); const float* bias = BW + (size_t)b * NWIN + q32 * 32 + e4;
        const float r = rsqrtf(rowss[row] * (1.0f / D) + EPS);
        *(f16x4*)(H + (size_t)row * FF + 128 * (q32 >> 3) + 32 * (q32 & 3) + 2 * e4 + 4 * ((q32 >> 2) & 1)) = act(g, u, r, *(const f32x4*)bias, *(const f32x4*)(bias + 16));
    }
};
struct EpiRes {
    static constexpr bool HAS_PRE = true;
    f16* X; f16* A; float* rowss_next; const float* GT; const float* CS; const float* RCS;
    __device__ __forceinline__ void pre(const Unit& u, LAS float* ev, int wid, int lane) const {
        const int i = (wid & 3) * 64 + lane; const size_t o = (size_t)(u.pm >> 5) * D + u.pn * 256 + i;
        if (wid < 4) { __builtin_amdgcn_global_load_lds((const unsigned*)(GT + o), (LAS unsigned*)(ev + (wid & 3) * 64), 4, 0, 0);
                       __builtin_amdgcn_global_load_lds((const unsigned*)(RCS + o), (LAS unsigned*)(ev + 512 + (wid & 3) * 64), 4, 0, 0); }
        else if (CS) __builtin_amdgcn_global_load_lds((const unsigned*)(CS + o), (LAS unsigned*)(ev + 256 + (wid & 3) * 64), 4, 0, 0);
    }
    __device__ __forceinline__ void operator()(const f32x4 (&acc)[2][2][4][2], const Unit& u, int wr, int wc, int fr_in, int fq_in, const LAS float* ev) const {
        const int fr = opaque_v(fr_in), fq = opaque_v(fq_in);
        const int col0 = u.pn * 256 + wc * 32 + 8 * fq;
        const LAS float* gt = ev + wc * 32 + 8 * fq; const LAS float* cs = ev + 256 + wc * 32 + 8 * fq; const LAS float* rc = ev + 512 + wc * 32 + 8 * fq;
        char* ab = (char*)A + (size_t)(u.pm * (D / 64) + 4 * u.pn + (wc >> 1)) * 32768 + (size_t)(8 * wr + (wc & 1)) * 1024;
        const unsigned lo = (unsigned)(fr * 64 + ((16 * fq) ^ (32 * (fr >> 3))));
        const bool lastsite = (CS == nullptr);
        f32x4 gv[2][2], rv[2][2], cv[2][2];
#pragma unroll
        for (int bj = 0; bj < 2; ++bj)
#pragma unroll
            for (int n = 0; n < 2; ++n) { gv[bj][n] = *(const LAS f32x4*)(gt + bj * 128 + 4 * n); rv[bj][n] = *(const LAS f32x4*)(rc + bj * 128 + 4 * n); cv[bj][n] = *(const LAS f32x4*)(cs + bj * 128 + 4 * n); }
#pragma unroll
        for (int ai = 0; ai < 2; ++ai)
#pragma unroll
            for (int m = 0; m < 4; ++m) {
                const int row = u.pm * 256 + ai * 128 + wr * 64 + m * 16 + fr;
                float ss = 0.f;
#pragma unroll
                for (int bj = 0; bj < 2; ++bj) {
                    const int off = bj * 128;
                    f16x8* ap = (f16x8*)(ab + lo + (bj * 65536 + ai * 16384 + m * 2048));
                    const f16x8 ah = *ap;
                    f16x4 ao[2];
#pragma unroll
                    for (int n = 0; n < 2; ++n) {
                        f32x4 x = {(float)ah[4 * n], (float)ah[4 * n + 1], (float)ah[4 * n + 2], (float)ah[4 * n + 3]}; x = x * rv[bj][n] + gv[bj][n] * acc[ai][bj][m][n];
                        ss += (x[0] * x[0] + x[1] * x[1]) + (x[2] * x[2] + x[3] * x[3]);
                        ao[n] = cvt4(lastsite ? x : x * cv[bj][n]);
                    }
                    if (lastsite) *(f16x8*)(X + (size_t)row * D + col0 + off) = cat4(ao[0], ao[1]);
                    else *ap = cat4(ao[0], ao[1]);
                }
                ss += __shfl_xor(ss, 16); ss += __shfl_xor(ss, 32);
                if (fq == 0) atomicAdd(rowss_next + row, ss);
            }
    }
    __device__ __forceinline__ static int slot2col(int slot) { return (slot & ~31) + 8 * ((slot & 15) >> 2) + 4 * ((slot >> 4) & 1); }
    __device__ __forceinline__ void sk(int row, int slot, f32x4 v) const {
        const int col = slot2col(slot);
        const int b = row_batch(row);
        const f32x4 g4 = *(const f32x4*)(GT + (size_t)b * D + col), r4 = *(const f32x4*)(RCS + (size_t)b * D + col);
        f16* ar = A + (size_t)row * D + col; const f16x4 ah = *(const f16x4*)ar;
        f32x4 x = {(float)ah[0], (float)ah[1], (float)ah[2], (float)ah[3]}; x = x * r4 + g4 * v;
        if (CS) *(f16x4*)ar = cvt4(x * *(const f32x4*)(CS + (size_t)b * D + col));
        else *(f16x4*)(X + (size_t)row * D + col) = cvt4(x);
        atomicAdd(rowss_next + row, (x[0] * x[0] + x[1] * x[1]) + (x[2] * x[2] + x[3] * x[3]));
    }
};
template <bool EVEN> struct EpiZ {
    static constexpr bool HAS_PRE = true;
    const float* rowss; const float* BW; f16* Z; float* GATES;
    __device__ __forceinline__ void pre(const Unit& u, LAS float* ev, int wid, int lane) const {
        const int i = (wid & 3) * 64 + lane;
        const float* src = (wid < 4) ? rowss + u.pm * 256 + i : BW + (size_t)(u.pm >> 5) * NWIN + u.pn * 256 + i;
        __builtin_amdgcn_global_load_lds((const unsigned*)src, (LAS unsigned*)(ev + (wid < 4 ? 0 : 256) + (wid & 3) * 64), 4, 0, 0);
    }
    static constexpr int LDZ = EVEN ? NEV : NOD;
    __device__ __forceinline__ void put(int row, int col, f32x4 z) const {
        if (EVEN) {
            if (col < 2816) { if (col >= 1280 && col < 1792) z = z * 0.125f; *(f16x4*)(Z + (size_t)row * LDZ + col) = cvt4(z); }
            else if (col < NEVR) *(f32x4*)(GATES + (size_t)row * 16 + (col - 2816)) = z;
        } else *(f16x4*)(Z + (size_t)row * LDZ + col) = cvt4(z);
    }
    __device__ __forceinline__ void put8(int row, int col, f32x4 z0, f32x4 z1) const {
        if (EVEN) {
            if (col < 2816) { if (col >= 1280 && col < 1792) { z0 = z0 * 0.125f; z1 = z1 * 0.125f; } *(f16x8*)(Z + (size_t)row * LDZ + col) = cat4(cvt4(z0), cvt4(z1)); }
            else if (col < NEVR) { float* gp = GATES + (size_t)row * 16 + (col - 2816); *(f32x4*)gp = z0; *(f32x4*)(gp + 4) = z1; }
        } else *(f16x8*)(Z + (size_t)row * LDZ + col) = cat4(cvt4(z0), cvt4(z1));
    }
    __device__ __forceinline__ static int slot2col(int slot) { return (slot & ~31) + 8 * ((slot & 15) >> 2) + 4 * ((slot >> 4) & 1); }
    __device__ __forceinline__ void operator()(const f32x4 (&acc)[2][2][4][2], const Unit& u, int wr, int wc, int fr_in, int fq_in, const LAS float* ev) const {
        const int fr = opaque_v(fr_in), fq = opaque_v(fq_in);
        const int col0 = u.pn * 256 + wc * 32 + 8 * fq;
        f32x4 bv[2][2];
#pragma unroll
        for (int bj = 0; bj < 2; ++bj)
#pragma unroll
            for (int n = 0; n < 2; ++n) bv[bj][n] = *(const LAS f32x4*)(ev + 256 + wc * 32 + 4 * fq + bj * 128 + n * 16);
#pragma unroll
        for (int ai = 0; ai < 2; ++ai)
#pragma unroll
            for (int m = 0; m < 4; ++m) {
                const int row = u.pm * 256 + ai * 128 + wr * 64 + m * 16 + fr;
                const float r = rsqrtf(ev[ai * 128 + wr * 64 + m * 16 + fr] * (1.0f / D) + EPS);
#pragma unroll
                for (int bj = 0; bj < 2; ++bj) put8(row, col0 + bj * 128, acc[ai][bj][m][0] * r + bv[bj][0], acc[ai][bj][m][1] * r + bv[bj][1]);
            }
    }
    __device__ __forceinline__ void sk(int row, int slot, f32x4 v) const {
        const int b = row_batch(row); const float r = rsqrtf(rowss[row] * (1.0f / D) + EPS);
        put(row, slot2col(slot), v * r + *(const f32x4*)(BW + (size_t)b * NWIN + slot));
    }
};
struct EpiMod {
    static constexpr bool HAS_PRE = false;
    float* CS; float* GT; f16* SHA; const float* bmod; const float* NG; float* RCS;
    __device__ __forceinline__ void operator()(const f32x4 (&acc)[2][2][4][2], const Unit& u, int wr, int wc, int fr_in, int fq_in, const LAS float* ev) const {
        const int fr = opaque_v(fr_in), fq = opaque_v(fq_in);
        const int cu = u.pn * 256, l = cu / NMODC, jj = (cu - l * NMODC) >> 10, j = jj / 3, kind = jj - 3 * j, s = 3 * l + j;
        const int d0 = (cu & 1023) + wc * 32 + 4 * fq;
#pragma unroll
        for (int ai = 0; ai < 2; ++ai)
#pragma unroll
            for (int m = 0; m < 4; ++m) {
                const int row = ai * 128 + wr * 64 + m * 16 + fr;
#pragma unroll
                for (int bj = 0; bj < 2; ++bj)
#pragma unroll
                    for (int n = 0; n < 2; ++n) {
                        const int d = d0 + bj * 128 + n * 16;
                        const f32x4 v = acc[ai][bj][m][n] + *(const f32x4*)(bmod + cu - (cu & 1023) + d);
                        if (kind == 0) *tiled_ptr<f16x4>(SHA, s * 256 + row, d, D) = row < NBAT ? cvt4(v) : (f16x4){0, 0, 0, 0};
                        else if (row < NBAT) {
                            if (kind == 1) { const f32x4 c4 = *(const f32x4*)(NG + (l * 3 + j) * D + d) * (v + 1.0f); *(f32x4*)(CS + ((size_t)s * NBAT + row) * D + d) = c4;
                                *(f32x4*)(RCS + ((size_t)s * NBAT + row) * D + d) = (f32x4){1.0f / c4[0], 1.0f / c4[1], 1.0f / c4[2], 1.0f / c4[3]}; }
                            else *(f32x4*)(GT + ((size_t)s * NBAT + row) * D + d) = v * (j == 1 ? 1.0f : 0.5f);
                        }
                    }
            }
    }
};
struct EpiBias {
    static constexpr bool HAS_PRE = false;
    float* BW;
    __device__ __forceinline__ void operator()(const f32x4 (&acc)[2][2][4][2], const Unit& u, int wr, int wc, int fr_in, int fq_in, const LAS float* ev) const {
        const int fr = opaque_v(fr_in), fq = opaque_v(fq_in);
        const int col0 = u.pn * 256 + wc * 32 + 4 * fq;
#pragma unroll
        for (int ai = 0; ai < 2; ++ai)
#pragma unroll
            for (int m = 0; m < 4; ++m) {
                const int row = ai * 128 + wr * 64 + m * 16 + fr;
                if (row < NBAT) {
#pragma unroll
                    for (int bj = 0; bj < 2; ++bj)
#pragma unroll
                        for (int n = 0; n < 2; ++n) *(f32x4*)(BW + (size_t)row * NWIN + col0 + bj * 128 + n * 16) = acc[ai][bj][m][n];
                }
            }
    }
};

template <bool SWIGLU, int K, class Epi>
__device__ __forceinline__ void skinny_phase(ldsp_t lds, const f16* A, const f16* Bt, int N, const Epi& E, int G, int c, int nunits) {
    const int tid = opaque_v(threadIdx.x), wid = __builtin_amdgcn_readfirstlane(tid >> 6), lane = tid & 63, fr = lane & 15, fq = lane >> 4;
    const int grp = c & 7, rem = nunits % G, r0 = (rem + 7 - grp) >> 3;
    int r = (c >> 3) - r0, nr = ((G - grp + 7) >> 3) - r0;
    if (r < 0 || nr <= 0) { if (nr > 0) return; r = c >> 3; nr = (G - grp + 7) >> 3; }
    constexpr int AS = K + 8;
    constexpr int KS = (!SWIGLU && K > 2048) ? 4 : 1;
    LAS f16* As = (LAS f16*)lds;
    LAS float* red = (LAS float*)(lds + 16 * AS * 2);
    const f16* Ag = A + (size_t)(16 * grp) * K;
    for (int i = tid; i < 16 * (K / 8); i += 512) { const int row = i / (K / 8), ch = i - row * (K / 8);
        const unsigned long long* gp = (const unsigned long long*)(Ag + (size_t)row * K + 8 * ch);
        const unsigned long long lo = __hip_atomic_load(gp, __ATOMIC_RELAXED, __HIP_MEMORY_SCOPE_AGENT), hi = __hip_atomic_load(gp + 1, __ATOMIC_RELAXED, __HIP_MEMORY_SCOPE_AGENT);
        LAS unsigned long long* lp = (LAS unsigned long long*)(As + row * AS + 8 * ch); lp[0] = lo; lp[1] = hi; }
    __syncthreads();
    const int nitem = SWIGLU ? N / 32 : N / 16;
    const LAS f16* ap = As + fr * AS + 8 * fq;
    const int wq = wid / KS, kq = wid - wq * KS, nwq = 8 / KS;
    constexpr int KSTEPS = K / 32 / KS;
    for (int t0 = 0; t0 < nitem; t0 += nwq * nr) {
        const int t = t0 + wq * nr + r; const bool on = t < nitem;
        const int n0 = SWIGLU ? 32 * t : 16 * t;
        f32x4 acc0 = {0.f, 0.f, 0.f, 0.f}, acc1 = {0.f, 0.f, 0.f, 0.f};
        if (on) {
            const char* bp = (const char*)Bt + tiled_byte(n0 + fr, 8 * fq, K);
            const LAS f16* apk = ap + 32 * KSTEPS * kq;
#pragma unroll 8
            for (int ks = 0; ks < KSTEPS; ++ks) {
                const int kg = KSTEPS * kq + ks; const size_t ko = (size_t)(kg >> 1) * 32768 + (size_t)(kg & 1) * 1024;
                const f16x8 a = *(const LAS f16x8*)(apk + 32 * ks);
                const f16x8 b0 = *(const f16x8*)(bp + ko);
                acc0 = __builtin_amdgcn_mfma_f32_16x16x32_f16(b0, a, acc0, 0, 0, 0);
                if constexpr (SWIGLU) { const f16x8 b1 = *(const f16x8*)(bp + ko + 2048); acc1 = __builtin_amdgcn_mfma_f32_16x16x32_f16(b1, a, acc1, 0, 0, 0); }
            }
        }
        if constexpr (KS > 1) {
            *(LAS f32x4*)(red + (wid * 64 + lane) * 4) = acc0;
            __syncthreads();
            if (kq == 0) {
#pragma unroll
                for (int j = 1; j < KS; ++j) acc0 = acc0 + *(const LAS f32x4*)(red + ((wid + j) * 64 + lane) * 4);
            }
            __syncthreads();
        }
        const int row = MP + 16 * grp + fr;
        if (on && kq == 0) {
            if constexpr (SWIGLU) E.sk(row, t, 4 * fq, acc0, acc1);
            else E.sk(row, n0 + 4 * fq, acc0);
        }
    }
    __syncthreads();
}

struct Frame {
    ldsp_t lds; int tid, lane, wave, G, bid;
    float* out; unsigned char* ws;
};
#define FIN(i) (((const float* const __attribute__((address_space(4)))*)__builtin_amdgcn_kernarg_segment_ptr())[i])
#define WSP(T_, off) ((T_*)(F.ws + (off)))

__device__ __forceinline__ void tr_item(const float* W, int K, int Nsrc, int Ndst, int perm, f16* WT, LAS float* scr, int item, int lane) {
    const int nblk = Ndst / 64, kb = item / nblk, nb64 = item - kb * nblk, k0 = 32 * kb, n0 = 64 * nb64;
    const int kr = lane >> 4, c16 = lane & 15, nb = 2 * nb64 + (c16 >> 3), c4 = c16 & 7;
    int sc = 32 * nb + 4 * c4;
    if (perm == 2) sc = 32 * nb + 8 * (c4 & 3) + 4 * (c4 >> 2);
    else if (perm == 1) sc = (c4 >> 2) * FF + 128 * (nb64 >> 2) + 32 * (nb64 & 3) + 8 * (c4 & 3) + 4 * (c16 >> 3);
    const bool ok = sc < Nsrc;
    f32x4 v[8];
#pragma unroll
    for (int i = 0; i < 8; ++i) v[i] = ok ? __builtin_nontemporal_load((const f32x4*)(W + (size_t)(k0 + 4 * i + kr) * Nsrc + sc)) : (f32x4){0.f, 0.f, 0.f, 0.f};
#pragma unroll
    for (int i = 0; i < 8; ++i) { LAS float* d = scr + (4 * i + kr) * 65 + 4 * c16; d[0] = v[i][0]; d[1] = v[i][1]; d[2] = v[i][2]; d[3] = v[i][3]; }
    LDS_WAIT(); asm volatile("" ::: "memory");
    const int c = lane & 3;
#pragma unroll
    for (int j = 0; j < 4; ++j) { const int n = (lane >> 2) + 16 * j; const LAS float* sp = scr + (8 * c) * 65 + n;
        f16x8 o;
#pragma unroll
        for (int e = 0; e < 8; ++e) o[e] = (f16)sp[e * 65];
        const int row = perm == 1 ? 256 * (nb64 >> 2) + 128 * (n >> 5) + 32 * (nb64 & 3) + (n & 31) : n0 + n;
        *tiled_ptr<f16x8>(WT, row, k0 + 8 * c, K) = o; }
    LDS_WAIT(); asm volatile("" ::: "memory");
}
struct MatDesc { const float* src; int K, Nsrc, Ndst, perm; f16* dst; };
__device__ __forceinline__ void mat_desc(Frame& F, int mi, MatDesc& d) {
    if (mi < 8) { const int l = mi >> 1, i = mi & 1; d = {FIN(I_FWI) + (size_t)mi * D * FF2, D, FF2, FF2, 1, WSP(f16, WS_WIN) + (size_t)site_off(3 * l + 2 * i) * D}; }
    else if (mi < 10) { const int e = mi - 8; d = {FIN(I_EWI) + (size_t)e * D * NEVR, D, NEVR, NEV, 2, WSP(f16, WS_WIN) + (size_t)site_off(6 * e + 1) * D}; }
    else if (mi < 12) { const int o = mi - 10; d = {FIN(I_OWI) + (size_t)o * D * NOD, D, NOD, NOD, 2, WSP(f16, WS_WIN) + (size_t)site_off(6 * o + 4) * D}; }
    else if (mi < 20) { const int k = mi - 12; d = {FIN(I_FWO) + (size_t)k * FF * D, FF, D, D, 2, WSP(f16, WS_WFO) + (size_t)k * D * FF}; }
    else if (mi < 22) { const int e = mi - 20; d = {FIN(I_EWO) + (size_t)e * D * D, D, D, D, 2, WSP(f16, WS_WEO) + (size_t)e * D * D}; }
    else if (mi < 24) { const int o = mi - 22; d = {FIN(I_OWO) + (size_t)o * 512 * D, 512, D, D, 2, WSP(f16, WS_WOO) + (size_t)o * D * 512}; }
    else { const int l = mi - 24; d = {FIN(I_WMOD) + (size_t)l * D * NMODC, D, NMODC, NMODC, 0, WSP(f16, WS_WMOD) + (size_t)l * NMODC * D}; }
}
__device__ __forceinline__ void cache_shift(const float* in, float* out, int W, size_t gtid, size_t gstride) {
    const size_t per = (size_t)(W - 1) * 64, total = per * 256;
    for (size_t i = gtid; i < total; i += gstride) {
        const size_t es = i / per, off = i - es * per;
        const f32x4 v = __builtin_nontemporal_load((const f32x4*)(in + es * (size_t)W * 256 + 256) + off);
        __builtin_nontemporal_store(v, (f32x4*)(out + es * (size_t)W * 256) + off);
    }
}
__device__ __forceinline__ void phase_pr0(Frame& F, int mlo, int mhi, bool do_ac, unsigned* ctr) {
    LAS float* scr = (LAS float*)(F.lds + F.wave * 16384);
    const int gw = F.bid * 8 + F.wave, NGW = F.G * 8;
    if (ctr) {
        int total = 0;
        for (int mi = mlo; mi < mhi; ++mi) { MatDesc d; mat_desc(F, mi, d); total += (d.K / 64) * (d.Ndst / 32); }
        for (;;) {
            unsigned g0 = 0; if (F.lane == 0) g0 = xb_add(ctr, 4u);
            g0 = (unsigned)__builtin_amdgcn_readfirstlane((int)g0);
            if ((int)g0 >= total) break;
            for (int j = 0; j < 4 && (int)g0 + j < total; ++j) {
                int g = (int)g0 + j, mi = mlo; MatDesc d; mat_desc(F, mi, d); int items = (d.K / 64) * (d.Ndst / 32);
                while (g >= items) { g -= items; ++mi; mat_desc(F, mi, d); items = (d.K / 64) * (d.Ndst / 32); }
                tr_item(d.src, d.K, d.Nsrc, d.Ndst, d.perm, d.dst, scr, g, F.lane);
            }
        }
    } else {
    int base = 0;
    for (int mi = mlo; mi < mhi; ++mi) {
        MatDesc d; mat_desc(F, mi, d);
        const int items = (d.K / 64) * (d.Ndst / 32);
        int it = gw - (base % NGW); if (it < 0) it += NGW;
        for (; it < items; it += NGW) tr_item(d.src, d.K, d.Nsrc, d.Ndst, d.perm, d.dst, scr, it, F.lane);
        base += items;
    }
    }
    if (do_ac) { f16* AC = WSP(f16, WS_AC);
      for (int i = F.bid * 512 + F.tid; i < 256 * D; i += F.G * 512) { const int b = i >> 10, d = i & 1023; float v = 0.f;
          if (b < NBAT) { const float c = b < NB ? FIN(I_CP)[b * D + d] : FIN(I_CSMP)[(b - NB) * D + d]; v = c / (1.0f + __expf(-c)); }
          *tiled_ptr<f16>(AC, b, d, D) = (f16)v; } }
}
__device__ __forceinline__ void phase_pr2(Frame& F) {
    const float* CS0 = WSP(float, WS_CS);
    f16* X = WSP(f16, WS_X); f16* A = WSP(f16, WS_A); float* rowss = (float*)(F.ws + RSS_OFF);
    constexpr int NU = NWIN / 256, NIT = MALL / 4;
    const int nbw = (F.G < NU ? F.G : NU) * 8, nfw = F.G * 8 - nbw;
    int it_lo = 0, it_hi = NIT, it_idx = F.bid * 8 + F.wave, it_st = F.G * 8;
    if (nfw > 0) { const int ib = NIT < nbw ? NIT : nbw;
        if (F.bid < NU) { it_hi = ib; it_st = nbw; } else { it_lo = ib; it_idx = (F.bid - NU) * 8 + F.wave; it_st = nfw; } }
    for (int it = it_lo + it_idx; it < it_hi; it += it_st) { const int m0 = it * 4;
        f32x4 xv[4][4];
#pragma unroll
        for (int r = 0; r < 4; ++r) { const int m = m0 + r; const float* xr = m < MP ? FIN(I_XP) + (size_t)m * D : FIN(I_XS) + (size_t)(m - MP) * D;
#pragma unroll
            for (int q = 0; q < 4; ++q) xv[r][q] = __builtin_nontemporal_load((const f32x4*)(xr + q * 256 + F.lane * 4)); }
#pragma unroll
        for (int r = 0; r < 4; ++r) { const int m = m0 + r; const float* cs = CS0 + (size_t)row_batch(m) * D; float ss = 0.f;
#pragma unroll
            for (int q = 0; q < 4; ++q) { const int d = q * 256 + F.lane * 4;
                const f32x4 x = xv[r][q];
                ss += (x[0] * x[0] + x[1] * x[1]) + (x[2] * x[2] + x[3] * x[3]);
                const f16x4 av = cvt4(x * *(const f32x4*)(cs + d));
                if (m < MP) *tiled_ptr<f16x4>(A, m, d, D) = av; else *(f16x4*)(A + (size_t)m * D + d) = av; }
            ss = wave_sum(ss);
            if (F.lane == 0) rowss[m] = ss; }
    }
}
template <int O0, int O1, int O2, int O3, int O4, int O5, int O6, int O7>
__device__ __forceinline__ void tr_read8(unsigned base, f16x4 (&r)[8]) {
    asm volatile("ds_read_b64_tr_b16 %0, %8 offset:%9\n\tds_read_b64_tr_b16 %1, %8 offset:%10\n\tds_read_b64_tr_b16 %2, %8 offset:%11\n\tds_read_b64_tr_b16 %3, %8 offset:%12\n\t"
                 "ds_read_b64_tr_b16 %4, %8 offset:%13\n\tds_read_b64_tr_b16 %5, %8 offset:%14\n\tds_read_b64_tr_b16 %6, %8 offset:%15\n\tds_read_b64_tr_b16 %7, %8 offset:%16\n\ts_waitcnt lgkmcnt(0)"
                 : "=&v"(r[0]), "=&v"(r[1]), "=&v"(r[2]), "=&v"(r[3]), "=&v"(r[4]), "=&v"(r[5]), "=&v"(r[6]), "=&v"(r[7])
                 : "v"(base), "n"(O0), "n"(O1), "n"(O2), "n"(O3), "n"(O4), "n"(O5), "n"(O6), "n"(O7) : "memory");
}
__device__ __forceinline__ unsigned lds_addr(const LAS void* p) { return (unsigned)(unsigned long long)p; }
struct BandAttn { const f16* Z; int ldz, qcol, kcol, vcol; f16* O; int ldo, ocol; float* LSE; const float* sinks; int tiledO; };
constexpr int KS_STR = 72, VS_STR = 96;
constexpr int ATT_KS = 0, ATT_VS = 256 * KS_STR * 2;
__device__ __forceinline__ void band_attn_unit(ldsp_t lds, const BandAttn& P, int tokbase, int stride, int blk, int kvh) {
    const int tid = opaque_v(threadIdx.x), w = __builtin_amdgcn_readfirstlane(tid >> 6), lane = tid & 63, c = lane & 31, hh = lane >> 5;
    LAS f16* Ks = (LAS f16*)(lds + ATT_KS); LAS f16* Vs = (LAS f16*)(lds + ATT_VS);
    f16x8 qfa[2][4];
    { const int head_ = kvh * 4 + (w >> 1);
#pragma unroll
      for (int qt = 0; qt < 2; ++qt) { const int mr_ = tokbase + stride * (128 * blk + 64 * (w & 1) + 32 * qt + c);
#pragma unroll
          for (int ks = 0; ks < 4; ++ks) qfa[qt][ks] = *(const f16x8*)(P.Z + (size_t)mr_ * P.ldz + P.qcol + head_ * 64 + 16 * ks + 8 * hh); } }
#pragma unroll
    for (int i = 0; i < 4; ++i) {
        const int cid = tid + 512 * i, key = cid >> 3, ch = cid & 7, p = 128 * blk - 128 + key;
        f16x8 kv = {0, 0, 0, 0, 0, 0, 0, 0}, vv = {0, 0, 0, 0, 0, 0, 0, 0};
        if (p >= 0) { const f16* zr = P.Z + (size_t)(tokbase + stride * p) * P.ldz + kvh * 64 + 8 * ch; kv = *(const f16x8*)(zr + P.kcol); vv = *(const f16x8*)(zr + P.vcol); }
        *(LAS f16x8*)(Ks + key * KS_STR + 8 * ch) = kv;
        *(LAS f16x8*)(Vs + key * VS_STR + 8 * ch) = vv;
    }
    __syncthreads();
    const int g = w >> 1, qh = w & 1, head = kvh * 4 + g;
    const unsigned vlane = lds_addr(Vs) + (unsigned)((4 * hh + ((lane & 15) >> 2)) * (VS_STR * 2) + (16 * ((lane >> 4) & 1) + 4 * (lane & 3)) * 2);
    const float sink = P.sinks ? P.sinks[head] : -INFINITY;
    constexpr float SC = 0.125f, L2E = 1.4426950408889634f;
#pragma unroll
    for (int qt = 0; qt < 2; ++qt) {
        const int i0 = 64 * qh + 32 * qt;
        const int mrow = tokbase + stride * (128 * blk + i0 + c);
        f16x8 qf[4];
#pragma unroll
        for (int ks = 0; ks < 4; ++ks) qf[ks] = qt ? qfa[1][ks] : qfa[0][ks];
        f32x16 s[5];
#pragma unroll
        for (int kt = 0; kt < 5; ++kt) {
#pragma unroll
            for (int i = 0; i < 16; ++i) s[kt][i] = 0.f;
#pragma unroll
            for (int ks = 0; ks < 4; ++ks) {
                const f16x8 a = *(const LAS f16x8*)(Ks + (i0 + 32 * kt + c) * KS_STR + 16 * ks + 8 * hh);
                s[kt] = __builtin_amdgcn_mfma_f32_32x32x16_f16(a, qf[ks], s[kt], 0, 0, 0);
            }
        }
        float mx = -INFINITY;
        const int cm = c - 4 * hh;
#pragma unroll
        for (int i = 0; i < 16; ++i) { const int kb = (i & 3) + 8 * (i >> 2);
            s[0][i] = (kb >= cm) ? s[0][i] : -INFINITY; s[4][i] = (kb <= cm) ? s[4][i] : -INFINITY; }
        if (blk == 0) {
            asm volatile("" ::: "memory");
#pragma unroll
            for (int kt = 0; kt < 5; ++kt)
#pragma unroll
                for (int i = 0; i < 16; ++i) { const int kr = (i & 3) + 8 * (i >> 2) + 4 * hh; s[kt][i] = (i0 + 32 * kt + kr >= 128) ? s[kt][i] : -INFINITY; }
        }
#pragma unroll
        for (int kt = 0; kt < 5; ++kt)
#pragma unroll
            for (int i = 0; i < 16; ++i) mx = fmaxf(mx, s[kt][i]);
        mx = fmaxf(mx, __shfl_xor(mx, 32));
        mx = fmaxf(mx * SC, sink);
        constexpr float CE = SC * L2E; const float moff = mx * L2E;
        float sum = 0.f; f16x8 pf[5][2];
#pragma unroll
        for (int kt = 0; kt < 5; ++kt)
#pragma unroll
            for (int i = 0; i < 16; ++i) { const float pv = __builtin_amdgcn_exp2f(__builtin_fmaf(s[kt][i], CE, -moff)); sum += pv; pf[kt][i >> 3][i & 7] = (f16)pv; }
        sum += __shfl_xor(sum, 32);
        sum += __builtin_amdgcn_exp2f((sink - mx) * L2E);
        const float inv = __builtin_amdgcn_rcpf(sum);
        f32x16 o[2];
#pragma unroll
        for (int i = 0; i < 16; ++i) { o[0][i] = 0.f; o[1][i] = 0.f; }
        const unsigned vb = vlane + (unsigned)(i0 * (VS_STR * 2));
#define BA_PV(KT) { f16x4 r[8]; constexpr int B_ = (KT) * 32 * VS_STR * 2, S_ = 16 * VS_STR * 2, H_ = 8 * VS_STR * 2; \
            tr_read8<B_, B_ + H_, B_ + S_, B_ + S_ + H_, B_ + 64, B_ + 64 + H_, B_ + 64 + S_, B_ + 64 + S_ + H_>(vb, r); \
            o[0] = __builtin_amdgcn_mfma_f32_32x32x16_f16(cat4(r[0], r[1]), pf[KT][0], o[0], 0, 0, 0); o[0] = __builtin_amdgcn_mfma_f32_32x32x16_f16(cat4(r[2], r[3]), pf[KT][1], o[0], 0, 0, 0); \
            o[1] = __builtin_amdgcn_mfma_f32_32x32x16_f16(cat4(r[4], r[5]), pf[KT][0], o[1], 0, 0, 0); o[1] = __builtin_amdgcn_mfma_f32_32x32x16_f16(cat4(r[6], r[7]), pf[KT][1], o[1], 0, 0, 0); }
        BA_PV(0) BA_PV(1) BA_PV(2) BA_PV(3) BA_PV(4)
#undef BA_PV
#pragma unroll
        for (int dt = 0; dt < 2; ++dt) {
            const int ocol = P.ocol + head * 64 + 32 * dt + 4 * hh;
#pragma unroll
            for (int rg = 0; rg < 4; ++rg) { f32x4 v = {o[dt][4 * rg] * inv, o[dt][4 * rg + 1] * inv, o[dt][4 * rg + 2] * inv, o[dt][4 * rg + 3] * inv};
                f16x4* op = P.tiledO ? tiled_ptr<f16x4>(P.O, mrow, ocol + 8 * rg, P.ldo) : (f16x4*)(P.O + (size_t)mrow * P.ldo + ocol + 8 * rg);
                *op = cvt4(v); }
        }
        if (P.LSE && hh == 0) P.LSE[(size_t)mrow * 8 + head] = mx + __logf(sum);
    }
    __syncthreads();
}
__device__ __forceinline__ void kv_export(const f16* Z, int ldz, int kcol, int vcol, int m0, int nrows, float* out, int tid0, int nthr) {
    for (int i = tid0; i < nrows * 32; i += nthr) {
        const int r = i >> 5, ch = i & 31, isv = ch >> 4, c8 = (ch & 15) * 8;
        const f16x8 v = *(const f16x8*)(Z + (size_t)(m0 + r) * ldz + (isv ? vcol : kcol) + c8);
        float* o = out + (size_t)r * 256 + isv * 128 + c8;
        *(f32x4*)o = (f32x4){(float)v[0], (float)v[1], (float)v[2], (float)v[3]}; *(f32x4*)(o + 4) = (f32x4){(float)v[4], (float)v[5], (float)v[6], (float)v[7]};
    }
}

__device__ __forceinline__ void gate_scan(const float* GATES, const float* bg, int m0, int h, int lane, LAS float* gb, LAS float* ga, LAS float* gcm, float& amax, float& bL, float& a0o, float& a1o) {
    const float* g0 = GATES + (size_t)(m0 + 2 * lane) * 16;
    const float ig0 = g0[h] + bg[h], ig1 = g0[16 + h] + bg[h];
    const float lf0 = logsigmoidf_(g0[8 + h] + bg[8 + h]), lf1 = logsigmoidf_(g0[24 + h] + bg[8 + h]);
    float s = lf0 + lf1;
#pragma unroll
    for (int o = 1; o < 64; o <<= 1) { const float t = __shfl_up(s, o); if (lane >= o) s += t; }
    const float b0 = (s - (lf0 + lf1)) + lf0, b1 = b0 + lf1;
    const float a0 = ig0 - b0, a1 = ig1 - b1;
    float mx = fmaxf(a0, a1);
#pragma unroll
    for (int o = 1; o < 64; o <<= 1) { const float t = __shfl_up(mx, o); if (lane >= o) mx = fmaxf(mx, t); }
    float ex = __shfl_up(mx, 1); if (lane == 0) ex = -INFINITY;
    const float c0 = fmaxf(ex, a0), c1 = fmaxf(c0, a1);
    gb[2 * lane] = b0; gb[2 * lane + 1] = b1; ga[2 * lane] = a0; ga[2 * lane + 1] = a1; gcm[2 * lane] = c0; gcm[2 * lane + 1] = c1;
    amax = __shfl(mx, 63); bL = __shfl(s, 63); a0o = a0; a1o = a1;
}
constexpr int X1_KS = 0, X1_VS = 18432, X1_G = 36864, X1_HEAD = 38912, X1_STR = 72;
__device__ __forceinline__ void mlstm_x1_unit(Frame& F, int e, int b, int ch, int hp) {
    const int tid = F.tid, w = F.wave, lane = F.lane, hg = w >> 2, wv = w & 3, gt = tid & 255, h = 2 * hp + hg;
    ldsp_t base = F.lds + hg * X1_HEAD;
    LAS f16* Ksm = (LAS f16*)(base + X1_KS); LAS f16* Vsm = (LAS f16*)(base + X1_VS);
    LAS float* gb = (LAS float*)(base + X1_G); LAS float* ga = gb + 128; LAS float* gcm = ga + 128; LAS float* gwk = gcm + 128;
    const f16* Z = WSP(f16, WS_Z); const float* GATES = WSP(float, WS_GATES); const float* bg = FIN(I_EBG) + e * 16;
    const int m0 = b * T + 128 * ch, idx = (b * 8 + h) * 64 + ch;
    float amax = 0.f, bL = 0.f;
    f16x8 kxa[4], vxa[4];
#pragma unroll
    for (int i = 0; i < 4; ++i) { const int cid = gt + 256 * i, s_ = cid >> 3, c8 = cid & 7; const f16* zr = Z + (size_t)(m0 + s_) * NEV + h * 64 + 8 * c8;
        kxa[i] = *(const f16x8*)(zr + 1280); vxa[i] = *(const f16x8*)(zr + 1792); }
    if (wv == 0) { float a0, a1; gate_scan(GATES, bg, m0, h, lane, gb, ga, gcm, amax, bL, a0, a1); gwk[2 * lane] = __expf(a0 - amax); gwk[2 * lane + 1] = __expf(a1 - amax); }
    __syncthreads();
#pragma unroll
    for (int i = 0; i < 4; ++i) {
        const int cid = gt + 256 * i, s_ = cid >> 3, c8 = cid & 7;
        const f16x8 kx = kxa[i], vx = vxa[i]; const float wk = gwk[s_];
        f16x8 ks;
#pragma unroll
        for (int q = 0; q < 8; ++q) ks[q] = (f16)((float)kx[q] * wk);
        *(LAS f16x8*)(Ksm + s_ * X1_STR + 8 * c8) = ks; *(LAS f16x8*)(Vsm + s_ * X1_STR + 8 * c8) = vx;
    }
    __syncthreads();
    const int fr = lane & 15, fq = lane >> 4;
    const unsigned lof = (unsigned)((8 * fq + (fr >> 2)) * (X1_STR * 2) + 4 * (fr & 3) * 2);
    const unsigned vaddr = lds_addr(Vsm) + lof + (unsigned)(16 * wv * 2), kaddr = lds_addr(Ksm) + lof;
    constexpr int R4 = 4 * X1_STR * 2, R32 = 32 * X1_STR * 2;
    f16x4 rv[8];
    tr_read8<0, R4, R32, R32 + R4, 2 * R32, 2 * R32 + R4, 3 * R32, 3 * R32 + R4>(vaddr, rv);
    float* DC = WSP(float, WS_DC) + (size_t)idx * 4096;
    f32x4 accn = {0.f, 0.f, 0.f, 0.f};
    f16x8 ones;
#pragma unroll
    for (int q = 0; q < 8; ++q) ones[q] = (fr == 0) ? (f16)1.0f : (f16)0.0f;
#define X1_TILE(DKT) { f16x4 rk[8]; tr_read8<(DKT) * 32, (DKT) * 32 + R4, (DKT) * 32 + R32, (DKT) * 32 + R32 + R4, (DKT) * 32 + 2 * R32, (DKT) * 32 + 2 * R32 + R4, (DKT) * 32 + 3 * R32, (DKT) * 32 + 3 * R32 + R4>(kaddr, rk); \
        f32x4 acc = {0.f, 0.f, 0.f, 0.f}; \
        _Pragma("unroll") for (int ks = 0; ks < 4; ++ks) { const f16x8 bf = cat4(rk[2 * ks], rk[2 * ks + 1]); acc = __builtin_amdgcn_mfma_f32_16x16x32_f16(cat4(rv[2 * ks], rv[2 * ks + 1]), bf, acc, 0, 0, 0); \
            if ((DKT) == wv) accn = __builtin_amdgcn_mfma_f32_16x16x32_f16(ones, bf, accn, 0, 0, 0); } \
        _Pragma("unroll") for (int r = 0; r < 4; ++r) DC[(16 * wv + 4 * fq + r) * 64 + 16 * (DKT) + fr] = acc[r]; }
    X1_TILE(0) X1_TILE(1) X1_TILE(2) X1_TILE(3)
#undef X1_TILE
    if (fq == 0) WSP(float, WS_DN)[(size_t)idx * 64 + 16 * wv + fr] = accn[0];
    if (gt == 0) { float* SC = WSP(float, WS_SC); SC[idx] = bL + amax; SC[1024 + idx] = bL; }
    __syncthreads();
}
__device__ __forceinline__ void mlstm_scan(Frame& F, int e) {
    const int gid0 = F.bid * 512; if (gid0 >= 16 * 4160) return;
    const int bh0 = gid0 / 4160;
    const float* SC = WSP(float, WS_SC); float* MPV = WSP(float, WS_SC) + 2048;
    LAS float* sc = (LAS float*)F.lds;
    if (F.tid < 256) { const int hw = F.tid >> 7, c = (F.tid >> 1) & 63, k = F.tid & 1, bhs = bh0 + hw; sc[F.tid] = bhs < 16 ? SC[k * 1024 + bhs * 64 + c] : 0.f; }
    __syncthreads();
    const int gid = gid0 + F.tid;
    if (gid < 16 * 4160) {
        const int bh = gid / 4160, el = gid - bh * 4160; const bool isc = el < 4096;
        const float* src = isc ? WSP(float, WS_DC) + (size_t)bh * 64 * 4096 + el : WSP(float, WS_DN) + (size_t)bh * 64 * 64 + (el - 4096);
        const int sstr = isc ? 4096 : 64;
        f16* cp = WSP(f16, WS_CP) + (size_t)bh * 64 * 4096 + el; float* np = WSP(float, WS_NP) + (size_t)bh * 64 * 64 + (el - 4096);
        const LAS float* scb = sc + (bh - bh0) * 128;
        float dvv[64];
#pragma unroll
        for (int c = 0; c < 64; ++c) dvv[c] = src[(size_t)c * sstr];
        float st = 0.f, mst = 0.f;
#pragma unroll
        for (int c = 0; c < 64; ++c) {
            const float mloc = scb[2 * c], bL = scb[2 * c + 1];
            if (isc) cp[(size_t)c * 4096] = (f16)st; else np[c * 64] = st;
            if (el == 0) MPV[bh * 64 + c] = mst;
            const float mnew = fmaxf(bL + mst, mloc);
            st = __expf(bL + mst - mnew) * st + __expf(mloc - mnew) * dvv[c]; mst = mnew;
        }
        const int b = bh >> 3, h = bh & 7;
        if (isc) { const int dv = el >> 6, dk = el & 63; F.out[O_BCP + ((size_t)((e * 2 + b) * 8 + h) * 64 + dk) * 64 + dv] = st; }
        else F.out[O_BNP + (size_t)((e * 2 + b) * 8 + h) * 64 + (el - 4096)] = st;
        if (el == 0) F.out[O_BMP + (e * 2 + b) * 8 + h] = mst;
    }
    __syncthreads();
}
constexpr int X3_KR = 0, X3_VS = 18432, X3_G = 43008, X3_HEAD = 45056;
__device__ __forceinline__ void mlstm_x3_unit(Frame& F, int e, int b, int ch, int hp) {
    const int tid = F.tid, w = F.wave, lane = F.lane, hg = w >> 2, tt = w & 3, gt = tid & 255, h = 2 * hp + hg, c = lane & 31, hh = lane >> 5;
    ldsp_t base = F.lds + hg * X3_HEAD;
    LAS f16* Kr = (LAS f16*)(base + X3_KR); LAS f16* Vs = (LAS f16*)(base + X3_VS);
    LAS float* gb = (LAS float*)(base + X3_G); LAS float* ga = gb + 128; LAS float* gcm = ga + 128; LAS float* npv = gcm + 128;
    const f16* Z = WSP(f16, WS_Z); const float* GATES = WSP(float, WS_GATES); const float* bg = FIN(I_EBG) + e * 16;
    const int m0 = b * T + 128 * ch, idx = (b * 8 + h) * 64 + ch;
    f16x8 kxa[4], vxa[4];
#pragma unroll
    for (int i = 0; i < 4; ++i) { const int cid = gt + 256 * i, s = cid >> 3, c8 = cid & 7; const f16* zr = Z + (size_t)(m0 + s) * NEV + h * 64 + 8 * c8;
        kxa[i] = *(const f16x8*)(zr + 1280); vxa[i] = *(const f16x8*)(zr + 1792); }
    if (tt == 0) { float t0, t1, t2, t3; gate_scan(GATES, bg, m0, h, lane, gb, ga, gcm, t0, t1, t2, t3); }
#pragma unroll
    for (int i = 0; i < 4; ++i) {
        const int cid = gt + 256 * i, s = cid >> 3, c8 = cid & 7;
        const f16x8 kx = kxa[i], vx = vxa[i];
        *(LAS f16x8*)(Kr + s * KS_STR + 8 * c8) = kx;
        *(LAS f16x8*)(Vs + s * VS_STR + 8 * c8) = vx;
    }
    if (gt < 64) npv[gt] = WSP(float, WS_NP)[(size_t)idx * 64 + gt];
    __syncthreads();
    const float mst = WSP(float, WS_SC)[2048 + idx];
    const int t = 32 * tt + c, mrow = m0 + t;
    const float bt = gb[t], mm = fmaxf(mst, gcm[t]), mt = bt + mm;
    f16x8 qf[4];
#pragma unroll
    for (int ks = 0; ks < 4; ++ks) qf[ks] = *(const f16x8*)(Z + (size_t)mrow * NEV + 768 + h * 64 + 16 * ks + 8 * hh);
    f32x16 num[2];
#pragma unroll
    for (int i = 0; i < 16; ++i) { num[0][i] = 0.f; num[1][i] = 0.f; }
    float qsum = 0.f;
    const unsigned vlane = lds_addr(Vs) + (unsigned)((4 * hh + ((lane & 15) >> 2)) * (VS_STR * 2) + (16 * ((lane >> 4) & 1) + 4 * (lane & 3)) * 2);
    for (int st = 0; st <= tt; ++st) {
        f32x16 sa;
#pragma unroll
        for (int i = 0; i < 16; ++i) sa[i] = 0.f;
#pragma unroll
        for (int ks = 0; ks < 4; ++ks) { const f16x8 a = *(const LAS f16x8*)(Kr + (32 * st + c) * KS_STR + 16 * ks + 8 * hh); sa = __builtin_amdgcn_mfma_f32_32x32x16_f16(a, qf[ks], sa, 0, 0, 0); }
        f16x8 wf[2];
        const bool diag = (st == tt);
        constexpr float L2E_ = 1.4426950408889634f; const float mml = mm * L2E_;
#pragma unroll
        for (int rg = 0; rg < 4; ++rg) {
            const int s0 = 32 * st + 8 * rg + 4 * hh;
            const f32x4 g4 = *(const LAS f32x4*)(ga + s0);
#pragma unroll
            for (int q = 0; q < 4; ++q) {
                const int i = 4 * rg + q;
                float dd = __builtin_amdgcn_exp2f(__builtin_fmaf(g4[q], L2E_, -mml));
                if (diag) dd = (s0 + q <= t) ? dd : 0.f;
                const float wv_ = sa[i] * dd;
                qsum += wv_; wf[i >> 3][i & 7] = (f16)wv_;
            }
        }
        { f16x4 r[8]; constexpr int S_ = 16 * VS_STR * 2, H_ = 8 * VS_STR * 2;
          tr_read8<0, H_, S_, S_ + H_, 64, 64 + H_, 64 + S_, 64 + S_ + H_>(vlane + (unsigned)(st * 32 * VS_STR * 2), r);
          num[0] = __builtin_amdgcn_mfma_f32_32x32x16_f16(cat4(r[0], r[1]), wf[0], num[0], 0, 0, 0); num[0] = __builtin_amdgcn_mfma_f32_32x32x16_f16(cat4(r[2], r[3]), wf[1], num[0], 0, 0, 0);
          num[1] = __builtin_amdgcn_mfma_f32_32x32x16_f16(cat4(r[4], r[5]), wf[0], num[1], 0, 0, 0); num[1] = __builtin_amdgcn_mfma_f32_32x32x16_f16(cat4(r[6], r[7]), wf[1], num[1], 0, 0, 0); }
    }
    qsum += __shfl_xor(qsum, 32);
    f32x16 ni[2];
#pragma unroll
    for (int i = 0; i < 16; ++i) { ni[0][i] = 0.f; ni[1][i] = 0.f; }
    const f16* CP = WSP(f16, WS_CP) + (size_t)idx * 4096;
#pragma unroll
    for (int dt = 0; dt < 2; ++dt)
#pragma unroll
        for (int ks = 0; ks < 4; ++ks) { const f16x8 a = *(const f16x8*)(CP + (32 * dt + c) * 64 + 16 * ks + 8 * hh); ni[dt] = __builtin_amdgcn_mfma_f32_32x32x16_f16(a, qf[ks], ni[dt], 0, 0, 0); }
    float qni = 0.f;
#pragma unroll
    for (int ks = 0; ks < 4; ++ks)
#pragma unroll
        for (int j = 0; j < 8; ++j) qni += (float)qf[ks][j] * npv[16 * ks + 8 * hh + j];
    qni += __shfl_xor(qni, 32);
    const float inter = __expf(mst - mm);
    const float qn = qsum + inter * qni, invd = __builtin_amdgcn_rcpf(fmaxf(fabsf(qn), __expf(-mt)));
    float ssq = 0.f;
#pragma unroll
    for (int dt = 0; dt < 2; ++dt)
#pragma unroll
        for (int i = 0; i < 16; ++i) { const float hv = (num[dt][i] + inter * ni[dt][i]) * invd; num[dt][i] = hv; ssq += hv * hv; }
    ssq += __shfl_xor(ssq, 32);
    const float rinv = rsqrtf(ssq * (1.0f / 64.0f) + EPS);
    const float* hgain = FIN(I_EHG) + (e * 8 + h) * 64;
    f16* O = WSP(f16, WS_O);
#pragma unroll
    for (int dt = 0; dt < 2; ++dt)
#pragma unroll
        for (int rg = 0; rg < 4; ++rg) {
            const int dv0 = 32 * dt + 8 * rg + 4 * hh;
            const f16x4 bo = *(const f16x4*)(Z + (size_t)mrow * NEV + 2304 + h * 64 + dv0); const f32x4 gn = *(const f32x4*)(hgain + dv0);
            f32x4 y;
#pragma unroll
            for (int q = 0; q < 4; ++q) y[q] = num[dt][4 * rg + q] * rinv * gn[q] * sigmoidf_((float)bo[q]);
            *tiled_ptr<f16x4>(O, mrow, 512 + h * 64 + dv0, D) = cvt4(y);
        }
    __syncthreads();
}

constexpr int DA_QS = 0, DA_KC = 1024, DA_VC = 36352, DA_SC = 69376, DA_RD = 71488, DA_KSTR = 68;
__device__ __forceinline__ void dec_attn(Frame& F, const float* cache, int dil, int kvh, const f16* zrow, int qcol, int kcol, int vcol, const float* sinks, float& o_out, float& lse_out) {
    const int tid = F.tid, lane = F.lane, w = F.wave;
    LAS float* qs = (LAS float*)(F.lds + DA_QS); LAS float* Kc = (LAS float*)(F.lds + DA_KC); LAS float* Vc = (LAS float*)(F.lds + DA_VC);
    LAS float* sc = (LAS float*)(F.lds + DA_SC); LAS float* rd = (LAS float*)(F.lds + DA_RD);
#pragma unroll
    for (int i = 0; i < 4; ++i) {
        const int cid = tid + 512 * i, j = cid >> 4, c4 = cid & 15;
        const float* src = cache + (size_t)(dil * j) * 256 + kvh * 64 + 4 * c4;
        const f32x4 kk = *(const f32x4*)src, vv = *(const f32x4*)(src + 128);
        *(LAS f32x4*)(Kc + j * DA_KSTR + 4 * c4) = kk;
        *(LAS f32x4*)(Vc + j * 64 + 4 * c4) = vv;
    }
    if (tid < 64) { Kc[128 * DA_KSTR + tid] = (float)zrow[kcol + kvh * 64 + tid]; Vc[128 * 64 + tid] = (float)zrow[vcol + kvh * 64 + tid]; }
    if (tid < 256) qs[tid] = (float)zrow[qcol + kvh * 256 + tid];
    __syncthreads();
    for (int jj = tid; jj < 516; jj += 512) {
        const int j = jj >> 2, g = jj & 3; f32x4 s4 = {0.f, 0.f, 0.f, 0.f};
#pragma unroll
        for (int d = 0; d < 64; d += 4) s4 = s4 + *(const LAS f32x4*)(qs + g * 64 + d) * *(const LAS f32x4*)(Kc + j * DA_KSTR + d);
        sc[g * 132 + j] = ((s4[0] + s4[1]) + (s4[2] + s4[3])) * 0.125f;
    }
    __syncthreads();
    if (w < 4) {
        const float sk = sinks ? sinks[kvh * 4 + w] : -INFINITY;
        const float v0 = sc[w * 132 + lane], v1 = sc[w * 132 + 64 + lane], v2 = lane == 0 ? sc[w * 132 + 128] : -INFINITY;
        float mx = wave_max(fmaxf(fmaxf(v0, v1), v2)); mx = fmaxf(mx, sk);
        const float p0 = __expf(v0 - mx), p1 = __expf(v1 - mx), p2 = lane == 0 ? __expf(v2 - mx) : 0.f;
        const float sum = wave_sum(p0 + p1 + p2) + __expf(sk - mx);
        sc[w * 132 + lane] = p0; sc[w * 132 + 64 + lane] = p1; if (lane == 0) { sc[w * 132 + 128] = p2; rd[w] = sum; rd[4 + w] = mx; }
    }
    __syncthreads();
    if (tid < 256) {
        const int g = tid >> 6, d = tid & 63; float o = 0.f;
#pragma unroll 4
        for (int j = 0; j < 128; j += 4) { const f32x4 p4 = *(const LAS f32x4*)(sc + g * 132 + j);
            o += p4[0] * Vc[j * 64 + d]; o += p4[1] * Vc[(j + 1) * 64 + d]; o += p4[2] * Vc[(j + 2) * 64 + d]; o += p4[3] * Vc[(j + 3) * 64 + d]; }
        o += sc[g * 132 + 128] * Vc[128 * 64 + d];
        const float den = rd[g]; o_out = o * __builtin_amdgcn_rcpf(den); lse_out = rd[4 + g] + __logf(den);
    }
    __syncthreads();
}
__device__ __forceinline__ void sample_attn_even(Frame& F, int e, int s, int kvh) {
    const f16* zrow = WSP(f16, WS_Z) + (size_t)(MP + s) * NEV;
    float o = 0.f, lse = 0.f;
    dec_attn(F, FIN(I_CA) + ((size_t)e * NS + s) * 128 * 256, 1, kvh, zrow, 0, 512, 640, FIN(I_ESK) + e * 8, o, lse);
    if (F.tid < 256) WSP(f16, WS_O)[(size_t)(MP + s) * D + kvh * 256 + F.tid] = (f16)o;
    if (F.tid < 128) { const int isv = F.tid >> 6, d = F.tid & 63;
        F.out[O_AKVS + (((size_t)e * NS + s) * 128 + 127) * 256 + isv * 128 + kvh * 64 + d] = (float)zrow[(isv ? 640 : 512) + kvh * 64 + d]; }
}
__device__ __forceinline__ void sample_attn_odd(Frame& F, int oi, int s, int kvh) {
    const f16* zrow = WSP(f16, WS_Z) + (size_t)(MP + s) * NOD;
    float o[3] = {0.f, 0.f, 0.f}, lse[3] = {0.f, 0.f, 0.f};
    dec_attn(F, FIN(I_CC1) + ((size_t)oi * NS + s) * 128 * 256, 1, kvh, zrow, 0, 512, 640, nullptr, o[0], lse[0]);
    dec_attn(F, FIN(I_CC2) + ((size_t)oi * NS + s) * 512 * 256, 4, kvh, zrow, 768, 1280, 1408, nullptr, o[1], lse[1]);
    dec_attn(F, FIN(I_CC3) + ((size_t)oi * NS + s) * 2048 * 256, 16, kvh, zrow, 1536, 2048, 2176, nullptr, o[2], lse[2]);
    if (F.tid < 256) {
        const float mx = fmaxf(fmaxf(lse[0], lse[1]), lse[2]);
        const float w0 = __expf(lse[0] - mx), w1 = __expf(lse[1] - mx), w2 = __expf(lse[2] - mx);
        WSP(f16, WS_O)[(size_t)(MP + s) * 512 + kvh * 256 + F.tid] = (f16)((w0 * o[0] + w1 * o[1] + w2 * o[2]) / (w0 + w1 + w2));
    }
    if (F.tid < 384) { const int g = F.tid >> 7, r = F.tid & 127, isv = r >> 6, d = r & 63;
        const int W = g == 0 ? 128 : (g == 1 ? 512 : 2048); const size_t ob = g == 0 ? O_C1S : (g == 1 ? O_C2S : O_C3S);
        F.out[ob + (((size_t)oi * NS + s) * W + (W - 1)) * 256 + isv * 128 + kvh * 64 + d] = (float)zrow[768 * g + (isv ? 640 : 512) + kvh * 64 + d]; }
}
__device__ __forceinline__ void sample_mlstm(Frame& F, int e, int s) {
    const int h = F.wave, lane = F.lane, m = MP + s;
    const f16* zrow = WSP(f16, WS_Z) + (size_t)m * NEV; const float* gr = WSP(float, WS_GATES) + (size_t)m * 16; const float* bg = FIN(I_EBG) + e * 16;
    const float q = (float)zrow[768 + h * 64 + lane], k = (float)zrow[1280 + h * 64 + lane], v = (float)zrow[1792 + h * 64 + lane], bo = (float)zrow[2304 + h * 64 + lane];
    const float ig = gr[h] + bg[h], lf = logsigmoidf_(gr[8 + h] + bg[8 + h]);
    const size_t sh = ((size_t)e * NS + s) * 8 + h;
    const float mst = FIN(I_SBM)[sh], nst = FIN(I_SBN)[sh * 64 + lane];
    const float mt = fmaxf(lf + mst, ig), dsc = __expf(ig - mt), inter = __expf(lf + mst - mt);
    const float qk = wave_sum(q * k), qn_i = wave_sum(q * nst);
    const float* C = FIN(I_SBC) + sh * 4096; float* Co = F.out + O_BCS + sh * 4096;
    float qc = 0.f;
#pragma unroll 8
    for (int dk = 0; dk < 64; ++dk) {
        const float cv = C[dk * 64 + lane], qd = __shfl(q, dk), kd = __shfl(k, dk);
        qc += qd * cv; Co[dk * 64 + lane] = inter * cv + dsc * kd * v;
    }
    const float wgt = qk * dsc, num = wgt * v + inter * qc, qn = wgt + inter * qn_i;
    const float hv = num / fmaxf(fabsf(qn), __expf(-mt));
    const float rinv = rsqrtf(wave_sum(hv * hv) * (1.0f / 64.0f) + EPS);
    WSP(f16, WS_O)[(size_t)m * D + 512 + h * 64 + lane] = (f16)(hv * rinv * FIN(I_EHG)[(e * 8 + h) * 64 + lane] * sigmoidf_(bo));
    F.out[O_BNS + sh * 64 + lane] = inter * nst + dsc * k;
    if (lane == 0) F.out[O_BMS + sh] = mt;
}

__device__ __forceinline__ void phase_e1(Frame& F, int e, int tmask) {
    BandAttn P{WSP(f16, WS_Z), NEV, 0, 512, 640, WSP(f16, WS_O), D, 0, nullptr, FIN(I_ESK) + e * 8, 1};
    for (int u = F.bid; u < 1152; u += F.G) {
        if (u < 256) { if (!(tmask & 1)) continue; const int kvh = u & 1, blk = (u >> 1) & 63, b = u >> 7;
            band_attn_unit(F.lds, P, b * T, 1, blk, kvh);
            if (blk == 63 && kvh == 0) kv_export(P.Z, NEV, 512, 640, b * T + T - 128, 128, F.out + O_AKVP + (size_t)(e * 2 + b) * 128 * 256, F.tid, 512);
        } else if (u < 768) { if (!(tmask & 2)) continue; const int v = u - 256; mlstm_x1_unit(F, e, v >> 8, (v >> 2) & 63, v & 3); }
        else if (u < 1024) { if (!(tmask & 4)) continue; const int v = u - 768; sample_attn_even(F, e, v >> 1, v & 1); }
        else { if (!(tmask & 8)) continue; sample_mlstm(F, e, u - 1024); }
    }
}
__device__ __forceinline__ void phase_e3(Frame& F, int e) {
    for (int u = F.bid; u < 512; u += F.G) mlstm_x3_unit(F, e, u >> 8, (u >> 2) & 63, u & 3);
}
__device__ __forceinline__ void phase_o1(Frame& F, int oi, int tmask) {
    const f16* Z = WSP(f16, WS_Z);
    for (int u = F.bid; u < 768 + 256 + 42; u += F.G) {
        if (u < 768) {
            if (!(tmask & 1)) continue;
            const int g = u >> 8, v = u & 255, kvh = v & 1, r = v >> 1;
            const int dil = g == 0 ? 1 : (g == 1 ? 4 : 16), nblk = 64 / dil;
            const int b = r >> 6, rr = r & 63, res = rr / nblk, blk = rr % nblk;
            BandAttn P{Z, NOD, 768 * g, 768 * g + 512, 768 * g + 640, WSP(f16, WS_OG) + (size_t)g * MP * 512, 512, 0, WSP(float, WS_LSE) + (size_t)g * MP * 8, nullptr, 0};
            band_attn_unit(F.lds, P, b * T + res, dil, blk, kvh);
        } else if (u < 1024) { if (!(tmask & 4)) continue; const int v = u - 768; sample_attn_odd(F, oi, v >> 1, v & 1); }
        else {
            if (!(tmask & 16)) continue;
            const int v = u - 1024; int g, q; if (v < 2) { g = 0; q = v; } else if (v < 10) { g = 1; q = v - 2; } else { g = 2; q = v - 10; }
            const int W = 128 << (2 * g), per = W / 128, b = q / per, part = q % per;
            const size_t ob = g == 0 ? O_C1P : (g == 1 ? O_C2P : O_C3P);
            kv_export(Z, NOD, 768 * g + 512, 768 * g + 640, b * T + T - W + part * 128, 128, F.out + ob + ((size_t)(oi * 2 + b) * W + part * 128) * 256, F.tid, 512);
        }
    }
}
__device__ __forceinline__ void phase_o2(Frame& F) {
    const f16* OG = WSP(f16, WS_OG); const float* LSE = WSP(float, WS_LSE); f16* O = WSP(f16, WS_O);
    for (int i0 = F.bid; i0 < MP / 8; i0 += F.G) {
        const size_t m = (size_t)((i0 & 7) * (MP / 64) + (i0 >> 3)) * 8 + (F.tid >> 6); const int c8 = F.tid & 63, hd = c8 >> 3;
        const float l0 = LSE[m * 8 + hd], l1 = LSE[(size_t)MP * 8 + m * 8 + hd], l2 = LSE[(size_t)2 * MP * 8 + m * 8 + hd];
        const float mx = fmaxf(fmaxf(l0, l1), l2); float w0 = __expf(l0 - mx), w1 = __expf(l1 - mx), w2 = __expf(l2 - mx); const float inv = 1.0f / (w0 + w1 + w2);
        w0 *= inv; w1 *= inv; w2 *= inv;
        const f16x8 a = *(const f16x8*)(OG + m * 512 + c8 * 8), b = *(const f16x8*)(OG + (size_t)MP * 512 + m * 512 + c8 * 8), c = *(const f16x8*)(OG + (size_t)2 * MP * 512 + m * 512 + c8 * 8);
        f16x8 o;
#pragma unroll
        for (int q = 0; q < 8; ++q) o[q] = (f16)(w0 * (float)a[q] + w1 * (float)b[q] + w2 * (float)c[q]);
        *tiled_ptr<f16x8>(O, (int)m, c8 * 8, 512) = o;
    }
}
__device__ __forceinline__ void phase_final(Frame& F) {
    const f16* X = WSP(f16, WS_X); const float* rss = (const float*)(F.ws + RSS_OFF) + (size_t)12 * MALL; const float* fg = FIN(I_FG);
    for (int m = F.bid * 8 + F.wave; m < MALL; m += F.G * 8) {
        const float r = rsqrtf(rss[m] * (1.0f / D) + EPS);
#pragma unroll
        for (int q = 0; q < 4; ++q) { const int d = q * 256 + F.lane * 4; const f16x4 xh = *(const f16x4*)(X + (size_t)m * D + d); const f32x4 x = {(float)xh[0], (float)xh[1], (float)xh[2], (float)xh[3]}, g = *(const f32x4*)(fg + d);
            *(f32x4*)(F.out + O_Y + (size_t)m * D + d) = x * r * g; }
    }
}

struct Args;
__device__ __forceinline__ bool phase_enter(Frame& F, const Args& args);
#define REP(bit) _Pragma("unroll 1") for (int rep_ = 0; rep_ < ((PROBE_DUP & (bit)) ? 2 : 1); ++rep_)
#ifndef P_MASK
#define P_MASK 0
#endif
constexpr bool P_SK = !(P_MASK & 1), P_MIX = !(P_MASK & 2), P_Z = !(P_MASK & 4), P_RES = !(P_MASK & 8), P_SW = !(P_MASK & 16), P_PR = !(P_MASK & 32), P_E1 = !(P_MASK & 64), P_E3 = !(P_MASK & 128), P_O1 = !(P_MASK & 256);
struct Args { const float* in[N_IN]; float* out; unsigned char* ws; int ph_lo, ph_hi; };
constexpr int PH_LAYER0 = 4, PH_PER_LAYER = 9, PH_FINAL = PH_LAYER0 + 4 * PH_PER_LAYER, N_PHASES = PH_FINAL + 1;

__device__ __forceinline__ bool phase_enter(Frame& F, const Args& args) {
    F.tid = opaque_v(threadIdx.x); F.lane = F.tid & 63; F.wave = __builtin_amdgcn_readfirstlane(F.tid >> 6);
    F.out = opaque_p(args.out); F.ws = opaque_p(args.ws);
    return true;
}
__global__ void __launch_bounds__(512, 2) fwd_kernel(Args args) {
    extern __shared__ __attribute__((aligned(16))) unsigned char lds_raw[];
    Frame F;
    F.lds = (ldsp_t)lds_raw; F.tid = threadIdx.x; F.lane = F.tid & 63; F.wave = __builtin_amdgcn_readfirstlane(F.tid >> 6); F.G = gridDim.x; F.bid = blockIdx.x;
    F.out = args.out; F.ws = args.ws;
    volatile LAS unsigned* MISC = (volatile LAS unsigned*)(F.lds + MISC_OFF);
    if (F.tid < 32) MISC[F.tid] = 0u;
    __syncthreads();
    XcdBarrier bar = xcd_barrier_post((unsigned*)(F.ws + WS_CTL) + CW_BAR, MISC + 8);
    const int lo = args.ph_lo, hi = args.ph_hi;
    const CopyQ CQ{args.in[I_CC3], args.in[I_CC2], args.in[I_CA], args.in[I_CC1], args.out, (unsigned*)(args.ws + WS_CTL) + CW_Q};
#define IN(k) (lo <= (k) && (k) < hi && phase_enter(F, args))
#define SEAM(k) do { if (IN((k) + 1)) { xcd_barrier(bar, CQ); if constexpr ((PROBE_DUP & 64) != 0) xcd_barrier(bar, CQ); } } while (0)
#define LSEAM(k) do { if (IN((k) + 1)) { if (fastp) xcc_barrier(bar, CQ); else xcd_barrier(bar, CQ); } } while (0)
    unsigned fastp = 0u;
    float* rowss = (float*)(F.ws + RSS_OFF);

    _Pragma("unroll 1") for (int prep_ = 0; prep_ < ((PROBE_DUP & 32) ? 2 : 1); ++prep_) {
    if (IN(0)) { REP(1) { if constexpr (P_PR) phase_pr0(F, 24, 28, true, nullptr); } SEAM(0);
        if (MK_N_LAUNCHES == 1 && hi == N_PHASES && MISC[8 + 10] != 0u) { fastp = 1u; F.bid = (int)(MISC[8 + 12] * 8u + bar.x); } }
    if (IN(1)) {
        pg8::Gemm g{WSP(f16, WS_AC), WSP(f16, WS_WMOD), 256, 4 * NMODC, D}; pg8::StaticOrder S; S.init(256, 4 * NMODC, F.G, F.bid);
        EpiMod E{WSP(float, WS_CS), WSP(float, WS_GT), WSP(f16, WS_SHA), FIN(I_BMOD), FIN(I_NG), WSP(float, WS_RCS)};
        if constexpr (P_PR) pg8::gemm_phase<EpiMod, pg8::StaticOrder>(F.lds, g, S, E);
        if constexpr (P_PR) { phase_enter(F, args); phase_pr0(F, 0, 24, false, (unsigned*)(F.ws + WS_CTL) + CW_Q + 128); }
        SEAM(1);
    }
    if (IN(3)) {
        pg8::Gemm g{WSP(f16, WS_SHA), WSP(f16, WS_WIN), 256 * NSITE, NWIN, D}; pg8::DiagOrder S{F.G, F.bid};
        EpiBias E{WSP(float, WS_BW)};
        if constexpr (P_PR) pg8::gemm_phase<EpiBias, pg8::DiagOrder>(F.lds, g, S, E);
        if constexpr (P_PR) { phase_enter(F, args); phase_pr2(F); }
        SEAM(3);
    }
    }
    for (int l = 0; l < 4; ++l) {
        const int pb = PH_LAYER0 + PH_PER_LAYER * l, s0 = 3 * l; const bool even = (l & 1) == 0; const int ei = l >> 1;
#pragma unroll 1
        for (int ffn = 0; ffn < 2; ++ffn) {
            if (ffn == 1) {
                if (IN(pb + 2)) {
                    const int so = site_off(s0 + 1), N = even ? NEV : NOD;
                    pg8::Gemm g{WSP(f16, WS_A), WSP(f16, WS_WIN) + (size_t)so * D, MP, N, D}; pg8::StaticOrder S; S.init(MP, N, F.G, F.bid);
                    if (even) { EpiZ<true> E{rowss + (size_t)(s0 + 1) * MALL, WSP(float, WS_BW) + so, WSP(f16, WS_Z), WSP(float, WS_GATES)};
                        if constexpr (P_Z) pg8::gemm_phase<EpiZ<true>, pg8::StaticOrder>(F.lds, g, S, E);
                        if constexpr ((PROBE_DUP & 128) != 0) { phase_enter(F, args); pg8::gemm_phase<EpiZ<true>, pg8::StaticOrder>(F.lds, g, S, E); }
                        if constexpr (P_SK) skinny_phase<false, D>(F.lds, g.A + (size_t)MP * D, g.Bt, N, E, F.G, F.bid, S.nwg); }
                    else { EpiZ<false> E{rowss + (size_t)(s0 + 1) * MALL, WSP(float, WS_BW) + so, WSP(f16, WS_Z), WSP(float, WS_GATES)};
                        if constexpr (P_Z) pg8::gemm_phase<EpiZ<false>, pg8::StaticOrder>(F.lds, g, S, E);
                        if constexpr ((PROBE_DUP & 128) != 0) { phase_enter(F, args); pg8::gemm_phase<EpiZ<false>, pg8::StaticOrder>(F.lds, g, S, E); }
                        if constexpr (P_SK) skinny_phase<false, D>(F.lds, g.A + (size_t)MP * D, g.Bt, N, E, F.G, F.bid, S.nwg); }
                    SEAM(pb + 2);
                }
                if (IN(pb + 3)) { REP(2) if constexpr (P_MIX) { const int tm = rep_ ? PROBE_TMASK : 31; if (even) { if constexpr (P_E1) phase_e1(F, ei, tm); } else { if constexpr (P_O1) phase_o1(F, ei, tm); } } SEAM(pb + 3); }
                if (IN(pb + 4)) { REP(4096) if constexpr (P_MIX) { if (even) mlstm_scan(F, ei); else phase_o2(F); } if (even) SEAM(pb + 4); else LSEAM(pb + 4); }
                if (even && IN(pb + 5)) { REP(8192) if constexpr (P_MIX && P_E3) { phase_e3(F, ei); } SEAM(pb + 5); }
                if (IN(pb + 6)) {
                    const int K = even ? D : 512; const f16* Bt = even ? WSP(f16, WS_WEO) + (size_t)ei * D * D : WSP(f16, WS_WOO) + (size_t)ei * D * 512;
                    pg8::Gemm g{WSP(f16, WS_O), Bt, MP, D, K}; pg8::StaticOrder S; S.init(MP, D, F.G, F.bid);
                    EpiRes E{WSP(f16, WS_X), WSP(f16, WS_A), rowss + (size_t)(s0 + 2) * MALL, WSP(float, WS_GT) + (size_t)(s0 + 1) * NBAT * D, WSP(float, WS_CS) + (size_t)(s0 + 2) * NBAT * D, WSP(float, WS_RCS) + (size_t)(s0 + 1) * NBAT * D};
                    if constexpr ((PROBE_DUP & 256) != 0) { EpiRes E2{(f16*)(F.ws + WS_END), (f16*)(F.ws + WS_END + (size_t)MALL * D * 4), (float*)(F.ws + WS_END + (size_t)MALL * D * 6), E.GT, E.CS, E.RCS};
                        pg8::gemm_phase<EpiRes, pg8::StaticOrder>(F.lds, g, S, E2); phase_enter(F, args); }
                    if constexpr (P_RES) pg8::gemm_phase<EpiRes, pg8::StaticOrder>(F.lds, g, S, E);
                    if constexpr (P_SK) { if (even) skinny_phase<false, D>(F.lds, g.A + (size_t)MP * D, g.Bt, D, E, F.G, F.bid, S.nwg); else skinny_phase<false, 512>(F.lds, g.A + (size_t)MP * 512, g.Bt, D, E, F.G, F.bid, S.nwg); }
                    LSEAM(pb + 6);
                }
            }
            const int sf = s0 + 2 * ffn, pin = pb + (ffn ? 7 : 0);
            if (IN(pin)) {
                const int so = site_off(sf);
                pg8::Gemm g{WSP(f16, WS_A), WSP(f16, WS_WIN) + (size_t)so * D, MP, FF2, D}; pg8::StaticOrder S; S.init(MP, FF2, F.G, F.bid);
                EpiSwiglu E{rowss + (size_t)sf * MALL, WSP(float, WS_BW) + so, WSP(f16, WS_H)};
                if constexpr (P_SW) pg8::gemm_phase<EpiSwiglu, pg8::StaticOrder>(F.lds, g, S, E);
                if constexpr ((PROBE_DUP & 4) != 0) { phase_enter(F, args); pg8::gemm_phase<EpiSwiglu, pg8::StaticOrder>(F.lds, g, S, E); }
                REP(8) { if constexpr (P_SK) skinny_phase<true, D>(F.lds, g.A + (size_t)MP * D, g.Bt, FF2, E, F.G, F.bid, S.nwg); }
                LSEAM(pin);
            }
            if (IN(pin + 1)) {
                pg8::Gemm g{WSP(f16, WS_H), WSP(f16, WS_WFO) + (size_t)(2 * l + ffn) * D * FF, MP, D, FF}; pg8::StaticOrder S; S.init(MP, D, F.G, F.bid);
                EpiRes E{WSP(f16, WS_X), WSP(f16, WS_A), rowss + (size_t)(sf + 1) * MALL, WSP(float, WS_GT) + (size_t)sf * NBAT * D, (sf + 1 < NSITE) ? WSP(float, WS_CS) + (size_t)(sf + 1) * NBAT * D : nullptr, WSP(float, WS_RCS) + (size_t)sf * NBAT * D};
                if constexpr ((PROBE_DUP & 16) != 0) { EpiRes E2{(f16*)(F.ws + WS_END), (f16*)(F.ws + WS_END + (size_t)MALL * D * 4), (float*)(F.ws + WS_END + (size_t)MALL * D * 6), E.GT, E.CS, E.RCS};
                    pg8::gemm_phase<EpiRes, pg8::StaticOrder>(F.lds, g, S, E2); phase_enter(F, args); }
                if constexpr (P_RES) pg8::gemm_phase<EpiRes, pg8::StaticOrder>(F.lds, g, S, E);
                if constexpr (P_SK) skinny_phase<false, FF>(F.lds, g.A + (size_t)MP * FF, g.Bt, D, E, F.G, F.bid, S.nwg);
                if (pin + 1 == PH_FINAL - 1) SEAM(pin + 1); else LSEAM(pin + 1);
            }
        }
    }
    if (IN(PH_FINAL)) {
        phase_final(F);
        if constexpr ((PROBE_DUP & 512) != 0) { phase_enter(F, args); phase_final(F); }
        for (;;) {
            __syncthreads();
            if (F.tid == 0) MISC[24] = xb_add(CQ.head, 1u);
            __syncthreads();
            const unsigned ch = MISC[24];
            if (ch >= (unsigned)CQ_N) break;
            copy_chunk(CQ, (int)ch, F.tid);
        }
        if constexpr ((PROBE_DUP & 1024) != 0) {
            CopyQ CQ2 = CQ; CQ2.head = CQ.head + 64;
            for (;;) {
                __syncthreads();
                if (F.tid == 0) MISC[24] = xb_add(CQ2.head, 1u);
                __syncthreads();
                const unsigned ch = MISC[24];
                if (ch >= (unsigned)CQ_N) break;
                copy_chunk(CQ2, (int)ch, F.tid);
            }
        }
    }
#undef IN
#undef SEAM
}

extern "C" void kernel_launch(void* const* d_in, const int* in_sizes, int n_in, void* d_out, int out_size, void* d_ws, size_t ws_size, hipStream_t stream) {
    static int grid = 0;
    if (grid == 0) {
        if (n_in != N_IN || (size_t)out_size != O_END || ws_size < WS_END) { fprintf(stderr, "kernel_launch: unexpected shapes n_in %d out %d ws %zu (need %zu / %zu)\n", n_in, out_size, ws_size, (size_t)O_END, (size_t)WS_END); grid = -1; return; }
        int dev = 0, cus = 0, per_cu = 0;
        if (hipGetDevice(&dev) != hipSuccess || hipDeviceGetAttribute(&cus, hipDeviceAttributeMultiprocessorCount, dev) != hipSuccess) { grid = -1; return; }
        if (hipFuncSetAttribute((const void*)fwd_kernel, hipFuncAttributeMaxDynamicSharedMemorySize, LDS_BYTES) != hipSuccess) { fprintf(stderr, "kernel_launch: hipFuncSetAttribute failed\n"); grid = -1; return; }
        if (hipOccupancyMaxActiveBlocksPerMultiprocessor(&per_cu, (const void*)fwd_kernel, 512, LDS_BYTES) != hipSuccess || per_cu < 1) { fprintf(stderr, "kernel_launch: occupancy query says %d\n", per_cu); }
        (void)hipGetLastError();
        grid = cus;
    }
    if (grid < 0) return;
    (void)hipMemsetAsync((char*)d_ws + WS_CTL, 0, CTL_ZERO_BYTES, stream);
    Args a{};
    for (int i = 0; i < N_IN; ++i) a.in[i] = (const float*)d_in[i];
    a.out = (float*)d_out; a.ws = (unsigned char*)d_ws;
#if MK_N_LAUNCHES == 1
    a.ph_lo = 0; a.ph_hi = N_PHASES;
    hipLaunchKernelGGL(fwd_kernel, dim3(grid), dim3(512), LDS_BYTES, stream, a);
#else
    for (int p = 0; p < N_PHASES; ++p) { a.ph_lo = p; a.ph_hi = p + 1; hipLaunchKernelGGL(fwd_kernel, dim3(grid), dim3(512), LDS_BYTES, stream, a); }
#endif
}
```

```cpp
#include <hip/hip_runtime.h>
#include <cstdio>
#include <cstdint>

#ifndef PROBE_DUP
#define PROBE_DUP 0
#endif
#ifndef PROBE_TMASK
#define PROBE_TMASK 19
#endif
#ifndef MK_N_LAUNCHES
#define MK_N_LAUNCHES 1
#endif

#define GAS __attribute__((address_space(1)))
#define LAS __attribute__((address_space(3)))
typedef _Float16 f16;
typedef _Float16 f16x8 __attribute__((ext_vector_type(8)));
typedef _Float16 f16x4 __attribute__((ext_vector_type(4)));
typedef float f32x4 __attribute__((ext_vector_type(4)));
typedef float f32x16 __attribute__((ext_vector_type(16)));
typedef unsigned u32x4 __attribute__((ext_vector_type(4)));
typedef unsigned u32x2 __attribute__((ext_vector_type(2)));
typedef LAS unsigned char* ldsp_t;

constexpr int D = 1024, T = 8192, NB = 2, MP = NB * T, NS = 128, MALL = MP + NS, NBAT = NB + NS;
constexpr int FF = 2816, FF2 = 5632, NEV = 3072, NEVR = 2832, NOD = 2304, NMODC = 9216;
constexpr int NSITE = 12;
constexpr float EPS = 1e-6f;
__host__ __device__ __forceinline__ constexpr int site_N(int s) { return (s % 3 != 1) ? FF2 : (((s / 3) % 2 == 0) ? NEV : NOD); }
__host__ __device__ __forceinline__ constexpr int site_off(int s) { const int r = s % 6; return (s / 6) * 27904 + (r == 0 ? 0 : r == 1 ? 5632 : r == 2 ? 8704 : r == 3 ? 14336 : r == 4 ? 19968 : 22272); }
static_assert(site_off(1) == 5632 && site_off(2) == 8704 && site_off(3) == 14336 && site_off(4) == 19968 && site_off(5) == 22272 && site_off(6) == 27904 && site_off(7) == 27904 + 5632, "site_off");
constexpr int NWIN = site_off(NSITE);
static_assert(NWIN == 55808, "win rows");

constexpr size_t alignup(size_t x) { return (x + 4095) & ~(size_t)4095; }
constexpr size_t WS_CTL = 0, CTL_ZERO_BYTES = 1u << 20;
constexpr int CW_BAR = 1024;
constexpr size_t RSS_OFF = 65536;
static_assert(RSS_OFF + (size_t)13 * MALL * 4 <= CTL_ZERO_BYTES, "ctl");
constexpr size_t WS_WIN = alignup(CTL_ZERO_BYTES);
constexpr size_t WS_WFO = alignup(WS_WIN + (size_t)NWIN * D * 2);
constexpr size_t WS_WEO = alignup(WS_WFO + (size_t)8 * D * FF * 2);
constexpr size_t WS_WOO = alignup(WS_WEO + (size_t)2 * D * D * 2);
constexpr size_t WS_WMOD = alignup(WS_WOO + (size_t)2 * D * 512 * 2);
constexpr size_t WS_AC = alignup(WS_WMOD + (size_t)4 * NMODC * D * 2);
constexpr size_t WS_MOD = alignup(WS_AC + (size_t)256 * D * 2);
constexpr size_t WS_CS = alignup(WS_MOD + (size_t)NBAT * 4 * NMODC * 4);
constexpr size_t WS_GT = alignup(WS_CS + (size_t)NSITE * NBAT * D * 4);
constexpr size_t WS_RCS = alignup(WS_GT + (size_t)NSITE * NBAT * D * 4);
constexpr size_t WS_SHA = alignup(WS_RCS + (size_t)NSITE * NBAT * D * 4);
constexpr size_t WS_BW = alignup(WS_SHA + (size_t)NSITE * 256 * D * 2);
constexpr size_t WS_X = alignup(WS_BW + (size_t)NBAT * NWIN * 4);
constexpr size_t WS_A = alignup(WS_X + (size_t)MALL * D * 4);
constexpr size_t WS_H = alignup(WS_A + (size_t)MALL * D * 2);
constexpr size_t WS_Z = alignup(WS_H + (size_t)MALL * FF * 2);
constexpr size_t WS_GATES = alignup(WS_Z + (size_t)MALL * NEV * 2);
constexpr size_t WS_O = alignup(WS_GATES + (size_t)MALL * 16 * 4);
constexpr size_t WS_OG = alignup(WS_O + (size_t)MALL * D * 2);
constexpr size_t WS_LSE = alignup(WS_OG + (size_t)3 * MP * 512 * 2);
constexpr size_t WS_DC = alignup(WS_LSE + (size_t)3 * MP * 8 * 4);
constexpr size_t WS_DN = alignup(WS_DC + (size_t)16 * 64 * 4096 * 4);
constexpr size_t WS_CP = alignup(WS_DN + (size_t)16 * 64 * 64 * 4);
constexpr size_t WS_NP = alignup(WS_CP + (size_t)16 * 64 * 4096 * 2);
constexpr size_t WS_SC = alignup(WS_NP + (size_t)16 * 64 * 64 * 4);
constexpr size_t WS_END = alignup(WS_SC + (size_t)3 * 16 * 64 * 4);

constexpr size_t O_Y = 0;
constexpr size_t O_AKVP = O_Y + (size_t)MALL * D;
constexpr size_t O_AKVS = O_AKVP + (size_t)2 * 2 * 128 * 256;
constexpr size_t O_BCP = O_AKVS + (size_t)2 * 128 * 128 * 256;
constexpr size_t O_BCS = O_BCP + (size_t)2 * 2 * 8 * 4096;
constexpr size_t O_BNP = O_BCS + (size_t)2 * 128 * 8 * 4096;
constexpr size_t O_BNS = O_BNP + (size_t)2 * 2 * 8 * 64;
constexpr size_t O_BMP = O_BNS + (size_t)2 * 128 * 8 * 64;
constexpr size_t O_BMS = O_BMP + (size_t)2 * 2 * 8;
constexpr size_t O_C1P = O_BMS + (size_t)2 * 128 * 8;
constexpr size_t O_C1S = O_C1P + (size_t)2 * 2 * 128 * 256;
constexpr size_t O_C2P = O_C1S + (size_t)2 * 128 * 128 * 256;
constexpr size_t O_C2S = O_C2P + (size_t)2 * 2 * 512 * 256;
constexpr size_t O_C3P = O_C2S + (size_t)2 * 128 * 512 * 256;
constexpr size_t O_C3S = O_C3P + (size_t)2 * 2 * 2048 * 256;
constexpr size_t O_END = O_C3S + (size_t)2 * 128 * 2048 * 256;

enum { I_XP = 0, I_XS, I_CA, I_SBC, I_SBN, I_SBM, I_CC1, I_CC2, I_CC3, I_CP, I_CSMP, I_WMOD, I_BMOD, I_NG, I_FWI, I_FWO, I_EWI, I_EBG, I_ESK, I_EHG, I_EWO, I_OWI, I_OWO, I_FG, N_IN };

constexpr int RING_BYTES = 131072;
constexpr int MISC_OFF = RING_BYTES + 320;
constexpr int PF_OFF = 139264;
constexpr int EPI_OFF = 133120, EPI_STRIDE = 4096;
constexpr int LDS_BYTES = 147456;

#define RLX_AGENT __ATOMIC_RELAXED, __HIP_MEMORY_SCOPE_AGENT
#define LDS_WAIT() asm volatile("s_waitcnt lgkmcnt(0)" ::: "memory")
#define VM_WAIT() asm volatile("s_waitcnt vmcnt(0)" ::: "memory")

#define XB_TMO      128
#define XB_XCNT(j)  (256  + 64 * (j))
#define XB_XSUB(j)  (1280 + 64 * (j))
#define XB_XGEN(j)  (2304 + 64 * (j))
#define XB_TOP      3328
#define XB_TOPGEN   3392
#define XB_LSUB(j)  (3456 + 64 * (j))
#define XCD_BAR_WORDS 4480
#define XB_SPIN_CAP (1u << 21)
__device__ __forceinline__ unsigned xb_ld(unsigned* p)              { return __hip_atomic_load(p, __ATOMIC_RELAXED, __HIP_MEMORY_SCOPE_AGENT); }
__device__ __forceinline__ unsigned xb_add(unsigned* p, unsigned v) { return __hip_atomic_fetch_add(p, v, __ATOMIC_RELAXED, __HIP_MEMORY_SCOPE_AGENT); }
__device__ __forceinline__ unsigned xb_xcc_id() { return (unsigned)__builtin_amdgcn_s_getreg((3 << 11) | 20) & 0xFu; }
#define XB_SPIN(cond, bar) do { unsigned _sp = 0; while (cond) { __builtin_amdgcn_s_sleep(1); \
    if ((++_sp & 255u) == 0u) { if (xb_ld(&(bar)[XB_TMO])) break; if (_sp > XB_SPIN_CAP) { atomicAdd(&(bar)[XB_TMO], 1u); break; } } } } while (0)
struct XcdBarrier { unsigned* bar; unsigned x; volatile LAS unsigned* st; };
__device__ __forceinline__ XcdBarrier xcd_barrier_post(unsigned* bar, volatile LAS unsigned* st) {
    XcdBarrier b; b.bar = bar; b.x = xb_xcc_id(); b.st = st;
    if (threadIdx.x == 0) st[12] = xb_add(&bar[XB_XCNT(b.x)], 1u);
    return b;
}
__device__ __forceinline__ void xcd_barrier_complete(unsigned* bar, unsigned x, unsigned& nloc, unsigned& nx) {
    const unsigned G = gridDim.x * gridDim.y * gridDim.z;
    unsigned sum, cnt, mine, sp = 0u;
    for (;;) {
        sum = 0u; cnt = 0u; mine = 0u;
#pragma unroll
        for (unsigned j = 0; j < 16; ++j) { const unsigned c = xb_ld(&bar[XB_XCNT(j)]); sum += c; cnt += (c > 0u) ? 1u : 0u; mine = (j == x) ? c : mine; }
        if (sum == G) break;
        __builtin_amdgcn_s_sleep(1);
        if ((++sp & 255u) == 0u) { if (xb_ld(&bar[XB_TMO])) break; if (sp > XB_SPIN_CAP) { atomicAdd(&bar[XB_TMO], 1u); break; } }
    }
    nloc = mine > 0u ? mine : 1u; nx = cnt > 0u ? cnt : 1u;
}
__device__ __forceinline__ unsigned xcd_census_even(unsigned* bar) {
    const unsigned G = gridDim.x; if (G % 8u) return 0u;
    unsigned ok = 1u;
#pragma unroll
    for (unsigned j = 0; j < 16; ++j) { const unsigned c = xb_ld(&bar[XB_XCNT(j)]); ok &= (c == (j < 8u ? G / 8u : 0u)) ? 1u : 0u; }
    return ok;
}
constexpr int CQ_CH = 4096;
constexpr int CQ_N3 = 2047 * 16384 / CQ_CH, CQ_N2 = 511 * 16384 / CQ_CH, CQ_NA = 127 * 16384 / CQ_CH, CQ_N = CQ_N3 + CQ_N2 + 2 * CQ_NA;
constexpr int CW_Q = 512;
struct CopyQ { const float* c3; const float* c2; const float* ca; const float* c1; float* out; unsigned* head; };
__device__ __forceinline__ void copy_chunk(const CopyQ& Q, int chunk, int tid) {
    const float* in; float* out; int W;
    if (chunk < CQ_N3) { in = Q.c3; out = Q.out + O_C3S; W = 2048; }
    else if (chunk < CQ_N3 + CQ_N2) { chunk -= CQ_N3; in = Q.c2; out = Q.out + O_C2S; W = 512; }
    else if (chunk < CQ_N3 + CQ_N2 + CQ_NA) { chunk -= CQ_N3 + CQ_N2; in = Q.ca; out = Q.out + O_AKVS; W = 128; }
    else { chunk -= CQ_N3 + CQ_N2 + CQ_NA; in = Q.c1; out = Q.out + O_C1S; W = 128; }
    const unsigned wm1 = (unsigned)(W - 1);
    f32x4 v[8]; size_t doff[8];
#pragma unroll
    for (int j = 0; j < 8; ++j) {
        const unsigned i = (unsigned)chunk * CQ_CH + j * 512 + tid, r = i >> 6, es = r / wm1, rr = r - es * wm1;
        const size_t o = ((size_t)es * W + rr) * 256 + (i & 63) * 4; doff[j] = o;
        v[j] = __builtin_nontemporal_load((const f32x4*)(in + o + 256));
    }
#pragma unroll
    for (int j = 0; j < 8; ++j) __builtin_nontemporal_store(v[j], (f32x4*)(out + doff[j]));
}
template <int MODE  >
__device__ __forceinline__ void xb_wait_work(unsigned* bar, unsigned* pw, unsigned same, bool need_wait, volatile LAS unsigned* W, const CopyQ& Q) {
    const int tid = threadIdx.x;
    for (unsigned it = 0;; ++it) {
        const unsigned par = (it & 1u) * 2u;
        if (tid == 0) {
            unsigned rel = need_wait ? 0u : 1u;
            if (!rel) { for (int sp = 0; sp < 12; ++sp) { const unsigned v_ = xb_ld(pw); if (MODE == 0 ? (v_ != same) : (v_ >= same)) { rel = 1u; break; } __builtin_amdgcn_s_sleep(1); } }
            if (!rel && (it & 255u) == 255u) { if (xb_ld(&bar[XB_TMO])) rel = 1u; else if (it > (1u << 16)) { atomicAdd(&bar[XB_TMO], 1u); rel = 1u; } }
            unsigned ch = 0xffffffffu;
            if ((PROBE_DUP & 2048) == 0 && !rel && xb_ld(Q.head) < (unsigned)CQ_N) ch = xb_add(Q.head, 1u);
            W[par] = rel; W[par + 1] = ch;
        }
        __syncthreads();
        const unsigned rel = W[par], ch = W[par + 1];
        if (rel) break;
        if (ch < (unsigned)CQ_N) copy_chunk(Q, (int)ch, tid);
    }
}
__device__ __forceinline__ void xcd_barrier(const XcdBarrier& b, const CopyQ& Q) {
    asm volatile("s_waitcnt vmcnt(0)" ::: "memory");
    __syncthreads();
    unsigned* bar = b.bar;
    volatile LAS unsigned* W = b.st + 4;
    if (threadIdx.x == 0) {
        __builtin_amdgcn_s_waitcnt(0);
        unsigned nloc = b.st[0], nx = b.st[1];
        if (nloc == 0u) { xcd_barrier_complete(bar, b.x, nloc, nx); b.st[0] = nloc; b.st[1] = nx; b.st[10] = xcd_census_even(bar); }
        const unsigned old = xb_add(&bar[XB_XSUB(b.x)], 1u);
        const unsigned gen = old / nloc;
        unsigned role, val;
        if (old + 1u == (gen + 1u) * nloc) {
            __builtin_amdgcn_fence(__ATOMIC_RELEASE, "agent");
            asm volatile("s_waitcnt vmcnt(0)" ::: "memory");
            const unsigned og = xb_add(&bar[XB_TOP], 1u);
            const unsigned tg = og / nx;
            if (og + 1u == (tg + 1u) * nx) { xb_add(&bar[XB_TOPGEN], 1u); role = 2u; val = 0u; }
            else { role = 1u; val = tg; }
        } else { role = 0u; val = gen; }
        b.st[8] = role; b.st[9] = val;
    }
    __syncthreads();
    const unsigned role = b.st[8], val = b.st[9];
    xb_wait_work<0>(bar, role == 1u ? &bar[XB_TOPGEN] : &bar[XB_XGEN(b.x)], val, role != 2u, W, Q);
    if (threadIdx.x == 0) {
        __builtin_amdgcn_fence(__ATOMIC_ACQUIRE, "agent");
        if (role != 0u) xb_add(&bar[XB_XGEN(b.x)], 1u);
        asm volatile("s_waitcnt vmcnt(0)" ::: "memory");
    }
    __syncthreads();
}

__device__ __forceinline__ void xcc_barrier(const XcdBarrier& b, const CopyQ& Q) {
    asm volatile("s_waitcnt vmcnt(0)" ::: "memory");
    __syncthreads();
    unsigned* bar = b.bar;
    if (threadIdx.x == 0) {
        __builtin_amdgcn_s_waitcnt(0);
        const unsigned gen = b.st[11]; b.st[11] = gen + 1u;
        (void)xb_add(&bar[XB_LSUB(b.x)], 1u);
        b.st[9] = (gen + 1u) * b.st[0];
    }
    __syncthreads();
    const unsigned target = b.st[9];
    xb_wait_work<1>(bar, &bar[XB_LSUB(b.x)], target, true, b.st + 4, Q);
    asm volatile("" ::: "memory");
    __syncthreads();
}

__device__ __forceinline__ int opaque_v(int x) { asm volatile("" : "+v"(x)); return x; }
template <class P> __device__ __forceinline__ P* opaque_p(P* p) { asm volatile("" : "+s"(p)); return p; }
__device__ __forceinline__ float wave_sum(float v) {
#pragma unroll
    for (int o = 1; o < 64; o <<= 1) v += __shfl_xor(v, o);
    return v;
}
__device__ __forceinline__ float wave_max(float v) {
#pragma unroll
    for (int o = 1; o < 64; o <<= 1) v = fmaxf(v, __shfl_xor(v, o));
    return v;
}
__device__ __forceinline__ f16x4 cvt4(f32x4 v) { f16x4 r; r[0] = (f16)v[0]; r[1] = (f16)v[1]; r[2] = (f16)v[2]; r[3] = (f16)v[3]; return r; }
__device__ __forceinline__ f16x8 cat4(f16x4 lo, f16x4 hi) { f16x8 a; a[0] = lo[0]; a[1] = lo[1]; a[2] = lo[2]; a[3] = lo[3]; a[4] = hi[0]; a[5] = hi[1]; a[6] = hi[2]; a[7] = hi[3]; return a; }
__device__ __forceinline__ float sigmoidf_(float x) { return __builtin_amdgcn_rcpf(1.0f + __expf(-x)); }
__device__ __forceinline__ float logsigmoidf_(float x) { return fminf(x, 0.f) - log1pf(__expf(-fabsf(x))); }
__device__ __forceinline__ int row_batch(int m) { return m < MP ? (m >> 13) : (NB + m - MP); }

namespace pg8 {
constexpr int BM = 256, BK = 64, HALF = 128, HTB = HALF * BK * 2, STAGE_BYTES = 8 * HTB, NXCD = 8, WGM = 8;
__host__ __device__ __forceinline__ int lds_byte(int r, int c) { const int st = (r >> 4) * 2 + (c >> 5), rr = r & 15, cc = c & 31, ob = rr * 64 + cc * 2; return st * 1024 + (ob ^ (((ob >> 9) & 1) << 5)); }
__host__ __device__ __forceinline__ void stage_rc(int b, int& R, int& C) { const int st = b / 1024, sb = b % 1024, swz = sb ^ (((sb >> 9) & 1) << 5); R = (st >> 1) * 16 + swz / 64; C = (st & 1) * 32 + (swz % 64) / 2; }
struct Unit { int pm, pn; };
struct Gemm { const f16* A; const f16* Bt; int M, N, K; };
struct StaticOrder {
    int nM, nN, nwg, G, c;
    __host__ __device__ void init(int M, int N, int G_, int c_) { nM = M / BM; nN = N / BM; nwg = nM * nN; G = G_; c = c_; }
    __host__ __device__ bool next(int i, Unit& u) const {
        const long L = (long)i * G + c; if (L >= nwg) return false;
        int wgid = (int)L; { const int q = nwg / NXCD, r = nwg % NXCD, xcd = wgid % NXCD, off = wgid / NXCD; wgid = (xcd < r ? xcd * (q + 1) : r * (q + 1) + (xcd - r) * q) + off; }
        const int nig = WGM * nN, gid = wgid / nig, fm = gid * WGM, gsz = (nM - fm) < WGM ? (nM - fm) : WGM;
        u.pm = fm + ((wgid % nig) % gsz); u.pn = (wgid % nig) / gsz; return true;
    }
    __device__ __forceinline__ void a_ready(const Unit&) const {}
    __device__ __forceinline__ void done(const Unit&) const {}
};
struct DiagOrder {
    int G, c;
    __device__ bool next(int i, Unit& u) const {
        const int L = i * G + c; if (L >= NWIN / BM) return false;
        int s = 0, acc = 0;
#pragma unroll
        for (int k = 0; k < NSITE; ++k) { const int n = site_N(k) / BM; if (L >= acc + n) { s = k + 1; } acc += n; }
        u.pm = s; u.pn = L; return true;
    }
    __device__ __forceinline__ void a_ready(const Unit&) const {}
    __device__ __forceinline__ void done(const Unit&) const {}
};

template <class Epi, class Sched, bool ALIGN_EPI = true>
__device__ __forceinline__ void gemm_phase(ldsp_t lds, const Gemm g, const Sched& S, const Epi& E) {
    const int tid = opaque_v(threadIdx.x), wid = __builtin_amdgcn_readfirstlane(tid >> 6), lane = tid & 63, wr = wid >> 2, wc = wid & 3, fr = lane & 15, fq = lane >> 4;
    const int K = g.K, nt = K / BK;
    const int rot = (((S.c & 7) * nt) >> 3) & ~1;
    unsigned voffA[2];
#pragma unroll
    for (int i = 0; i < 2; ++i) voffA[i] = (unsigned)(tid * 16 + i * 8192);
#define voffB voffA
    const size_t kstep = (size_t)(2 * HTB);
    const size_t hstep = (size_t)HTB;
    const size_t tstep = (size_t)nt * kstep;
    const unsigned ldsw = (unsigned)wid * 1024u;
    const int aoff = lds_byte(wr * 64 + fr, fq * 8), boff = lds_byte(wc * 32 + fr, fq * 8);
#define PG8_SA(b, h) (((b) * 2 + (h)) * HTB)
#define PG8_SB(b, h) ((4 + (b) * 2 + (h)) * HTB)
#define PG8_STAGE_X(bufoff, gbase, voff, AUX) do { _Pragma("unroll") for (int _i = 0; _i < 2; ++_i) \
        __builtin_amdgcn_global_load_lds((const unsigned*)((const char*)(gbase) + (voff)[_i]), (LAS unsigned*)(lds + (bufoff) + ldsw + _i * 8192), 16, 0, AUX); } while (0)
#define PG8_STAGE(bufoff, gbase, voff) PG8_STAGE_X(bufoff, gbase, voff, 0)
#define PG8_STAGEA(bufoff, gbase, voff) PG8_STAGE_X(bufoff, gbase, voff, 16)
#define PG8_LDA(dst, b, h) do { _Pragma("unroll") for (int m = 0; m < 4; ++m) _Pragma("unroll") for (int k = 0; k < 2; ++k) dst[m][k] = *(const LAS f16x8*)(lds + PG8_SA(b, h) + aoff + m * 2048 + k * 1024); } while (0)
#define PG8_LDB(dst, b, h) do { _Pragma("unroll") for (int n = 0; n < 2; ++n) _Pragma("unroll") for (int k = 0; k < 2; ++k) dst[n][k] = *(const LAS f16x8*)(lds + PG8_SB(b, h) + boff + n * 2048 + k * 1024); } while (0)
#define PG8_MMA(ai, bj, At, Bt) do { __builtin_amdgcn_s_setprio(1); _Pragma("unroll") for (int m = 0; m < 4; ++m) _Pragma("unroll") for (int n = 0; n < 2; ++n) _Pragma("unroll") for (int k = 0; k < 2; ++k) \
        acc[ai][bj][m][n] = __builtin_amdgcn_mfma_f32_16x16x32_f16(Bt[n][k], At[m][k], acc[ai][bj][m][n], 0, 0, 0); __builtin_amdgcn_s_setprio(0); } while (0)
#define PG8_WAIT_V(n) asm volatile("s_waitcnt vmcnt(" #n ")" ::: "memory")
#define PG8_WAIT_L(n) asm volatile("s_waitcnt lgkmcnt(" #n ")" ::: "memory")
#define PG8_BAR __builtin_amdgcn_s_barrier()
#define PG8_SCHED __builtin_amdgcn_sched_barrier(0)
    Unit cur, nxt; int ui = 0;
    if (!S.next(0, cur)) return;
    f32x4 acc[2][2][4][2];
#pragma unroll
    for (int a = 0; a < 2; ++a)
#pragma unroll
        for (int b = 0; b < 2; ++b)
#pragma unroll
            for (int m = 0; m < 4; ++m)
#pragma unroll
                for (int n = 0; n < 2; ++n) acc[a][b][m][n] = (f32x4){0.f, 0.f, 0.f, 0.f};
    f16x8 At[4][2], B0[2][2], B1[2][2];
    const char* cA = (const char*)g.A + (size_t)cur.pm * tstep; const char* cB = (const char*)g.Bt + (size_t)cur.pn * tstep;
    S.a_ready(cur);
    const size_t rstep = (size_t)rot * kstep;
    PG8_STAGE(PG8_SB(0, 0), cB + rstep, voffB); PG8_STAGE(PG8_SB(0, 1), cB + rstep + hstep, voffB); PG8_STAGEA(PG8_SA(0, 0), cA + rstep, voffA); PG8_STAGEA(PG8_SA(0, 1), cA + rstep + hstep, voffA);
    if (wr == 1) PG8_BAR;
    PG8_WAIT_V(2); PG8_BAR;
    PG8_STAGE(PG8_SB(1, 0), cB + rstep + kstep, voffB); PG8_STAGEA(PG8_SA(1, 0), cA + rstep + kstep, voffA); PG8_STAGE(PG8_SB(1, 1), cB + rstep + hstep + kstep, voffB);
    PG8_WAIT_V(6); PG8_BAR;
    if constexpr (Epi::HAS_PRE) E.pre(cur, (LAS float*)(lds + EPI_OFF), wid, opaque_v(lane));
    for (;;) {
        const bool has_next = S.next(ui + 1, nxt);
        const char* nA = has_next ? (const char*)g.A + (size_t)nxt.pm * tstep : cA; const char* nB = has_next ? (const char*)g.Bt + (size_t)nxt.pn * tstep : cB;
        for (int t = 0; t < nt; t += 2) {
            const bool last = (t == nt - 2);
            int t1 = t + 1 + rot, t2 = t + 2 + rot; t1 -= (t1 >= nt) ? nt : 0; t2 -= (t2 >= nt) ? nt : 0;
            const char* a1 = cA + (size_t)t1 * kstep;
            const size_t nxoff = has_next ? rstep : (size_t)((nt - 2 + rot) % nt) * kstep;
            const char* a2 = last ? nA + nxoff : cA + (size_t)t2 * kstep; const char* b2 = last ? nB + nxoff : cB + (size_t)t2 * kstep;
            const char* a3 = a2 + kstep; const char* b3 = b2 + kstep;
            if (last && has_next) S.a_ready(nxt);
            PG8_LDB(B0, 0, 0); PG8_LDB(B1, 0, 1); PG8_SCHED; PG8_LDA(At, 0, 0); PG8_STAGEA(PG8_SA(1, 1), a1 + hstep, voffA);
            PG8_WAIT_V(8); PG8_WAIT_L(0); PG8_BAR; PG8_MMA(0, 0, At, B0); PG8_MMA(0, 1, At, B1); PG8_BAR; PG8_SCHED;
            PG8_LDA(At, 0, 1); PG8_STAGE(PG8_SB(0, 0), b2, voffB); PG8_STAGE(PG8_SB(0, 1), b2 + hstep, voffB); PG8_STAGEA(PG8_SA(0, 0), a2, voffA);
            PG8_WAIT_V(8); PG8_WAIT_L(0); PG8_BAR; PG8_MMA(1, 0, At, B0); PG8_MMA(1, 1, At, B1); PG8_BAR; PG8_SCHED;
            PG8_LDB(B0, 1, 0); PG8_LDB(B1, 1, 1); PG8_SCHED; PG8_LDA(At, 1, 0); PG8_STAGEA(PG8_SA(0, 1), a2 + hstep, voffA);
            PG8_WAIT_V(8); PG8_WAIT_L(0); PG8_BAR; PG8_MMA(0, 0, At, B0); PG8_MMA(0, 1, At, B1); PG8_BAR; PG8_SCHED;
            PG8_LDA(At, 1, 1); PG8_STAGE(PG8_SB(1, 0), b3, voffB); PG8_STAGE(PG8_SB(1, 1), b3 + hstep, voffB); PG8_STAGEA(PG8_SA(1, 0), a3, voffA);
            PG8_WAIT_V(8); PG8_WAIT_L(0); PG8_BAR; PG8_MMA(1, 0, At, B0); PG8_MMA(1, 1, At, B1); PG8_BAR; PG8_SCHED;
        }
        if constexpr (ALIGN_EPI) { if (wr == 0) PG8_BAR; }
        E(acc, cur, wr, wc, fr, fq, (const LAS float*)(lds + EPI_OFF + (ui & 1) * EPI_STRIDE)); S.done(cur);
        if (!has_next) break;
#pragma unroll
        for (int a = 0; a < 2; ++a)
#pragma unroll
            for (int b = 0; b < 2; ++b)
#pragma unroll
                for (int m = 0; m < 4; ++m)
#pragma unroll
                    for (int n = 0; n < 2; ++n) acc[a][b][m][n] = (f32x4){0.f, 0.f, 0.f, 0.f};
        cur = nxt; cA = nA; cB = nB; ++ui;
        if constexpr (Epi::HAS_PRE) E.pre(cur, (LAS float*)(lds + EPI_OFF + (ui & 1) * EPI_STRIDE), wid, opaque_v(lane));
        if constexpr (ALIGN_EPI) { if (wr == 1) PG8_BAR; }
    }
    PG8_WAIT_V(0);
    if constexpr (!ALIGN_EPI) { if (wr == 0) PG8_BAR; }
    PG8_BAR;
#undef PG8_SA
#undef PG8_SB
#undef PG8_STAGE
#undef voffB
#undef PG8_STAGEA
#undef PG8_STAGE_X
#undef PG8_LDA
#undef PG8_LDB
#undef PG8_MMA
#undef PG8_WAIT_V
#undef PG8_WAIT_L
#undef PG8_BAR
#undef PG8_SCHED
}
}
__host__ __device__ __forceinline__ size_t tiled_byte(int row, int col, int K) {
    return ((size_t)((row >> 8) * (K >> 6) + (col >> 6)) * 2 + ((row >> 7) & 1)) * 16384 + (size_t)pg8::lds_byte(row & 127, col & 63);
}
template <class V> __device__ __forceinline__ V* tiled_ptr(f16* base, int row, int col, int K) { return (V*)((char*)base + tiled_byte(row, col, K)); }

using pg8::Unit;
struct EpiSwiglu {
    static constexpr bool HAS_PRE = true;
    const float* rowss; const float* BW; f16* H;
    __device__ __forceinline__ void pre(const Unit& u, LAS float* ev, int wid, int lane) const {
        const int i = (wid & 3) * 64 + lane;
        const float* src = (wid < 4) ? rowss + u.pm * 256 + i : BW + (size_t)(u.pm >> 5) * NWIN + u.pn * 256 + i;
        __builtin_amdgcn_global_load_lds((const unsigned*)src, (LAS unsigned*)(ev + (wid < 4 ? 0 : 256) + (wid & 3) * 64), 4, 0, 0);
    }
    __device__ __forceinline__ static f16x4 act(f32x4 g, f32x4 u, float r, f32x4 bg, f32x4 bu) {
        f32x4 o;
#pragma unroll
        for (int e = 0; e < 4; ++e) { const float gg = g[e] * r + bg[e], uu = u[e] * r + bu[e]; o[e] = gg * uu * __builtin_amdgcn_rcpf(1.0f + __expf(-gg)); }
        return cvt4(o);
    }
    __device__ __forceinline__ void operator()(const f32x4 (&acc)[2][2][4][2], const Unit& u, int wr, int wc, int fr_in, int fq_in, const LAS float* ev) const {
        const int fr = opaque_v(fr_in), fq = opaque_v(fq_in);
        f32x4 bg[2], bu[2];
#pragma unroll
        for (int bj = 0; bj < 2; ++bj) { const int cg = 256 + bj * 128 + wc * 32 + 4 * fq; bg[bj] = *(const LAS f32x4*)(ev + cg); bu[bj] = *(const LAS f32x4*)(ev + cg + 16); }
        char* hb = (char*)H + (size_t)(u.pm * (FF / 64) + 2 * u.pn + (wc >> 1)) * 32768 + (size_t)(8 * wr + (wc & 1)) * 1024;
        const unsigned lo = (unsigned)(fr * 64 + ((16 * fq) ^ (32 * (fr >> 3))));
#pragma unroll
        for (int ai = 0; ai < 2; ++ai)
#pragma unroll
            for (int m = 0; m < 4; ++m) {
                const float r = rsqrtf(ev[ai * 128 + wr * 64 + m * 16 + fr] * (1.0f / D) + EPS);
                const f16x4 h0 = act(acc[ai][0][m][0], acc[ai][0][m][1], r, bg[0], bu[0]), h1 = act(acc[ai][1][m][0], acc[ai][1][m][1], r, bg[1], bu[1]);
                *(f16x8*)(hb + lo + (ai * 16384 + m * 2048)) = cat4(h0, h1);
            }
    }
    __device__ __forceinline__ void sk(int row, int q32, int e4, f32x4 g, f32x4 u) const {
        const int b = row_batch(row); const float* bias = BW + (size_t)b * NWIN + q32 * 32 + e4;
        const float r = rsqrtf(rowss[row] * (1.0f / D) + EPS);
        *(f16x4*)(H + (size_t)row * FF + 128 * (q32 >> 3) + 32 * (q32 & 3) + 2 * e4 + 4 * ((q32 >> 2) & 1)) = act(g, u, r, *(const f32x4*)bias, *(const f32x4*)(bias + 16));
    }
};
struct EpiRes {
    static constexpr bool HAS_PRE = true;
    f16* X; f16* A; float* rowss_next; const float* GT; const float* CS; const float* RCS;
    __device__ __forceinline__ void pre(const Unit& u, LAS float* ev, int wid, int lane) const {
        const int i = (wid & 3) * 64 + lane; const size_t o = (size_t)(u.pm >> 5) * D + u.pn * 256 + i;
        if (wid < 4) { __builtin_amdgcn_global_load_lds((const unsigned*)(GT + o), (LAS unsigned*)(ev + (wid & 3) * 64), 4, 0, 0);
                       __builtin_amdgcn_global_load_lds((const unsigned*)(RCS + o), (LAS unsigned*)(ev + 512 + (wid & 3) * 64), 4, 0, 0); }
        else if (CS) __builtin_amdgcn_global_load_lds((const unsigned*)(CS + o), (LAS unsigned*)(ev + 256 + (wid & 3) * 64), 4, 0, 0);
    }
    __device__ __forceinline__ void operator()(const f32x4 (&acc)[2][2][4][2], const Unit& u, int wr, int wc, int fr_in, int fq_in, const LAS float* ev) const {
        const int fr = opaque_v(fr_in), fq = opaque_v(fq_in);
        const int col0 = u.pn * 256 + wc * 32 + 8 * fq;
        const LAS float* gt = ev + wc * 32 + 8 * fq; const LAS float* cs = ev + 256 + wc * 32 + 8 * fq; const LAS float* rc = ev + 512 + wc * 32 + 8 * fq;
        char* ab = (char*)A + (size_t)(u.pm * (D / 64) + 4 * u.pn + (wc >> 1)) * 32768 + (size_t)(8 * wr + (wc & 1)) * 1024;
        const unsigned lo = (unsigned)(fr * 64 + ((16 * fq) ^ (32 * (fr >> 3))));
        const bool lastsite = (CS == nullptr);
        f32x4 gv[2][2], rv[2][2], cv[2][2];
#pragma unroll
        for (int bj = 0; bj < 2; ++bj)
#pragma unroll
            for (int n = 0; n < 2; ++n) { gv[bj][n] = *(const LAS f32x4*)(gt + bj * 128 + 4 * n); rv[bj][n] = *(const LAS f32x4*)(rc + bj * 128 + 4 * n); cv[bj][n] = *(const LAS f32x4*)(cs + bj * 128 + 4 * n); }
#pragma unroll
        for (int ai = 0; ai < 2; ++ai)
#pragma unroll
            for (int m = 0; m < 4; ++m) {
                const int row = u.pm * 256 + ai * 128 + wr * 64 + m * 16 + fr;
                float ss = 0.f;
#pragma unroll
                for (int bj = 0; bj < 2; ++bj) {
                    const int off = bj * 128;
                    f16x8* ap = (f16x8*)(ab + lo + (bj * 65536 + ai * 16384 + m * 2048));
                    const f16x8 ah = *ap;
                    f16x4 ao[2];
#pragma unroll
                    for (int n = 0; n < 2; ++n) {
                        f32x4 x = {(float)ah[4 * n], (float)ah[4 * n + 1], (float)ah[4 * n + 2], (float)ah[4 * n + 3]}; x = x * rv[bj][n] + gv[bj][n] * acc[ai][bj][m][n];
                        ss += (x[0] * x[0] + x[1] * x[1]) + (x[2] * x[2] + x[3] * x[3]);
                        ao[n] = cvt4(lastsite ? x : x * cv[bj][n]);
                    }
                    if (lastsite) *(f16x8*)(X + (size_t)row * D + col0 + off) = cat4(ao[0], ao[1]);
                    else *ap = cat4(ao[0], ao[1]);
                }
                ss += __shfl_xor(ss, 16); ss += __shfl_xor(ss, 32);
                if (fq == 0) atomicAdd(rowss_next + row, ss);
            }
    }
    __device__ __forceinline__ static int slot2col(int slot) { return (slot & ~31) + 8 * ((slot & 15) >> 2) + 4 * ((slot >> 4) & 1); }
    __device__ __forceinline__ void sk(int row, int slot, f32x4 v) const {
        const int col = slot2col(slot);
        const int b = row_batch(row);
        const f32x4 g4 = *(const f32x4*)(GT + (size_t)b * D + col), r4 = *(const f32x4*)(RCS + (size_t)b * D + col);
        f16* ar = A + (size_t)row * D + col; const f16x4 ah = *(const f16x4*)ar;
        f32x4 x = {(float)ah[0], (float)ah[1], (float)ah[2], (float)ah[3]}; x = x * r4 + g4 * v;
        if (CS) *(f16x4*)ar = cvt4(x * *(const f32x4*)(CS + (size_t)b * D + col));
        else *(f16x4*)(X + (size_t)row * D + col) = cvt4(x);
        atomicAdd(rowss_next + row, (x[0] * x[0] + x[1] * x[1]) + (x[2] * x[2] + x[3] * x[3]));
    }
};
template <bool EVEN> struct EpiZ {
    static constexpr bool HAS_PRE = true;
    const float* rowss; const float* BW; f16* Z; float* GATES;
    __device__ __forceinline__ void pre(const Unit& u, LAS float* ev, int wid, int lane) const {
        const int i = (wid & 3) * 64 + lane;
        const float* src = (wid < 4) ? rowss + u.pm * 256 + i : BW + (size_t)(u.pm >> 5) * NWIN + u.pn * 256 + i;
        __builtin_amdgcn_global_load_lds((const unsigned*)src, (LAS unsigned*)(ev + (wid < 4 ? 0 : 256) + (wid & 3) * 64), 4, 0, 0);
    }
    static constexpr int LDZ = EVEN ? NEV : NOD;
    __device__ __forceinline__ void put(int row, int col, f32x4 z) const {
        if (EVEN) {
            if (col < 2816) { if (col >= 1280 && col < 1792) z = z * 0.125f; *(f16x4*)(Z + (size_t)row * LDZ + col) = cvt4(z); }
            else if (col < NEVR) *(f32x4*)(GATES + (size_t)row * 16 + (col - 2816)) = z;
        } else *(f16x4*)(Z + (size_t)row * LDZ + col) = cvt4(z);
    }
    __device__ __forceinline__ void put8(int row, int col, f32x4 z0, f32x4 z1) const {
        if (EVEN) {
            if (col < 2816) { if (col >= 1280 && col < 1792) { z0 = z0 * 0.125f; z1 = z1 * 0.125f; } *(f16x8*)(Z + (size_t)row * LDZ + col) = cat4(cvt4(z0), cvt4(z1)); }
            else if (col < NEVR) { float* gp = GATES + (size_t)row * 16 + (col - 2816); *(f32x4*)gp = z0; *(f32x4*)(gp + 4) = z1; }
        } else *(f16x8*)(Z + (size_t)row * LDZ + col) = cat4(cvt4(z0), cvt4(z1));
    }
    __device__ __forceinline__ static int slot2col(int slot) { return (slot & ~31) + 8 * ((slot & 15) >> 2) + 4 * ((slot >> 4) & 1); }
    __device__ __forceinline__ void operator()(const f32x4 (&acc)[2][2][4][2], const Unit& u, int wr, int wc, int fr_in, int fq_in, const LAS float* ev) const {
        const int fr = opaque_v(fr_in), fq = opaque_v(fq_in);
        const int col0 = u.pn * 256 + wc * 32 + 8 * fq;
        f32x4 bv[2][2];
#pragma unroll
        for (int bj = 0; bj < 2; ++bj)
#pragma unroll
            for (int n = 0; n < 2; ++n) bv[bj][n] = *(const LAS f32x4*)(ev + 256 + wc * 32 + 4 * fq + bj * 128 + n * 16);
#pragma unroll
        for (int ai = 0; ai < 2; ++ai)
#pragma unroll
            for (int m = 0; m < 4; ++m) {
                const int row = u.pm * 256 + ai * 128 + wr * 64 + m * 16 + fr;
                const float r = rsqrtf(ev[ai * 128 + wr * 64 + m * 16 + fr] * (1.0f / D) + EPS);
#pragma unroll
                for (int bj = 0; bj < 2; ++bj) put8(row, col0 + bj * 128, acc[ai][bj][m][0] * r + bv[bj][0], acc[ai][bj][m][1] * r + bv[bj][1]);
            }
    }
    __device__ __forceinline__ void sk(int row, int slot, f32x4 v) const {
        const int b = row_batch(row); const float r = rsqrtf(rowss[row] * (1.0f / D) + EPS);
        put(row, slot2col(slot), v * r + *(const f32x4*)(BW + (size_t)b * NWIN + slot));
    }
};
struct EpiMod {
    static constexpr bool HAS_PRE = false;
    float* CS; float* GT; f16* SHA; const float* bmod; const float* NG; float* RCS;
    __device__ __forceinline__ void operator()(const f32x4 (&acc)[2][2][4][2], const Unit& u, int wr, int wc, int fr_in, int fq_in, const LAS float* ev) const {
        const int fr = opaque_v(fr_in), fq = opaque_v(fq_in);
        const int cu = u.pn * 256, l = cu / NMODC, jj = (cu - l * NMODC) >> 10, j = jj / 3, kind = jj - 3 * j, s = 3 * l + j;
        const int d0 = (cu & 1023) + wc * 32 + 4 * fq;
#pragma unroll
        for (int ai = 0; ai < 2; ++ai)
#pragma unroll
            for (int m = 0; m < 4; ++m) {
                const int row = ai * 128 + wr * 64 + m * 16 + fr;
#pragma unroll
                for (int bj = 0; bj < 2; ++bj)
#pragma unroll
                    for (int n = 0; n < 2; ++n) {
                        const int d = d0 + bj * 128 + n * 16;
                        const f32x4 v = acc[ai][bj][m][n] + *(const f32x4*)(bmod + cu - (cu & 1023) + d);
                        if (kind == 0) *tiled_ptr<f16x4>(SHA, s * 256 + row, d, D) = row < NBAT ? cvt4(v) : (f16x4){0, 0, 0, 0};
                        else if (row < NBAT) {
                            if (kind == 1) { const f32x4 c4 = *(const f32x4*)(NG + (l * 3 + j) * D + d) * (v + 1.0f); *(f32x4*)(CS + ((size_t)s * NBAT + row) * D + d) = c4;
                                *(f32x4*)(RCS + ((size_t)s * NBAT + row) * D + d) = (f32x4){1.0f / c4[0], 1.0f / c4[1], 1.0f / c4[2], 1.0f / c4[3]}; }
                            else *(f32x4*)(GT + ((size_t)s * NBAT + row) * D + d) = v * (j == 1 ? 1.0f : 0.5f);
                        }
                    }
            }
    }
};
struct EpiBias {
    static constexpr bool HAS_PRE = false;
    float* BW;
    __device__ __forceinline__ void operator()(const f32x4 (&acc)[2][2][4][2], const Unit& u, int wr, int wc, int fr_in, int fq_in, const LAS float* ev) const {
        const int fr = opaque_v(fr_in), fq = opaque_v(fq_in);
        const int col0 = u.pn * 256 + wc * 32 + 4 * fq;
#pragma unroll
        for (int ai = 0; ai < 2; ++ai)
#pragma unroll
            for (int m = 0; m < 4; ++m) {
                const int row = ai * 128 + wr * 64 + m * 16 + fr;
                if (row < NBAT) {
#pragma unroll
                    for (int bj = 0; bj < 2; ++bj)
#pragma unroll
                        for (int n = 0; n < 2; ++n) *(f32x4*)(BW + (size_t)row * NWIN + col0 + bj * 128 + n * 16) = acc[ai][bj][m][n];
                }
            }
    }
};

template <bool SWIGLU, int K, class Epi>
__device__ __forceinline__ void skinny_phase(ldsp_t lds, const f16* A, const f16* Bt, int N, const Epi& E, int G, int c, int nunits) {
    const int tid = opaque_v(threadIdx.x), wid = __builtin_amdgcn_readfirstlane(tid >> 6), lane = tid & 63, fr = lane & 15, fq = lane >> 4;
    const int grp = c & 7, rem = nunits % G, r0 = (rem + 7 - grp) >> 3;
    int r = (c >> 3) - r0, nr = ((G - grp + 7) >> 3) - r0;
    if (r < 0 || nr <= 0) { if (nr > 0) return; r = c >> 3; nr = (G - grp + 7) >> 3; }
    constexpr int AS = K + 8;
    constexpr int KS = (!SWIGLU && K > 2048) ? 4 : 1;
    LAS f16* As = (LAS f16*)lds;
    LAS float* red = (LAS float*)(lds + 16 * AS * 2);
    const f16* Ag = A + (size_t)(16 * grp) * K;
    for (int i = tid; i < 16 * (K / 8); i += 512) { const int row = i / (K / 8), ch = i - row * (K / 8);
        const unsigned long long* gp = (const unsigned long long*)(Ag + (size_t)row * K + 8 * ch);
        const unsigned long long lo = __hip_atomic_load(gp, __ATOMIC_RELAXED, __HIP_MEMORY_SCOPE_AGENT), hi = __hip_atomic_load(gp + 1, __ATOMIC_RELAXED, __HIP_MEMORY_SCOPE_AGENT);
        LAS unsigned long long* lp = (LAS unsigned long long*)(As + row * AS + 8 * ch); lp[0] = lo; lp[1] = hi; }
    __syncthreads();
    const int nitem = SWIGLU ? N / 32 : N / 16;
    const LAS f16* ap = As + fr * AS + 8 * fq;
    const int wq = wid / KS, kq = wid - wq * KS, nwq = 8 / KS;
    constexpr int KSTEPS = K / 32 / KS;
    for (int t0 = 0; t0 < nitem; t0 += nwq * nr) {
        const int t = t0 + wq * nr + r; const bool on = t < nitem;
        const int n0 = SWIGLU ? 32 * t : 16 * t;
        f32x4 acc0 = {0.f, 0.f, 0.f, 0.f}, acc1 = {0.f, 0.f, 0.f, 0.f};
        if (on) {
            const char* bp = (const char*)Bt + tiled_byte(n0 + fr, 8 * fq, K);
            const LAS f16* apk = ap + 32 * KSTEPS * kq;
#pragma unroll 8
            for (int ks = 0; ks < KSTEPS; ++ks) {
                const int kg = KSTEPS * kq + ks; const size_t ko = (size_t)(kg >> 1) * 32768 + (size_t)(kg & 1) * 1024;
                const f16x8 a = *(const LAS f16x8*)(apk + 32 * ks);
                const f16x8 b0 = *(const f16x8*)(bp + ko);
                acc0 = __builtin_amdgcn_mfma_f32_16x16x32_f16(b0, a, acc0, 0, 0, 0);
                if constexpr (SWIGLU) { const f16x8 b1 = *(const f16x8*)(bp + ko + 2048); acc1 = __builtin_amdgcn_mfma_f32_16x16x32_f16(b1, a, acc1, 0, 0, 0); }
            }
        }
        if constexpr (KS > 1) {
            *(LAS f32x4*)(red + (wid * 64 + lane) * 4) = acc0;
            __syncthreads();
            if (kq == 0) {
#pragma unroll
                for (int j = 1; j < KS; ++j) acc0 = acc0 + *(const LAS f32x4*)(red + ((wid + j) * 64 + lane) * 4);
            }
            __syncthreads();
        }
        const int row = MP + 16 * grp + fr;
        if (on && kq == 0) {
            if constexpr (SWIGLU) E.sk(row, t, 4 * fq, acc0, acc1);
            else E.sk(row, n0 + 4 * fq, acc0);
        }
    }
    __syncthreads();
}

struct Frame {
    ldsp_t lds; int tid, lane, wave, G, bid;
    float* out; unsigned char* ws;
};
#define FIN(i) (((const float* const __attribute__((address_space(4)))*)__builtin_amdgcn_kernarg_segment_ptr())[i])
#define WSP(T_, off) ((T_*)(F.ws + (off)))

__device__ __forceinline__ void tr_item(const float* W, int K, int Nsrc, int Ndst, int perm, f16* WT, LAS float* scr, int item, int lane) {
    const int nblk = Ndst / 64, kb = item / nblk, nb64 = item - kb * nblk, k0 = 32 * kb, n0 = 64 * nb64;
    const int kr = lane >> 4, c16 = lane & 15, nb = 2 * nb64 + (c16 >> 3), c4 = c16 & 7;
    int sc = 32 * nb + 4 * c4;
    if (perm == 2) sc = 32 * nb + 8 * (c4 & 3) + 4 * (c4 >> 2);
    else if (perm == 1) sc = (c4 >> 2) * FF + 128 * (nb64 >> 2) + 32 * (nb64 & 3) + 8 * (c4 & 3) + 4 * (c16 >> 3);
    const bool ok = sc < Nsrc;
    f32x4 v[8];
#pragma unroll
    for (int i = 0; i < 8; ++i) v[i] = ok ? __builtin_nontemporal_load((const f32x4*)(W + (size_t)(k0 + 4 * i + kr) * Nsrc + sc)) : (f32x4){0.f, 0.f, 0.f, 0.f};
#pragma unroll
    for (int i = 0; i < 8; ++i) { LAS float* d = scr + (4 * i + kr) * 65 + 4 * c16; d[0] = v[i][0]; d[1] = v[i][1]; d[2] = v[i][2]; d[3] = v[i][3]; }
    LDS_WAIT(); asm volatile("" ::: "memory");
    const int c = lane & 3;
#pragma unroll
    for (int j = 0; j < 4; ++j) { const int n = (lane >> 2) + 16 * j; const LAS float* sp = scr + (8 * c) * 65 + n;
        f16x8 o;
#pragma unroll
        for (int e = 0; e < 8; ++e) o[e] = (f16)sp[e * 65];
        const int row = perm == 1 ? 256 * (nb64 >> 2) + 128 * (n >> 5) + 32 * (nb64 & 3) + (n & 31) : n0 + n;
        *tiled_ptr<f16x8>(WT, row, k0 + 8 * c, K) = o; }
    LDS_WAIT(); asm volatile("" ::: "memory");
}
struct MatDesc { const float* src; int K, Nsrc, Ndst, perm; f16* dst; };
__device__ __forceinline__ void mat_desc(Frame& F, int mi, MatDesc& d) {
    if (mi < 8) { const int l = mi >> 1, i = mi & 1; d = {FIN(I_FWI) + (size_t)mi * D * FF2, D, FF2, FF2, 1, WSP(f16, WS_WIN) + (size_t)site_off(3 * l + 2 * i) * D}; }
    else if (mi < 10) { const int e = mi - 8; d = {FIN(I_EWI) + (size_t)e * D * NEVR, D, NEVR, NEV, 2, WSP(f16, WS_WIN) + (size_t)site_off(6 * e + 1) * D}; }
    else if (mi < 12) { const int o = mi - 10; d = {FIN(I_OWI) + (size_t)o * D * NOD, D, NOD, NOD, 2, WSP(f16, WS_WIN) + (size_t)site_off(6 * o + 4) * D}; }
    else if (mi < 20) { const int k = mi - 12; d = {FIN(I_FWO) + (size_t)k * FF * D, FF, D, D, 2, WSP(f16, WS_WFO) + (size_t)k * D * FF}; }
    else if (mi < 22) { const int e = mi - 20; d = {FIN(I_EWO) + (size_t)e * D * D, D, D, D, 2, WSP(f16, WS_WEO) + (size_t)e * D * D}; }
    else if (mi < 24) { const int o = mi - 22; d = {FIN(I_OWO) + (size_t)o * 512 * D, 512, D, D, 2, WSP(f16, WS_WOO) + (size_t)o * D * 512}; }
    else { const int l = mi - 24; d = {FIN(I_WMOD) + (size_t)l * D * NMODC, D, NMODC, NMODC, 0, WSP(f16, WS_WMOD) + (size_t)l * NMODC * D}; }
}
__device__ __forceinline__ void cache_shift(const float* in, float* out, int W, size_t gtid, size_t gstride) {
    const size_t per = (size_t)(W - 1) * 64, total = per * 256;
    for (size_t i = gtid; i < total; i += gstride) {
        const size_t es = i / per, off = i - es * per;
        const f32x4 v = __builtin_nontemporal_load((const f32x4*)(in + es * (size_t)W * 256 + 256) + off);
        __builtin_nontemporal_store(v, (f32x4*)(out + es * (size_t)W * 256) + off);
    }
}
__device__ __forceinline__ void phase_pr0(Frame& F, int mlo, int mhi, bool do_ac, unsigned* ctr) {
    LAS float* scr = (LAS float*)(F.lds + F.wave * 16384);
    const int gw = F.bid * 8 + F.wave, NGW = F.G * 8;
    if (ctr) {
        int total = 0;
        for (int mi = mlo; mi < mhi; ++mi) { MatDesc d; mat_desc(F, mi, d); total += (d.K / 64) * (d.Ndst / 32); }
        for (;;) {
            unsigned g0 = 0; if (F.lane == 0) g0 = xb_add(ctr, 4u);
            g0 = (unsigned)__builtin_amdgcn_readfirstlane((int)g0);
            if ((int)g0 >= total) break;
            for (int j = 0; j < 4 && (int)g0 + j < total; ++j) {
                int g = (int)g0 + j, mi = mlo; MatDesc d; mat_desc(F, mi, d); int items = (d.K / 64) * (d.Ndst / 32);
                while (g >= items) { g -= items; ++mi; mat_desc(F, mi, d); items = (d.K / 64) * (d.Ndst / 32); }
                tr_item(d.src, d.K, d.Nsrc, d.Ndst, d.perm, d.dst, scr, g, F.lane);
            }
        }
    } else {
    int base = 0;
    for (int mi = mlo; mi < mhi; ++mi) {
        MatDesc d; mat_desc(F, mi, d);
        const int items = (d.K / 64) * (d.Ndst / 32);
        int it = gw - (base % NGW); if (it < 0) it += NGW;
        for (; it < items; it += NGW) tr_item(d.src, d.K, d.Nsrc, d.Ndst, d.perm, d.dst, scr, it, F.lane);
        base += items;
    }
    }
    if (do_ac) { f16* AC = WSP(f16, WS_AC);
      for (int i = F.bid * 512 + F.tid; i < 256 * D; i += F.G * 512) { const int b = i >> 10, d = i & 1023; float v = 0.f;
          if (b < NBAT) { const float c = b < NB ? FIN(I_CP)[b * D + d] : FIN(I_CSMP)[(b - NB) * D + d]; v = c / (1.0f + __expf(-c)); }
          *tiled_ptr<f16>(AC, b, d, D) = (f16)v; } }
}
__device__ __forceinline__ void phase_pr2(Frame& F) {
    const float* CS0 = WSP(float, WS_CS);
    f16* X = WSP(f16, WS_X); f16* A = WSP(f16, WS_A); float* rowss = (float*)(F.ws + RSS_OFF);
    constexpr int NU = NWIN / 256, NIT = MALL / 4;
    const int nbw = (F.G < NU ? F.G : NU) * 8, nfw = F.G * 8 - nbw;
    int it_lo = 0, it_hi = NIT, it_idx = F.bid * 8 + F.wave, it_st = F.G * 8;
    if (nfw > 0) { const int ib = NIT < nbw ? NIT : nbw;
        if (F.bid < NU) { it_hi = ib; it_st = nbw; } else { it_lo = ib; it_idx = (F.bid - NU) * 8 + F.wave; it_st = nfw; } }
    for (int it = it_lo + it_idx; it < it_hi; it += it_st) { const int m0 = it * 4;
        f32x4 xv[4][4];
#pragma unroll
        for (int r = 0; r < 4; ++r) { const int m = m0 + r; const float* xr = m < MP ? FIN(I_XP) + (size_t)m * D : FIN(I_XS) + (size_t)(m - MP) * D;
#pragma unroll
            for (int q = 0; q < 4; ++q) xv[r][q] = __builtin_nontemporal_load((const f32x4*)(xr + q * 256 + F.lane * 4)); }
#pragma unroll
        for (int r = 0; r < 4; ++r) { const int m = m0 + r; const float* cs = CS0 + (size_t)row_batch(m) * D; float ss = 0.f;
#pragma unroll
            for (int q = 0; q < 4; ++q) { const int d = q * 256 + F.lane * 4;
                const f32x4 x = xv[r][q];
                ss += (x[0] * x[0] + x[1] * x[1]) + (x[2] * x[2] + x[3] * x[3]);
                const f16x4 av = cvt4(x * *(const f32x4*)(cs + d));
                if (m < MP) *tiled_ptr<f16x4>(A, m, d, D) = av; else *(f16x4*)(A + (size_t)m * D + d) = av; }
            ss = wave_sum(ss);
            if (F.lane == 0) rowss[m] = ss; }
    }
}
template <int O0, int O1, int O2, int O3, int O4, int O5, int O6, int O7>
__device__ __forceinline__ void tr_read8(unsigned base, f16x4 (&r)[8]) {
    asm volatile("ds_read_b64_tr_b16 %0, %8 offset:%9\n\tds_read_b64_tr_b16 %1, %8 offset:%10\n\tds_read_b64_tr_b16 %2, %8 offset:%11\n\tds_read_b64_tr_b16 %3, %8 offset:%12\n\t"
                 "ds_read_b64_tr_b16 %4, %8 offset:%13\n\tds_read_b64_tr_b16 %5, %8 offset:%14\n\tds_read_b64_tr_b16 %6, %8 offset:%15\n\tds_read_b64_tr_b16 %7, %8 offset:%16\n\ts_waitcnt lgkmcnt(0)"
                 : "=&v"(r[0]), "=&v"(r[1]), "=&v"(r[2]), "=&v"(r[3]), "=&v"(r[4]), "=&v"(r[5]), "=&v"(r[6]), "=&v"(r[7])
                 : "v"(base), "n"(O0), "n"(O1), "n"(O2), "n"(O3), "n"(O4), "n"(O5), "n"(O6), "n"(O7) : "memory");
}
__device__ __forceinline__ unsigned lds_addr(const LAS void* p) { return (unsigned)(unsigned long long)p; }
struct BandAttn { const f16* Z; int ldz, qcol, kcol, vcol; f16* O; int ldo, ocol; float* LSE; const float* sinks; int tiledO; };
constexpr int KS_STR = 72, VS_STR = 96;
constexpr int ATT_KS = 0, ATT_VS = 256 * KS_STR * 2;
__device__ __forceinline__ void band_attn_unit(ldsp_t lds, const BandAttn& P, int tokbase, int stride, int blk, int kvh) {
    const int tid = opaque_v(threadIdx.x), w = __builtin_amdgcn_readfirstlane(tid >> 6), lane = tid & 63, c = lane & 31, hh = lane >> 5;
    LAS f16* Ks = (LAS f16*)(lds + ATT_KS); LAS f16* Vs = (LAS f16*)(lds + ATT_VS);
    f16x8 qfa[2][4];
    { const int head_ = kvh * 4 + (w >> 1);
#pragma unroll
      for (int qt = 0; qt < 2; ++qt) { const int mr_ = tokbase + stride * (128 * blk + 64 * (w & 1) + 32 * qt + c);
#pragma unroll
          for (int ks = 0; ks < 4; ++ks) qfa[qt][ks] = *(const f16x8*)(P.Z + (size_t)mr_ * P.ldz + P.qcol + head_ * 64 + 16 * ks + 8 * hh); } }
#pragma unroll
    for (int i = 0; i < 4; ++i) {
        const int cid = tid + 512 * i, key = cid >> 3, ch = cid & 7, p = 128 * blk - 128 + key;
        f16x8 kv = {0, 0, 0, 0, 0, 0, 0, 0}, vv = {0, 0, 0, 0, 0, 0, 0, 0};
        if (p >= 0) { const f16* zr = P.Z + (size_t)(tokbase + stride * p) * P.ldz + kvh * 64 + 8 * ch; kv = *(const f16x8*)(zr + P.kcol); vv = *(const f16x8*)(zr + P.vcol); }
        *(LAS f16x8*)(Ks + key * KS_STR + 8 * ch) = kv;
        *(LAS f16x8*)(Vs + key * VS_STR + 8 * ch) = vv;
    }
    __syncthreads();
    const int g = w >> 1, qh = w & 1, head = kvh * 4 + g;
    const unsigned vlane = lds_addr(Vs) + (unsigned)((4 * hh + ((lane & 15) >> 2)) * (VS_STR * 2) + (16 * ((lane >> 4) & 1) + 4 * (lane & 3)) * 2);
    const float sink = P.sinks ? P.sinks[head] : -INFINITY;
    constexpr float SC = 0.125f, L2E = 1.4426950408889634f;
#pragma unroll
    for (int qt = 0; qt < 2; ++qt) {
        const int i0 = 64 * qh + 32 * qt;
        const int mrow = tokbase + stride * (128 * blk + i0 + c);
        f16x8 qf[4];
#pragma unroll
        for (int ks = 0; ks < 4; ++ks) qf[ks] = qt ? qfa[1][ks] : qfa[0][ks];
        f32x16 s[5];
#pragma unroll
        for (int kt = 0; kt < 5; ++kt) {
#pragma unroll
            for (int i = 0; i < 16; ++i) s[kt][i] = 0.f;
#pragma unroll
            for (int ks = 0; ks < 4; ++ks) {
                const f16x8 a = *(const LAS f16x8*)(Ks + (i0 + 32 * kt + c) * KS_STR + 16 * ks + 8 * hh);
                s[kt] = __builtin_amdgcn_mfma_f32_32x32x16_f16(a, qf[ks], s[kt], 0, 0, 0);
            }
        }
        float mx = -INFINITY;
        const int cm = c - 4 * hh;
#pragma unroll
        for (int i = 0; i < 16; ++i) { const int kb = (i & 3) + 8 * (i >> 2);
            s[0][i] = (kb >= cm) ? s[0][i] : -INFINITY; s[4][i] = (kb <= cm) ? s[4][i] : -INFINITY; }
        if (blk == 0) {
            asm volatile("" ::: "memory");
#pragma unroll
            for (int kt = 0; kt < 5; ++kt)
#pragma unroll
                for (int i = 0; i < 16; ++i) { const int kr = (i & 3) + 8 * (i >> 2) + 4 * hh; s[kt][i] = (i0 + 32 * kt + kr >= 128) ? s[kt][i] : -INFINITY; }
        }
#pragma unroll
        for (int kt = 0; kt < 5; ++kt)
#pragma unroll
            for (int i = 0; i < 16; ++i) mx = fmaxf(mx, s[kt][i]);
        mx = fmaxf(mx, __shfl_xor(mx, 32));
        mx = fmaxf(mx * SC, sink);
        constexpr float CE = SC * L2E; const float moff = mx * L2E;
        float sum = 0.f; f16x8 pf[5][2];
#pragma unroll
        for (int kt = 0; kt < 5; ++kt)
#pragma unroll
            for (int i = 0; i < 16; ++i) { const float pv = __builtin_amdgcn_exp2f(__builtin_fmaf(s[kt][i], CE, -moff)); sum += pv; pf[kt][i >> 3][i & 7] = (f16)pv; }
        sum += __shfl_xor(sum, 32);
        sum += __builtin_amdgcn_exp2f((sink - mx) * L2E);
        const float inv = __builtin_amdgcn_rcpf(sum);
        f32x16 o[2];
#pragma unroll
        for (int i = 0; i < 16; ++i) { o[0][i] = 0.f; o[1][i] = 0.f; }
        const unsigned vb = vlane + (unsigned)(i0 * (VS_STR * 2));
#define BA_PV(KT) { f16x4 r[8]; constexpr int B_ = (KT) * 32 * VS_STR * 2, S_ = 16 * VS_STR * 2, H_ = 8 * VS_STR * 2; \
            tr_read8<B_, B_ + H_, B_ + S_, B_ + S_ + H_, B_ + 64, B_ + 64 + H_, B_ + 64 + S_, B_ + 64 + S_ + H_>(vb, r); \
            o[0] = __builtin_amdgcn_mfma_f32_32x32x16_f16(cat4(r[0], r[1]), pf[KT][0], o[0], 0, 0, 0); o[0] = __builtin_amdgcn_mfma_f32_32x32x16_f16(cat4(r[2], r[3]), pf[KT][1], o[0], 0, 0, 0); \
            o[1] = __builtin_amdgcn_mfma_f32_32x32x16_f16(cat4(r[4], r[5]), pf[KT][0], o[1], 0, 0, 0); o[1] = __builtin_amdgcn_mfma_f32_32x32x16_f16(cat4(r[6], r[7]), pf[KT][1], o[1], 0, 0, 0); }
        BA_PV(0) BA_PV(1) BA_PV(2) BA_PV(3) BA_PV(4)
#undef BA_PV
#pragma unroll
        for (int dt = 0; dt < 2; ++dt) {
            const int ocol = P.ocol + head * 64 + 32 * dt + 4 * hh;
#pragma unroll
            for (int rg = 0; rg < 4; ++rg) { f32x4 v = {o[dt][4 * rg] * inv, o[dt][4 * rg + 1] * inv, o[dt][4 * rg + 2] * inv, o[dt][4 * rg + 3] * inv};
                f16x4* op = P.tiledO ? tiled_ptr<f16x4>(P.O, mrow, ocol + 8 * rg, P.ldo) : (f16x4*)(P.O + (size_t)mrow * P.ldo + ocol + 8 * rg);
                *op = cvt4(v); }
        }
        if (P.LSE && hh == 0) P.LSE[(size_t)mrow * 8 + head] = mx + __logf(sum);
    }
    __syncthreads();
}
__device__ __forceinline__ void kv_export(const f16* Z, int ldz, int kcol, int vcol, int m0, int nrows, float* out, int tid0, int nthr) {
    for (int i0 = tid0; i0 < nrows * 32; i0 += 8 * nthr) {
        f16x8 v[8];
#pragma unroll
        for (int j = 0; j < 8; ++j) { const int i = i0 + j * nthr, r = i >> 5, ch = i & 31, isv = ch >> 4, c8 = (ch & 15) * 8;
            v[j] = i < nrows * 32 ? *(const f16x8*)(Z + (size_t)(m0 + r) * ldz + (isv ? vcol : kcol) + c8) : (f16x8){0, 0, 0, 0, 0, 0, 0, 0}; }
#pragma unroll
        for (int j = 0; j < 8; ++j) { const int i = i0 + j * nthr, r = i >> 5, ch = i & 31, isv = ch >> 4, c8 = (ch & 15) * 8;
            if (i < nrows * 32) { float* o = out + (size_t)r * 256 + isv * 128 + c8;
                *(f32x4*)o = (f32x4){(float)v[j][0], (float)v[j][1], (float)v[j][2], (float)v[j][3]}; *(f32x4*)(o + 4) = (f32x4){(float)v[j][4], (float)v[j][5], (float)v[j][6], (float)v[j][7]}; } }
    }
}

__device__ __forceinline__ void gate_scan(const float* GATES, const float* bg, int m0, int h, int lane, LAS float* gb, LAS float* ga, LAS float* gcm, float& amax, float& bL, float& a0o, float& a1o) {
    const float* g0 = GATES + (size_t)(m0 + 2 * lane) * 16;
    const float ig0 = g0[h] + bg[h], ig1 = g0[16 + h] + bg[h];
    const float lf0 = logsigmoidf_(g0[8 + h] + bg[8 + h]), lf1 = logsigmoidf_(g0[24 + h] + bg[8 + h]);
    float s = lf0 + lf1;
#pragma unroll
    for (int o = 1; o < 64; o <<= 1) { const float t = __shfl_up(s, o); if (lane >= o) s += t; }
    const float b0 = (s - (lf0 + lf1)) + lf0, b1 = b0 + lf1;
    const float a0 = ig0 - b0, a1 = ig1 - b1;
    float mx = fmaxf(a0, a1);
#pragma unroll
    for (int o = 1; o < 64; o <<= 1) { const float t = __shfl_up(mx, o); if (lane >= o) mx = fmaxf(mx, t); }
    float ex = __shfl_up(mx, 1); if (lane == 0) ex = -INFINITY;
    const float c0 = fmaxf(ex, a0), c1 = fmaxf(c0, a1);
    gb[2 * lane] = b0; gb[2 * lane + 1] = b1; ga[2 * lane] = a0; ga[2 * lane + 1] = a1; gcm[2 * lane] = c0; gcm[2 * lane + 1] = c1;
    amax = __shfl(mx, 63); bL = __shfl(s, 63); a0o = a0; a1o = a1;
}
constexpr int X1_KS = 0, X1_VS = 18432, X1_G = 36864, X1_HEAD = 38912, X1_STR = 72;
__device__ __forceinline__ void mlstm_x1_unit(Frame& F, int e, int b, int ch, int hp) {
    const int tid = F.tid, w = F.wave, lane = F.lane, hg = w >> 2, wv = w & 3, gt = tid & 255, h = 2 * hp + hg;
    ldsp_t base = F.lds + hg * X1_HEAD;
    LAS f16* Ksm = (LAS f16*)(base + X1_KS); LAS f16* Vsm = (LAS f16*)(base + X1_VS);
    LAS float* gb = (LAS float*)(base + X1_G); LAS float* ga = gb + 128; LAS float* gcm = ga + 128; LAS float* gwk = gcm + 128;
    const f16* Z = WSP(f16, WS_Z); const float* GATES = WSP(float, WS_GATES); const float* bg = FIN(I_EBG) + e * 16;
    const int m0 = b * T + 128 * ch, idx = (b * 8 + h) * 64 + ch;
    float amax = 0.f, bL = 0.f;
    f16x8 kxa[4], vxa[4];
#pragma unroll
    for (int i = 0; i < 4; ++i) { const int cid = gt + 256 * i, s_ = cid >> 3, c8 = cid & 7; const f16* zr = Z + (size_t)(m0 + s_) * NEV + h * 64 + 8 * c8;
        kxa[i] = *(const f16x8*)(zr + 1280); vxa[i] = *(const f16x8*)(zr + 1792); }
    if (wv == 0) { float a0, a1; gate_scan(GATES, bg, m0, h, lane, gb, ga, gcm, amax, bL, a0, a1); gwk[2 * lane] = __expf(a0 - amax); gwk[2 * lane + 1] = __expf(a1 - amax); }
    __syncthreads();
#pragma unroll
    for (int i = 0; i < 4; ++i) {
        const int cid = gt + 256 * i, s_ = cid >> 3, c8 = cid & 7;
        const f16x8 kx = kxa[i], vx = vxa[i]; const float wk = gwk[s_];
        f16x8 ks;
#pragma unroll
        for (int q = 0; q < 8; ++q) ks[q] = (f16)((float)kx[q] * wk);
        *(LAS f16x8*)(Ksm + s_ * X1_STR + 8 * c8) = ks; *(LAS f16x8*)(Vsm + s_ * X1_STR + 8 * c8) = vx;
    }
    __syncthreads();
    const int fr = lane & 15, fq = lane >> 4;
    const unsigned lof = (unsigned)((8 * fq + (fr >> 2)) * (X1_STR * 2) + 4 * (fr & 3) * 2);
    const unsigned vaddr = lds_addr(Vsm) + lof + (unsigned)(16 * wv * 2), kaddr = lds_addr(Ksm) + lof;
    constexpr int R4 = 4 * X1_STR * 2, R32 = 32 * X1_STR * 2;
    f16x4 rv[8];
    tr_read8<0, R4, R32, R32 + R4, 2 * R32, 2 * R32 + R4, 3 * R32, 3 * R32 + R4>(vaddr, rv);
    float* DC = WSP(float, WS_DC) + (size_t)idx * 4096;
    f32x4 accn = {0.f, 0.f, 0.f, 0.f};
    f16x8 ones;
#pragma unroll
    for (int q = 0; q < 8; ++q) ones[q] = (fr == 0) ? (f16)1.0f : (f16)0.0f;
#define X1_TILE(DKT) { f16x4 rk[8]; tr_read8<(DKT) * 32, (DKT) * 32 + R4, (DKT) * 32 + R32, (DKT) * 32 + R32 + R4, (DKT) * 32 + 2 * R32, (DKT) * 32 + 2 * R32 + R4, (DKT) * 32 + 3 * R32, (DKT) * 32 + 3 * R32 + R4>(kaddr, rk); \
        f32x4 acc = {0.f, 0.f, 0.f, 0.f}; \
        _Pragma("unroll") for (int ks = 0; ks < 4; ++ks) { const f16x8 bf = cat4(rk[2 * ks], rk[2 * ks + 1]); acc = __builtin_amdgcn_mfma_f32_16x16x32_f16(cat4(rv[2 * ks], rv[2 * ks + 1]), bf, acc, 0, 0, 0); \
            if ((DKT) == wv) accn = __builtin_amdgcn_mfma_f32_16x16x32_f16(ones, bf, accn, 0, 0, 0); } \
        _Pragma("unroll") for (int r = 0; r < 4; ++r) DC[(16 * wv + 4 * fq + r) * 64 + 16 * (DKT) + fr] = acc[r]; }
    X1_TILE(0) X1_TILE(1) X1_TILE(2) X1_TILE(3)
#undef X1_TILE
    if (fq == 0) WSP(float, WS_DN)[(size_t)idx * 64 + 16 * wv + fr] = accn[0];
    if (gt == 0) { float* SC = WSP(float, WS_SC); SC[idx] = bL + amax; SC[1024 + idx] = bL; }
    __syncthreads();
}
__device__ __forceinline__ void mlstm_scan(Frame& F, int e) {
    const int gid0 = F.bid * 512; if (gid0 >= 16 * 4160) return;
    const int bh0 = gid0 / 4160;
    const float* SC = WSP(float, WS_SC); float* MPV = WSP(float, WS_SC) + 2048;
    LAS float* sc = (LAS float*)F.lds;
    if (F.tid < 256) { const int hw = F.tid >> 7, c = (F.tid >> 1) & 63, k = F.tid & 1, bhs = bh0 + hw; sc[F.tid] = bhs < 16 ? SC[k * 1024 + bhs * 64 + c] : 0.f; }
    __syncthreads();
    const int gid = gid0 + F.tid;
    if (gid < 16 * 4160) {
        const int bh = gid / 4160, el = gid - bh * 4160; const bool isc = el < 4096;
        const float* src = isc ? WSP(float, WS_DC) + (size_t)bh * 64 * 4096 + el : WSP(float, WS_DN) + (size_t)bh * 64 * 64 + (el - 4096);
        const int sstr = isc ? 4096 : 64;
        f16* cp = WSP(f16, WS_CP) + (size_t)bh * 64 * 4096 + el; float* np = WSP(float, WS_NP) + (size_t)bh * 64 * 64 + (el - 4096);
        const LAS float* scb = sc + (bh - bh0) * 128;
        float dvv[64];
#pragma unroll
        for (int c = 0; c < 64; ++c) dvv[c] = src[(size_t)c * sstr];
        float st = 0.f, mst = 0.f;
#pragma unroll
        for (int c = 0; c < 64; ++c) {
            const float mloc = scb[2 * c], bL = scb[2 * c + 1];
            if (isc) cp[(size_t)c * 4096] = (f16)st; else np[c * 64] = st;
            if (el == 0) MPV[bh * 64 + c] = mst;
            const float mnew = fmaxf(bL + mst, mloc);
            st = __expf(bL + mst - mnew) * st + __expf(mloc - mnew) * dvv[c]; mst = mnew;
        }
        const int b = bh >> 3, h = bh & 7;
        if (isc) { const int dv = el >> 6, dk = el & 63; F.out[O_BCP + ((size_t)((e * 2 + b) * 8 + h) * 64 + dk) * 64 + dv] = st; }
        else F.out[O_BNP + (size_t)((e * 2 + b) * 8 + h) * 64 + (el - 4096)] = st;
        if (el == 0) F.out[O_BMP + (e * 2 + b) * 8 + h] = mst;
    }
    __syncthreads();
}
constexpr int X3_KR = 0, X3_VS = 18432, X3_G = 43008, X3_HEAD = 45056;
__device__ __forceinline__ void mlstm_x3_unit(Frame& F, int e, int b, int ch, int hp) {
    const int tid = F.tid, w = F.wave, lane = F.lane, hg = w >> 2, tt = w & 3, gt = tid & 255, h = 2 * hp + hg, c = lane & 31, hh = lane >> 5;
    ldsp_t base = F.lds + hg * X3_HEAD;
    LAS f16* Kr = (LAS f16*)(base + X3_KR); LAS f16* Vs = (LAS f16*)(base + X3_VS);
    LAS float* gb = (LAS float*)(base + X3_G); LAS float* ga = gb + 128; LAS float* gcm = ga + 128; LAS float* npv = gcm + 128;
    const f16* Z = WSP(f16, WS_Z); const float* GATES = WSP(float, WS_GATES); const float* bg = FIN(I_EBG) + e * 16;
    const int m0 = b * T + 128 * ch, idx = (b * 8 + h) * 64 + ch;
    f16x8 kxa[4], vxa[4];
#pragma unroll
    for (int i = 0; i < 4; ++i) { const int cid = gt + 256 * i, s = cid >> 3, c8 = cid & 7; const f16* zr = Z + (size_t)(m0 + s) * NEV + h * 64 + 8 * c8;
        kxa[i] = *(const f16x8*)(zr + 1280); vxa[i] = *(const f16x8*)(zr + 1792); }
    if (tt == 0) { float t0, t1, t2, t3; gate_scan(GATES, bg, m0, h, lane, gb, ga, gcm, t0, t1, t2, t3); }
#pragma unroll
    for (int i = 0; i < 4; ++i) {
        const int cid = gt + 256 * i, s = cid >> 3, c8 = cid & 7;
        const f16x8 kx = kxa[i], vx = vxa[i];
        *(LAS f16x8*)(Kr + s * KS_STR + 8 * c8) = kx;
        *(LAS f16x8*)(Vs + s * VS_STR + 8 * c8) = vx;
    }
    if (gt < 64) npv[gt] = WSP(float, WS_NP)[(size_t)idx * 64 + gt];
    __syncthreads();
    const float mst = WSP(float, WS_SC)[2048 + idx];
    const int t = 32 * tt + c, mrow = m0 + t;
    const float bt = gb[t], mm = fmaxf(mst, gcm[t]), mt = bt + mm;
    f16x8 qf[4];
#pragma unroll
    for (int ks = 0; ks < 4; ++ks) qf[ks] = *(const f16x8*)(Z + (size_t)mrow * NEV + 768 + h * 64 + 16 * ks + 8 * hh);
    f32x16 num[2];
#pragma unroll
    for (int i = 0; i < 16; ++i) { num[0][i] = 0.f; num[1][i] = 0.f; }
    float qsum = 0.f;
    const unsigned vlane = lds_addr(Vs) + (unsigned)((4 * hh + ((lane & 15) >> 2)) * (VS_STR * 2) + (16 * ((lane >> 4) & 1) + 4 * (lane & 3)) * 2);
    for (int st = 0; st <= tt; ++st) {
        f32x16 sa;
#pragma unroll
        for (int i = 0; i < 16; ++i) sa[i] = 0.f;
#pragma unroll
        for (int ks = 0; ks < 4; ++ks) { const f16x8 a = *(const LAS f16x8*)(Kr + (32 * st + c) * KS_STR + 16 * ks + 8 * hh); sa = __builtin_amdgcn_mfma_f32_32x32x16_f16(a, qf[ks], sa, 0, 0, 0); }
        f16x8 wf[2];
        const bool diag = (st == tt);
        constexpr float L2E_ = 1.4426950408889634f; const float mml = mm * L2E_;
#pragma unroll
        for (int rg = 0; rg < 4; ++rg) {
            const int s0 = 32 * st + 8 * rg + 4 * hh;
            const f32x4 g4 = *(const LAS f32x4*)(ga + s0);
#pragma unroll
            for (int q = 0; q < 4; ++q) {
                const int i = 4 * rg + q;
                float dd = __builtin_amdgcn_exp2f(__builtin_fmaf(g4[q], L2E_, -mml));
                if (diag) dd = (s0 + q <= t) ? dd : 0.f;
                const float wv_ = sa[i] * dd;
                qsum += wv_; wf[i >> 3][i & 7] = (f16)wv_;
            }
        }
        { f16x4 r[8]; constexpr int S_ = 16 * VS_STR * 2, H_ = 8 * VS_STR * 2;
          tr_read8<0, H_, S_, S_ + H_, 64, 64 + H_, 64 + S_, 64 + S_ + H_>(vlane + (unsigned)(st * 32 * VS_STR * 2), r);
          num[0] = __builtin_amdgcn_mfma_f32_32x32x16_f16(cat4(r[0], r[1]), wf[0], num[0], 0, 0, 0); num[0] = __builtin_amdgcn_mfma_f32_32x32x16_f16(cat4(r[2], r[3]), wf[1], num[0], 0, 0, 0);
          num[1] = __builtin_amdgcn_mfma_f32_32x32x16_f16(cat4(r[4], r[5]), wf[0], num[1], 0, 0, 0); num[1] = __builtin_amdgcn_mfma_f32_32x32x16_f16(cat4(r[6], r[7]), wf[1], num[1], 0, 0, 0); }
    }
    qsum += __shfl_xor(qsum, 32);
    f32x16 ni[2];
#pragma unroll
    for (int i = 0; i < 16; ++i) { ni[0][i] = 0.f; ni[1][i] = 0.f; }
    const f16* CP = WSP(f16, WS_CP) + (size_t)idx * 4096;
#pragma unroll
    for (int dt = 0; dt < 2; ++dt)
#pragma unroll
        for (int ks = 0; ks < 4; ++ks) { const f16x8 a = *(const f16x8*)(CP + (32 * dt + c) * 64 + 16 * ks + 8 * hh); ni[dt] = __builtin_amdgcn_mfma_f32_32x32x16_f16(a, qf[ks], ni[dt], 0, 0, 0); }
    float qni = 0.f;
#pragma unroll
    for (int ks = 0; ks < 4; ++ks)
#pragma unroll
        for (int j = 0; j < 8; ++j) qni += (float)qf[ks][j] * npv[16 * ks + 8 * hh + j];
    qni += __shfl_xor(qni, 32);
    const float inter = __expf(mst - mm);
    const float qn = qsum + inter * qni, invd = __builtin_amdgcn_rcpf(fmaxf(fabsf(qn), __expf(-mt)));
    float ssq = 0.f;
#pragma unroll
    for (int dt = 0; dt < 2; ++dt)
#pragma unroll
        for (int i = 0; i < 16; ++i) { const float hv = (num[dt][i] + inter * ni[dt][i]) * invd; num[dt][i] = hv; ssq += hv * hv; }
    ssq += __shfl_xor(ssq, 32);
    const float rinv = rsqrtf(ssq * (1.0f / 64.0f) + EPS);
    const float* hgain = FIN(I_EHG) + (e * 8 + h) * 64;
    f16* O = WSP(f16, WS_O);
#pragma unroll
    for (int dt = 0; dt < 2; ++dt)
#pragma unroll
        for (int rg = 0; rg < 4; ++rg) {
            const int dv0 = 32 * dt + 8 * rg + 4 * hh;
            const f16x4 bo = *(const f16x4*)(Z + (size_t)mrow * NEV + 2304 + h * 64 + dv0); const f32x4 gn = *(const f32x4*)(hgain + dv0);
            f32x4 y;
#pragma unroll
            for (int q = 0; q < 4; ++q) y[q] = num[dt][4 * rg + q] * rinv * gn[q] * sigmoidf_((float)bo[q]);
            *tiled_ptr<f16x4>(O, mrow, 512 + h * 64 + dv0, D) = cvt4(y);
        }
    __syncthreads();
}

constexpr int DA_QS = 0, DA_KC = 1024, DA_VC = 36352, DA_SC = 69376, DA_RD = 71488, DA_KSTR = 68;
__device__ __forceinline__ void dec_attn(Frame& F, const float* cache, int dil, int kvh, const f16* zrow, int qcol, int kcol, int vcol, const float* sinks, float& o_out, float& lse_out) {
    const int tid = F.tid, lane = F.lane, w = F.wave;
    LAS float* qs = (LAS float*)(F.lds + DA_QS); LAS float* Kc = (LAS float*)(F.lds + DA_KC); LAS float* Vc = (LAS float*)(F.lds + DA_VC);
    LAS float* sc = (LAS float*)(F.lds + DA_SC); LAS float* rd = (LAS float*)(F.lds + DA_RD);
#pragma unroll
    for (int i = 0; i < 4; ++i) {
        const int cid = tid + 512 * i, j = cid >> 4, c4 = cid & 15;
        const float* src = cache + (size_t)(dil * j) * 256 + kvh * 64 + 4 * c4;
        const f32x4 kk = *(const f32x4*)src, vv = *(const f32x4*)(src + 128);
        *(LAS f32x4*)(Kc + j * DA_KSTR + 4 * c4) = kk;
        *(LAS f32x4*)(Vc + j * 64 + 4 * c4) = vv;
    }
    if (tid < 64) { Kc[128 * DA_KSTR + tid] = (float)zrow[kcol + kvh * 64 + tid]; Vc[128 * 64 + tid] = (float)zrow[vcol + kvh * 64 + tid]; }
    if (tid < 256) qs[tid] = (float)zrow[qcol + kvh * 256 + tid];
    __syncthreads();
    for (int jj = tid; jj < 516; jj += 512) {
        const int j = jj >> 2, g = jj & 3; f32x4 s4 = {0.f, 0.f, 0.f, 0.f};
#pragma unroll
        for (int d = 0; d < 64; d += 4) s4 = s4 + *(const LAS f32x4*)(qs + g * 64 + d) * *(const LAS f32x4*)(Kc + j * DA_KSTR + d);
        sc[g * 132 + j] = ((s4[0] + s4[1]) + (s4[2] + s4[3])) * 0.125f;
    }
    __syncthreads();
    if (w < 4) {
        const float sk = sinks ? sinks[kvh * 4 + w] : -INFINITY;
        const float v0 = sc[w * 132 + lane], v1 = sc[w * 132 + 64 + lane], v2 = lane == 0 ? sc[w * 132 + 128] : -INFINITY;
        float mx = wave_max(fmaxf(fmaxf(v0, v1), v2)); mx = fmaxf(mx, sk);
        const float p0 = __expf(v0 - mx), p1 = __expf(v1 - mx), p2 = lane == 0 ? __expf(v2 - mx) : 0.f;
        const float sum = wave_sum(p0 + p1 + p2) + __expf(sk - mx);
        sc[w * 132 + lane] = p0; sc[w * 132 + 64 + lane] = p1; if (lane == 0) { sc[w * 132 + 128] = p2; rd[w] = sum; rd[4 + w] = mx; }
    }
    __syncthreads();
    if (tid < 256) {
        const int g = tid >> 6, d = tid & 63; float o = 0.f;
#pragma unroll 4
        for (int j = 0; j < 128; j += 4) { const f32x4 p4 = *(const LAS f32x4*)(sc + g * 132 + j);
            o += p4[0] * Vc[j * 64 + d]; o += p4[1] * Vc[(j + 1) * 64 + d]; o += p4[2] * Vc[(j + 2) * 64 + d]; o += p4[3] * Vc[(j + 3) * 64 + d]; }
        o += sc[g * 132 + 128] * Vc[128 * 64 + d];
        const float den = rd[g]; o_out = o * __builtin_amdgcn_rcpf(den); lse_out = rd[4 + g] + __logf(den);
    }
    __syncthreads();
}
__device__ __forceinline__ void sample_attn_even(Frame& F, int e, int s, int kvh) {
    const f16* zrow = WSP(f16, WS_Z) + (size_t)(MP + s) * NEV;
    float o = 0.f, lse = 0.f;
    dec_attn(F, FIN(I_CA) + ((size_t)e * NS + s) * 128 * 256, 1, kvh, zrow, 0, 512, 640, FIN(I_ESK) + e * 8, o, lse);
    if (F.tid < 256) WSP(f16, WS_O)[(size_t)(MP + s) * D + kvh * 256 + F.tid] = (f16)o;
    if (F.tid < 128) { const int isv = F.tid >> 6, d = F.tid & 63;
        F.out[O_AKVS + (((size_t)e * NS + s) * 128 + 127) * 256 + isv * 128 + kvh * 64 + d] = (float)zrow[(isv ? 640 : 512) + kvh * 64 + d]; }
}
__device__ __forceinline__ void sample_attn_odd(Frame& F, int oi, int s, int kvh) {
    const f16* zrow = WSP(f16, WS_Z) + (size_t)(MP + s) * NOD;
    float o[3] = {0.f, 0.f, 0.f}, lse[3] = {0.f, 0.f, 0.f};
    dec_attn(F, FIN(I_CC1) + ((size_t)oi * NS + s) * 128 * 256, 1, kvh, zrow, 0, 512, 640, nullptr, o[0], lse[0]);
    dec_attn(F, FIN(I_CC2) + ((size_t)oi * NS + s) * 512 * 256, 4, kvh, zrow, 768, 1280, 1408, nullptr, o[1], lse[1]);
    dec_attn(F, FIN(I_CC3) + ((size_t)oi * NS + s) * 2048 * 256, 16, kvh, zrow, 1536, 2048, 2176, nullptr, o[2], lse[2]);
    if (F.tid < 256) {
        const float mx = fmaxf(fmaxf(lse[0], lse[1]), lse[2]);
        const float w0 = __expf(lse[0] - mx), w1 = __expf(lse[1] - mx), w2 = __expf(lse[2] - mx);
        WSP(f16, WS_O)[(size_t)(MP + s) * 512 + kvh * 256 + F.tid] = (f16)((w0 * o[0] + w1 * o[1] + w2 * o[2]) / (w0 + w1 + w2));
    }
    if (F.tid < 384) { const int g = F.tid >> 7, r = F.tid & 127, isv = r >> 6, d = r & 63;
        const int W = g == 0 ? 128 : (g == 1 ? 512 : 2048); const size_t ob = g == 0 ? O_C1S : (g == 1 ? O_C2S : O_C3S);
        F.out[ob + (((size_t)oi * NS + s) * W + (W - 1)) * 256 + isv * 128 + kvh * 64 + d] = (float)zrow[768 * g + (isv ? 640 : 512) + kvh * 64 + d]; }
}
__device__ __forceinline__ void sample_mlstm(Frame& F, int e, int s) {
    const int h = F.wave, lane = F.lane, m = MP + s;
    const f16* zrow = WSP(f16, WS_Z) + (size_t)m * NEV; const float* gr = WSP(float, WS_GATES) + (size_t)m * 16; const float* bg = FIN(I_EBG) + e * 16;
    const float q = (float)zrow[768 + h * 64 + lane], k = (float)zrow[1280 + h * 64 + lane], v = (float)zrow[1792 + h * 64 + lane], bo = (float)zrow[2304 + h * 64 + lane];
    const float ig = gr[h] + bg[h], lf = logsigmoidf_(gr[8 + h] + bg[8 + h]);
    const size_t sh = ((size_t)e * NS + s) * 8 + h;
    const float mst = FIN(I_SBM)[sh], nst = FIN(I_SBN)[sh * 64 + lane];
    const float mt = fmaxf(lf + mst, ig), dsc = __expf(ig - mt), inter = __expf(lf + mst - mt);
    const float qk = wave_sum(q * k), qn_i = wave_sum(q * nst);
    const float* C = FIN(I_SBC) + sh * 4096; float* Co = F.out + O_BCS + sh * 4096;
    float qc = 0.f;
    float cvv[64];
#pragma unroll
    for (int dk = 0; dk < 64; ++dk) cvv[dk] = __builtin_nontemporal_load(C + dk * 64 + lane);
#pragma unroll
    for (int dk = 0; dk < 64; ++dk) {
        const float cv = cvv[dk], qd = __shfl(q, dk), kd = __shfl(k, dk);
        qc += qd * cv; Co[dk * 64 + lane] = inter * cv + dsc * kd * v;
    }
    const float wgt = qk * dsc, num = wgt * v + inter * qc, qn = wgt + inter * qn_i;
    const float hv = num / fmaxf(fabsf(qn), __expf(-mt));
    const float rinv = rsqrtf(wave_sum(hv * hv) * (1.0f / 64.0f) + EPS);
    WSP(f16, WS_O)[(size_t)m * D + 512 + h * 64 + lane] = (f16)(hv * rinv * FIN(I_EHG)[(e * 8 + h) * 64 + lane] * sigmoidf_(bo));
    F.out[O_BNS + sh * 64 + lane] = inter * nst + dsc * k;
    if (lane == 0) F.out[O_BMS + sh] = mt;
}

__device__ __forceinline__ void phase_e1(Frame& F, int e, int tmask) {
    BandAttn P{WSP(f16, WS_Z), NEV, 0, 512, 640, WSP(f16, WS_O), D, 0, nullptr, FIN(I_ESK) + e * 8, 1};
    for (int u = F.bid; u < 1152; u += F.G) {
        if (u < 256) { if (!(tmask & 1)) continue; const int kvh = u & 1, blk = (u >> 1) & 63, b = u >> 7;
            band_attn_unit(F.lds, P, b * T, 1, blk, kvh);
            if (blk == 63 && kvh == 0) kv_export(P.Z, NEV, 512, 640, b * T + T - 128, 128, F.out + O_AKVP + (size_t)(e * 2 + b) * 128 * 256, F.tid, 512);
        } else if (u < 768) { if (!(tmask & 2)) continue; const int v = u - 256; mlstm_x1_unit(F, e, v >> 8, (v >> 2) & 63, v & 3); }
        else if (u < 1024) { if (!(tmask & 4)) continue; const int v = u - 768; sample_attn_even(F, e, v >> 1, v & 1); }
        else { if (!(tmask & 8)) continue; sample_mlstm(F, e, u - 1024); }
    }
}
__device__ __forceinline__ void phase_e3(Frame& F, int e) {
    for (int u = F.bid; u < 512; u += F.G) mlstm_x3_unit(F, e, u >> 8, (u >> 2) & 63, u & 3);
}
__device__ __forceinline__ void phase_o1(Frame& F, int oi, int tmask) {
    const f16* Z = WSP(f16, WS_Z);
    for (int u = F.bid; u < 768 + 256 + 42; u += F.G) {
        if (u < 768) {
            if (!(tmask & 1)) continue;
            const int g = u >> 8, v = u & 255, kvh = v & 1, r = v >> 1;
            const int dil = g == 0 ? 1 : (g == 1 ? 4 : 16), nblk = 64 / dil;
            const int b = r >> 6, rr = r & 63, res = rr / nblk, blk = rr % nblk;
            BandAttn P{Z, NOD, 768 * g, 768 * g + 512, 768 * g + 640, WSP(f16, WS_OG) + (size_t)g * MP * 512, 512, 0, WSP(float, WS_LSE) + (size_t)g * MP * 8, nullptr, 0};
            band_attn_unit(F.lds, P, b * T + res, dil, blk, kvh);
        } else if (u < 1024) { if (!(tmask & 4)) continue; const int v = u - 768; sample_attn_odd(F, oi, v >> 1, v & 1); }
        else {
            if (!(tmask & 16)) continue;
            const int v = u - 1024; int g, q; if (v < 2) { g = 0; q = v; } else if (v < 10) { g = 1; q = v - 2; } else { g = 2; q = v - 10; }
            const int W = 128 << (2 * g), per = W / 128, b = q / per, part = q % per;
            const size_t ob = g == 0 ? O_C1P : (g == 1 ? O_C2P : O_C3P);
            kv_export(Z, NOD, 768 * g + 512, 768 * g + 640, b * T + T - W + part * 128, 128, F.out + ob + ((size_t)(oi * 2 + b) * W + part * 128) * 256, F.tid, 512);
        }
    }
}
__device__ __forceinline__ void phase_o2(Frame& F) {
    const f16* OG = WSP(f16, WS_OG); const float* LSE = WSP(float, WS_LSE); f16* O = WSP(f16, WS_O);
    for (int i0 = F.bid; i0 < MP / 8; i0 += 2 * F.G) {
        size_t m[2]; bool ok[2]; float l0[2], l1[2], l2[2]; f16x8 a[2], b[2], c[2];
        const int c8 = F.tid & 63, hd = c8 >> 3;
#pragma unroll
        for (int j = 0; j < 2; ++j) { const int ib = i0 + j * F.G; ok[j] = ib < MP / 8; const int ic = ok[j] ? ib : i0;
            m[j] = (size_t)((ic & 7) * (MP / 64) + (ic >> 3)) * 8 + (F.tid >> 6);
            l0[j] = LSE[m[j] * 8 + hd]; l1[j] = LSE[(size_t)MP * 8 + m[j] * 8 + hd]; l2[j] = LSE[(size_t)2 * MP * 8 + m[j] * 8 + hd];
            a[j] = *(const f16x8*)(OG + m[j] * 512 + c8 * 8); b[j] = *(const f16x8*)(OG + (size_t)MP * 512 + m[j] * 512 + c8 * 8); c[j] = *(const f16x8*)(OG + (size_t)2 * MP * 512 + m[j] * 512 + c8 * 8); }
#pragma unroll
        for (int j = 0; j < 2; ++j) {
            const float mx = fmaxf(fmaxf(l0[j], l1[j]), l2[j]); float w0 = __expf(l0[j] - mx), w1 = __expf(l1[j] - mx), w2 = __expf(l2[j] - mx); const float inv = 1.0f / (w0 + w1 + w2);
            w0 *= inv; w1 *= inv; w2 *= inv;
            f16x8 o;
#pragma unroll
            for (int q = 0; q < 8; ++q) o[q] = (f16)(w0 * (float)a[j][q] + w1 * (float)b[j][q] + w2 * (float)c[j][q]);
            if (ok[j]) *tiled_ptr<f16x8>(O, (int)m[j], c8 * 8, 512) = o;
        }
    }
}
__device__ __forceinline__ void phase_final(Frame& F) {
    const f16* X = WSP(f16, WS_X); const float* rss = (const float*)(F.ws + RSS_OFF) + (size_t)12 * MALL; const float* fg = FIN(I_FG);
    f32x4 g[4];
#pragma unroll
    for (int q = 0; q < 4; ++q) g[q] = *(const f32x4*)(fg + q * 256 + F.lane * 4);
    for (int m0 = F.bid * 8 + F.wave; m0 < MALL; m0 += F.G * 32) {
        f16x4 xh[4][4]; float rs[4];
#pragma unroll
        for (int j = 0; j < 4; ++j) { const int m = m0 + j * F.G * 8 < MALL ? m0 + j * F.G * 8 : m0; rs[j] = rss[m];
#pragma unroll
            for (int q = 0; q < 4; ++q) xh[j][q] = *(const f16x4*)(X + (size_t)m * D + q * 256 + F.lane * 4); }
#pragma unroll
        for (int j = 0; j < 4; ++j) { const int m = m0 + j * F.G * 8; if (m < MALL) { const float r = rsqrtf(rs[j] * (1.0f / D) + EPS);
#pragma unroll
            for (int q = 0; q < 4; ++q) { const f32x4 x = {(float)xh[j][q][0], (float)xh[j][q][1], (float)xh[j][q][2], (float)xh[j][q][3]};
                __builtin_nontemporal_store(x * r * g[q], (f32x4*)(F.out + O_Y + (size_t)m * D + q * 256 + F.lane * 4)); } } }
    }
}

struct Args;
__device__ __forceinline__ bool phase_enter(Frame& F, const Args& args);
#define REP(bit) _Pragma("unroll 1") for (int rep_ = 0; rep_ < ((PROBE_DUP & (bit)) ? 2 : 1); ++rep_)
#ifndef P_MASK
#define P_MASK 0
#endif
constexpr bool P_SK = !(P_MASK & 1), P_MIX = !(P_MASK & 2), P_Z = !(P_MASK & 4), P_RES = !(P_MASK & 8), P_SW = !(P_MASK & 16), P_PR = !(P_MASK & 32), P_E1 = !(P_MASK & 64), P_E3 = !(P_MASK & 128), P_O1 = !(P_MASK & 256);
struct Args { const float* in[N_IN]; float* out; unsigned char* ws; int ph_lo, ph_hi; };
constexpr int PH_LAYER0 = 4, PH_PER_LAYER = 9, PH_FINAL = PH_LAYER0 + 4 * PH_PER_LAYER, N_PHASES = PH_FINAL + 1;

__device__ __forceinline__ bool phase_enter(Frame& F, const Args& args) {
    F.tid = opaque_v(threadIdx.x); F.lane = F.tid & 63; F.wave = __builtin_amdgcn_readfirstlane(F.tid >> 6);
    F.out = opaque_p(args.out); F.ws = opaque_p(args.ws);
    return true;
}
__global__ void __launch_bounds__(512, 2) fwd_kernel(Args args) {
    extern __shared__ __attribute__((aligned(16))) unsigned char lds_raw[];
    Frame F;
    F.lds = (ldsp_t)lds_raw; F.tid = threadIdx.x; F.lane = F.tid & 63; F.wave = __builtin_amdgcn_readfirstlane(F.tid >> 6); F.G = gridDim.x; F.bid = blockIdx.x;
    F.out = args.out; F.ws = args.ws;
    volatile LAS unsigned* MISC = (volatile LAS unsigned*)(F.lds + MISC_OFF);
    if (F.tid < 32) MISC[F.tid] = 0u;
    __syncthreads();
    XcdBarrier bar = xcd_barrier_post((unsigned*)(F.ws + WS_CTL) + CW_BAR, MISC + 8);
    const int lo = args.ph_lo, hi = args.ph_hi;
    const CopyQ CQ{args.in[I_CC3], args.in[I_CC2], args.in[I_CA], args.in[I_CC1], args.out, (unsigned*)(args.ws + WS_CTL) + CW_Q};
#define IN(k) (lo <= (k) && (k) < hi && phase_enter(F, args))
#define SEAM(k) do { if (IN((k) + 1)) { xcd_barrier(bar, CQ); if constexpr ((PROBE_DUP & 64) != 0) xcd_barrier(bar, CQ); } } while (0)
#define LSEAM(k) do { if (IN((k) + 1)) { if (fastp) xcc_barrier(bar, CQ); else xcd_barrier(bar, CQ); } } while (0)
    unsigned fastp = 0u;
    float* rowss = (float*)(F.ws + RSS_OFF);

    _Pragma("unroll 1") for (int prep_ = 0; prep_ < ((PROBE_DUP & 32) ? 2 : 1); ++prep_) {
    if (IN(0)) { REP(1) { if constexpr (P_PR) phase_pr0(F, 24, 28, true, nullptr); } SEAM(0);
        if (MK_N_LAUNCHES == 1 && hi == N_PHASES && MISC[8 + 10] != 0u) { fastp = 1u; F.bid = (int)(MISC[8 + 12] * 8u + bar.x); } }
    if (IN(1)) {
        pg8::Gemm g{WSP(f16, WS_AC), WSP(f16, WS_WMOD), 256, 4 * NMODC, D}; pg8::StaticOrder S; S.init(256, 4 * NMODC, F.G, F.bid);
        EpiMod E{WSP(float, WS_CS), WSP(float, WS_GT), WSP(f16, WS_SHA), FIN(I_BMOD), FIN(I_NG), WSP(float, WS_RCS)};
        if constexpr (P_PR) pg8::gemm_phase<EpiMod, pg8::StaticOrder>(F.lds, g, S, E);
        if constexpr (P_PR) { phase_enter(F, args); phase_pr0(F, 0, 24, false, (unsigned*)(F.ws + WS_CTL) + CW_Q + 128); }
        SEAM(1);
    }
    if (IN(3)) {
        pg8::Gemm g{WSP(f16, WS_SHA), WSP(f16, WS_WIN), 256 * NSITE, NWIN, D}; pg8::DiagOrder S{F.G, F.bid};
        EpiBias E{WSP(float, WS_BW)};
        if constexpr (P_PR) pg8::gemm_phase<EpiBias, pg8::DiagOrder>(F.lds, g, S, E);
        if constexpr (P_PR) { phase_enter(F, args); phase_pr2(F); }
        SEAM(3);
    }
    }
    for (int l = 0; l < 4; ++l) {
        const int pb = PH_LAYER0 + PH_PER_LAYER * l, s0 = 3 * l; const bool even = (l & 1) == 0; const int ei = l >> 1;
#pragma unroll 1
        for (int ffn = 0; ffn < 2; ++ffn) {
            if (ffn == 1) {
                if (IN(pb + 2)) {
                    const int so = site_off(s0 + 1), N = even ? NEV : NOD;
                    pg8::Gemm g{WSP(f16, WS_A), WSP(f16, WS_WIN) + (size_t)so * D, MP, N, D}; pg8::StaticOrder S; S.init(MP, N, F.G, F.bid);
                    if (even) { EpiZ<true> E{rowss + (size_t)(s0 + 1) * MALL, WSP(float, WS_BW) + so, WSP(f16, WS_Z), WSP(float, WS_GATES)};
                        if constexpr (P_Z) pg8::gemm_phase<EpiZ<true>, pg8::StaticOrder>(F.lds, g, S, E);
                        if constexpr ((PROBE_DUP & 128) != 0) { phase_enter(F, args); pg8::gemm_phase<EpiZ<true>, pg8::StaticOrder>(F.lds, g, S, E); }
                        if constexpr (P_SK) skinny_phase<false, D>(F.lds, g.A + (size_t)MP * D, g.Bt, N, E, F.G, F.bid, S.nwg); }
                    else { EpiZ<false> E{rowss + (size_t)(s0 + 1) * MALL, WSP(float, WS_BW) + so, WSP(f16, WS_Z), WSP(float, WS_GATES)};
                        if constexpr (P_Z) pg8::gemm_phase<EpiZ<false>, pg8::StaticOrder>(F.lds, g, S, E);
                        if constexpr ((PROBE_DUP & 128) != 0) { phase_enter(F, args); pg8::gemm_phase<EpiZ<false>, pg8::StaticOrder>(F.lds, g, S, E); }
                        if constexpr (P_SK) skinny_phase<false, D>(F.lds, g.A + (size_t)MP * D, g.Bt, N, E, F.G, F.bid, S.nwg); }
                    SEAM(pb + 2);
                }
                if (IN(pb + 3)) { REP(2) if constexpr (P_MIX) { const int tm = rep_ ? PROBE_TMASK : 31; if (even) { if constexpr (P_E1) phase_e1(F, ei, tm); } else { if constexpr (P_O1) phase_o1(F, ei, tm); } } SEAM(pb + 3); }
                if (IN(pb + 4)) { REP(4096) if constexpr (P_MIX) { if (even) mlstm_scan(F, ei); else phase_o2(F); } if (even) SEAM(pb + 4); else LSEAM(pb + 4); }
                if (even && IN(pb + 5)) { REP(8192) if constexpr (P_MIX && P_E3) { phase_e3(F, ei); } SEAM(pb + 5); }
                if (IN(pb + 6)) {
                    const int K = even ? D : 512; const f16* Bt = even ? WSP(f16, WS_WEO) + (size_t)ei * D * D : WSP(f16, WS_WOO) + (size_t)ei * D * 512;
                    pg8::Gemm g{WSP(f16, WS_O), Bt, MP, D, K}; pg8::StaticOrder S; S.init(MP, D, F.G, F.bid);
                    EpiRes E{WSP(f16, WS_X), WSP(f16, WS_A), rowss + (size_t)(s0 + 2) * MALL, WSP(float, WS_GT) + (size_t)(s0 + 1) * NBAT * D, WSP(float, WS_CS) + (size_t)(s0 + 2) * NBAT * D, WSP(float, WS_RCS) + (size_t)(s0 + 1) * NBAT * D};
                    if constexpr ((PROBE_DUP & 256) != 0) { EpiRes E2{(f16*)(F.ws + WS_END), (f16*)(F.ws + WS_END + (size_t)MALL * D * 4), (float*)(F.ws + WS_END + (size_t)MALL * D * 6), E.GT, E.CS, E.RCS};
                        pg8::gemm_phase<EpiRes, pg8::StaticOrder>(F.lds, g, S, E2); phase_enter(F, args); }
                    if constexpr (P_RES) pg8::gemm_phase<EpiRes, pg8::StaticOrder>(F.lds, g, S, E);
                    if constexpr (P_SK) { if (even) skinny_phase<false, D>(F.lds, g.A + (size_t)MP * D, g.Bt, D, E, F.G, F.bid, S.nwg); else skinny_phase<false, 512>(F.lds, g.A + (size_t)MP * 512, g.Bt, D, E, F.G, F.bid, S.nwg); }
                    LSEAM(pb + 6);
                }
            }
            const int sf = s0 + 2 * ffn, pin = pb + (ffn ? 7 : 0);
            if (IN(pin)) {
                const int so = site_off(sf);
                pg8::Gemm g{WSP(f16, WS_A), WSP(f16, WS_WIN) + (size_t)so * D, MP, FF2, D}; pg8::StaticOrder S; S.init(MP, FF2, F.G, F.bid);
                EpiSwiglu E{rowss + (size_t)sf * MALL, WSP(float, WS_BW) + so, WSP(f16, WS_H)};
                if constexpr (P_SW) pg8::gemm_phase<EpiSwiglu, pg8::StaticOrder>(F.lds, g, S, E);
                if constexpr ((PROBE_DUP & 4) != 0) { phase_enter(F, args); pg8::gemm_phase<EpiSwiglu, pg8::StaticOrder>(F.lds, g, S, E); }
                REP(8) { if constexpr (P_SK) skinny_phase<true, D>(F.lds, g.A + (size_t)MP * D, g.Bt, FF2, E, F.G, F.bid, S.nwg); }
                LSEAM(pin);
            }
            if (IN(pin + 1)) {
                pg8::Gemm g{WSP(f16, WS_H), WSP(f16, WS_WFO) + (size_t)(2 * l + ffn) * D * FF, MP, D, FF}; pg8::StaticOrder S; S.init(MP, D, F.G, F.bid);
                EpiRes E{WSP(f16, WS_X), WSP(f16, WS_A), rowss + (size_t)(sf + 1) * MALL, WSP(float, WS_GT) + (size_t)sf * NBAT * D, (sf + 1 < NSITE) ? WSP(float, WS_CS) + (size_t)(sf + 1) * NBAT * D : nullptr, WSP(float, WS_RCS) + (size_t)sf * NBAT * D};
                if constexpr ((PROBE_DUP & 16) != 0) { EpiRes E2{(f16*)(F.ws + WS_END), (f16*)(F.ws + WS_END + (size_t)MALL * D * 4), (float*)(F.ws + WS_END + (size_t)MALL * D * 6), E.GT, E.CS, E.RCS};
                    pg8::gemm_phase<EpiRes, pg8::StaticOrder>(F.lds, g, S, E2); phase_enter(F, args); }
                if constexpr (P_RES) pg8::gemm_phase<EpiRes, pg8::StaticOrder>(F.lds, g, S, E);
                if constexpr (P_SK) skinny_phase<false, FF>(F.lds, g.A + (size_t)MP * FF, g.Bt, D, E, F.G, F.bid, S.nwg);
                if (pin + 1 == PH_FINAL - 1) SEAM(pin + 1); else LSEAM(pin + 1);
            }
        }
    }
    if (IN(PH_FINAL)) {
        phase_final(F);
        if constexpr ((PROBE_DUP & 512) != 0) { phase_enter(F, args); phase_final(F); }
        for (;;) {
            __syncthreads();
            if (F.tid == 0) MISC[24] = xb_add(CQ.head, 1u);
            __syncthreads();
            const unsigned ch = MISC[24];
            if (ch >= (unsigned)CQ_N) break;
            copy_chunk(CQ, (int)ch, F.tid);
        }
        if constexpr ((PROBE_DUP & 1024) != 0) {
            CopyQ CQ2 = CQ; CQ2.head = CQ.head + 64;
            for (;;) {
                __syncthreads();
                if (F.tid == 0) MISC[24] = xb_add(CQ2.head, 1u);
                __syncthreads();
                const unsigned ch = MISC[24];
                if (ch >= (unsigned)CQ_N) break;
                copy_chunk(CQ2, (int)ch, F.tid);
            }
        }
    }
#undef IN
#undef SEAM
}

extern "C" void kernel_launch(void* const* d_in, const int* in_sizes, int n_in, void* d_out, int out_size, void* d_ws, size_t ws_size, hipStream_t stream) {
    static int grid = 0;
    if (grid == 0) {
        if (n_in != N_IN || (size_t)out_size != O_END || ws_size < WS_END) { fprintf(stderr, "kernel_launch: unexpected shapes n_in %d out %d ws %zu (need %zu / %zu)\n", n_in, out_size, ws_size, (size_t)O_END, (size_t)WS_END); grid = -1; return; }
        int dev = 0, cus = 0, per_cu = 0;
        if (hipGetDevice(&dev) != hipSuccess || hipDeviceGetAttribute(&cus, hipDeviceAttributeMultiprocessorCount, dev) != hipSuccess) { grid = -1; return; }
        if (hipFuncSetAttribute((const void*)fwd_kernel, hipFuncAttributeMaxDynamicSharedMemorySize, LDS_BYTES) != hipSuccess) { fprintf(stderr, "kernel_launch: hipFuncSetAttribute failed\n"); grid = -1; return; }
        if (hipOccupancyMaxActiveBlocksPerMultiprocessor(&per_cu, (const void*)fwd_kernel, 512, LDS_BYTES) != hipSuccess || per_cu < 1) { fprintf(stderr, "kernel_launch: occupancy query says %d\n", per_cu); }
        (void)hipGetLastError();
        grid = cus;
    }
    if (grid < 0) return;
    (void)hipMemsetAsync((char*)d_ws + WS_CTL, 0, CTL_ZERO_BYTES, stream);
    Args a{};
    for (int i = 0; i < N_IN; ++i) a.in[i] = (const float*)d_in[i];
    a.out = (float*)d_out; a.ws = (unsigned char*)d_ws;
#if MK_N_LAUNCHES == 1
    a.ph_lo = 0; a.ph_hi = N_PHASES;
    hipLaunchKernelGGL(fwd_kernel, dim3(grid), dim3(512), LDS_BYTES, stream, a);
#else
    for (int p = 0; p < N_PHASES; ++p) { a.ph_lo = p; a.ph_hi = p + 1; hipLaunchKernelGGL(fwd_kernel, dim3(grid), dim3(512), LDS_BYTES, stream, a); }
#endif
}
```

```cpp
#include <hip/hip_runtime.h>
#include <cstdio>
#include <cstdint>

#ifndef PROBE_DUP
#define PROBE_DUP 0
#endif
#ifndef PROBE_TMASK
#define PROBE_TMASK 19
#endif
#ifndef MK_N_LAUNCHES
#define MK_N_LAUNCHES 1
#endif

#define GAS __attribute__((address_space(1)))
#define LAS __attribute__((address_space(3)))
typedef _Float16 f16;
typedef _Float16 f16x8 __attribute__((ext_vector_type(8)));
typedef _Float16 f16x4 __attribute__((ext_vector_type(4)));
typedef float f32x4 __attribute__((ext_vector_type(4)));
typedef float f32x16 __attribute__((ext_vector_type(16)));
typedef unsigned u32x4 __attribute__((ext_vector_type(4)));
typedef unsigned u32x2 __attribute__((ext_vector_type(2)));
typedef LAS unsigned char* ldsp_t;

constexpr int D = 1024, T = 8192, NB = 2, MP = NB * T, NS = 128, MALL = MP + NS, NBAT = NB + NS;
constexpr int FF = 2816, FF2 = 5632, NEV = 3072, NEVR = 2832, NOD = 2304, NMODC = 9216;
constexpr int NSITE = 12;
constexpr float EPS = 1e-6f;
__host__ __device__ __forceinline__ constexpr int site_N(int s) { return (s % 3 != 1) ? FF2 : (((s / 3) % 2 == 0) ? NEV : NOD); }
__host__ __device__ __forceinline__ constexpr int site_off(int s) { const int r = s % 6; return (s / 6) * 27904 + (r == 0 ? 0 : r == 1 ? 5632 : r == 2 ? 8704 : r == 3 ? 14336 : r == 4 ? 19968 : 22272); }
static_assert(site_off(1) == 5632 && site_off(2) == 8704 && site_off(3) == 14336 && site_off(4) == 19968 && site_off(5) == 22272 && site_off(6) == 27904 && site_off(7) == 27904 + 5632, "site_off");
constexpr int NWIN = site_off(NSITE);
static_assert(NWIN == 55808, "win rows");

constexpr size_t alignup(size_t x) { return (x + 4095) & ~(size_t)4095; }
constexpr size_t WS_CTL = 0, CTL_ZERO_BYTES = 1u << 20;
constexpr int CW_BAR = 1024;
constexpr size_t RSS_OFF = 65536;
static_assert(RSS_OFF + (size_t)13 * MALL * 4 <= CTL_ZERO_BYTES, "ctl");
constexpr size_t WS_WIN = alignup(CTL_ZERO_BYTES);
constexpr size_t WS_WFO = alignup(WS_WIN + (size_t)NWIN * D * 2);
constexpr size_t WS_WEO = alignup(WS_WFO + (size_t)8 * D * FF * 2);
constexpr size_t WS_WOO = alignup(WS_WEO + (size_t)2 * D * D * 2);
constexpr size_t WS_WMOD = alignup(WS_WOO + (size_t)2 * D * 512 * 2);
constexpr size_t WS_AC = alignup(WS_WMOD + (size_t)4 * NMODC * D * 2);
constexpr size_t WS_MOD = alignup(WS_AC + (size_t)256 * D * 2);
constexpr size_t WS_CS = alignup(WS_MOD + (size_t)NBAT * 4 * NMODC * 4);
constexpr size_t WS_GT = alignup(WS_CS + (size_t)NSITE * NBAT * D * 4);
constexpr size_t WS_RCS = alignup(WS_GT + (size_t)NSITE * NBAT * D * 4);
constexpr size_t WS_SHA = alignup(WS_RCS + (size_t)NSITE * NBAT * D * 4);
constexpr size_t WS_BW = alignup(WS_SHA + (size_t)NSITE * 256 * D * 2);
constexpr size_t WS_X = alignup(WS_BW + (size_t)NBAT * NWIN * 4);
constexpr size_t WS_A = alignup(WS_X + (size_t)MALL * D * 4);
constexpr size_t WS_H = alignup(WS_A + (size_t)MALL * D * 2);
constexpr size_t WS_Z = alignup(WS_H + (size_t)MALL * FF * 2);
constexpr size_t WS_GATES = alignup(WS_Z + (size_t)MALL * NEV * 2);
constexpr size_t WS_O = alignup(WS_GATES + (size_t)MALL * 16 * 4);
constexpr size_t WS_OG = alignup(WS_O + (size_t)MALL * D * 2);
constexpr size_t WS_LSE = alignup(WS_OG + (size_t)3 * MP * 512 * 2);
constexpr size_t WS_DC = alignup(WS_LSE + (size_t)3 * MP * 8 * 4);
constexpr size_t WS_DN = alignup(WS_DC + (size_t)16 * 64 * 4096 * 4);
constexpr size_t WS_CP = alignup(WS_DN + (size_t)16 * 64 * 64 * 4);
constexpr size_t WS_NP = alignup(WS_CP + (size_t)16 * 64 * 4096 * 2);
constexpr size_t WS_SC = alignup(WS_NP + (size_t)16 * 64 * 64 * 4);
constexpr size_t WS_END = alignup(WS_SC + (size_t)3 * 16 * 64 * 4);

constexpr size_t O_Y = 0;
constexpr size_t O_AKVP = O_Y + (size_t)MALL * D;
constexpr size_t O_AKVS = O_AKVP + (size_t)2 * 2 * 128 * 256;
constexpr size_t O_BCP = O_AKVS + (size_t)2 * 128 * 128 * 256;
constexpr size_t O_BCS = O_BCP + (size_t)2 * 2 * 8 * 4096;
constexpr size_t O_BNP = O_BCS + (size_t)2 * 128 * 8 * 4096;
constexpr size_t O_BNS = O_BNP + (size_t)2 * 2 * 8 * 64;
constexpr size_t O_BMP = O_BNS + (size_t)2 * 128 * 8 * 64;
constexpr size_t O_BMS = O_BMP + (size_t)2 * 2 * 8;
constexpr size_t O_C1P = O_BMS + (size_t)2 * 128 * 8;
constexpr size_t O_C1S = O_C1P + (size_t)2 * 2 * 128 * 256;
constexpr size_t O_C2P = O_C1S + (size_t)2 * 128 * 128 * 256;
constexpr size_t O_C2S = O_C2P + (size_t)2 * 2 * 512 * 256;
constexpr size_t O_C3P = O_C2S + (size_t)2 * 128 * 512 * 256;
constexpr size_t O_C3S = O_C3P + (size_t)2 * 2 * 2048 * 256;
constexpr size_t O_END = O_C3S + (size_t)2 * 128 * 2048 * 256;

enum { I_XP = 0, I_XS, I_CA, I_SBC, I_SBN, I_SBM, I_CC1, I_CC2, I_CC3, I_CP, I_CSMP, I_WMOD, I_BMOD, I_NG, I_FWI, I_FWO, I_EWI, I_EBG, I_ESK, I_EHG, I_EWO, I_OWI, I_OWO, I_FG, N_IN };

constexpr int RING_BYTES = 131072;
constexpr int MISC_OFF = RING_BYTES + 320;
constexpr int PF_OFF = 139264;
constexpr int EPI_OFF = 133120, EPI_STRIDE = 4096;
constexpr int LDS_BYTES = 147456;

#define RLX_AGENT __ATOMIC_RELAXED, __HIP_MEMORY_SCOPE_AGENT
#define LDS_WAIT() asm volatile("s_waitcnt lgkmcnt(0)" ::: "memory")
#define VM_WAIT() asm volatile("s_waitcnt vmcnt(0)" ::: "memory")

#define XB_TMO      128
#define XB_XCNT(j)  (256  + 64 * (j))
#define XB_XSUB(j)  (1280 + 64 * (j))
#define XB_XGEN(j)  (2304 + 64 * (j))
#define XB_TOP      3328
#define XB_TOPGEN   3392
#define XB_LSUB(j)  (3456 + 64 * (j))
#define XCD_BAR_WORDS 4480
#define XB_SPIN_CAP (1u << 21)
__device__ __forceinline__ unsigned xb_ld(unsigned* p)              { return __hip_atomic_load(p, __ATOMIC_RELAXED, __HIP_MEMORY_SCOPE_AGENT); }
__device__ __forceinline__ unsigned xb_add(unsigned* p, unsigned v) { return __hip_atomic_fetch_add(p, v, __ATOMIC_RELAXED, __HIP_MEMORY_SCOPE_AGENT); }
__device__ __forceinline__ unsigned xb_xcc_id() { return (unsigned)__builtin_amdgcn_s_getreg((3 << 11) | 20) & 0xFu; }
#define XB_SPIN(cond, bar) do { unsigned _sp = 0; while (cond) { __builtin_amdgcn_s_sleep(1); \
    if ((++_sp & 255u) == 0u) { if (xb_ld(&(bar)[XB_TMO])) break; if (_sp > XB_SPIN_CAP) { atomicAdd(&(bar)[XB_TMO], 1u); break; } } } } while (0)
struct XcdBarrier { unsigned* bar; unsigned x; volatile LAS unsigned* st; };
__device__ __forceinline__ XcdBarrier xcd_barrier_post(unsigned* bar, volatile LAS unsigned* st) {
    XcdBarrier b; b.bar = bar; b.x = xb_xcc_id(); b.st = st;
    if (threadIdx.x == 0) st[12] = xb_add(&bar[XB_XCNT(b.x)], 1u);
    return b;
}
__device__ __forceinline__ void xcd_barrier_complete(unsigned* bar, unsigned x, unsigned& nloc, unsigned& nx) {
    const unsigned G = gridDim.x * gridDim.y * gridDim.z;
    unsigned sum, cnt, mine, sp = 0u;
    for (;;) {
        sum = 0u; cnt = 0u; mine = 0u;
#pragma unroll
        for (unsigned j = 0; j < 16; ++j) { const unsigned c = xb_ld(&bar[XB_XCNT(j)]); sum += c; cnt += (c > 0u) ? 1u : 0u; mine = (j == x) ? c : mine; }
        if (sum == G) break;
        __builtin_amdgcn_s_sleep(1);
        if ((++sp & 255u) == 0u) { if (xb_ld(&bar[XB_TMO])) break; if (sp > XB_SPIN_CAP) { atomicAdd(&bar[XB_TMO], 1u); break; } }
    }
    nloc = mine > 0u ? mine : 1u; nx = cnt > 0u ? cnt : 1u;
}
__device__ __forceinline__ unsigned xcd_census_even(unsigned* bar) {
    const unsigned G = gridDim.x; if (G % 8u) return 0u;
    unsigned ok = 1u;
#pragma unroll
    for (unsigned j = 0; j < 16; ++j) { const unsigned c = xb_ld(&bar[XB_XCNT(j)]); ok &= (c == (j < 8u ? G / 8u : 0u)) ? 1u : 0u; }
    return ok;
}
constexpr int CQ_CH = 4096;
constexpr int CQ_N3 = 2047 * 16384 / CQ_CH, CQ_N2 = 511 * 16384 / CQ_CH, CQ_NA = 127 * 16384 / CQ_CH, CQ_N = CQ_N3 + CQ_N2 + 2 * CQ_NA;
constexpr int CW_Q = 512;
struct CopyQ { const float* c3; const float* c2; const float* ca; const float* c1; float* out; unsigned* head; };
__device__ __forceinline__ void copy_chunk(const CopyQ& Q, int chunk, int tid) {
    const float* in; float* out; int W;
    if (chunk < CQ_N3) { in = Q.c3; out = Q.out + O_C3S; W = 2048; }
    else if (chunk < CQ_N3 + CQ_N2) { chunk -= CQ_N3; in = Q.c2; out = Q.out + O_C2S; W = 512; }
    else if (chunk < CQ_N3 + CQ_N2 + CQ_NA) { chunk -= CQ_N3 + CQ_N2; in = Q.ca; out = Q.out + O_AKVS; W = 128; }
    else { chunk -= CQ_N3 + CQ_N2 + CQ_NA; in = Q.c1; out = Q.out + O_C1S; W = 128; }
    const unsigned wm1 = (unsigned)(W - 1);
    f32x4 v[8]; size_t doff[8];
#pragma unroll
    for (int j = 0; j < 8; ++j) {
        const unsigned i = (unsigned)chunk * CQ_CH + j * 512 + tid, r = i >> 6, es = r / wm1, rr = r - es * wm1;
        const size_t o = ((size_t)es * W + rr) * 256 + (i & 63) * 4; doff[j] = o;
        v[j] = __builtin_nontemporal_load((const f32x4*)(in + o + 256));
    }
#pragma unroll
    for (int j = 0; j < 8; ++j) __builtin_nontemporal_store(v[j], (f32x4*)(out + doff[j]));
}
template <int MODE  >
__device__ __forceinline__ void xb_wait_work(unsigned* bar, unsigned* pw, unsigned same, bool need_wait, volatile LAS unsigned* W, const CopyQ& Q) {
    const int tid = threadIdx.x;
    for (unsigned it = 0;; ++it) {
        const unsigned par = (it & 1u) * 2u;
        if (tid == 0) {
            unsigned rel = need_wait ? 0u : 1u;
            if (!rel) { for (int sp = 0; sp < 12; ++sp) { const unsigned v_ = xb_ld(pw); if (MODE == 0 ? (v_ != same) : (v_ >= same)) { rel = 1u; break; } __builtin_amdgcn_s_sleep(1); } }
            if (!rel && (it & 255u) == 255u) { if (xb_ld(&bar[XB_TMO])) rel = 1u; else if (it > (1u << 16)) { atomicAdd(&bar[XB_TMO], 1u); rel = 1u; } }
            unsigned ch = 0xffffffffu;
            if ((PROBE_DUP & 2048) == 0 && !rel && xb_ld(Q.head) < (unsigned)CQ_N) ch = xb_add(Q.head, 1u);
            W[par] = rel; W[par + 1] = ch;
        }
        __syncthreads();
        const unsigned rel = W[par], ch = W[par + 1];
        if (rel) break;
        if (ch < (unsigned)CQ_N) copy_chunk(Q, (int)ch, tid);
    }
}
__device__ __forceinline__ void xcd_barrier(const XcdBarrier& b, const CopyQ& Q) {
    asm volatile("s_waitcnt vmcnt(0)" ::: "memory");
    __syncthreads();
    unsigned* bar = b.bar;
    volatile LAS unsigned* W = b.st + 4;
    if (threadIdx.x == 0) {
        __builtin_amdgcn_s_waitcnt(0);
        unsigned nloc = b.st[0], nx = b.st[1];
        if (nloc == 0u) { xcd_barrier_complete(bar, b.x, nloc, nx); b.st[0] = nloc; b.st[1] = nx; b.st[10] = xcd_census_even(bar); }
        const unsigned old = xb_add(&bar[XB_XSUB(b.x)], 1u);
        const unsigned gen = old / nloc;
        unsigned role, val;
        if (old + 1u == (gen + 1u) * nloc) {
            __builtin_amdgcn_fence(__ATOMIC_RELEASE, "agent");
            asm volatile("s_waitcnt vmcnt(0)" ::: "memory");
            const unsigned og = xb_add(&bar[XB_TOP], 1u);
            const unsigned tg = og / nx;
            if (og + 1u == (tg + 1u) * nx) { xb_add(&bar[XB_TOPGEN], 1u); role = 2u; val = 0u; }
            else { role = 1u; val = tg; }
        } else { role = 0u; val = gen; }
        b.st[8] = role; b.st[9] = val;
    }
    __syncthreads();
    const unsigned role = b.st[8], val = b.st[9];
    xb_wait_work<0>(bar, role == 1u ? &bar[XB_TOPGEN] : &bar[XB_XGEN(b.x)], val, role != 2u, W, Q);
    if (threadIdx.x == 0) {
        __builtin_amdgcn_fence(__ATOMIC_ACQUIRE, "agent");
        if (role != 0u) xb_add(&bar[XB_XGEN(b.x)], 1u);
        asm volatile("s_waitcnt vmcnt(0)" ::: "memory");
    }
    __syncthreads();
}

__device__ __forceinline__ void xcc_barrier(const XcdBarrier& b, const CopyQ& Q) {
    asm volatile("s_waitcnt vmcnt(0)" ::: "memory");
    __syncthreads();
    unsigned* bar = b.bar;
    if (threadIdx.x == 0) {
        __builtin_amdgcn_s_waitcnt(0);
        const unsigned gen = b.st[11]; b.st[11] = gen + 1u;
        (void)xb_add(&bar[XB_LSUB(b.x)], 1u);
        b.st[9] = (gen + 1u) * b.st[0];
    }
    __syncthreads();
    const unsigned target = b.st[9];
    xb_wait_work<1>(bar, &bar[XB_LSUB(b.x)], target, true, b.st + 4, Q);
    asm volatile("" ::: "memory");
    __syncthreads();
}

__device__ __forceinline__ int opaque_v(int x) { asm volatile("" : "+v"(x)); return x; }
template <class P> __device__ __forceinline__ P* opaque_p(P* p) { asm volatile("" : "+s"(p)); return p; }
__device__ __forceinline__ float wave_sum(float v) {
#pragma unroll
    for (int o = 1; o < 64; o <<= 1) v += __shfl_xor(v, o);
    return v;
}
__device__ __forceinline__ float wave_max(float v) {
#pragma unroll
    for (int o = 1; o < 64; o <<= 1) v = fmaxf(v, __shfl_xor(v, o));
    return v;
}
__device__ __forceinline__ f16x4 cvt4(f32x4 v) { f16x4 r; r[0] = (f16)v[0]; r[1] = (f16)v[1]; r[2] = (f16)v[2]; r[3] = (f16)v[3]; return r; }
__device__ __forceinline__ f16x8 cat4(f16x4 lo, f16x4 hi) { f16x8 a; a[0] = lo[0]; a[1] = lo[1]; a[2] = lo[2]; a[3] = lo[3]; a[4] = hi[0]; a[5] = hi[1]; a[6] = hi[2]; a[7] = hi[3]; return a; }
__device__ __forceinline__ float sigmoidf_(float x) { return __builtin_amdgcn_rcpf(1.0f + __expf(-x)); }
__device__ __forceinline__ float logsigmoidf_(float x) { return fminf(x, 0.f) - log1pf(__expf(-fabsf(x))); }
__device__ __forceinline__ int row_batch(int m) { return m < MP ? (m >> 13) : (NB + m - MP); }

namespace pg8 {
constexpr int BM = 256, BK = 64, HALF = 128, HTB = HALF * BK * 2, STAGE_BYTES = 8 * HTB, NXCD = 8, WGM = 8;
__host__ __device__ __forceinline__ int lds_byte(int r, int c) { const int st = (r >> 4) * 2 + (c >> 5), rr = r & 15, cc = c & 31, ob = rr * 64 + cc * 2; return st * 1024 + (ob ^ (((ob >> 9) & 1) << 5)); }
__host__ __device__ __forceinline__ void stage_rc(int b, int& R, int& C) { const int st = b / 1024, sb = b % 1024, swz = sb ^ (((sb >> 9) & 1) << 5); R = (st >> 1) * 16 + swz / 64; C = (st & 1) * 32 + (swz % 64) / 2; }
struct Unit { int pm, pn; };
struct Gemm { const f16* A; const f16* Bt; int M, N, K; };
struct StaticOrder {
    int nM, nN, nwg, G, c;
    __host__ __device__ void init(int M, int N, int G_, int c_) { nM = M / BM; nN = N / BM; nwg = nM * nN; G = G_; c = c_; }
    __host__ __device__ bool next(int i, Unit& u) const {
        const long L = (long)i * G + c; if (L >= nwg) return false;
        int wgid = (int)L; { const int q = nwg / NXCD, r = nwg % NXCD, xcd = wgid % NXCD, off = wgid / NXCD; wgid = (xcd < r ? xcd * (q + 1) : r * (q + 1) + (xcd - r) * q) + off; }
        const int nig = WGM * nN, gid = wgid / nig, fm = gid * WGM, gsz = (nM - fm) < WGM ? (nM - fm) : WGM;
        u.pm = fm + ((wgid % nig) % gsz); u.pn = (wgid % nig) / gsz; return true;
    }
    __device__ __forceinline__ void a_ready(const Unit&) const {}
    __device__ __forceinline__ void done(const Unit&) const {}
};
struct DiagOrder {
    int G, c;
    __device__ bool next(int i, Unit& u) const {
        const int L = i * G + c; if (L >= NWIN / BM) return false;
        int s = 0, acc = 0;
#pragma unroll
        for (int k = 0; k < NSITE; ++k) { const int n = site_N(k) / BM; if (L >= acc + n) { s = k + 1; } acc += n; }
        u.pm = s; u.pn = L; return true;
    }
    __device__ __forceinline__ void a_ready(const Unit&) const {}
    __device__ __forceinline__ void done(const Unit&) const {}
};

template <class Epi, class Sched, bool ALIGN_EPI = true>
__device__ __forceinline__ void gemm_phase(ldsp_t lds, const Gemm g, const Sched& S, const Epi& E) {
    const int tid = opaque_v(threadIdx.x), wid = __builtin_amdgcn_readfirstlane(tid >> 6), lane = tid & 63, wr = wid >> 2, wc = wid & 3, fr = lane & 15, fq = lane >> 4;
    const int K = g.K, nt = K / BK;
    const int rot = (((S.c & 7) * nt) >> 3) & ~1;
    unsigned voffA[2];
#pragma unroll
    for (int i = 0; i < 2; ++i) voffA[i] = (unsigned)(tid * 16 + i * 8192);
#define voffB voffA
    const size_t kstep = (size_t)(2 * HTB);
    const size_t hstep = (size_t)HTB;
    const size_t tstep = (size_t)nt * kstep;
    const unsigned ldsw = (unsigned)wid * 1024u;
    const int aoff = lds_byte(wr * 64 + fr, fq * 8), boff = lds_byte(wc * 32 + fr, fq * 8);
#define PG8_SA(b, h) (((b) * 2 + (h)) * HTB)
#define PG8_SB(b, h) ((4 + (b) * 2 + (h)) * HTB)
#define PG8_STAGE_X(bufoff, gbase, voff, AUX) do { _Pragma("unroll") for (int _i = 0; _i < 2; ++_i) \
        __builtin_amdgcn_global_load_lds((const unsigned*)((const char*)(gbase) + (voff)[_i]), (LAS unsigned*)(lds + (bufoff) + ldsw + _i * 8192), 16, 0, AUX); } while (0)
#define PG8_STAGE(bufoff, gbase, voff) PG8_STAGE_X(bufoff, gbase, voff, 0)
#define PG8_STAGEA(bufoff, gbase, voff) PG8_STAGE_X(bufoff, gbase, voff, 16)
#define PG8_LDA(dst, b, h) do { _Pragma("unroll") for (int m = 0; m < 4; ++m) _Pragma("unroll") for (int k = 0; k < 2; ++k) dst[m][k] = *(const LAS f16x8*)(lds + PG8_SA(b, h) + aoff + m * 2048 + k * 1024); } while (0)
#define PG8_LDB(dst, b, h) do { _Pragma("unroll") for (int n = 0; n < 2; ++n) _Pragma("unroll") for (int k = 0; k < 2; ++k) dst[n][k] = *(const LAS f16x8*)(lds + PG8_SB(b, h) + boff + n * 2048 + k * 1024); } while (0)
#define PG8_MMA(ai, bj, At, Bt) do { __builtin_amdgcn_s_setprio(1); _Pragma("unroll") for (int m = 0; m < 4; ++m) _Pragma("unroll") for (int n = 0; n < 2; ++n) _Pragma("unroll") for (int k = 0; k < 2; ++k) \
        acc[ai][bj][m][n] = __builtin_amdgcn_mfma_f32_16x16x32_f16(Bt[n][k], At[m][k], acc[ai][bj][m][n], 0, 0, 0); __builtin_amdgcn_s_setprio(0); } while (0)
#define PG8_WAIT_V(n) asm volatile("s_waitcnt vmcnt(" #n ")" ::: "memory")
#define PG8_WAIT_L(n) asm volatile("s_waitcnt lgkmcnt(" #n ")" ::: "memory")
#define PG8_BAR __builtin_amdgcn_s_barrier()
#define PG8_SCHED __builtin_amdgcn_sched_barrier(0)
    Unit cur, nxt; int ui = 0;
    if (!S.next(0, cur)) return;
    f32x4 acc[2][2][4][2];
#pragma unroll
    for (int a = 0; a < 2; ++a)
#pragma unroll
        for (int b = 0; b < 2; ++b)
#pragma unroll
            for (int m = 0; m < 4; ++m)
#pragma unroll
                for (int n = 0; n < 2; ++n) acc[a][b][m][n] = (f32x4){0.f, 0.f, 0.f, 0.f};
    f16x8 At[4][2], B0[2][2], B1[2][2];
    const char* cA = (const char*)g.A + (size_t)cur.pm * tstep; const char* cB = (const char*)g.Bt + (size_t)cur.pn * tstep;
    S.a_ready(cur);
    const size_t rstep = (size_t)rot * kstep;
    PG8_STAGE(PG8_SB(0, 0), cB + rstep, voffB); PG8_STAGE(PG8_SB(0, 1), cB + rstep + hstep, voffB); PG8_STAGEA(PG8_SA(0, 0), cA + rstep, voffA); PG8_STAGEA(PG8_SA(0, 1), cA + rstep + hstep, voffA);
    if (wr == 1) PG8_BAR;
    PG8_WAIT_V(2); PG8_BAR;
    PG8_STAGE(PG8_SB(1, 0), cB + rstep + kstep, voffB); PG8_STAGEA(PG8_SA(1, 0), cA + rstep + kstep, voffA); PG8_STAGE(PG8_SB(1, 1), cB + rstep + hstep + kstep, voffB);
    PG8_WAIT_V(6); PG8_BAR;
    if constexpr (Epi::HAS_PRE) E.pre(cur, (LAS float*)(lds + EPI_OFF), wid, opaque_v(lane));
    for (;;) {
        const bool has_next = S.next(ui + 1, nxt);
        const char* nA = has_next ? (const char*)g.A + (size_t)nxt.pm * tstep : cA; const char* nB = has_next ? (const char*)g.Bt + (size_t)nxt.pn * tstep : cB;
        for (int t = 0; t < nt; t += 2) {
            const bool last = (t == nt - 2);
            int t1 = t + 1 + rot, t2 = t + 2 + rot; t1 -= (t1 >= nt) ? nt : 0; t2 -= (t2 >= nt) ? nt : 0;
            const char* a1 = cA + (size_t)t1 * kstep;
            const size_t nxoff = has_next ? rstep : (size_t)((nt - 2 + rot) % nt) * kstep;
            const char* a2 = last ? nA + nxoff : cA + (size_t)t2 * kstep; const char* b2 = last ? nB + nxoff : cB + (size_t)t2 * kstep;
            const char* a3 = a2 + kstep; const char* b3 = b2 + kstep;
            if (last && has_next) S.a_ready(nxt);
            PG8_LDB(B0, 0, 0); PG8_LDB(B1, 0, 1); PG8_SCHED; PG8_LDA(At, 0, 0); PG8_STAGEA(PG8_SA(1, 1), a1 + hstep, voffA);
            PG8_WAIT_V(8); PG8_WAIT_L(0); PG8_BAR; PG8_MMA(0, 0, At, B0); PG8_MMA(0, 1, At, B1); PG8_BAR; PG8_SCHED;
            PG8_LDA(At, 0, 1); PG8_STAGE(PG8_SB(0, 0), b2, voffB); PG8_STAGE(PG8_SB(0, 1), b2 + hstep, voffB); PG8_STAGEA(PG8_SA(0, 0), a2, voffA);
            PG8_WAIT_V(8); PG8_WAIT_L(0); PG8_BAR; PG8_MMA(1, 0, At, B0); PG8_MMA(1, 1, At, B1); PG8_BAR; PG8_SCHED;
            PG8_LDB(B0, 1, 0); PG8_LDB(B1, 1, 1); PG8_SCHED; PG8_LDA(At, 1, 0); PG8_STAGEA(PG8_SA(0, 1), a2 + hstep, voffA);
            PG8_WAIT_V(8); PG8_WAIT_L(0); PG8_BAR; PG8_MMA(0, 0, At, B0); PG8_MMA(0, 1, At, B1); PG8_BAR; PG8_SCHED;
            PG8_LDA(At, 1, 1); PG8_STAGE(PG8_SB(1, 0), b3, voffB); PG8_STAGE(PG8_SB(1, 1), b3 + hstep, voffB); PG8_STAGEA(PG8_SA(1, 0), a3, voffA);
            PG8_WAIT_V(8); PG8_WAIT_L(0); PG8_BAR; PG8_MMA(1, 0, At, B0); PG8_MMA(1, 1, At, B1); PG8_BAR; PG8_SCHED;
        }
        if constexpr (ALIGN_EPI) { if (wr == 0) PG8_BAR; }
        E(acc, cur, wr, wc, fr, fq, (const LAS float*)(lds + EPI_OFF + (ui & 1) * EPI_STRIDE)); S.done(cur);
        if (!has_next) break;
#pragma unroll
        for (int a = 0; a < 2; ++a)
#pragma unroll
            for (int b = 0; b < 2; ++b)
#pragma unroll
                for (int m = 0; m < 4; ++m)
#pragma unroll
                    for (int n = 0; n < 2; ++n) acc[a][b][m][n] = (f32x4){0.f, 0.f, 0.f, 0.f};
        cur = nxt; cA = nA; cB = nB; ++ui;
        if constexpr (Epi::HAS_PRE) E.pre(cur, (LAS float*)(lds + EPI_OFF + (ui & 1) * EPI_STRIDE), wid, opaque_v(lane));
        if constexpr (ALIGN_EPI) { if (wr == 1) PG8_BAR; }
    }
    PG8_WAIT_V(0);
    if constexpr (!ALIGN_EPI) { if (wr == 0) PG8_BAR; }
    PG8_BAR;
#undef PG8_SA
#undef PG8_SB
#undef PG8_STAGE
#undef voffB
#undef PG8_STAGEA
#undef PG8_STAGE_X
#undef PG8_LDA
#undef PG8_LDB
#undef PG8_MMA
#undef PG8_WAIT_V
#undef PG8_WAIT_L
#undef PG8_BAR
#undef PG8_SCHED
}
}
__host__ __device__ __forceinline__ size_t tiled_byte(int row, int col, int K) {
    return ((size_t)((row >> 8) * (K >> 6) + (col >> 6)) * 2 + ((row >> 7) & 1)) * 16384 + (size_t)pg8::lds_byte(row & 127, col & 63);
}
template <class V> __device__ __forceinline__ V* tiled_ptr(f16* base, int row, int col, int K) { return (V*)((char*)base + tiled_byte(row, col, K)); }

using pg8::Unit;
struct EpiSwiglu {
    static constexpr bool HAS_PRE = true;
    const float* rowss; const float* BW; f16* H;
    __device__ __forceinline__ void pre(const Unit& u, LAS float* ev, int wid, int lane) const {
        const int i = (wid & 3) * 64 + lane;
        const float* src = (wid < 4) ? rowss + u.pm * 256 + i : BW + (size_t)(u.pm >> 5) * NWIN + u.pn * 256 + i;
        __builtin_amdgcn_global_load_lds((const unsigned*)src, (LAS unsigned*)(ev + (wid < 4 ? 0 : 256) + (wid & 3) * 64), 4, 0, 0);
    }
    __device__ __forceinline__ static f16x4 act(f32x4 g, f32x4 u, float r, f32x4 bg, f32x4 bu) {
        f32x4 o;
#pragma unroll
        for (int e = 0; e < 4; ++e) { const float gg = g[e] * r + bg[e], uu = u[e] * r + bu[e]; o[e] = gg * uu * __builtin_amdgcn_rcpf(1.0f + __expf(-gg)); }
        return cvt4(o);
    }
    __device__ __forceinline__ void operator()(const f32x4 (&acc)[2][2][4][2], const Unit& u, int wr, int wc, int fr_in, int fq_in, const LAS float* ev) const {
        const int fr = opaque_v(fr_in), fq = opaque_v(fq_in);
        f32x4 bg[2], bu[2];
#pragma unroll
        for (int bj = 0; bj < 2; ++bj) { const int cg = 256 + bj * 128 + wc * 32 + 4 * fq; bg[bj] = *(const LAS f32x4*)(ev + cg); bu[bj] = *(const LAS f32x4*)(ev + cg + 16); }
        char* hb = (char*)H + (size_t)(u.pm * (FF / 64) + 2 * u.pn + (wc >> 1)) * 32768 + (size_t)(8 * wr + (wc & 1)) * 1024;
        const unsigned lo = (unsigned)(fr * 64 + ((16 * fq) ^ (32 * (fr >> 3))));
#pragma unroll
        for (int ai = 0; ai < 2; ++ai)
#pragma unroll
            for (int m = 0; m < 4; ++m) {
                const float r = rsqrtf(ev[ai * 128 + wr * 64 + m * 16 + fr] * (1.0f / D) + EPS);
                const f16x4 h0 = act(acc[ai][0][m][0], acc[ai][0][m][1], r, bg[0], bu[0]), h1 = act(acc[ai][1][m][0], acc[ai][1][m][1], r, bg[1], bu[1]);
                *(f16x8*)(hb + lo + (ai * 16384 + m * 2048)) = cat4(h0, h1);
            }
    }
    __device__ __forceinline__ void sk(int row, int q32, int e4, f32x4 g, f32x4 u) const {
        const int b = row_batch(row); const float* bias = BW + (size_t)b * NWIN + q32 * 32 + e4;
        const float r = rsqrtf(rowss[row] * (1.0f / D) + EPS);
        *(f16x4*)(H + (size_t)row * FF + 128 * (q32 >> 3) + 32 * (q32 & 3) + 2 * e4 + 4 * ((q32 >> 2) & 1)) = act(g, u, r, *(const f32x4*)bias, *(const f32x4*)(bias + 16));
    }
};
struct EpiRes {
    static constexpr bool HAS_PRE = true;
    f16* X; f16* A; float* rowss_next; const float* GT; const float* CS; const float* RCS;
    __device__ __forceinline__ void pre(const Unit& u, LAS float* ev, int wid, int lane) const {
        const int i = (wid & 3) * 64 + lane; const size_t o = (size_t)(u.pm >> 5) * D + u.pn * 256 + i;
        if (wid < 4) { __builtin_amdgcn_global_load_lds((const unsigned*)(GT + o), (LAS unsigned*)(ev + (wid & 3) * 64), 4, 0, 0);
                       __builtin_amdgcn_global_load_lds((const unsigned*)(RCS + o), (LAS unsigned*)(ev + 512 + (wid & 3) * 64), 4, 0, 0); }
        else if (CS) __builtin_amdgcn_global_load_lds((const unsigned*)(CS + o), (LAS unsigned*)(ev + 256 + (wid & 3) * 64), 4, 0, 0);
    }
    __device__ __forceinline__ void operator()(const f32x4 (&acc)[2][2][4][2], const Unit& u, int wr, int wc, int fr_in, int fq_in, const LAS float* ev) const {
        const int fr = opaque_v(fr_in), fq = opaque_v(fq_in);
        const int col0 = u.pn * 256 + wc * 32 + 8 * fq;
        const LAS float* gt = ev + wc * 32 + 8 * fq; const LAS float* cs = ev + 256 + wc * 32 + 8 * fq; const LAS float* rc = ev + 512 + wc * 32 + 8 * fq;
        char* ab = (char*)A + (size_t)(u.pm * (D / 64) + 4 * u.pn + (wc >> 1)) * 32768 + (size_t)(8 * wr + (wc & 1)) * 1024;
        const unsigned lo = (unsigned)(fr * 64 + ((16 * fq) ^ (32 * (fr >> 3))));
        const bool lastsite = (CS == nullptr);
        f32x4 gv[2][2], rv[2][2], cv[2][2];
#pragma unroll
        for (int bj = 0; bj < 2; ++bj)
#pragma unroll
            for (int n = 0; n < 2; ++n) { gv[bj][n] = *(const LAS f32x4*)(gt + bj * 128 + 4 * n); rv[bj][n] = *(const LAS f32x4*)(rc + bj * 128 + 4 * n); cv[bj][n] = *(const LAS f32x4*)(cs + bj * 128 + 4 * n); }
#pragma unroll
        for (int ai = 0; ai < 2; ++ai)
#pragma unroll
            for (int m = 0; m < 4; ++m) {
                const int row = u.pm * 256 + ai * 128 + wr * 64 + m * 16 + fr;
                float ss = 0.f;
#pragma unroll
                for (int bj = 0; bj < 2; ++bj) {
                    const int off = bj * 128;
                    f16x8* ap = (f16x8*)(ab + lo + (bj * 65536 + ai * 16384 + m * 2048));
                    const f16x8 ah = *ap;
                    f16x4 ao[2];
#pragma unroll
                    for (int n = 0; n < 2; ++n) {
                        f32x4 x = {(float)ah[4 * n], (float)ah[4 * n + 1], (float)ah[4 * n + 2], (float)ah[4 * n + 3]}; x = x * rv[bj][n] + gv[bj][n] * acc[ai][bj][m][n];
                        ss += (x[0] * x[0] + x[1] * x[1]) + (x[2] * x[2] + x[3] * x[3]);
                        ao[n] = cvt4(lastsite ? x : x * cv[bj][n]);
                    }
                    if (lastsite) *(f16x8*)(X + (size_t)row * D + col0 + off) = cat4(ao[0], ao[1]);
                    else *ap = cat4(ao[0], ao[1]);
                }
                ss += __shfl_xor(ss, 16); ss += __shfl_xor(ss, 32);
                if (fq == 0) atomicAdd(rowss_next + row, ss);
            }
    }
    __device__ __forceinline__ static int slot2col(int slot) { return (slot & ~31) + 8 * ((slot & 15) >> 2) + 4 * ((slot >> 4) & 1); }
    __device__ __forceinline__ void sk(int row, int slot, f32x4 v) const {
        const int col = slot2col(slot);
        const int b = row_batch(row);
        const f32x4 g4 = *(const f32x4*)(GT + (size_t)b * D + col), r4 = *(const f32x4*)(RCS + (size_t)b * D + col);
        f16* ar = A + (size_t)row * D + col; const f16x4 ah = *(const f16x4*)ar;
        f32x4 x = {(float)ah[0], (float)ah[1], (float)ah[2], (float)ah[3]}; x = x * r4 + g4 * v;
        if (CS) *(f16x4*)ar = cvt4(x * *(const f32x4*)(CS + (size_t)b * D + col));
        else *(f16x4*)(X + (size_t)row * D + col) = cvt4(x);
        atomicAdd(rowss_next + row, (x[0] * x[0] + x[1] * x[1]) + (x[2] * x[2] + x[3] * x[3]));
    }
};
template <bool EVEN> struct EpiZ {
    static constexpr bool HAS_PRE = true;
    const float* rowss; const float* BW; f16* Z; float* GATES;
    __device__ __forceinline__ void pre(const Unit& u, LAS float* ev, int wid, int lane) const {
        const int i = (wid & 3) * 64 + lane;
        const float* src = (wid < 4) ? rowss + u.pm * 256 + i : BW + (size_t)(u.pm >> 5) * NWIN + u.pn * 256 + i;
        __builtin_amdgcn_global_load_lds((const unsigned*)src, (LAS unsigned*)(ev + (wid < 4 ? 0 : 256) + (wid & 3) * 64), 4, 0, 0);
    }
    static constexpr int LDZ = EVEN ? NEV : NOD;
    __device__ __forceinline__ void put(int row, int col, f32x4 z) const {
        if (EVEN) {
            if (col < 2816) { if (col >= 1280 && col < 1792) z = z * 0.125f; *(f16x4*)(Z + (size_t)row * LDZ + col) = cvt4(z); }
            else if (col < NEVR) *(f32x4*)(GATES + (size_t)row * 16 + (col - 2816)) = z;
        } else *(f16x4*)(Z + (size_t)row * LDZ + col) = cvt4(z);
    }
    __device__ __forceinline__ void put8(int row, int col, f32x4 z0, f32x4 z1) const {
        if (EVEN) {
            if (col < 2816) { if (col >= 1280 && col < 1792) { z0 = z0 * 0.125f; z1 = z1 * 0.125f; } *(f16x8*)(Z + (size_t)row * LDZ + col) = cat4(cvt4(z0), cvt4(z1)); }
            else if (col < NEVR) { float* gp = GATES + (size_t)row * 16 + (col - 2816); *(f32x4*)gp = z0; *(f32x4*)(gp + 4) = z1; }
        } else *(f16x8*)(Z + (size_t)row * LDZ + col) = cat4(cvt4(z0), cvt4(z1));
    }
    __device__ __forceinline__ static int slot2col(int slot) { return (slot & ~31) + 8 * ((slot & 15) >> 2) + 4 * ((slot >> 4) & 1); }
    __device__ __forceinline__ void operator()(const f32x4 (&acc)[2][2][4][2], const Unit& u, int wr, int wc, int fr_in, int fq_in, const LAS float* ev) const {
        const int fr = opaque_v(fr_in), fq = opaque_v(fq_in);
        const int col0 = u.pn * 256 + wc * 32 + 8 * fq;
        f32x4 bv[2][2];
#pragma unroll
        for (int bj = 0; bj < 2; ++bj)
#pragma unroll
            for (int n = 0; n < 2; ++n) bv[bj][n] = *(const LAS f32x4*)(ev + 256 + wc * 32 + 4 * fq + bj * 128 + n * 16);
#pragma unroll
        for (int ai = 0; ai < 2; ++ai)
#pragma unroll
            for (int m = 0; m < 4; ++m) {
                const int row = u.pm * 256 + ai * 128 + wr * 64 + m * 16 + fr;
                const float r = rsqrtf(ev[ai * 128 + wr * 64 + m * 16 + fr] * (1.0f / D) + EPS);
#pragma unroll
                for (int bj = 0; bj < 2; ++bj) put8(row, col0 + bj * 128, acc[ai][bj][m][0] * r + bv[bj][0], acc[ai][bj][m][1] * r + bv[bj][1]);
            }
    }
    __device__ __forceinline__ void sk(int row, int slot, f32x4 v) const {
        const int b = row_batch(row); const float r = rsqrtf(rowss[row] * (1.0f / D) + EPS);
        put(row, slot2col(slot), v * r + *(const f32x4*)(BW + (size_t)b * NWIN + slot));
    }
};
struct EpiMod {
    static constexpr bool HAS_PRE = false;
    float* CS; float* GT; f16* SHA; const float* bmod; const float* NG; float* RCS;
    __device__ __forceinline__ void operator()(const f32x4 (&acc)[2][2][4][2], const Unit& u, int wr, int wc, int fr_in, int fq_in, const LAS float* ev) const {
        const int fr = opaque_v(fr_in), fq = opaque_v(fq_in);
        const int cu = u.pn * 256, l = cu / NMODC, jj = (cu - l * NMODC) >> 10, j = jj / 3, kind = jj - 3 * j, s = 3 * l + j;
        const int d0 = (cu & 1023) + wc * 32 + 4 * fq;
#pragma unroll
        for (int ai = 0; ai < 2; ++ai)
#pragma unroll
            for (int m = 0; m < 4; ++m) {
                const int row = ai * 128 + wr * 64 + m * 16 + fr;
#pragma unroll
                for (int bj = 0; bj < 2; ++bj)
#pragma unroll
                    for (int n = 0; n < 2; ++n) {
                        const int d = d0 + bj * 128 + n * 16;
                        const f32x4 v = acc[ai][bj][m][n] + *(const f32x4*)(bmod + cu - (cu & 1023) + d);
                        if (kind == 0) *tiled_ptr<f16x4>(SHA, s * 256 + row, d, D) = row < NBAT ? cvt4(v) : (f16x4){0, 0, 0, 0};
                        else if (row < NBAT) {
                            if (kind == 1) { const f32x4 c4 = *(const f32x4*)(NG + (l * 3 + j) * D + d) * (v + 1.0f); *(f32x4*)(CS + ((size_t)s * NBAT + row) * D + d) = c4;
                                *(f32x4*)(RCS + ((size_t)s * NBAT + row) * D + d) = (f32x4){1.0f / c4[0], 1.0f / c4[1], 1.0f / c4[2], 1.0f / c4[3]}; }
                            else *(f32x4*)(GT + ((size_t)s * NBAT + row) * D + d) = v * (j == 1 ? 1.0f : 0.5f);
                        }
                    }
            }
    }
};
struct EpiBias {
    static constexpr bool HAS_PRE = false;
    float* BW;
    __device__ __forceinline__ void operator()(const f32x4 (&acc)[2][2][4][2], const Unit& u, int wr, int wc, int fr_in, int fq_in, const LAS float* ev) const {
        const int fr = opaque_v(fr_in), fq = opaque_v(fq_in);
        const int col0 = u.pn * 256 + wc * 32 + 4 * fq;
#pragma unroll
        for (int ai = 0; ai < 2; ++ai)
#pragma unroll
            for (int m = 0; m < 4; ++m) {
                const int row = ai * 128 + wr * 64 + m * 16 + fr;
                if (row < NBAT) {
#pragma unroll
                    for (int bj = 0; bj < 2; ++bj)
#pragma unroll
                        for (int n = 0; n < 2; ++n) *(f32x4*)(BW + (size_t)row * NWIN + col0 + bj * 128 + n * 16) = acc[ai][bj][m][n];
                }
            }
    }
};

template <bool SWIGLU, int K, class Epi>
__device__ __forceinline__ void skinny_phase(ldsp_t lds, const f16* A, const f16* Bt, int N, const Epi& E, int G, int c, int nunits) {
    const int tid = opaque_v(threadIdx.x), wid = __builtin_amdgcn_readfirstlane(tid >> 6), lane = tid & 63, fr = lane & 15, fq = lane >> 4;
    const int grp = c & 7, rem = nunits % G, r0 = (rem + 7 - grp) >> 3;
    int r = (c >> 3) - r0, nr = ((G - grp + 7) >> 3) - r0;
    if (r < 0 || nr <= 0) { if (nr > 0) return; r = c >> 3; nr = (G - grp + 7) >> 3; }
    constexpr int AS = K + 8;
    constexpr int KS = (!SWIGLU && K > 2048) ? 4 : 1;
    LAS f16* As = (LAS f16*)lds;
    LAS float* red = (LAS float*)(lds + 16 * AS * 2);
    const f16* Ag = A + (size_t)(16 * grp) * K;
    {
        constexpr int NPC = K / 256; static_assert(16 * (K / 8) == NPC * 512, "K must be a multiple of 256");
        unsigned long long alo[NPC], ahi[NPC];
#pragma unroll
        for (int j = 0; j < NPC; ++j) { const int i = tid + 512 * j, row = i / (K / 8), ch = i - row * (K / 8);
            const unsigned long long* gp = (const unsigned long long*)(Ag + (size_t)row * K + 8 * ch);
            alo[j] = __hip_atomic_load(gp, __ATOMIC_RELAXED, __HIP_MEMORY_SCOPE_AGENT); ahi[j] = __hip_atomic_load(gp + 1, __ATOMIC_RELAXED, __HIP_MEMORY_SCOPE_AGENT); }
#pragma unroll
        for (int j = 0; j < NPC; ++j) { const int i = tid + 512 * j, row = i / (K / 8), ch = i - row * (K / 8);
            LAS unsigned long long* lp = (LAS unsigned long long*)(As + row * AS + 8 * ch); lp[0] = alo[j]; lp[1] = ahi[j]; }
    }
    __syncthreads();
    const int nitem = SWIGLU ? N / 32 : N / 16;
    const LAS f16* ap = As + fr * AS + 8 * fq;
    const int wq = wid / KS, kq = wid - wq * KS, nwq = 8 / KS;
    constexpr int KSTEPS = K / 32 / KS;
    for (int t0 = 0; t0 < nitem; t0 += nwq * nr) {
        const int t = t0 + wq * nr + r; const bool on = t < nitem;
        const int n0 = SWIGLU ? 32 * t : 16 * t;
        f32x4 acc0 = {0.f, 0.f, 0.f, 0.f}, acc1 = {0.f, 0.f, 0.f, 0.f};
        if (on) {
            const char* bp = (const char*)Bt + tiled_byte(n0 + fr, 8 * fq, K);
            const LAS f16* apk = ap + 32 * KSTEPS * kq;
            constexpr int UNR = SWIGLU ? 8 : (KSTEPS % 16 == 0 ? 16 : (KSTEPS % 11 == 0 ? 11 : 8));
            static_assert(KSTEPS % UNR == 0, "K-step grouping");
#pragma unroll 1
            for (int ks0 = 0; ks0 < KSTEPS; ks0 += UNR) {
                f16x8 b0[UNR], b1[SWIGLU ? UNR : 1];
#pragma unroll
                for (int u = 0; u < UNR; ++u) { const int kg = KSTEPS * kq + ks0 + u; const size_t ko = (size_t)(kg >> 1) * 32768 + (size_t)(kg & 1) * 1024;
                    b0[u] = *(const f16x8*)(bp + ko);
                    if constexpr (SWIGLU) b1[u] = *(const f16x8*)(bp + ko + 2048); }
#pragma unroll
                for (int u = 0; u < UNR; ++u) { const f16x8 a = *(const LAS f16x8*)(apk + 32 * (ks0 + u));
                    acc0 = __builtin_amdgcn_mfma_f32_16x16x32_f16(b0[u], a, acc0, 0, 0, 0);
                    if constexpr (SWIGLU) acc1 = __builtin_amdgcn_mfma_f32_16x16x32_f16(b1[u], a, acc1, 0, 0, 0); }
            }
        }
        if constexpr (KS > 1) {
            *(LAS f32x4*)(red + (wid * 64 + lane) * 4) = acc0;
            __syncthreads();
            if (kq == 0) {
#pragma unroll
                for (int j = 1; j < KS; ++j) acc0 = acc0 + *(const LAS f32x4*)(red + ((wid + j) * 64 + lane) * 4);
            }
            __syncthreads();
        }
        const int row = MP + 16 * grp + fr;
        if (on && kq == 0) {
            if constexpr (SWIGLU) E.sk(row, t, 4 * fq, acc0, acc1);
            else E.sk(row, n0 + 4 * fq, acc0);
        }
    }
    __syncthreads();
}

struct Frame {
    ldsp_t lds; int tid, lane, wave, G, bid;
    float* out; unsigned char* ws;
};
#define FIN(i) (((const float* const __attribute__((address_space(4)))*)__builtin_amdgcn_kernarg_segment_ptr())[i])
#define WSP(T_, off) ((T_*)(F.ws + (off)))

__device__ __forceinline__ void tr_item(const float* W, int K, int Nsrc, int Ndst, int perm, f16* WT, LAS float* scr, int item, int lane) {
    const int nblk = Ndst / 64, kb = item / nblk, nb64 = item - kb * nblk, k0 = 32 * kb, n0 = 64 * nb64;
    const int kr = lane >> 4, c16 = lane & 15, nb = 2 * nb64 + (c16 >> 3), c4 = c16 & 7;
    int sc = 32 * nb + 4 * c4;
    if (perm == 2) sc = 32 * nb + 8 * (c4 & 3) + 4 * (c4 >> 2);
    else if (perm == 1) sc = (c4 >> 2) * FF + 128 * (nb64 >> 2) + 32 * (nb64 & 3) + 8 * (c4 & 3) + 4 * (c16 >> 3);
    const bool ok = sc < Nsrc;
    f32x4 v[8];
#pragma unroll
    for (int i = 0; i < 8; ++i) v[i] = ok ? __builtin_nontemporal_load((const f32x4*)(W + (size_t)(k0 + 4 * i + kr) * Nsrc + sc)) : (f32x4){0.f, 0.f, 0.f, 0.f};
#pragma unroll
    for (int i = 0; i < 8; ++i) { LAS float* d = scr + (4 * i + kr) * 65 + 4 * c16; d[0] = v[i][0]; d[1] = v[i][1]; d[2] = v[i][2]; d[3] = v[i][3]; }
    LDS_WAIT(); asm volatile("" ::: "memory");
    const int c = lane & 3;
#pragma unroll
    for (int j = 0; j < 4; ++j) { const int n = (lane >> 2) + 16 * j; const LAS float* sp = scr + (8 * c) * 65 + n;
        f16x8 o;
#pragma unroll
        for (int e = 0; e < 8; ++e) o[e] = (f16)sp[e * 65];
        const int row = perm == 1 ? 256 * (nb64 >> 2) + 128 * (n >> 5) + 32 * (nb64 & 3) + (n & 31) : n0 + n;
        *tiled_ptr<f16x8>(WT, row, k0 + 8 * c, K) = o; }
    LDS_WAIT(); asm volatile("" ::: "memory");
}
struct MatDesc { const float* src; int K, Nsrc, Ndst, perm; f16* dst; };
__device__ __forceinline__ void mat_desc(Frame& F, int mi, MatDesc& d) {
    if (mi < 8) { const int l = mi >> 1, i = mi & 1; d = {FIN(I_FWI) + (size_t)mi * D * FF2, D, FF2, FF2, 1, WSP(f16, WS_WIN) + (size_t)site_off(3 * l + 2 * i) * D}; }
    else if (mi < 10) { const int e = mi - 8; d = {FIN(I_EWI) + (size_t)e * D * NEVR, D, NEVR, NEV, 2, WSP(f16, WS_WIN) + (size_t)site_off(6 * e + 1) * D}; }
    else if (mi < 12) { const int o = mi - 10; d = {FIN(I_OWI) + (size_t)o * D * NOD, D, NOD, NOD, 2, WSP(f16, WS_WIN) + (size_t)site_off(6 * o + 4) * D}; }
    else if (mi < 20) { const int k = mi - 12; d = {FIN(I_FWO) + (size_t)k * FF * D, FF, D, D, 2, WSP(f16, WS_WFO) + (size_t)k * D * FF}; }
    else if (mi < 22) { const int e = mi - 20; d = {FIN(I_EWO) + (size_t)e * D * D, D, D, D, 2, WSP(f16, WS_WEO) + (size_t)e * D * D}; }
    else if (mi < 24) { const int o = mi - 22; d = {FIN(I_OWO) + (size_t)o * 512 * D, 512, D, D, 2, WSP(f16, WS_WOO) + (size_t)o * D * 512}; }
    else { const int l = mi - 24; d = {FIN(I_WMOD) + (size_t)l * D * NMODC, D, NMODC, NMODC, 0, WSP(f16, WS_WMOD) + (size_t)l * NMODC * D}; }
}
__device__ __forceinline__ void cache_shift(const float* in, float* out, int W, size_t gtid, size_t gstride) {
    const size_t per = (size_t)(W - 1) * 64, total = per * 256;
    for (size_t i = gtid; i < total; i += gstride) {
        const size_t es = i / per, off = i - es * per;
        const f32x4 v = __builtin_nontemporal_load((const f32x4*)(in + es * (size_t)W * 256 + 256) + off);
        __builtin_nontemporal_store(v, (f32x4*)(out + es * (size_t)W * 256) + off);
    }
}
__device__ __forceinline__ void phase_pr0(Frame& F, int mlo, int mhi, bool do_ac, unsigned* ctr) {
    LAS float* scr = (LAS float*)(F.lds + F.wave * 16384);
    const int gw = F.bid * 8 + F.wave, NGW = F.G * 8;
    if (ctr) {
        int total = 0;
        for (int mi = mlo; mi < mhi; ++mi) { MatDesc d; mat_desc(F, mi, d); total += (d.K / 64) * (d.Ndst / 32); }
        for (;;) {
            unsigned g0 = 0; if (F.lane == 0) g0 = xb_add(ctr, 4u);
            g0 = (unsigned)__builtin_amdgcn_readfirstlane((int)g0);
            if ((int)g0 >= total) break;
            for (int j = 0; j < 4 && (int)g0 + j < total; ++j) {
                int g = (int)g0 + j, mi = mlo; MatDesc d; mat_desc(F, mi, d); int items = (d.K / 64) * (d.Ndst / 32);
                while (g >= items) { g -= items; ++mi; mat_desc(F, mi, d); items = (d.K / 64) * (d.Ndst / 32); }
                tr_item(d.src, d.K, d.Nsrc, d.Ndst, d.perm, d.dst, scr, g, F.lane);
            }
        }
    } else {
    int base = 0;
    for (int mi = mlo; mi < mhi; ++mi) {
        MatDesc d; mat_desc(F, mi, d);
        const int items = (d.K / 64) * (d.Ndst / 32);
        int it = gw - (base % NGW); if (it < 0) it += NGW;
        for (; it < items; it += NGW) tr_item(d.src, d.K, d.Nsrc, d.Ndst, d.perm, d.dst, scr, it, F.lane);
        base += items;
    }
    }
    if (do_ac) { f16* AC = WSP(f16, WS_AC);
      for (int i = F.bid * 512 + F.tid; i < 256 * D; i += F.G * 512) { const int b = i >> 10, d = i & 1023; float v = 0.f;
          if (b < NBAT) { const float c = b < NB ? FIN(I_CP)[b * D + d] : FIN(I_CSMP)[(b - NB) * D + d]; v = c / (1.0f + __expf(-c)); }
          *tiled_ptr<f16>(AC, b, d, D) = (f16)v; } }
}
__device__ __forceinline__ void phase_pr2(Frame& F) {
    const float* CS0 = WSP(float, WS_CS);
    f16* X = WSP(f16, WS_X); f16* A = WSP(f16, WS_A); float* rowss = (float*)(F.ws + RSS_OFF);
    constexpr int NU = NWIN / 256, NIT = MALL / 4;
    const int nbw = (F.G < NU ? F.G : NU) * 8, nfw = F.G * 8 - nbw;
    int it_lo = 0, it_hi = NIT, it_idx = F.bid * 8 + F.wave, it_st = F.G * 8;
    if (nfw > 0) { const int ib = NIT < nbw ? NIT : nbw;
        if (F.bid < NU) { it_hi = ib; it_st = nbw; } else { it_lo = ib; it_idx = (F.bid - NU) * 8 + F.wave; it_st = nfw; } }
    for (int it = it_lo + it_idx; it < it_hi; it += it_st) { const int m0 = it * 4;
        f32x4 xv[4][4];
#pragma unroll
        for (int r = 0; r < 4; ++r) { const int m = m0 + r; const float* xr = m < MP ? FIN(I_XP) + (size_t)m * D : FIN(I_XS) + (size_t)(m - MP) * D;
#pragma unroll
            for (int q = 0; q < 4; ++q) xv[r][q] = __builtin_nontemporal_load((const f32x4*)(xr + q * 256 + F.lane * 4)); }
#pragma unroll
        for (int r = 0; r < 4; ++r) { const int m = m0 + r; const float* cs = CS0 + (size_t)row_batch(m) * D; float ss = 0.f;
#pragma unroll
            for (int q = 0; q < 4; ++q) { const int d = q * 256 + F.lane * 4;
                const f32x4 x = xv[r][q];
                ss += (x[0] * x[0] + x[1] * x[1]) + (x[2] * x[2] + x[3] * x[3]);
                const f16x4 av = cvt4(x * *(const f32x4*)(cs + d));
                if (m < MP) *tiled_ptr<f16x4>(A, m, d, D) = av; else *(f16x4*)(A + (size_t)m * D + d) = av; }
            ss = wave_sum(ss);
            if (F.lane == 0) rowss[m] = ss; }
    }
}
template <int O0, int O1, int O2, int O3, int O4, int O5, int O6, int O7>
__device__ __forceinline__ void tr_read8(unsigned base, f16x4 (&r)[8]) {
    asm volatile("ds_read_b64_tr_b16 %0, %8 offset:%9\n\tds_read_b64_tr_b16 %1, %8 offset:%10\n\tds_read_b64_tr_b16 %2, %8 offset:%11\n\tds_read_b64_tr_b16 %3, %8 offset:%12\n\t"
                 "ds_read_b64_tr_b16 %4, %8 offset:%13\n\tds_read_b64_tr_b16 %5, %8 offset:%14\n\tds_read_b64_tr_b16 %6, %8 offset:%15\n\tds_read_b64_tr_b16 %7, %8 offset:%16\n\ts_waitcnt lgkmcnt(0)"
                 : "=&v"(r[0]), "=&v"(r[1]), "=&v"(r[2]), "=&v"(r[3]), "=&v"(r[4]), "=&v"(r[5]), "=&v"(r[6]), "=&v"(r[7])
                 : "v"(base), "n"(O0), "n"(O1), "n"(O2), "n"(O3), "n"(O4), "n"(O5), "n"(O6), "n"(O7) : "memory");
}
__device__ __forceinline__ unsigned lds_addr(const LAS void* p) { return (unsigned)(unsigned long long)p; }
struct BandAttn { const f16* Z; int ldz, qcol, kcol, vcol; f16* O; int ldo, ocol; float* LSE; const float* sinks; int tiledO; };
constexpr int KS_STR = 72, VS_STR = 96;
constexpr int ATT_KS = 0, ATT_VS = 256 * KS_STR * 2;
__device__ __forceinline__ void band_attn_unit(ldsp_t lds, const BandAttn& P, int tokbase, int stride, int blk, int kvh) {
    const int tid = opaque_v(threadIdx.x), w = __builtin_amdgcn_readfirstlane(tid >> 6), lane = tid & 63, c = lane & 31, hh = lane >> 5;
    LAS f16* Ks = (LAS f16*)(lds + ATT_KS); LAS f16* Vs = (LAS f16*)(lds + ATT_VS);
    f16x8 qfa[2][4];
    { const int head_ = kvh * 4 + (w >> 1);
#pragma unroll
      for (int qt = 0; qt < 2; ++qt) { const int mr_ = tokbase + stride * (128 * blk + 64 * (w & 1) + 32 * qt + c);
#pragma unroll
          for (int ks = 0; ks < 4; ++ks) qfa[qt][ks] = *(const f16x8*)(P.Z + (size_t)mr_ * P.ldz + P.qcol + head_ * 64 + 16 * ks + 8 * hh); } }
#pragma unroll
    for (int i = 0; i < 4; ++i) {
        const int cid = tid + 512 * i, key = cid >> 3, ch = cid & 7, p = 128 * blk - 128 + key;
        f16x8 kv = {0, 0, 0, 0, 0, 0, 0, 0}, vv = {0, 0, 0, 0, 0, 0, 0, 0};
        if (p >= 0) { const f16* zr = P.Z + (size_t)(tokbase + stride * p) * P.ldz + kvh * 64 + 8 * ch; kv = *(const f16x8*)(zr + P.kcol); vv = *(const f16x8*)(zr + P.vcol); }
        *(LAS f16x8*)(Ks + key * KS_STR + 8 * ch) = kv;
        *(LAS f16x8*)(Vs + key * VS_STR + 8 * ch) = vv;
    }
    __syncthreads();
    const int g = w >> 1, qh = w & 1, head = kvh * 4 + g;
    const unsigned vlane = lds_addr(Vs) + (unsigned)((4 * hh + ((lane & 15) >> 2)) * (VS_STR * 2) + (16 * ((lane >> 4) & 1) + 4 * (lane & 3)) * 2);
    const float sink = P.sinks ? P.sinks[head] : -INFINITY;
    constexpr float SC = 0.125f, L2E = 1.4426950408889634f;
#pragma unroll
    for (int qt = 0; qt < 2; ++qt) {
        const int i0 = 64 * qh + 32 * qt;
        const int mrow = tokbase + stride * (128 * blk + i0 + c);
        f16x8 qf[4];
#pragma unroll
        for (int ks = 0; ks < 4; ++ks) qf[ks] = qt ? qfa[1][ks] : qfa[0][ks];
        f32x16 s[5];
#pragma unroll
        for (int kt = 0; kt < 5; ++kt) {
#pragma unroll
            for (int i = 0; i < 16; ++i) s[kt][i] = 0.f;
#pragma unroll
            for (int ks = 0; ks < 4; ++ks) {
                const f16x8 a = *(const LAS f16x8*)(Ks + (i0 + 32 * kt + c) * KS_STR + 16 * ks + 8 * hh);
                s[kt] = __builtin_amdgcn_mfma_f32_32x32x16_f16(a, qf[ks], s[kt], 0, 0, 0);
            }
        }
        float mx = -INFINITY;
        const int cm = c - 4 * hh;
#pragma unroll
        for (int i = 0; i < 16; ++i) { const int kb = (i & 3) + 8 * (i >> 2);
            s[0][i] = (kb >= cm) ? s[0][i] : -INFINITY; s[4][i] = (kb <= cm) ? s[4][i] : -INFINITY; }
        if (blk == 0) {
            asm volatile("" ::: "memory");
#pragma unroll
            for (int kt = 0; kt < 5; ++kt)
#pragma unroll
                for (int i = 0; i < 16; ++i) { const int kr = (i & 3) + 8 * (i >> 2) + 4 * hh; s[kt][i] = (i0 + 32 * kt + kr >= 128) ? s[kt][i] : -INFINITY; }
        }
#pragma unroll
        for (int kt = 0; kt < 5; ++kt)
#pragma unroll
            for (int i = 0; i < 16; ++i) mx = fmaxf(mx, s[kt][i]);
        mx = fmaxf(mx, __shfl_xor(mx, 32));
        mx = fmaxf(mx * SC, sink);
        constexpr float CE = SC * L2E; const float moff = mx * L2E;
        float sum = 0.f; f16x8 pf[5][2];
#pragma unroll
        for (int kt = 0; kt < 5; ++kt)
#pragma unroll
            for (int i = 0; i < 16; ++i) { const float pv = __builtin_amdgcn_exp2f(__builtin_fmaf(s[kt][i], CE, -moff)); sum += pv; pf[kt][i >> 3][i & 7] = (f16)pv; }
        sum += __shfl_xor(sum, 32);
        sum += __builtin_amdgcn_exp2f((sink - mx) * L2E);
        const float inv = __builtin_amdgcn_rcpf(sum);
        f32x16 o[2];
#pragma unroll
        for (int i = 0; i < 16; ++i) { o[0][i] = 0.f; o[1][i] = 0.f; }
        const unsigned vb = vlane + (unsigned)(i0 * (VS_STR * 2));
#define BA_PV(KT) { f16x4 r[8]; constexpr int B_ = (KT) * 32 * VS_STR * 2, S_ = 16 * VS_STR * 2, H_ = 8 * VS_STR * 2; \
            tr_read8<B_, B_ + H_, B_ + S_, B_ + S_ + H_, B_ + 64, B_ + 64 + H_, B_ + 64 + S_, B_ + 64 + S_ + H_>(vb, r); \
            o[0] = __builtin_amdgcn_mfma_f32_32x32x16_f16(cat4(r[0], r[1]), pf[KT][0], o[0], 0, 0, 0); o[0] = __builtin_amdgcn_mfma_f32_32x32x16_f16(cat4(r[2], r[3]), pf[KT][1], o[0], 0, 0, 0); \
            o[1] = __builtin_amdgcn_mfma_f32_32x32x16_f16(cat4(r[4], r[5]), pf[KT][0], o[1], 0, 0, 0); o[1] = __builtin_amdgcn_mfma_f32_32x32x16_f16(cat4(r[6], r[7]), pf[KT][1], o[1], 0, 0, 0); }
        BA_PV(0) BA_PV(1) BA_PV(2) BA_PV(3) BA_PV(4)
#undef BA_PV
#pragma unroll
        for (int dt = 0; dt < 2; ++dt) {
            const int ocol = P.ocol + head * 64 + 32 * dt + 4 * hh;
#pragma unroll
            for (int rg = 0; rg < 4; ++rg) { f32x4 v = {o[dt][4 * rg] * inv, o[dt][4 * rg + 1] * inv, o[dt][4 * rg + 2] * inv, o[dt][4 * rg + 3] * inv};
                f16x4* op = P.tiledO ? tiled_ptr<f16x4>(P.O, mrow, ocol + 8 * rg, P.ldo) : (f16x4*)(P.O + (size_t)mrow * P.ldo + ocol + 8 * rg);
                *op = cvt4(v); }
        }
        if (P.LSE && hh == 0) P.LSE[(size_t)mrow * 8 + head] = mx + __logf(sum);
    }
    __syncthreads();
}
__device__ __forceinline__ void kv_export(const f16* Z, int ldz, int kcol, int vcol, int m0, int nrows, float* out, int tid0, int nthr) {
    for (int i0 = tid0; i0 < nrows * 32; i0 += 8 * nthr) {
        f16x8 v[8];
#pragma unroll
        for (int j = 0; j < 8; ++j) { const int i = i0 + j * nthr, r = i >> 5, ch = i & 31, isv = ch >> 4, c8 = (ch & 15) * 8;
            v[j] = i < nrows * 32 ? *(const f16x8*)(Z + (size_t)(m0 + r) * ldz + (isv ? vcol : kcol) + c8) : (f16x8){0, 0, 0, 0, 0, 0, 0, 0}; }
#pragma unroll
        for (int j = 0; j < 8; ++j) { const int i = i0 + j * nthr, r = i >> 5, ch = i & 31, isv = ch >> 4, c8 = (ch & 15) * 8;
            if (i < nrows * 32) { float* o = out + (size_t)r * 256 + isv * 128 + c8;
                *(f32x4*)o = (f32x4){(float)v[j][0], (float)v[j][1], (float)v[j][2], (float)v[j][3]}; *(f32x4*)(o + 4) = (f32x4){(float)v[j][4], (float)v[j][5], (float)v[j][6], (float)v[j][7]}; } }
    }
}

__device__ __forceinline__ void gate_scan(const float* GATES, const float* bg, int m0, int h, int lane, LAS float* gb, LAS float* ga, LAS float* gcm, float& amax, float& bL, float& a0o, float& a1o) {
    const float* g0 = GATES + (size_t)(m0 + 2 * lane) * 16;
    const float ig0 = g0[h] + bg[h], ig1 = g0[16 + h] + bg[h];
    const float lf0 = logsigmoidf_(g0[8 + h] + bg[8 + h]), lf1 = logsigmoidf_(g0[24 + h] + bg[8 + h]);
    float s = lf0 + lf1;
#pragma unroll
    for (int o = 1; o < 64; o <<= 1) { const float t = __shfl_up(s, o); if (lane >= o) s += t; }
    const float b0 = (s - (lf0 + lf1)) + lf0, b1 = b0 + lf1;
    const float a0 = ig0 - b0, a1 = ig1 - b1;
    float mx = fmaxf(a0, a1);
#pragma unroll
    for (int o = 1; o < 64; o <<= 1) { const float t = __shfl_up(mx, o); if (lane >= o) mx = fmaxf(mx, t); }
    float ex = __shfl_up(mx, 1); if (lane == 0) ex = -INFINITY;
    const float c0 = fmaxf(ex, a0), c1 = fmaxf(c0, a1);
    gb[2 * lane] = b0; gb[2 * lane + 1] = b1; ga[2 * lane] = a0; ga[2 * lane + 1] = a1; gcm[2 * lane] = c0; gcm[2 * lane + 1] = c1;
    amax = __shfl(mx, 63); bL = __shfl(s, 63); a0o = a0; a1o = a1;
}
constexpr int X1_KS = 0, X1_VS = 18432, X1_G = 36864, X1_HEAD = 38912, X1_STR = 72;
__device__ __forceinline__ void mlstm_x1_unit(Frame& F, int e, int b, int ch, int hp) {
    const int tid = F.tid, w = F.wave, lane = F.lane, hg = w >> 2, wv = w & 3, gt = tid & 255, h = 2 * hp + hg;
    ldsp_t base = F.lds + hg * X1_HEAD;
    LAS f16* Ksm = (LAS f16*)(base + X1_KS); LAS f16* Vsm = (LAS f16*)(base + X1_VS);
    LAS float* gb = (LAS float*)(base + X1_G); LAS float* ga = gb + 128; LAS float* gcm = ga + 128; LAS float* gwk = gcm + 128;
    const f16* Z = WSP(f16, WS_Z); const float* GATES = WSP(float, WS_GATES); const float* bg = FIN(I_EBG) + e * 16;
    const int m0 = b * T + 128 * ch, idx = (b * 8 + h) * 64 + ch;
    float amax = 0.f, bL = 0.f;
    f16x8 kxa[4], vxa[4];
#pragma unroll
    for (int i = 0; i < 4; ++i) { const int cid = gt + 256 * i, s_ = cid >> 3, c8 = cid & 7; const f16* zr = Z + (size_t)(m0 + s_) * NEV + h * 64 + 8 * c8;
        kxa[i] = *(const f16x8*)(zr + 1280); vxa[i] = *(const f16x8*)(zr + 1792); }
    if (wv == 0) { float a0, a1; gate_scan(GATES, bg, m0, h, lane, gb, ga, gcm, amax, bL, a0, a1); gwk[2 * lane] = __expf(a0 - amax); gwk[2 * lane + 1] = __expf(a1 - amax); }
    __syncthreads();
#pragma unroll
    for (int i = 0; i < 4; ++i) {
        const int cid = gt + 256 * i, s_ = cid >> 3, c8 = cid & 7;
        const f16x8 kx = kxa[i], vx = vxa[i]; const float wk = gwk[s_];
        f16x8 ks;
#pragma unroll
        for (int q = 0; q < 8; ++q) ks[q] = (f16)((float)kx[q] * wk);
        *(LAS f16x8*)(Ksm + s_ * X1_STR + 8 * c8) = ks; *(LAS f16x8*)(Vsm + s_ * X1_STR + 8 * c8) = vx;
    }
    __syncthreads();
    const int fr = lane & 15, fq = lane >> 4;
    const unsigned lof = (unsigned)((8 * fq + (fr >> 2)) * (X1_STR * 2) + 4 * (fr & 3) * 2);
    const unsigned vaddr = lds_addr(Vsm) + lof + (unsigned)(16 * wv * 2), kaddr = lds_addr(Ksm) + lof;
    constexpr int R4 = 4 * X1_STR * 2, R32 = 32 * X1_STR * 2;
    f16x4 rv[8];
    tr_read8<0, R4, R32, R32 + R4, 2 * R32, 2 * R32 + R4, 3 * R32, 3 * R32 + R4>(vaddr, rv);
    float* DC = WSP(float, WS_DC) + (size_t)idx * 4096;
    f32x4 accn = {0.f, 0.f, 0.f, 0.f};
    f16x8 ones;
#pragma unroll
    for (int q = 0; q < 8; ++q) ones[q] = (fr == 0) ? (f16)1.0f : (f16)0.0f;
#define X1_TILE(DKT) { f16x4 rk[8]; tr_read8<(DKT) * 32, (DKT) * 32 + R4, (DKT) * 32 + R32, (DKT) * 32 + R32 + R4, (DKT) * 32 + 2 * R32, (DKT) * 32 + 2 * R32 + R4, (DKT) * 32 + 3 * R32, (DKT) * 32 + 3 * R32 + R4>(kaddr, rk); \
        f32x4 acc = {0.f, 0.f, 0.f, 0.f}; \
        _Pragma("unroll") for (int ks = 0; ks < 4; ++ks) { const f16x8 bf = cat4(rk[2 * ks], rk[2 * ks + 1]); acc = __builtin_amdgcn_mfma_f32_16x16x32_f16(cat4(rv[2 * ks], rv[2 * ks + 1]), bf, acc, 0, 0, 0); \
            if ((DKT) == wv) accn = __builtin_amdgcn_mfma_f32_16x16x32_f16(ones, bf, accn, 0, 0, 0); } \
        _Pragma("unroll") for (int r = 0; r < 4; ++r) DC[(16 * wv + 4 * fq + r) * 64 + 16 * (DKT) + fr] = acc[r]; }
    X1_TILE(0) X1_TILE(1) X1_TILE(2) X1_TILE(3)
#undef X1_TILE
    if (fq == 0) WSP(float, WS_DN)[(size_t)idx * 64 + 16 * wv + fr] = accn[0];
    if (gt == 0) { float* SC = WSP(float, WS_SC); SC[idx] = bL + amax; SC[1024 + idx] = bL; }
    __syncthreads();
}
__device__ __forceinline__ void mlstm_scan(Frame& F, int e) {
    const int gid0 = F.bid * 512; if (gid0 >= 16 * 4160) return;
    const int bh0 = gid0 / 4160;
    const float* SC = WSP(float, WS_SC); float* MPV = WSP(float, WS_SC) + 2048;
    LAS float* sc = (LAS float*)F.lds;
    if (F.tid < 256) { const int hw = F.tid >> 7, c = (F.tid >> 1) & 63, k = F.tid & 1, bhs = bh0 + hw; sc[F.tid] = bhs < 16 ? SC[k * 1024 + bhs * 64 + c] : 0.f; }
    __syncthreads();
    const int gid = gid0 + F.tid;
    if (gid < 16 * 4160) {
        const int bh = gid / 4160, el = gid - bh * 4160; const bool isc = el < 4096;
        const float* src = isc ? WSP(float, WS_DC) + (size_t)bh * 64 * 4096 + el : WSP(float, WS_DN) + (size_t)bh * 64 * 64 + (el - 4096);
        const int sstr = isc ? 4096 : 64;
        f16* cp = WSP(f16, WS_CP) + (size_t)bh * 64 * 4096 + el; float* np = WSP(float, WS_NP) + (size_t)bh * 64 * 64 + (el - 4096);
        const LAS float* scb = sc + (bh - bh0) * 128;
        float dvv[64];
#pragma unroll
        for (int c = 0; c < 64; ++c) dvv[c] = src[(size_t)c * sstr];
        float st = 0.f, mst = 0.f;
#pragma unroll
        for (int c = 0; c < 64; ++c) {
            const float mloc = scb[2 * c], bL = scb[2 * c + 1];
            if (isc) cp[(size_t)c * 4096] = (f16)st; else np[c * 64] = st;
            if (el == 0) MPV[bh * 64 + c] = mst;
            const float mnew = fmaxf(bL + mst, mloc);
            st = __expf(bL + mst - mnew) * st + __expf(mloc - mnew) * dvv[c]; mst = mnew;
        }
        const int b = bh >> 3, h = bh & 7;
        if (isc) { const int dv = el >> 6, dk = el & 63; F.out[O_BCP + ((size_t)((e * 2 + b) * 8 + h) * 64 + dk) * 64 + dv] = st; }
        else F.out[O_BNP + (size_t)((e * 2 + b) * 8 + h) * 64 + (el - 4096)] = st;
        if (el == 0) F.out[O_BMP + (e * 2 + b) * 8 + h] = mst;
    }
    __syncthreads();
}
constexpr int X3_KR = 0, X3_VS = 18432, X3_G = 43008, X3_HEAD = 45056;
__device__ __forceinline__ void mlstm_x3_unit(Frame& F, int e, int b, int ch, int hp) {
    const int tid = F.tid, w = F.wave, lane = F.lane, hg = w >> 2, tt = w & 3, gt = tid & 255, h = 2 * hp + hg, c = lane & 31, hh = lane >> 5;
    ldsp_t base = F.lds + hg * X3_HEAD;
    LAS f16* Kr = (LAS f16*)(base + X3_KR); LAS f16* Vs = (LAS f16*)(base + X3_VS);
    LAS float* gb = (LAS float*)(base + X3_G); LAS float* ga = gb + 128; LAS float* gcm = ga + 128; LAS float* npv = gcm + 128;
    const f16* Z = WSP(f16, WS_Z); const float* GATES = WSP(float, WS_GATES); const float* bg = FIN(I_EBG) + e * 16;
    const int m0 = b * T + 128 * ch, idx = (b * 8 + h) * 64 + ch;
    f16x8 kxa[4], vxa[4];
#pragma unroll
    for (int i = 0; i < 4; ++i) { const int cid = gt + 256 * i, s = cid >> 3, c8 = cid & 7; const f16* zr = Z + (size_t)(m0 + s) * NEV + h * 64 + 8 * c8;
        kxa[i] = *(const f16x8*)(zr + 1280); vxa[i] = *(const f16x8*)(zr + 1792); }
    if (tt == 0) { float t0, t1, t2, t3; gate_scan(GATES, bg, m0, h, lane, gb, ga, gcm, t0, t1, t2, t3); }
#pragma unroll
    for (int i = 0; i < 4; ++i) {
        const int cid = gt + 256 * i, s = cid >> 3, c8 = cid & 7;
        const f16x8 kx = kxa[i], vx = vxa[i];
        *(LAS f16x8*)(Kr + s * KS_STR + 8 * c8) = kx;
        *(LAS f16x8*)(Vs + s * VS_STR + 8 * c8) = vx;
    }
    if (gt < 64) npv[gt] = WSP(float, WS_NP)[(size_t)idx * 64 + gt];
    __syncthreads();
    const float mst = WSP(float, WS_SC)[2048 + idx];
    const int t = 32 * tt + c, mrow = m0 + t;
    const float bt = gb[t], mm = fmaxf(mst, gcm[t]), mt = bt + mm;
    f16x8 qf[4];
#pragma unroll
    for (int ks = 0; ks < 4; ++ks) qf[ks] = *(const f16x8*)(Z + (size_t)mrow * NEV + 768 + h * 64 + 16 * ks + 8 * hh);
    f32x16 num[2];
#pragma unroll
    for (int i = 0; i < 16; ++i) { num[0][i] = 0.f; num[1][i] = 0.f; }
    float qsum = 0.f;
    const unsigned vlane = lds_addr(Vs) + (unsigned)((4 * hh + ((lane & 15) >> 2)) * (VS_STR * 2) + (16 * ((lane >> 4) & 1) + 4 * (lane & 3)) * 2);
    for (int st = 0; st <= tt; ++st) {
        f32x16 sa;
#pragma unroll
        for (int i = 0; i < 16; ++i) sa[i] = 0.f;
#pragma unroll
        for (int ks = 0; ks < 4; ++ks) { const f16x8 a = *(const LAS f16x8*)(Kr + (32 * st + c) * KS_STR + 16 * ks + 8 * hh); sa = __builtin_amdgcn_mfma_f32_32x32x16_f16(a, qf[ks], sa, 0, 0, 0); }
        f16x8 wf[2];
        const bool diag = (st == tt);
        constexpr float L2E_ = 1.4426950408889634f; const float mml = mm * L2E_;
#pragma unroll
        for (int rg = 0; rg < 4; ++rg) {
            const int s0 = 32 * st + 8 * rg + 4 * hh;
            const f32x4 g4 = *(const LAS f32x4*)(ga + s0);
#pragma unroll
            for (int q = 0; q < 4; ++q) {
                const int i = 4 * rg + q;
                float dd = __builtin_amdgcn_exp2f(__builtin_fmaf(g4[q], L2E_, -mml));
                if (diag) dd = (s0 + q <= t) ? dd : 0.f;
                const float wv_ = sa[i] * dd;
                qsum += wv_; wf[i >> 3][i & 7] = (f16)wv_;
            }
        }
        { f16x4 r[8]; constexpr int S_ = 16 * VS_STR * 2, H_ = 8 * VS_STR * 2;
          tr_read8<0, H_, S_, S_ + H_, 64, 64 + H_, 64 + S_, 64 + S_ + H_>(vlane + (unsigned)(st * 32 * VS_STR * 2), r);
          num[0] = __builtin_amdgcn_mfma_f32_32x32x16_f16(cat4(r[0], r[1]), wf[0], num[0], 0, 0, 0); num[0] = __builtin_amdgcn_mfma_f32_32x32x16_f16(cat4(r[2], r[3]), wf[1], num[0], 0, 0, 0);
          num[1] = __builtin_amdgcn_mfma_f32_32x32x16_f16(cat4(r[4], r[5]), wf[0], num[1], 0, 0, 0); num[1] = __builtin_amdgcn_mfma_f32_32x32x16_f16(cat4(r[6], r[7]), wf[1], num[1], 0, 0, 0); }
    }
    qsum += __shfl_xor(qsum, 32);
    f32x16 ni[2];
#pragma unroll
    for (int i = 0; i < 16; ++i) { ni[0][i] = 0.f; ni[1][i] = 0.f; }
    const f16* CP = WSP(f16, WS_CP) + (size_t)idx * 4096;
#pragma unroll
    for (int dt = 0; dt < 2; ++dt)
#pragma unroll
        for (int ks = 0; ks < 4; ++ks) { const f16x8 a = *(const f16x8*)(CP + (32 * dt + c) * 64 + 16 * ks + 8 * hh); ni[dt] = __builtin_amdgcn_mfma_f32_32x32x16_f16(a, qf[ks], ni[dt], 0, 0, 0); }
    float qni = 0.f;
#pragma unroll
    for (int ks = 0; ks < 4; ++ks)
#pragma unroll
        for (int j = 0; j < 8; ++j) qni += (float)qf[ks][j] * npv[16 * ks + 8 * hh + j];
    qni += __shfl_xor(qni, 32);
    const float inter = __expf(mst - mm);
    const float qn = qsum + inter * qni, invd = __builtin_amdgcn_rcpf(fmaxf(fabsf(qn), __expf(-mt)));
    float ssq = 0.f;
#pragma unroll
    for (int dt = 0; dt < 2; ++dt)
#pragma unroll
        for (int i = 0; i < 16; ++i) { const float hv = (num[dt][i] + inter * ni[dt][i]) * invd; num[dt][i] = hv; ssq += hv * hv; }
    ssq += __shfl_xor(ssq, 32);
    const float rinv = rsqrtf(ssq * (1.0f / 64.0f) + EPS);
    const float* hgain = FIN(I_EHG) + (e * 8 + h) * 64;
    f16* O = WSP(f16, WS_O);
#pragma unroll
    for (int dt = 0; dt < 2; ++dt)
#pragma unroll
        for (int rg = 0; rg < 4; ++rg) {
            const int dv0 = 32 * dt + 8 * rg + 4 * hh;
            const f16x4 bo = *(const f16x4*)(Z + (size_t)mrow * NEV + 2304 + h * 64 + dv0); const f32x4 gn = *(const f32x4*)(hgain + dv0);
            f32x4 y;
#pragma unroll
            for (int q = 0; q < 4; ++q) y[q] = num[dt][4 * rg + q] * rinv * gn[q] * sigmoidf_((float)bo[q]);
            *tiled_ptr<f16x4>(O, mrow, 512 + h * 64 + dv0, D) = cvt4(y);
        }
    __syncthreads();
}

constexpr int DA_QS = 0, DA_KC = 1024, DA_VC = 36352, DA_SC = 69376, DA_RD = 71488, DA_KSTR = 68;
struct DecKV { f32x4 k[4], v[4]; };
__device__ __forceinline__ void dec_load(const Frame& F, const float* cache, int dil, int kvh, DecKV& r) {
#pragma unroll
    for (int i = 0; i < 4; ++i) { const int cid = F.tid + 512 * i, j = cid >> 4, c4 = cid & 15;
        const float* src = cache + (size_t)(dil * j) * 256 + kvh * 64 + 4 * c4;
        r.k[i] = *(const f32x4*)src; r.v[i] = *(const f32x4*)(src + 128); }
}
__device__ __forceinline__ void dec_attn(Frame& F, const DecKV& kv, int kvh, const f16* zrow, int qcol, int kcol, int vcol, const float* sinks, float& o_out, float& lse_out) {
    const int tid = F.tid, lane = F.lane, w = F.wave;
    LAS float* qs = (LAS float*)(F.lds + DA_QS); LAS float* Kc = (LAS float*)(F.lds + DA_KC); LAS float* Vc = (LAS float*)(F.lds + DA_VC);
    LAS float* sc = (LAS float*)(F.lds + DA_SC); LAS float* rd = (LAS float*)(F.lds + DA_RD);
#pragma unroll
    for (int i = 0; i < 4; ++i) {
        const int cid = tid + 512 * i, j = cid >> 4, c4 = cid & 15;
        *(LAS f32x4*)(Kc + j * DA_KSTR + 4 * c4) = kv.k[i];
        *(LAS f32x4*)(Vc + j * 64 + 4 * c4) = kv.v[i];
    }
    if (tid < 64) { Kc[128 * DA_KSTR + tid] = (float)zrow[kcol + kvh * 64 + tid]; Vc[128 * 64 + tid] = (float)zrow[vcol + kvh * 64 + tid]; }
    if (tid < 256) qs[tid] = (float)zrow[qcol + kvh * 256 + tid];
    __syncthreads();
    for (int jj = tid; jj < 516; jj += 512) {
        const int j = jj >> 2, g = jj & 3; f32x4 s4 = {0.f, 0.f, 0.f, 0.f};
#pragma unroll
        for (int d = 0; d < 64; d += 4) s4 = s4 + *(const LAS f32x4*)(qs + g * 64 + d) * *(const LAS f32x4*)(Kc + j * DA_KSTR + d);
        sc[g * 132 + j] = ((s4[0] + s4[1]) + (s4[2] + s4[3])) * 0.125f;
    }
    __syncthreads();
    if (w < 4) {
        const float sk = sinks ? sinks[kvh * 4 + w] : -INFINITY;
        const float v0 = sc[w * 132 + lane], v1 = sc[w * 132 + 64 + lane], v2 = lane == 0 ? sc[w * 132 + 128] : -INFINITY;
        float mx = wave_max(fmaxf(fmaxf(v0, v1), v2)); mx = fmaxf(mx, sk);
        const float p0 = __expf(v0 - mx), p1 = __expf(v1 - mx), p2 = lane == 0 ? __expf(v2 - mx) : 0.f;
        const float sum = wave_sum(p0 + p1 + p2) + __expf(sk - mx);
        sc[w * 132 + lane] = p0; sc[w * 132 + 64 + lane] = p1; if (lane == 0) { sc[w * 132 + 128] = p2; rd[w] = sum; rd[4 + w] = mx; }
    }
    __syncthreads();
    if (tid < 256) {
        const int g = tid >> 6, d = tid & 63; float o = 0.f;
#pragma unroll 4
        for (int j = 0; j < 128; j += 4) { const f32x4 p4 = *(const LAS f32x4*)(sc + g * 132 + j);
            o += p4[0] * Vc[j * 64 + d]; o += p4[1] * Vc[(j + 1) * 64 + d]; o += p4[2] * Vc[(j + 2) * 64 + d]; o += p4[3] * Vc[(j + 3) * 64 + d]; }
        o += sc[g * 132 + 128] * Vc[128 * 64 + d];
        const float den = rd[g]; o_out = o * __builtin_amdgcn_rcpf(den); lse_out = rd[4 + g] + __logf(den);
    }
    __syncthreads();
}
__device__ __forceinline__ void sample_attn_even(Frame& F, int e, int s, int kvh) {
    const f16* zrow = WSP(f16, WS_Z) + (size_t)(MP + s) * NEV;
    float o = 0.f, lse = 0.f;
    DecKV kv; dec_load(F, FIN(I_CA) + ((size_t)e * NS + s) * 128 * 256, 1, kvh, kv);
    dec_attn(F, kv, kvh, zrow, 0, 512, 640, FIN(I_ESK) + e * 8, o, lse);
    if (F.tid < 256) WSP(f16, WS_O)[(size_t)(MP + s) * D + kvh * 256 + F.tid] = (f16)o;
    if (F.tid < 128) { const int isv = F.tid >> 6, d = F.tid & 63;
        F.out[O_AKVS + (((size_t)e * NS + s) * 128 + 127) * 256 + isv * 128 + kvh * 64 + d] = (float)zrow[(isv ? 640 : 512) + kvh * 64 + d]; }
}
__device__ __forceinline__ void sample_attn_odd(Frame& F, int oi, int s, int kvh) {
    const f16* zrow = WSP(f16, WS_Z) + (size_t)(MP + s) * NOD;
    float o[3] = {0.f, 0.f, 0.f}, lse[3] = {0.f, 0.f, 0.f};
    DecKV kv0, kv1, kv2;
    dec_load(F, FIN(I_CC1) + ((size_t)oi * NS + s) * 128 * 256, 1, kvh, kv0);
    dec_load(F, FIN(I_CC2) + ((size_t)oi * NS + s) * 512 * 256, 4, kvh, kv1);
    dec_load(F, FIN(I_CC3) + ((size_t)oi * NS + s) * 2048 * 256, 16, kvh, kv2);
    dec_attn(F, kv0, kvh, zrow, 0, 512, 640, nullptr, o[0], lse[0]);
    dec_attn(F, kv1, kvh, zrow, 768, 1280, 1408, nullptr, o[1], lse[1]);
    dec_attn(F, kv2, kvh, zrow, 1536, 2048, 2176, nullptr, o[2], lse[2]);
    if (F.tid < 256) {
        const float mx = fmaxf(fmaxf(lse[0], lse[1]), lse[2]);
        const float w0 = __expf(lse[0] - mx), w1 = __expf(lse[1] - mx), w2 = __expf(lse[2] - mx);
        WSP(f16, WS_O)[(size_t)(MP + s) * 512 + kvh * 256 + F.tid] = (f16)((w0 * o[0] + w1 * o[1] + w2 * o[2]) / (w0 + w1 + w2));
    }
    if (F.tid < 384) { const int g = F.tid >> 7, r = F.tid & 127, isv = r >> 6, d = r & 63;
        const int W = g == 0 ? 128 : (g == 1 ? 512 : 2048); const size_t ob = g == 0 ? O_C1S : (g == 1 ? O_C2S : O_C3S);
        F.out[ob + (((size_t)oi * NS + s) * W + (W - 1)) * 256 + isv * 128 + kvh * 64 + d] = (float)zrow[768 * g + (isv ? 640 : 512) + kvh * 64 + d]; }
}
__device__ __forceinline__ void sample_mlstm(Frame& F, int e, int s) {
    const int h = F.wave, lane = F.lane, m = MP + s;
    const f16* zrow = WSP(f16, WS_Z) + (size_t)m * NEV; const float* gr = WSP(float, WS_GATES) + (size_t)m * 16; const float* bg = FIN(I_EBG) + e * 16;
    const float q = (float)zrow[768 + h * 64 + lane], k = (float)zrow[1280 + h * 64 + lane], v = (float)zrow[1792 + h * 64 + lane], bo = (float)zrow[2304 + h * 64 + lane];
    const float ig = gr[h] + bg[h], lf = logsigmoidf_(gr[8 + h] + bg[8 + h]);
    const size_t sh = ((size_t)e * NS + s) * 8 + h;
    const float mst = FIN(I_SBM)[sh], nst = FIN(I_SBN)[sh * 64 + lane];
    const float mt = fmaxf(lf + mst, ig), dsc = __expf(ig - mt), inter = __expf(lf + mst - mt);
    const float qk = wave_sum(q * k), qn_i = wave_sum(q * nst);
    const float* C = FIN(I_SBC) + sh * 4096; float* Co = F.out + O_BCS + sh * 4096;
    float qc = 0.f;
    float cvv[64];
#pragma unroll
    for (int dk = 0; dk < 64; ++dk) cvv[dk] = __builtin_nontemporal_load(C + dk * 64 + lane);
#pragma unroll
    for (int dk = 0; dk < 64; ++dk) {
        const float cv = cvv[dk], qd = __shfl(q, dk), kd = __shfl(k, dk);
        qc += qd * cv; Co[dk * 64 + lane] = inter * cv + dsc * kd * v;
    }
    const float wgt = qk * dsc, num = wgt * v + inter * qc, qn = wgt + inter * qn_i;
    const float hv = num / fmaxf(fabsf(qn), __expf(-mt));
    const float rinv = rsqrtf(wave_sum(hv * hv) * (1.0f / 64.0f) + EPS);
    WSP(f16, WS_O)[(size_t)m * D + 512 + h * 64 + lane] = (f16)(hv * rinv * FIN(I_EHG)[(e * 8 + h) * 64 + lane] * sigmoidf_(bo));
    F.out[O_BNS + sh * 64 + lane] = inter * nst + dsc * k;
    if (lane == 0) F.out[O_BMS + sh] = mt;
}

__device__ __forceinline__ void phase_e1(Frame& F, int e, int tmask) {
    BandAttn P{WSP(f16, WS_Z), NEV, 0, 512, 640, WSP(f16, WS_O), D, 0, nullptr, FIN(I_ESK) + e * 8, 1};
    for (int u = F.bid; u < 1152; u += F.G) {
        if (u < 256) { if (!(tmask & 1)) continue; const int kvh = u & 1, blk = (u >> 1) & 63, b = u >> 7;
            band_attn_unit(F.lds, P, b * T, 1, blk, kvh);
            if (blk == 63 && kvh == 0) kv_export(P.Z, NEV, 512, 640, b * T + T - 128, 128, F.out + O_AKVP + (size_t)(e * 2 + b) * 128 * 256, F.tid, 512);
        } else if (u < 768) { if (!(tmask & 2)) continue; const int v = u - 256; mlstm_x1_unit(F, e, v >> 8, (v >> 2) & 63, v & 3); }
        else if (u < 1024) { if (!(tmask & 4)) continue; const int v = u - 768; sample_attn_even(F, e, v >> 1, v & 1); }
        else { if (!(tmask & 8)) continue; sample_mlstm(F, e, u - 1024); }
    }
}
__device__ __forceinline__ void phase_e3(Frame& F, int e) {
    for (int u = F.bid; u < 512; u += F.G) mlstm_x3_unit(F, e, u >> 8, (u >> 2) & 63, u & 3);
}
__device__ __forceinline__ void phase_o1(Frame& F, int oi, int tmask) {
    const f16* Z = WSP(f16, WS_Z);
    for (int u = F.bid; u < 768 + 256 + 42; u += F.G) {
        if (u < 768) {
            if (!(tmask & 1)) continue;
            const int g = u >> 8, v = u & 255, kvh = v & 1, r = v >> 1;
            const int dil = g == 0 ? 1 : (g == 1 ? 4 : 16), nblk = 64 / dil;
            const int b = r >> 6, rr = r & 63, res = rr / nblk, blk = rr % nblk;
            BandAttn P{Z, NOD, 768 * g, 768 * g + 512, 768 * g + 640, WSP(f16, WS_OG) + (size_t)g * MP * 512, 512, 0, WSP(float, WS_LSE) + (size_t)g * MP * 8, nullptr, 0};
            band_attn_unit(F.lds, P, b * T + res, dil, blk, kvh);
        } else if (u < 1024) { if (!(tmask & 4)) continue; const int v = u - 768; sample_attn_odd(F, oi, v >> 1, v & 1); }
        else {
            if (!(tmask & 16)) continue;
            const int v = u - 1024; int g, q; if (v < 2) { g = 0; q = v; } else if (v < 10) { g = 1; q = v - 2; } else { g = 2; q = v - 10; }
            const int W = 128 << (2 * g), per = W / 128, b = q / per, part = q % per;
            const size_t ob = g == 0 ? O_C1P : (g == 1 ? O_C2P : O_C3P);
            kv_export(Z, NOD, 768 * g + 512, 768 * g + 640, b * T + T - W + part * 128, 128, F.out + ob + ((size_t)(oi * 2 + b) * W + part * 128) * 256, F.tid, 512);
        }
    }
}
__device__ __forceinline__ void phase_o2(Frame& F) {
    const f16* OG = WSP(f16, WS_OG); const float* LSE = WSP(float, WS_LSE); f16* O = WSP(f16, WS_O);
    for (int i0 = F.bid; i0 < MP / 8; i0 += 2 * F.G) {
        size_t m[2]; bool ok[2]; float l0[2], l1[2], l2[2]; f16x8 a[2], b[2], c[2];
        const int c8 = F.tid & 63, hd = c8 >> 3;
#pragma unroll
        for (int j = 0; j < 2; ++j) { const int ib = i0 + j * F.G; ok[j] = ib < MP / 8; const int ic = ok[j] ? ib : i0;
            m[j] = (size_t)((ic & 7) * (MP / 64) + (ic >> 3)) * 8 + (F.tid >> 6);
            l0[j] = LSE[m[j] * 8 + hd]; l1[j] = LSE[(size_t)MP * 8 + m[j] * 8 + hd]; l2[j] = LSE[(size_t)2 * MP * 8 + m[j] * 8 + hd];
            a[j] = *(const f16x8*)(OG + m[j] * 512 + c8 * 8); b[j] = *(const f16x8*)(OG + (size_t)MP * 512 + m[j] * 512 + c8 * 8); c[j] = *(const f16x8*)(OG + (size_t)2 * MP * 512 + m[j] * 512 + c8 * 8); }
#pragma unroll
        for (int j = 0; j < 2; ++j) {
            const float mx = fmaxf(fmaxf(l0[j], l1[j]), l2[j]); float w0 = __expf(l0[j] - mx), w1 = __expf(l1[j] - mx), w2 = __expf(l2[j] - mx); const float inv = 1.0f / (w0 + w1 + w2);
            w0 *= inv; w1 *= inv; w2 *= inv;
            f16x8 o;
#pragma unroll
            for (int q = 0; q < 8; ++q) o[q] = (f16)(w0 * (float)a[j][q] + w1 * (float)b[j][q] + w2 * (float)c[j][q]);
            if (ok[j]) *tiled_ptr<f16x8>(O, (int)m[j], c8 * 8, 512) = o;
        }
    }
}
__device__ __forceinline__ void phase_final(Frame& F) {
    const f16* X = WSP(f16, WS_X); const float* rss = (const float*)(F.ws + RSS_OFF) + (size_t)12 * MALL; const float* fg = FIN(I_FG);
    f32x4 g[4];
#pragma unroll
    for (int q = 0; q < 4; ++q) g[q] = *(const f32x4*)(fg + q * 256 + F.lane * 4);
    for (int m0 = F.bid * 8 + F.wave; m0 < MALL; m0 += F.G * 32) {
        f16x4 xh[4][4]; float rs[4];
#pragma unroll
        for (int j = 0; j < 4; ++j) { const int m = m0 + j * F.G * 8 < MALL ? m0 + j * F.G * 8 : m0; rs[j] = rss[m];
#pragma unroll
            for (int q = 0; q < 4; ++q) xh[j][q] = *(const f16x4*)(X + (size_t)m * D + q * 256 + F.lane * 4); }
#pragma unroll
        for (int j = 0; j < 4; ++j) { const int m = m0 + j * F.G * 8; if (m < MALL) { const float r = rsqrtf(rs[j] * (1.0f / D) + EPS);
#pragma unroll
            for (int q = 0; q < 4; ++q) { const f32x4 x = {(float)xh[j][q][0], (float)xh[j][q][1], (float)xh[j][q][2], (float)xh[j][q][3]};
                __builtin_nontemporal_store(x * r * g[q], (f32x4*)(F.out + O_Y + (size_t)m * D + q * 256 + F.lane * 4)); } } }
    }
}

struct Args;
__device__ __forceinline__ bool phase_enter(Frame& F, const Args& args);
#define REP(bit) _Pragma("unroll 1") for (int rep_ = 0; rep_ < ((PROBE_DUP & (bit)) ? 2 : 1); ++rep_)
#ifndef P_MASK
#define P_MASK 0
#endif
constexpr bool P_SK = !(P_MASK & 1), P_MIX = !(P_MASK & 2), P_Z = !(P_MASK & 4), P_RES = !(P_MASK & 8), P_SW = !(P_MASK & 16), P_PR = !(P_MASK & 32), P_E1 = !(P_MASK & 64), P_E3 = !(P_MASK & 128), P_O1 = !(P_MASK & 256);
struct Args { const float* in[N_IN]; float* out; unsigned char* ws; int ph_lo, ph_hi; };
constexpr int PH_LAYER0 = 4, PH_PER_LAYER = 9, PH_FINAL = PH_LAYER0 + 4 * PH_PER_LAYER, N_PHASES = PH_FINAL + 1;

__device__ __forceinline__ bool phase_enter(Frame& F, const Args& args) {
    F.tid = opaque_v(threadIdx.x); F.lane = F.tid & 63; F.wave = __builtin_amdgcn_readfirstlane(F.tid >> 6);
    F.out = opaque_p(args.out); F.ws = opaque_p(args.ws);
    return true;
}
__global__ void __launch_bounds__(512, 2) fwd_kernel(Args args) {
    extern __shared__ __attribute__((aligned(16))) unsigned char lds_raw[];
    Frame F;
    F.lds = (ldsp_t)lds_raw; F.tid = threadIdx.x; F.lane = F.tid & 63; F.wave = __builtin_amdgcn_readfirstlane(F.tid >> 6); F.G = gridDim.x; F.bid = blockIdx.x;
    F.out = args.out; F.ws = args.ws;
    volatile LAS unsigned* MISC = (volatile LAS unsigned*)(F.lds + MISC_OFF);
    if (F.tid < 32) MISC[F.tid] = 0u;
    __syncthreads();
    XcdBarrier bar = xcd_barrier_post((unsigned*)(F.ws + WS_CTL) + CW_BAR, MISC + 8);
    const int lo = args.ph_lo, hi = args.ph_hi;
    const CopyQ CQ{args.in[I_CC3], args.in[I_CC2], args.in[I_CA], args.in[I_CC1], args.out, (unsigned*)(args.ws + WS_CTL) + CW_Q};
#define IN(k) (lo <= (k) && (k) < hi && phase_enter(F, args))
#define SEAM(k) do { if (IN((k) + 1)) { xcd_barrier(bar, CQ); if constexpr ((PROBE_DUP & 64) != 0) xcd_barrier(bar, CQ); } } while (0)
#define LSEAM(k) do { if (IN((k) + 1)) { if (fastp) xcc_barrier(bar, CQ); else xcd_barrier(bar, CQ); } } while (0)
    unsigned fastp = 0u;
    float* rowss = (float*)(F.ws + RSS_OFF);

    _Pragma("unroll 1") for (int prep_ = 0; prep_ < ((PROBE_DUP & 32) ? 2 : 1); ++prep_) {
    if (IN(0)) { REP(1) { if constexpr (P_PR) phase_pr0(F, 24, 28, true, nullptr); } SEAM(0);
        if (MK_N_LAUNCHES == 1 && hi == N_PHASES && MISC[8 + 10] != 0u) { fastp = 1u; F.bid = (int)(MISC[8 + 12] * 8u + bar.x); } }
    if (IN(1)) {
        pg8::Gemm g{WSP(f16, WS_AC), WSP(f16, WS_WMOD), 256, 4 * NMODC, D}; pg8::StaticOrder S; S.init(256, 4 * NMODC, F.G, F.bid);
        EpiMod E{WSP(float, WS_CS), WSP(float, WS_GT), WSP(f16, WS_SHA), FIN(I_BMOD), FIN(I_NG), WSP(float, WS_RCS)};
        if constexpr (P_PR) pg8::gemm_phase<EpiMod, pg8::StaticOrder>(F.lds, g, S, E);
        if constexpr (P_PR) { phase_enter(F, args); phase_pr0(F, 0, 24, false, (unsigned*)(F.ws + WS_CTL) + CW_Q + 128); }
        SEAM(1);
    }
    if (IN(3)) {
        pg8::Gemm g{WSP(f16, WS_SHA), WSP(f16, WS_WIN), 256 * NSITE, NWIN, D}; pg8::DiagOrder S{F.G, F.bid};
        EpiBias E{WSP(float, WS_BW)};
        if constexpr (P_PR) pg8::gemm_phase<EpiBias, pg8::DiagOrder>(F.lds, g, S, E);
        if constexpr (P_PR) { phase_enter(F, args); phase_pr2(F); }
        SEAM(3);
    }
    }
    for (int l = 0; l < 4; ++l) {
        const int pb = PH_LAYER0 + PH_PER_LAYER * l, s0 = 3 * l; const bool even = (l & 1) == 0; const int ei = l >> 1;
#pragma unroll 1
        for (int ffn = 0; ffn < 2; ++ffn) {
            if (ffn == 1) {
                if (IN(pb + 2)) {
                    const int so = site_off(s0 + 1), N = even ? NEV : NOD;
                    pg8::Gemm g{WSP(f16, WS_A), WSP(f16, WS_WIN) + (size_t)so * D, MP, N, D}; pg8::StaticOrder S; S.init(MP, N, F.G, F.bid);
                    if (even) { EpiZ<true> E{rowss + (size_t)(s0 + 1) * MALL, WSP(float, WS_BW) + so, WSP(f16, WS_Z), WSP(float, WS_GATES)};
                        if constexpr (P_Z) pg8::gemm_phase<EpiZ<true>, pg8::StaticOrder>(F.lds, g, S, E);
                        if constexpr ((PROBE_DUP & 128) != 0) { phase_enter(F, args); pg8::gemm_phase<EpiZ<true>, pg8::StaticOrder>(F.lds, g, S, E); }
                        if constexpr (P_SK) skinny_phase<false, D>(F.lds, g.A + (size_t)MP * D, g.Bt, N, E, F.G, F.bid, S.nwg); }
                    else { EpiZ<false> E{rowss + (size_t)(s0 + 1) * MALL, WSP(float, WS_BW) + so, WSP(f16, WS_Z), WSP(float, WS_GATES)};
                        if constexpr (P_Z) pg8::gemm_phase<EpiZ<false>, pg8::StaticOrder>(F.lds, g, S, E);
                        if constexpr ((PROBE_DUP & 128) != 0) { phase_enter(F, args); pg8::gemm_phase<EpiZ<false>, pg8::StaticOrder>(F.lds, g, S, E); }
                        if constexpr (P_SK) skinny_phase<false, D>(F.lds, g.A + (size_t)MP * D, g.Bt, N, E, F.G, F.bid, S.nwg); }
                    SEAM(pb + 2);
                }
                if (IN(pb + 3)) { REP(2) if constexpr (P_MIX) { const int tm = rep_ ? PROBE_TMASK : 31; if (even) { if constexpr (P_E1) phase_e1(F, ei, tm); } else { if constexpr (P_O1) phase_o1(F, ei, tm); } } SEAM(pb + 3); }
                if (IN(pb + 4)) { REP(4096) if constexpr (P_MIX) { if (even) mlstm_scan(F, ei); else phase_o2(F); } if (even) SEAM(pb + 4); else LSEAM(pb + 4); }
                if (even && IN(pb + 5)) { REP(8192) if constexpr (P_MIX && P_E3) { phase_e3(F, ei); } SEAM(pb + 5); }
                if (IN(pb + 6)) {
                    const int K = even ? D : 512; const f16* Bt = even ? WSP(f16, WS_WEO) + (size_t)ei * D * D : WSP(f16, WS_WOO) + (size_t)ei * D * 512;
                    pg8::Gemm g{WSP(f16, WS_O), Bt, MP, D, K}; pg8::StaticOrder S; S.init(MP, D, F.G, F.bid);
                    EpiRes E{WSP(f16, WS_X), WSP(f16, WS_A), rowss + (size_t)(s0 + 2) * MALL, WSP(float, WS_GT) + (size_t)(s0 + 1) * NBAT * D, WSP(float, WS_CS) + (size_t)(s0 + 2) * NBAT * D, WSP(float, WS_RCS) + (size_t)(s0 + 1) * NBAT * D};
                    if constexpr ((PROBE_DUP & 256) != 0) { EpiRes E2{(f16*)(F.ws + WS_END), (f16*)(F.ws + WS_END + (size_t)MALL * D * 4), (float*)(F.ws + WS_END + (size_t)MALL * D * 6), E.GT, E.CS, E.RCS};
                        pg8::gemm_phase<EpiRes, pg8::StaticOrder>(F.lds, g, S, E2); phase_enter(F, args); }
                    if constexpr (P_RES) pg8::gemm_phase<EpiRes, pg8::StaticOrder>(F.lds, g, S, E);
                    if constexpr (P_SK) { if (even) skinny_phase<false, D>(F.lds, g.A + (size_t)MP * D, g.Bt, D, E, F.G, F.bid, S.nwg); else skinny_phase<false, 512>(F.lds, g.A + (size_t)MP * 512, g.Bt, D, E, F.G, F.bid, S.nwg); }
                    LSEAM(pb + 6);
                }
            }
            const int sf = s0 + 2 * ffn, pin = pb + (ffn ? 7 : 0);
            if (IN(pin)) {
                const int so = site_off(sf);
                pg8::Gemm g{WSP(f16, WS_A), WSP(f16, WS_WIN) + (size_t)so * D, MP, FF2, D}; pg8::StaticOrder S; S.init(MP, FF2, F.G, F.bid);
                EpiSwiglu E{rowss + (size_t)sf * MALL, WSP(float, WS_BW) + so, WSP(f16, WS_H)};
                if constexpr (P_SW) pg8::gemm_phase<EpiSwiglu, pg8::StaticOrder>(F.lds, g, S, E);
                if constexpr ((PROBE_DUP & 4) != 0) { phase_enter(F, args); pg8::gemm_phase<EpiSwiglu, pg8::StaticOrder>(F.lds, g, S, E); }
                REP(8) { if constexpr (P_SK) skinny_phase<true, D>(F.lds, g.A + (size_t)MP * D, g.Bt, FF2, E, F.G, F.bid, S.nwg); }
                LSEAM(pin);
            }
            if (IN(pin + 1)) {
                pg8::Gemm g{WSP(f16, WS_H), WSP(f16, WS_WFO) + (size_t)(2 * l + ffn) * D * FF, MP, D, FF}; pg8::StaticOrder S; S.init(MP, D, F.G, F.bid);
                EpiRes E{WSP(f16, WS_X), WSP(f16, WS_A), rowss + (size_t)(sf + 1) * MALL, WSP(float, WS_GT) + (size_t)sf * NBAT * D, (sf + 1 < NSITE) ? WSP(float, WS_CS) + (size_t)(sf + 1) * NBAT * D : nullptr, WSP(float, WS_RCS) + (size_t)sf * NBAT * D};
                if constexpr ((PROBE_DUP & 16) != 0) { EpiRes E2{(f16*)(F.ws + WS_END), (f16*)(F.ws + WS_END + (size_t)MALL * D * 4), (float*)(F.ws + WS_END + (size_t)MALL * D * 6), E.GT, E.CS, E.RCS};
                    pg8::gemm_phase<EpiRes, pg8::StaticOrder>(F.lds, g, S, E2); phase_enter(F, args); }
                if constexpr (P_RES) pg8::gemm_phase<EpiRes, pg8::StaticOrder>(F.lds, g, S, E);
                if constexpr (P_SK) skinny_phase<false, FF>(F.lds, g.A + (size_t)MP * FF, g.Bt, D, E, F.G, F.bid, S.nwg);
                if (pin + 1 == PH_FINAL - 1) SEAM(pin + 1); else LSEAM(pin + 1);
            }
        }
    }
    if (IN(PH_FINAL)) {
        phase_final(F);
        if constexpr ((PROBE_DUP & 512) != 0) { phase_enter(F, args); phase_final(F); }
        for (;;) {
            __syncthreads();
            if (F.tid == 0) MISC[24] = xb_add(CQ.head, 1u);
            __syncthreads();
            const unsigned ch = MISC[24];
            if (ch >= (unsigned)CQ_N) break;
            copy_chunk(CQ, (int)ch, F.tid);
        }
        if constexpr ((PROBE_DUP & 1024) != 0) {
            CopyQ CQ2 = CQ; CQ2.head = CQ.head + 64;
            for (;;) {
                __syncthreads();
                if (F.tid == 0) MISC[24] = xb_add(CQ2.head, 1u);
                __syncthreads();
                const unsigned ch = MISC[24];
                if (ch >= (unsigned)CQ_N) break;
                copy_chunk(CQ2, (int)ch, F.tid);
            }
        }
    }
#undef IN
#undef SEAM
}

extern "C" void kernel_launch(void* const* d_in, const int* in_sizes, int n_in, void* d_out, int out_size, void* d_ws, size_t ws_size, hipStream_t stream) {
    static int grid = 0;
    if (grid == 0) {
        if (n_in != N_IN || (size_t)out_size != O_END || ws_size < WS_END) { fprintf(stderr, "kernel_launch: unexpected shapes n_in %d out %d ws %zu (need %zu / %zu)\n", n_in, out_size, ws_size, (size_t)O_END, (size_t)WS_END); grid = -1; return; }
        int dev = 0, cus = 0, per_cu = 0;
        if (hipGetDevice(&dev) != hipSuccess || hipDeviceGetAttribute(&cus, hipDeviceAttributeMultiprocessorCount, dev) != hipSuccess) { grid = -1; return; }
        if (hipFuncSetAttribute((const void*)fwd_kernel, hipFuncAttributeMaxDynamicSharedMemorySize, LDS_BYTES) != hipSuccess) { fprintf(stderr, "kernel_launch: hipFuncSetAttribute failed\n"); grid = -1; return; }
        if (hipOccupancyMaxActiveBlocksPerMultiprocessor(&per_cu, (const void*)fwd_kernel, 512, LDS_BYTES) != hipSuccess || per_cu < 1) { fprintf(stderr, "kernel_launch: occupancy query says %d\n", per_cu); }
        (void)hipGetLastError();
        grid = cus;
    }
    if (grid < 0) return;
    (void)hipMemsetAsync((char*)d_ws + WS_CTL, 0, CTL_ZERO_BYTES, stream);
    Args a{};
    for (int i = 0; i < N_IN; ++i) a.in[i] = (const float*)d_in[i];
    a.out = (float*)d_out; a.ws = (unsigned char*)d_ws;
#if MK_N_LAUNCHES == 1
    a.ph_lo = 0; a.ph_hi = N_PHASES;
    hipLaunchKernelGGL(fwd_kernel, dim3(grid), dim3(512), LDS_BYTES, stream, a);
#else
    for (int p = 0; p < N_PHASES; ++p) { a.ph_lo = p; a.ph_hi = p + 1; hipLaunchKernelGGL(fwd_kernel, dim3(grid), dim3(512), LDS_BYTES, stream, a); }
#endif
}
```

```cpp
#include <hip/hip_runtime.h>
#include <cstdio>
#include <cstdint>

#ifndef PROBE_DUP
#define PROBE_DUP 0
#endif
#ifndef PROBE_TMASK
#define PROBE_TMASK 19
#endif
#ifndef MK_N_LAUNCHES
#define MK_N_LAUNCHES 1
#endif

#define GAS __attribute__((address_space(1)))
#define LAS __attribute__((address_space(3)))
typedef _Float16 f16;
typedef _Float16 f16x8 __attribute__((ext_vector_type(8)));
typedef _Float16 f16x4 __attribute__((ext_vector_type(4)));
typedef float f32x4 __attribute__((ext_vector_type(4)));
typedef float f32x16 __attribute__((ext_vector_type(16)));
typedef unsigned u32x4 __attribute__((ext_vector_type(4)));
typedef unsigned u32x2 __attribute__((ext_vector_type(2)));
typedef LAS unsigned char* ldsp_t;

constexpr int D = 1024, T = 8192, NB = 2, MP = NB * T, NS = 128, MALL = MP + NS, NBAT = NB + NS;
constexpr int FF = 2816, FF2 = 5632, NEV = 3072, NEVR = 2832, NOD = 2304, NMODC = 9216;
constexpr int NSITE = 12;
constexpr float EPS = 1e-6f;
__host__ __device__ __forceinline__ constexpr int site_N(int s) { return (s % 3 != 1) ? FF2 : (((s / 3) % 2 == 0) ? NEV : NOD); }
__host__ __device__ __forceinline__ constexpr int site_off(int s) { const int r = s % 6; return (s / 6) * 27904 + (r == 0 ? 0 : r == 1 ? 5632 : r == 2 ? 8704 : r == 3 ? 14336 : r == 4 ? 19968 : 22272); }
static_assert(site_off(1) == 5632 && site_off(2) == 8704 && site_off(3) == 14336 && site_off(4) == 19968 && site_off(5) == 22272 && site_off(6) == 27904 && site_off(7) == 27904 + 5632, "site_off");
constexpr int NWIN = site_off(NSITE);
static_assert(NWIN == 55808, "win rows");

constexpr size_t alignup(size_t x) { return (x + 4095) & ~(size_t)4095; }
constexpr size_t WS_CTL = 0, CTL_ZERO_BYTES = 1u << 20;
constexpr int CW_BAR = 1024;
constexpr size_t RSS_OFF = 65536;
static_assert(RSS_OFF + (size_t)13 * MALL * 4 <= CTL_ZERO_BYTES, "ctl");
constexpr size_t WS_WIN = alignup(CTL_ZERO_BYTES);
constexpr size_t WS_WFO = alignup(WS_WIN + (size_t)NWIN * D * 2);
constexpr size_t WS_WEO = alignup(WS_WFO + (size_t)8 * D * FF * 2);
constexpr size_t WS_WOO = alignup(WS_WEO + (size_t)2 * D * D * 2);
constexpr size_t WS_WMOD = alignup(WS_WOO + (size_t)2 * D * 512 * 2);
constexpr size_t WS_AC = alignup(WS_WMOD + (size_t)4 * NMODC * D * 2);
constexpr size_t WS_MOD = alignup(WS_AC + (size_t)256 * D * 2);
constexpr size_t WS_CS = alignup(WS_MOD + (size_t)NBAT * 4 * NMODC * 4);
constexpr size_t WS_GT = alignup(WS_CS + (size_t)NSITE * NBAT * D * 4);
constexpr size_t WS_RCS = alignup(WS_GT + (size_t)NSITE * NBAT * D * 4);
constexpr size_t WS_SHA = alignup(WS_RCS + (size_t)NSITE * NBAT * D * 4);
constexpr size_t WS_BW = alignup(WS_SHA + (size_t)NSITE * 256 * D * 2);
constexpr size_t WS_X = alignup(WS_BW + (size_t)NBAT * NWIN * 4);
constexpr size_t WS_A = alignup(WS_X + (size_t)MALL * D * 4);
constexpr size_t WS_H = alignup(WS_A + (size_t)MALL * D * 2);
constexpr size_t WS_Z = alignup(WS_H + (size_t)MALL * FF * 2);
constexpr size_t WS_GATES = alignup(WS_Z + (size_t)MALL * NEV * 2);
constexpr size_t WS_O = alignup(WS_GATES + (size_t)MALL * 16 * 4);
constexpr size_t WS_OG = alignup(WS_O + (size_t)MALL * D * 2);
constexpr size_t WS_LSE = alignup(WS_OG + (size_t)3 * MP * 512 * 2);
constexpr size_t WS_DC = alignup(WS_LSE + (size_t)3 * MP * 8 * 4);
constexpr size_t WS_DN = alignup(WS_DC + (size_t)16 * 64 * 4096 * 4);
constexpr size_t WS_CP = alignup(WS_DN + (size_t)16 * 64 * 64 * 4);
constexpr size_t WS_NP = alignup(WS_CP + (size_t)16 * 64 * 4096 * 2);
constexpr size_t WS_SC = alignup(WS_NP + (size_t)16 * 64 * 64 * 4);
constexpr size_t WS_END = alignup(WS_SC + (size_t)3 * 16 * 64 * 4);

constexpr size_t O_Y = 0;
constexpr size_t O_AKVP = O_Y + (size_t)MALL * D;
constexpr size_t O_AKVS = O_AKVP + (size_t)2 * 2 * 128 * 256;
constexpr size_t O_BCP = O_AKVS + (size_t)2 * 128 * 128 * 256;
constexpr size_t O_BCS = O_BCP + (size_t)2 * 2 * 8 * 4096;
constexpr size_t O_BNP = O_BCS + (size_t)2 * 128 * 8 * 4096;
constexpr size_t O_BNS = O_BNP + (size_t)2 * 2 * 8 * 64;
constexpr size_t O_BMP = O_BNS + (size_t)2 * 128 * 8 * 64;
constexpr size_t O_BMS = O_BMP + (size_t)2 * 2 * 8;
constexpr size_t O_C1P = O_BMS + (size_t)2 * 128 * 8;
constexpr size_t O_C1S = O_C1P + (size_t)2 * 2 * 128 * 256;
constexpr size_t O_C2P = O_C1S + (size_t)2 * 128 * 128 * 256;
constexpr size_t O_C2S = O_C2P + (size_t)2 * 2 * 512 * 256;
constexpr size_t O_C3P = O_C2S + (size_t)2 * 128 * 512 * 256;
constexpr size_t O_C3S = O_C3P + (size_t)2 * 2 * 2048 * 256;
constexpr size_t O_END = O_C3S + (size_t)2 * 128 * 2048 * 256;

enum { I_XP = 0, I_XS, I_CA, I_SBC, I_SBN, I_SBM, I_CC1, I_CC2, I_CC3, I_CP, I_CSMP, I_WMOD, I_BMOD, I_NG, I_FWI, I_FWO, I_EWI, I_EBG, I_ESK, I_EHG, I_EWO, I_OWI, I_OWO, I_FG, N_IN };

constexpr int RING_BYTES = 131072;
constexpr int MISC_OFF = RING_BYTES + 320;
constexpr int PF_OFF = 139264;
constexpr int EPI_OFF = 133120, EPI_STRIDE = 4096;
constexpr int LDS_BYTES = 147456;

#define RLX_AGENT __ATOMIC_RELAXED, __HIP_MEMORY_SCOPE_AGENT
#define LDS_WAIT() asm volatile("s_waitcnt lgkmcnt(0)" ::: "memory")
#define VM_WAIT() asm volatile("s_waitcnt vmcnt(0)" ::: "memory")

#define XB_TMO      128
#define XB_XCNT(j)  (256  + 64 * (j))
#define XB_XSUB(j)  (1280 + 64 * (j))
#define XB_XGEN(j)  (2304 + 64 * (j))
#define XB_TOP      3328
#define XB_TOPGEN   3392
#define XB_LSUB(j)  (3456 + 64 * (j))
#define XCD_BAR_WORDS 4480
#define XB_SPIN_CAP (1u << 21)
__device__ __forceinline__ unsigned xb_ld(unsigned* p)              { return __hip_atomic_load(p, __ATOMIC_RELAXED, __HIP_MEMORY_SCOPE_AGENT); }
__device__ __forceinline__ unsigned xb_add(unsigned* p, unsigned v) { return __hip_atomic_fetch_add(p, v, __ATOMIC_RELAXED, __HIP_MEMORY_SCOPE_AGENT); }
__device__ __forceinline__ unsigned xb_xcc_id() { return (unsigned)__builtin_amdgcn_s_getreg((3 << 11) | 20) & 0xFu; }
#define XB_SPIN(cond, bar) do { unsigned _sp = 0; while (cond) { __builtin_amdgcn_s_sleep(1); \
    if ((++_sp & 255u) == 0u) { if (xb_ld(&(bar)[XB_TMO])) break; if (_sp > XB_SPIN_CAP) { atomicAdd(&(bar)[XB_TMO], 1u); break; } } } } while (0)
struct XcdBarrier { unsigned* bar; unsigned x; volatile LAS unsigned* st; };
__device__ __forceinline__ XcdBarrier xcd_barrier_post(unsigned* bar, volatile LAS unsigned* st) {
    XcdBarrier b; b.bar = bar; b.x = xb_xcc_id(); b.st = st;
    if (threadIdx.x == 0) st[12] = xb_add(&bar[XB_XCNT(b.x)], 1u);
    return b;
}
__device__ __forceinline__ void xcd_barrier_complete(unsigned* bar, unsigned x, unsigned& nloc, unsigned& nx) {
    const unsigned G = gridDim.x * gridDim.y * gridDim.z;
    unsigned sum, cnt, mine, sp = 0u;
    for (;;) {
        sum = 0u; cnt = 0u; mine = 0u;
#pragma unroll
        for (unsigned j = 0; j < 16; ++j) { const unsigned c = xb_ld(&bar[XB_XCNT(j)]); sum += c; cnt += (c > 0u) ? 1u : 0u; mine = (j == x) ? c : mine; }
        if (sum == G) break;
        __builtin_amdgcn_s_sleep(1);
        if ((++sp & 255u) == 0u) { if (xb_ld(&bar[XB_TMO])) break; if (sp > XB_SPIN_CAP) { atomicAdd(&bar[XB_TMO], 1u); break; } }
    }
    nloc = mine > 0u ? mine : 1u; nx = cnt > 0u ? cnt : 1u;
}
__device__ __forceinline__ unsigned xcd_census_even(unsigned* bar) {
    const unsigned G = gridDim.x; if (G % 8u) return 0u;
    unsigned ok = 1u;
#pragma unroll
    for (unsigned j = 0; j < 16; ++j) { const unsigned c = xb_ld(&bar[XB_XCNT(j)]); ok &= (c == (j < 8u ? G / 8u : 0u)) ? 1u : 0u; }
    return ok;
}
constexpr int CQ_CH = 4096;
constexpr int CQ_N3 = 2047 * 16384 / CQ_CH, CQ_N2 = 511 * 16384 / CQ_CH, CQ_NA = 127 * 16384 / CQ_CH, CQ_N = CQ_N3 + CQ_N2 + 2 * CQ_NA;
constexpr int CW_Q = 512;
struct CopyQ { const float* c3; const float* c2; const float* ca; const float* c1; float* out; unsigned* head; };
__device__ __forceinline__ void copy_chunk(const CopyQ& Q, int chunk, int tid) {
    const float* in; float* out; int W;
    if (chunk < CQ_N3) { in = Q.c3; out = Q.out + O_C3S; W = 2048; }
    else if (chunk < CQ_N3 + CQ_N2) { chunk -= CQ_N3; in = Q.c2; out = Q.out + O_C2S; W = 512; }
    else if (chunk < CQ_N3 + CQ_N2 + CQ_NA) { chunk -= CQ_N3 + CQ_N2; in = Q.ca; out = Q.out + O_AKVS; W = 128; }
    else { chunk -= CQ_N3 + CQ_N2 + CQ_NA; in = Q.c1; out = Q.out + O_C1S; W = 128; }
    const unsigned wm1 = (unsigned)(W - 1);
    f32x4 v[8]; size_t doff[8];
#pragma unroll
    for (int j = 0; j < 8; ++j) {
        const unsigned i = (unsigned)chunk * CQ_CH + j * 512 + tid, r = i >> 6, es = r / wm1, rr = r - es * wm1;
        const size_t o = ((size_t)es * W + rr) * 256 + (i & 63) * 4; doff[j] = o;
        v[j] = __builtin_nontemporal_load((const f32x4*)(in + o + 256));
    }
#pragma unroll
    for (int j = 0; j < 8; ++j) __builtin_nontemporal_store(v[j], (f32x4*)(out + doff[j]));
}
template <int MODE  >
__device__ __forceinline__ void xb_wait_work(unsigned* bar, unsigned* pw, unsigned same, bool need_wait, volatile LAS unsigned* W, const CopyQ& Q) {
    const int tid = threadIdx.x;
    for (unsigned it = 0;; ++it) {
        const unsigned par = (it & 1u) * 2u;
        if (tid == 0) {
            unsigned rel = need_wait ? 0u : 1u;
            if (!rel) { for (int sp = 0; sp < 12; ++sp) { const unsigned v_ = xb_ld(pw); if (MODE == 0 ? (v_ != same) : (v_ >= same)) { rel = 1u; break; } __builtin_amdgcn_s_sleep(1); } }
            if (!rel && (it & 255u) == 255u) { if (xb_ld(&bar[XB_TMO])) rel = 1u; else if (it > (1u << 16)) { atomicAdd(&bar[XB_TMO], 1u); rel = 1u; } }
            unsigned ch = 0xffffffffu;
            if ((PROBE_DUP & 2048) == 0 && !rel && xb_ld(Q.head) < (unsigned)CQ_N) ch = xb_add(Q.head, 1u);
            W[par] = rel; W[par + 1] = ch;
        }
        __syncthreads();
        const unsigned rel = W[par], ch = W[par + 1];
        if (rel) break;
        if (ch < (unsigned)CQ_N) copy_chunk(Q, (int)ch, tid);
    }
}
__device__ __forceinline__ void xcd_barrier(const XcdBarrier& b, const CopyQ& Q) {
    asm volatile("s_waitcnt vmcnt(0)" ::: "memory");
    __syncthreads();
    unsigned* bar = b.bar;
    volatile LAS unsigned* W = b.st + 4;
    if (threadIdx.x == 0) {
        __builtin_amdgcn_s_waitcnt(0);
        unsigned nloc = b.st[0], nx = b.st[1];
        if (nloc == 0u) { xcd_barrier_complete(bar, b.x, nloc, nx); b.st[0] = nloc; b.st[1] = nx; b.st[10] = xcd_census_even(bar); }
        const unsigned old = xb_add(&bar[XB_XSUB(b.x)], 1u);
        const unsigned gen = old / nloc;
        unsigned role, val;
        if (old + 1u == (gen + 1u) * nloc) {
            __builtin_amdgcn_fence(__ATOMIC_RELEASE, "agent");
            asm volatile("s_waitcnt vmcnt(0)" ::: "memory");
            const unsigned og = xb_add(&bar[XB_TOP], 1u);
            const unsigned tg = og / nx;
            if (og + 1u == (tg + 1u) * nx) { xb_add(&bar[XB_TOPGEN], 1u); role = 2u; val = 0u; }
            else { role = 1u; val = tg; }
        } else { role = 0u; val = gen; }
        b.st[8] = role; b.st[9] = val;
    }
    __syncthreads();
    const unsigned role = b.st[8], val = b.st[9];
    xb_wait_work<0>(bar, role == 1u ? &bar[XB_TOPGEN] : &bar[XB_XGEN(b.x)], val, role != 2u, W, Q);
    if (threadIdx.x == 0) {
        __builtin_amdgcn_fence(__ATOMIC_ACQUIRE, "agent");
        if (role != 0u) xb_add(&bar[XB_XGEN(b.x)], 1u);
        asm volatile("s_waitcnt vmcnt(0)" ::: "memory");
    }
    __syncthreads();
}

__device__ __forceinline__ void xcc_barrier(const XcdBarrier& b, const CopyQ& Q) {
    asm volatile("s_waitcnt vmcnt(0)" ::: "memory");
    __syncthreads();
    unsigned* bar = b.bar;
    if (threadIdx.x == 0) {
        __builtin_amdgcn_s_waitcnt(0);
        const unsigned gen = b.st[11]; b.st[11] = gen + 1u;
        (void)xb_add(&bar[XB_LSUB(b.x)], 1u);
        b.st[9] = (gen + 1u) * b.st[0];
    }
    __syncthreads();
    const unsigned target = b.st[9];
    xb_wait_work<1>(bar, &bar[XB_LSUB(b.x)], target, true, b.st + 4, Q);
    asm volatile("" ::: "memory");
    __syncthreads();
}

__device__ __forceinline__ int opaque_v(int x) { asm volatile("" : "+v"(x)); return x; }
template <class P> __device__ __forceinline__ P* opaque_p(P* p) { asm volatile("" : "+s"(p)); return p; }
__device__ __forceinline__ float wave_sum(float v) {
#pragma unroll
    for (int o = 1; o < 64; o <<= 1) v += __shfl_xor(v, o);
    return v;
}
__device__ __forceinline__ float wave_max(float v) {
#pragma unroll
    for (int o = 1; o < 64; o <<= 1) v = fmaxf(v, __shfl_xor(v, o));
    return v;
}
__device__ __forceinline__ f16x4 cvt4(f32x4 v) { f16x4 r; r[0] = (f16)v[0]; r[1] = (f16)v[1]; r[2] = (f16)v[2]; r[3] = (f16)v[3]; return r; }
__device__ __forceinline__ f16x8 cat4(f16x4 lo, f16x4 hi) { f16x8 a; a[0] = lo[0]; a[1] = lo[1]; a[2] = lo[2]; a[3] = lo[3]; a[4] = hi[0]; a[5] = hi[1]; a[6] = hi[2]; a[7] = hi[3]; return a; }
__device__ __forceinline__ float sigmoidf_(float x) { return __builtin_amdgcn_rcpf(1.0f + __expf(-x)); }
__device__ __forceinline__ float logsigmoidf_(float x) { return fminf(x, 0.f) - log1pf(__expf(-fabsf(x))); }
__device__ __forceinline__ int row_batch(int m) { return m < MP ? (m >> 13) : (NB + m - MP); }

namespace pg8 {
constexpr int BM = 256, BK = 64, HALF = 128, HTB = HALF * BK * 2, STAGE_BYTES = 8 * HTB, NXCD = 8, WGM = 8;
__host__ __device__ __forceinline__ int lds_byte(int r, int c) { const int st = (r >> 4) * 2 + (c >> 5), rr = r & 15, cc = c & 31, ob = rr * 64 + cc * 2; return st * 1024 + (ob ^ (((ob >> 9) & 1) << 5)); }
__host__ __device__ __forceinline__ void stage_rc(int b, int& R, int& C) { const int st = b / 1024, sb = b % 1024, swz = sb ^ (((sb >> 9) & 1) << 5); R = (st >> 1) * 16 + swz / 64; C = (st & 1) * 32 + (swz % 64) / 2; }
struct Unit { int pm, pn; };
struct Gemm { const f16* A; const f16* Bt; int M, N, K; };
struct StaticOrder {
    int nM, nN, nwg, G, c;
    __host__ __device__ void init(int M, int N, int G_, int c_) { nM = M / BM; nN = N / BM; nwg = nM * nN; G = G_; c = c_; }
    __host__ __device__ bool next(int i, Unit& u) const {
        const long L = (long)i * G + c; if (L >= nwg) return false;
        int wgid = (int)L; { const int q = nwg / NXCD, r = nwg % NXCD, xcd = wgid % NXCD, off = wgid / NXCD; wgid = (xcd < r ? xcd * (q + 1) : r * (q + 1) + (xcd - r) * q) + off; }
        const int nig = WGM * nN, gid = wgid / nig, fm = gid * WGM, gsz = (nM - fm) < WGM ? (nM - fm) : WGM;
        u.pm = fm + ((wgid % nig) % gsz); u.pn = (wgid % nig) / gsz; return true;
    }
    __device__ __forceinline__ void a_ready(const Unit&) const {}
    __device__ __forceinline__ void done(const Unit&) const {}
};
struct DiagOrder {
    int G, c;
    __device__ bool next(int i, Unit& u) const {
        const int L = i * G + c; if (L >= NWIN / BM) return false;
        int s = 0, acc = 0;
#pragma unroll
        for (int k = 0; k < NSITE; ++k) { const int n = site_N(k) / BM; if (L >= acc + n) { s = k + 1; } acc += n; }
        u.pm = s; u.pn = L; return true;
    }
    __device__ __forceinline__ void a_ready(const Unit&) const {}
    __device__ __forceinline__ void done(const Unit&) const {}
};

template <class Epi, class Sched, bool ALIGN_EPI = true>
__device__ __forceinline__ void gemm_phase(ldsp_t lds, const Gemm g, const Sched& S, const Epi& E) {
    const int tid = opaque_v(threadIdx.x), wid = __builtin_amdgcn_readfirstlane(tid >> 6), lane = tid & 63, wr = wid >> 2, wc = wid & 3, fr = lane & 15, fq = lane >> 4;
    const int K = g.K, nt = K / BK;
    const int rot = (((S.c & 7) * nt) >> 3) & ~1;
    unsigned voffA[2];
#pragma unroll
    for (int i = 0; i < 2; ++i) voffA[i] = (unsigned)(tid * 16 + i * 8192);
#define voffB voffA
    const size_t kstep = (size_t)(2 * HTB);
    const size_t hstep = (size_t)HTB;
    const size_t tstep = (size_t)nt * kstep;
    const unsigned ldsw = (unsigned)wid * 1024u;
    const int aoff = lds_byte(wr * 64 + fr, fq * 8), boff = lds_byte(wc * 32 + fr, fq * 8);
#define PG8_SA(b, h) (((b) * 2 + (h)) * HTB)
#define PG8_SB(b, h) ((4 + (b) * 2 + (h)) * HTB)
#define PG8_STAGE_X(bufoff, gbase, voff, AUX) do { _Pragma("unroll") for (int _i = 0; _i < 2; ++_i) \
        __builtin_amdgcn_global_load_lds((const unsigned*)((const char*)(gbase) + (voff)[_i]), (LAS unsigned*)(lds + (bufoff) + ldsw + _i * 8192), 16, 0, AUX); } while (0)
#define PG8_STAGE(bufoff, gbase, voff) PG8_STAGE_X(bufoff, gbase, voff, 0)
#define PG8_STAGEA(bufoff, gbase, voff) PG8_STAGE_X(bufoff, gbase, voff, 16)
#define PG8_LDA(dst, b, h) do { _Pragma("unroll") for (int m = 0; m < 4; ++m) _Pragma("unroll") for (int k = 0; k < 2; ++k) dst[m][k] = *(const LAS f16x8*)(lds + PG8_SA(b, h) + aoff + m * 2048 + k * 1024); } while (0)
#define PG8_LDB(dst, b, h) do { _Pragma("unroll") for (int n = 0; n < 2; ++n) _Pragma("unroll") for (int k = 0; k < 2; ++k) dst[n][k] = *(const LAS f16x8*)(lds + PG8_SB(b, h) + boff + n * 2048 + k * 1024); } while (0)
#define PG8_MMA(ai, bj, At, Bt) do { __builtin_amdgcn_s_setprio(1); _Pragma("unroll") for (int m = 0; m < 4; ++m) _Pragma("unroll") for (int n = 0; n < 2; ++n) _Pragma("unroll") for (int k = 0; k < 2; ++k) \
        acc[ai][bj][m][n] = __builtin_amdgcn_mfma_f32_16x16x32_f16(Bt[n][k], At[m][k], acc[ai][bj][m][n], 0, 0, 0); __builtin_amdgcn_s_setprio(0); } while (0)
#define PG8_WAIT_V(n) asm volatile("s_waitcnt vmcnt(" #n ")" ::: "memory")
#define PG8_WAIT_L(n) asm volatile("s_waitcnt lgkmcnt(" #n ")" ::: "memory")
#define PG8_BAR __builtin_amdgcn_s_barrier()
#define PG8_SCHED __builtin_amdgcn_sched_barrier(0)
    Unit cur, nxt; int ui = 0;
    if (!S.next(0, cur)) return;
    f32x4 acc[2][2][4][2];
#pragma unroll
    for (int a = 0; a < 2; ++a)
#pragma unroll
        for (int b = 0; b < 2; ++b)
#pragma unroll
            for (int m = 0; m < 4; ++m)
#pragma unroll
                for (int n = 0; n < 2; ++n) acc[a][b][m][n] = (f32x4){0.f, 0.f, 0.f, 0.f};
    f16x8 At[4][2], B0[2][2], B1[2][2];
    const char* cA = (const char*)g.A + (size_t)cur.pm * tstep; const char* cB = (const char*)g.Bt + (size_t)cur.pn * tstep;
    S.a_ready(cur);
    const size_t rstep = (size_t)rot * kstep;
    PG8_STAGE(PG8_SB(0, 0), cB + rstep, voffB); PG8_STAGE(PG8_SB(0, 1), cB + rstep + hstep, voffB); PG8_STAGEA(PG8_SA(0, 0), cA + rstep, voffA); PG8_STAGEA(PG8_SA(0, 1), cA + rstep + hstep, voffA);
    if (wr == 1) PG8_BAR;
    PG8_WAIT_V(2); PG8_BAR;
    PG8_STAGE(PG8_SB(1, 0), cB + rstep + kstep, voffB); PG8_STAGEA(PG8_SA(1, 0), cA + rstep + kstep, voffA); PG8_STAGE(PG8_SB(1, 1), cB + rstep + hstep + kstep, voffB);
    PG8_WAIT_V(6); PG8_BAR;
    if constexpr (Epi::HAS_PRE) E.pre(cur, (LAS float*)(lds + EPI_OFF), wid, opaque_v(lane));
    for (;;) {
        const bool has_next = S.next(ui + 1, nxt);
        const char* nA = has_next ? (const char*)g.A + (size_t)nxt.pm * tstep : cA; const char* nB = has_next ? (const char*)g.Bt + (size_t)nxt.pn * tstep : cB;
        for (int t = 0; t < nt; t += 2) {
            const bool last = (t == nt - 2);
            int t1 = t + 1 + rot, t2 = t + 2 + rot; t1 -= (t1 >= nt) ? nt : 0; t2 -= (t2 >= nt) ? nt : 0;
            const char* a1 = cA + (size_t)t1 * kstep;
            const size_t nxoff = has_next ? rstep : (size_t)((nt - 2 + rot) % nt) * kstep;
            const char* a2 = last ? nA + nxoff : cA + (size_t)t2 * kstep; const char* b2 = last ? nB + nxoff : cB + (size_t)t2 * kstep;
            const char* a3 = a2 + kstep; const char* b3 = b2 + kstep;
            if (last && has_next) S.a_ready(nxt);
            PG8_LDB(B0, 0, 0); PG8_LDB(B1, 0, 1); PG8_SCHED; PG8_LDA(At, 0, 0); PG8_STAGEA(PG8_SA(1, 1), a1 + hstep, voffA);
            PG8_WAIT_V(8); PG8_WAIT_L(0); PG8_BAR; PG8_MMA(0, 0, At, B0); PG8_MMA(0, 1, At, B1); PG8_BAR; PG8_SCHED;
            PG8_LDA(At, 0, 1); PG8_STAGE(PG8_SB(0, 0), b2, voffB); PG8_STAGE(PG8_SB(0, 1), b2 + hstep, voffB); PG8_STAGEA(PG8_SA(0, 0), a2, voffA);
            PG8_WAIT_V(8); PG8_WAIT_L(0); PG8_BAR; PG8_MMA(1, 0, At, B0); PG8_MMA(1, 1, At, B1); PG8_BAR; PG8_SCHED;
            PG8_LDB(B0, 1, 0); PG8_LDB(B1, 1, 1); PG8_SCHED; PG8_LDA(At, 1, 0); PG8_STAGEA(PG8_SA(0, 1), a2 + hstep, voffA);
            PG8_WAIT_V(8); PG8_WAIT_L(0); PG8_BAR; PG8_MMA(0, 0, At, B0); PG8_MMA(0, 1, At, B1); PG8_BAR; PG8_SCHED;
            PG8_LDA(At, 1, 1); PG8_STAGE(PG8_SB(1, 0), b3, voffB); PG8_STAGE(PG8_SB(1, 1), b3 + hstep, voffB); PG8_STAGEA(PG8_SA(1, 0), a3, voffA);
            PG8_WAIT_V(8); PG8_WAIT_L(0); PG8_BAR; PG8_MMA(1, 0, At, B0); PG8_MMA(1, 1, At, B1); PG8_BAR; PG8_SCHED;
        }
        if constexpr (ALIGN_EPI) { if (wr == 0) PG8_BAR; }
        E(acc, cur, wr, wc, fr, fq, (const LAS float*)(lds + EPI_OFF + (ui & 1) * EPI_STRIDE)); S.done(cur);
        if (!has_next) break;
#pragma unroll
        for (int a = 0; a < 2; ++a)
#pragma unroll
            for (int b = 0; b < 2; ++b)
#pragma unroll
                for (int m = 0; m < 4; ++m)
#pragma unroll
                    for (int n = 0; n < 2; ++n) acc[a][b][m][n] = (f32x4){0.f, 0.f, 0.f, 0.f};
        cur = nxt; cA = nA; cB = nB; ++ui;
        if constexpr (Epi::HAS_PRE) E.pre(cur, (LAS float*)(lds + EPI_OFF + (ui & 1) * EPI_STRIDE), wid, opaque_v(lane));
        if constexpr (ALIGN_EPI) { if (wr == 1) PG8_BAR; }
    }
    PG8_WAIT_V(0);
    if constexpr (!ALIGN_EPI) { if (wr == 0) PG8_BAR; }
    PG8_BAR;
#undef PG8_SA
#undef PG8_SB
#undef PG8_STAGE
#undef voffB
#undef PG8_STAGEA
#undef PG8_STAGE_X
#undef PG8_LDA
#undef PG8_LDB
#undef PG8_MMA
#undef PG8_WAIT_V
#undef PG8_WAIT_L
#undef PG8_BAR
#undef PG8_SCHED
}
}
__host__ __device__ __forceinline__ size_t tiled_byte(int row, int col, int K) {
    return ((size_t)((row >> 8) * (K >> 6) + (col >> 6)) * 2 + ((row >> 7) & 1)) * 16384 + (size_t)pg8::lds_byte(row & 127, col & 63);
}
template <class V> __device__ __forceinline__ V* tiled_ptr(f16* base, int row, int col, int K) { return (V*)((char*)base + tiled_byte(row, col, K)); }

using pg8::Unit;
struct EpiSwiglu {
    static constexpr bool HAS_PRE = true;
    const float* rowss; const float* BW; f16* H;
    __device__ __forceinline__ void pre(const Unit& u, LAS float* ev, int wid, int lane) const {
        const int i = (wid & 3) * 64 + lane;
        const float* src = (wid < 4) ? rowss + u.pm * 256 + i : BW + (size_t)(u.pm >> 5) * NWIN + u.pn * 256 + i;
        __builtin_amdgcn_global_load_lds((const unsigned*)src, (LAS unsigned*)(ev + (wid < 4 ? 0 : 256) + (wid & 3) * 64), 4, 0, 0);
    }
    __device__ __forceinline__ static f16x4 act(f32x4 g, f32x4 u, float r, f32x4 bg, f32x4 bu) {
        f32x4 o;
#pragma unroll
        for (int e = 0; e < 4; ++e) { const float gg = g[e] * r + bg[e], uu = u[e] * r + bu[e]; o[e] = gg * uu * __builtin_amdgcn_rcpf(1.0f + __expf(-gg)); }
        return cvt4(o);
    }
    __device__ __forceinline__ void operator()(const f32x4 (&acc)[2][2][4][2], const Unit& u, int wr, int wc, int fr_in, int fq_in, const LAS float* ev) const {
        const int fr = opaque_v(fr_in), fq = opaque_v(fq_in);
        f32x4 bg[2], bu[2];
#pragma unroll
        for (int bj = 0; bj < 2; ++bj) { const int cg = 256 + bj * 128 + wc * 32 + 4 * fq; bg[bj] = *(const LAS f32x4*)(ev + cg); bu[bj] = *(const LAS f32x4*)(ev + cg + 16); }
        char* hb = (char*)H + (size_t)(u.pm * (FF / 64) + 2 * u.pn + (wc >> 1)) * 32768 + (size_t)(8 * wr + (wc & 1)) * 1024;
        const unsigned lo = (unsigned)(fr * 64 + ((16 * fq) ^ (32 * (fr >> 3))));
#pragma unroll
        for (int ai = 0; ai < 2; ++ai)
#pragma unroll
            for (int m = 0; m < 4; ++m) {
                const float r = rsqrtf(ev[ai * 128 + wr * 64 + m * 16 + fr] * (1.0f / D) + EPS);
                const f16x4 h0 = act(acc[ai][0][m][0], acc[ai][0][m][1], r, bg[0], bu[0]), h1 = act(acc[ai][1][m][0], acc[ai][1][m][1], r, bg[1], bu[1]);
                *(f16x8*)(hb + lo + (ai * 16384 + m * 2048)) = cat4(h0, h1);
            }
    }
    __device__ __forceinline__ void sk(int row, int q32, int e4, f32x4 g, f32x4 u) const {
        const int b = row_batch(row); const float* bias = BW + (size_t)b * NWIN + q32 * 32 + e4;
        const float r = rsqrtf(rowss[row] * (1.0f / D) + EPS);
        *(f16x4*)(H + (size_t)row * FF + 128 * (q32 >> 3) + 32 * (q32 & 3) + 2 * e4 + 4 * ((q32 >> 2) & 1)) = act(g, u, r, *(const f32x4*)bias, *(const f32x4*)(bias + 16));
    }
};
struct EpiRes {
    static constexpr bool HAS_PRE = true;
    f16* X; f16* A; float* rowss_next; const float* GT; const float* CS; const float* RCS;
    __device__ __forceinline__ void pre(const Unit& u, LAS float* ev, int wid, int lane) const {
        const int i = (wid & 3) * 64 + lane; const size_t o = (size_t)(u.pm >> 5) * D + u.pn * 256 + i;
        if (wid < 4) { __builtin_amdgcn_global_load_lds((const unsigned*)(GT + o), (LAS unsigned*)(ev + (wid & 3) * 64), 4, 0, 0);
                       __builtin_amdgcn_global_load_lds((const unsigned*)(RCS + o), (LAS unsigned*)(ev + 512 + (wid & 3) * 64), 4, 0, 0); }
        else if (CS) __builtin_amdgcn_global_load_lds((const unsigned*)(CS + o), (LAS unsigned*)(ev + 256 + (wid & 3) * 64), 4, 0, 0);
    }
    __device__ __forceinline__ void operator()(const f32x4 (&acc)[2][2][4][2], const Unit& u, int wr, int wc, int fr_in, int fq_in, const LAS float* ev) const {
        const int fr = opaque_v(fr_in), fq = opaque_v(fq_in);
        const int col0 = u.pn * 256 + wc * 32 + 8 * fq;
        const LAS float* gt = ev + wc * 32 + 8 * fq; const LAS float* cs = ev + 256 + wc * 32 + 8 * fq; const LAS float* rc = ev + 512 + wc * 32 + 8 * fq;
        char* ab = (char*)A + (size_t)(u.pm * (D / 64) + 4 * u.pn + (wc >> 1)) * 32768 + (size_t)(8 * wr + (wc & 1)) * 1024;
        const unsigned lo = (unsigned)(fr * 64 + ((16 * fq) ^ (32 * (fr >> 3))));
        const bool lastsite = (CS == nullptr);
        f32x4 gv[2][2], rv[2][2], cv[2][2];
#pragma unroll
        for (int bj = 0; bj < 2; ++bj)
#pragma unroll
            for (int n = 0; n < 2; ++n) { gv[bj][n] = *(const LAS f32x4*)(gt + bj * 128 + 4 * n); rv[bj][n] = *(const LAS f32x4*)(rc + bj * 128 + 4 * n); cv[bj][n] = *(const LAS f32x4*)(cs + bj * 128 + 4 * n); }
#pragma unroll
        for (int ai = 0; ai < 2; ++ai)
#pragma unroll
            for (int m = 0; m < 4; ++m) {
                const int row = u.pm * 256 + ai * 128 + wr * 64 + m * 16 + fr;
                float ss = 0.f;
#pragma unroll
                for (int bj = 0; bj < 2; ++bj) {
                    const int off = bj * 128;
                    f16x8* ap = (f16x8*)(ab + lo + (bj * 65536 + ai * 16384 + m * 2048));
                    const f16x8 ah = *ap;
                    f16x4 ao[2];
#pragma unroll
                    for (int n = 0; n < 2; ++n) {
                        f32x4 x = {(float)ah[4 * n], (float)ah[4 * n + 1], (float)ah[4 * n + 2], (float)ah[4 * n + 3]}; x = x * rv[bj][n] + gv[bj][n] * acc[ai][bj][m][n];
                        ss += (x[0] * x[0] + x[1] * x[1]) + (x[2] * x[2] + x[3] * x[3]);
                        ao[n] = cvt4(lastsite ? x : x * cv[bj][n]);
                    }
                    if (lastsite) *(f16x8*)(X + (size_t)row * D + col0 + off) = cat4(ao[0], ao[1]);
                    else *ap = cat4(ao[0], ao[1]);
                }
                ss += __shfl_xor(ss, 16); ss += __shfl_xor(ss, 32);
                if (fq == 0) atomicAdd(rowss_next + row, ss);
            }
    }
    __device__ __forceinline__ static int slot2col(int slot) { return (slot & ~31) + 8 * ((slot & 15) >> 2) + 4 * ((slot >> 4) & 1); }
    __device__ __forceinline__ void sk(int row, int slot, f32x4 v) const {
        const int col = slot2col(slot);
        const int b = row_batch(row);
        const f32x4 g4 = *(const f32x4*)(GT + (size_t)b * D + col), r4 = *(const f32x4*)(RCS + (size_t)b * D + col);
        f16* ar = A + (size_t)row * D + col; const f16x4 ah = *(const f16x4*)ar;
        f32x4 x = {(float)ah[0], (float)ah[1], (float)ah[2], (float)ah[3]}; x = x * r4 + g4 * v;
        if (CS) *(f16x4*)ar = cvt4(x * *(const f32x4*)(CS + (size_t)b * D + col));
        else *(f16x4*)(X + (size_t)row * D + col) = cvt4(x);
        atomicAdd(rowss_next + row, (x[0] * x[0] + x[1] * x[1]) + (x[2] * x[2] + x[3] * x[3]));
    }
};
template <bool EVEN> struct EpiZ {
    static constexpr bool HAS_PRE = true;
    const float* rowss; const float* BW; f16* Z; float* GATES;
    __device__ __forceinline__ void pre(const Unit& u, LAS float* ev, int wid, int lane) const {
        const int i = (wid & 3) * 64 + lane;
        const float* src = (wid < 4) ? rowss + u.pm * 256 + i : BW + (size_t)(u.pm >> 5) * NWIN + u.pn * 256 + i;
        __builtin_amdgcn_global_load_lds((const unsigned*)src, (LAS unsigned*)(ev + (wid < 4 ? 0 : 256) + (wid & 3) * 64), 4, 0, 0);
    }
    static constexpr int LDZ = EVEN ? NEV : NOD;
    __device__ __forceinline__ void put(int row, int col, f32x4 z) const {
        if (EVEN) {
            if (col < 2816) { if (col >= 1280 && col < 1792) z = z * 0.125f; *(f16x4*)(Z + (size_t)row * LDZ + col) = cvt4(z); }
            else if (col < NEVR) *(f32x4*)(GATES + (size_t)row * 16 + (col - 2816)) = z;
        } else *(f16x4*)(Z + (size_t)row * LDZ + col) = cvt4(z);
    }
    __device__ __forceinline__ void put8(int row, int col, f32x4 z0, f32x4 z1) const {
        if (EVEN) {
            if (col < 2816) { if (col >= 1280 && col < 1792) { z0 = z0 * 0.125f; z1 = z1 * 0.125f; } *(f16x8*)(Z + (size_t)row * LDZ + col) = cat4(cvt4(z0), cvt4(z1)); }
            else if (col < NEVR) { float* gp = GATES + (size_t)row * 16 + (col - 2816); *(f32x4*)gp = z0; *(f32x4*)(gp + 4) = z1; }
        } else *(f16x8*)(Z + (size_t)row * LDZ + col) = cat4(cvt4(z0), cvt4(z1));
    }
    __device__ __forceinline__ static int slot2col(int slot) { return (slot & ~31) + 8 * ((slot & 15) >> 2) + 4 * ((slot >> 4) & 1); }
    __device__ __forceinline__ void operator()(const f32x4 (&acc)[2][2][4][2], const Unit& u, int wr, int wc, int fr_in, int fq_in, const LAS float* ev) const {
        const int fr = opaque_v(fr_in), fq = opaque_v(fq_in);
        const int col0 = u.pn * 256 + wc * 32 + 8 * fq;
        f32x4 bv[2][2];
#pragma unroll
        for (int bj = 0; bj < 2; ++bj)
#pragma unroll
            for (int n = 0; n < 2; ++n) bv[bj][n] = *(const LAS f32x4*)(ev + 256 + wc * 32 + 4 * fq + bj * 128 + n * 16);
#pragma unroll
        for (int ai = 0; ai < 2; ++ai)
#pragma unroll
            for (int m = 0; m < 4; ++m) {
                const int row = u.pm * 256 + ai * 128 + wr * 64 + m * 16 + fr;
                const float r = rsqrtf(ev[ai * 128 + wr * 64 + m * 16 + fr] * (1.0f / D) + EPS);
#pragma unroll
                for (int bj = 0; bj < 2; ++bj) put8(row, col0 + bj * 128, acc[ai][bj][m][0] * r + bv[bj][0], acc[ai][bj][m][1] * r + bv[bj][1]);
            }
    }
    __device__ __forceinline__ void sk(int row, int slot, f32x4 v) const {
        const int b = row_batch(row); const float r = rsqrtf(rowss[row] * (1.0f / D) + EPS);
        put(row, slot2col(slot), v * r + *(const f32x4*)(BW + (size_t)b * NWIN + slot));
    }
};
struct EpiMod {
    static constexpr bool HAS_PRE = false;
    float* CS; float* GT; f16* SHA; const float* bmod; const float* NG; float* RCS;
    __device__ __forceinline__ void operator()(const f32x4 (&acc)[2][2][4][2], const Unit& u, int wr, int wc, int fr_in, int fq_in, const LAS float* ev) const {
        const int fr = opaque_v(fr_in), fq = opaque_v(fq_in);
        const int cu = u.pn * 256, l = cu / NMODC, jj = (cu - l * NMODC) >> 10, j = jj / 3, kind = jj - 3 * j, s = 3 * l + j;
        const int d0 = (cu & 1023) + wc * 32 + 4 * fq;
#pragma unroll
        for (int ai = 0; ai < 2; ++ai)
#pragma unroll
            for (int m = 0; m < 4; ++m) {
                const int row = ai * 128 + wr * 64 + m * 16 + fr;
#pragma unroll
                for (int bj = 0; bj < 2; ++bj)
#pragma unroll
                    for (int n = 0; n < 2; ++n) {
                        const int d = d0 + bj * 128 + n * 16;
                        const f32x4 v = acc[ai][bj][m][n] + *(const f32x4*)(bmod + cu - (cu & 1023) + d);
                        if (kind == 0) *tiled_ptr<f16x4>(SHA, s * 256 + row, d, D) = row < NBAT ? cvt4(v) : (f16x4){0, 0, 0, 0};
                        else if (row < NBAT) {
                            if (kind == 1) { const f32x4 c4 = *(const f32x4*)(NG + (l * 3 + j) * D + d) * (v + 1.0f); *(f32x4*)(CS + ((size_t)s * NBAT + row) * D + d) = c4;
                                *(f32x4*)(RCS + ((size_t)s * NBAT + row) * D + d) = (f32x4){1.0f / c4[0], 1.0f / c4[1], 1.0f / c4[2], 1.0f / c4[3]}; }
                            else *(f32x4*)(GT + ((size_t)s * NBAT + row) * D + d) = v * (j == 1 ? 1.0f : 0.5f);
                        }
                    }
            }
    }
};
struct EpiBias {
    static constexpr bool HAS_PRE = false;
    float* BW;
    __device__ __forceinline__ void operator()(const f32x4 (&acc)[2][2][4][2], const Unit& u, int wr, int wc, int fr_in, int fq_in, const LAS float* ev) const {
        const int fr = opaque_v(fr_in), fq = opaque_v(fq_in);
        const int col0 = u.pn * 256 + wc * 32 + 4 * fq;
#pragma unroll
        for (int ai = 0; ai < 2; ++ai)
#pragma unroll
            for (int m = 0; m < 4; ++m) {
                const int row = ai * 128 + wr * 64 + m * 16 + fr;
                if (row < NBAT) {
#pragma unroll
                    for (int bj = 0; bj < 2; ++bj)
#pragma unroll
                        for (int n = 0; n < 2; ++n) *(f32x4*)(BW + (size_t)row * NWIN + col0 + bj * 128 + n * 16) = acc[ai][bj][m][n];
                }
            }
    }
};

template <bool SWIGLU, int K, class Epi>
__device__ __forceinline__ void skinny_phase(ldsp_t lds, const f16* A, const f16* Bt, int N, const Epi& E, int G, int c, int nunits) {
    const int tid = opaque_v(threadIdx.x), wid = __builtin_amdgcn_readfirstlane(tid >> 6), lane = tid & 63, fr = lane & 15, fq = lane >> 4;
    const int grp = c & 7, rem = nunits % G, r0 = (rem + 7 - grp) >> 3;
    int r = (c >> 3) - r0, nr = ((G - grp + 7) >> 3) - r0;
    if (r < 0 || nr <= 0) { if (nr > 0) return; r = c >> 3; nr = (G - grp + 7) >> 3; }
    constexpr int AS = K + 8;
    constexpr int KS = (!SWIGLU && K > 2048) ? 4 : 1;
    LAS f16* As = (LAS f16*)lds;
    LAS float* red = (LAS float*)(lds + 16 * AS * 2);
    const f16* Ag = A + (size_t)(16 * grp) * K;
    {
        constexpr int NPC = K / 256; static_assert(16 * (K / 8) == NPC * 512, "K must be a multiple of 256");
        unsigned long long alo[NPC], ahi[NPC];
#pragma unroll
        for (int j = 0; j < NPC; ++j) { const int i = tid + 512 * j, row = i / (K / 8), ch = i - row * (K / 8);
            const unsigned long long* gp = (const unsigned long long*)(Ag + (size_t)row * K + 8 * ch);
            alo[j] = __hip_atomic_load(gp, __ATOMIC_RELAXED, __HIP_MEMORY_SCOPE_AGENT); ahi[j] = __hip_atomic_load(gp + 1, __ATOMIC_RELAXED, __HIP_MEMORY_SCOPE_AGENT); }
#pragma unroll
        for (int j = 0; j < NPC; ++j) { const int i = tid + 512 * j, row = i / (K / 8), ch = i - row * (K / 8);
            LAS unsigned long long* lp = (LAS unsigned long long*)(As + row * AS + 8 * ch); lp[0] = alo[j]; lp[1] = ahi[j]; }
    }
    __syncthreads();
    const int nitem = SWIGLU ? N / 32 : N / 16;
    const LAS f16* ap = As + fr * AS + 8 * fq;
    const int wq = wid / KS, kq = wid - wq * KS, nwq = 8 / KS;
    constexpr int KSTEPS = K / 32 / KS;
    for (int t0 = 0; t0 < nitem; t0 += nwq * nr) {
        const int t = t0 + wq * nr + r; const bool on = t < nitem;
        const int n0 = SWIGLU ? 32 * t : 16 * t;
        f32x4 acc0 = {0.f, 0.f, 0.f, 0.f}, acc1 = {0.f, 0.f, 0.f, 0.f};
        if (on) {
            const char* bp = (const char*)Bt + tiled_byte(n0 + fr, 8 * fq, K);
            const LAS f16* apk = ap + 32 * KSTEPS * kq;
            constexpr int UNR = SWIGLU ? 8 : (KSTEPS % 16 == 0 ? 16 : (KSTEPS % 11 == 0 ? 11 : 8));
            static_assert(KSTEPS % UNR == 0, "K-step grouping");
#pragma unroll 1
            for (int ks0 = 0; ks0 < KSTEPS; ks0 += UNR) {
                f16x8 b0[UNR], b1[SWIGLU ? UNR : 1];
#pragma unroll
                for (int u = 0; u < UNR; ++u) { const int kg = KSTEPS * kq + ks0 + u; const size_t ko = (size_t)(kg >> 1) * 32768 + (size_t)(kg & 1) * 1024;
                    b0[u] = *(const f16x8*)(bp + ko);
                    if constexpr (SWIGLU) b1[u] = *(const f16x8*)(bp + ko + 2048); }
#pragma unroll
                for (int u = 0; u < UNR; ++u) { const f16x8 a = *(const LAS f16x8*)(apk + 32 * (ks0 + u));
                    acc0 = __builtin_amdgcn_mfma_f32_16x16x32_f16(b0[u], a, acc0, 0, 0, 0);
                    if constexpr (SWIGLU) acc1 = __builtin_amdgcn_mfma_f32_16x16x32_f16(b1[u], a, acc1, 0, 0, 0); }
            }
        }
        if constexpr (KS > 1) {
            *(LAS f32x4*)(red + (wid * 64 + lane) * 4) = acc0;
            __syncthreads();
            if (kq == 0) {
#pragma unroll
                for (int j = 1; j < KS; ++j) acc0 = acc0 + *(const LAS f32x4*)(red + ((wid + j) * 64 + lane) * 4);
            }
            __syncthreads();
        }
        const int row = MP + 16 * grp + fr;
        if (on && kq == 0) {
            if constexpr (SWIGLU) E.sk(row, t, 4 * fq, acc0, acc1);
            else E.sk(row, n0 + 4 * fq, acc0);
        }
    }
    __syncthreads();
}

__device__ __forceinline__ bool skinny_member(int G, int c, int nunits, int& grp, int& nr) {
    grp = c & 7; const int rem = nunits % G, r0 = (rem + 7 - grp) >> 3;
    const int r = (c >> 3) - r0; nr = ((G - grp + 7) >> 3) - r0;
    if (r < 0 || nr <= 0) { if (nr > 0) return false; nr = (G - grp + 7) >> 3; }
    return true;
}
constexpr int CW_SKB = 8192;
__device__ __forceinline__ void skinny_group_sync(unsigned* cnt, unsigned n, unsigned* bar) {
    asm volatile("s_waitcnt vmcnt(0)" ::: "memory");
    __syncthreads();
    if (threadIdx.x == 0) { (void)xb_add(cnt, 1u); XB_SPIN(xb_ld(cnt) < n, bar); }
    asm volatile("" ::: "memory");
    __syncthreads();
}

struct Frame {
    ldsp_t lds; int tid, lane, wave, G, bid;
    float* out; unsigned char* ws;
};
#define FIN(i) (((const float* const __attribute__((address_space(4)))*)__builtin_amdgcn_kernarg_segment_ptr())[i])
#define WSP(T_, off) ((T_*)(F.ws + (off)))

__device__ __forceinline__ void tr_item(const float* W, int K, int Nsrc, int Ndst, int perm, f16* WT, LAS float* scr, int item, int lane) {
    const int nblk = Ndst / 64, kb = item / nblk, nb64 = item - kb * nblk, k0 = 32 * kb, n0 = 64 * nb64;
    const int kr = lane >> 4, c16 = lane & 15, nb = 2 * nb64 + (c16 >> 3), c4 = c16 & 7;
    int sc = 32 * nb + 4 * c4;
    if (perm == 2) sc = 32 * nb + 8 * (c4 & 3) + 4 * (c4 >> 2);
    else if (perm == 1) sc = (c4 >> 2) * FF + 128 * (nb64 >> 2) + 32 * (nb64 & 3) + 8 * (c4 & 3) + 4 * (c16 >> 3);
    const bool ok = sc < Nsrc;
    f32x4 v[8];
#pragma unroll
    for (int i = 0; i < 8; ++i) v[i] = ok ? __builtin_nontemporal_load((const f32x4*)(W + (size_t)(k0 + 4 * i + kr) * Nsrc + sc)) : (f32x4){0.f, 0.f, 0.f, 0.f};
#pragma unroll
    for (int i = 0; i < 8; ++i) { LAS float* d = scr + (4 * i + kr) * 65 + 4 * c16; d[0] = v[i][0]; d[1] = v[i][1]; d[2] = v[i][2]; d[3] = v[i][3]; }
    LDS_WAIT(); asm volatile("" ::: "memory");
    const int c = lane & 3;
#pragma unroll
    for (int j = 0; j < 4; ++j) { const int n = (lane >> 2) + 16 * j; const LAS float* sp = scr + (8 * c) * 65 + n;
        f16x8 o;
#pragma unroll
        for (int e = 0; e < 8; ++e) o[e] = (f16)sp[e * 65];
        const int row = perm == 1 ? 256 * (nb64 >> 2) + 128 * (n >> 5) + 32 * (nb64 & 3) + (n & 31) : n0 + n;
        *tiled_ptr<f16x8>(WT, row, k0 + 8 * c, K) = o; }
    LDS_WAIT(); asm volatile("" ::: "memory");
}
struct MatDesc { const float* src; int K, Nsrc, Ndst, perm; f16* dst; };
__device__ __forceinline__ void mat_desc(Frame& F, int mi, MatDesc& d) {
    if (mi < 8) { const int l = mi >> 1, i = mi & 1; d = {FIN(I_FWI) + (size_t)mi * D * FF2, D, FF2, FF2, 1, WSP(f16, WS_WIN) + (size_t)site_off(3 * l + 2 * i) * D}; }
    else if (mi < 10) { const int e = mi - 8; d = {FIN(I_EWI) + (size_t)e * D * NEVR, D, NEVR, NEV, 2, WSP(f16, WS_WIN) + (size_t)site_off(6 * e + 1) * D}; }
    else if (mi < 12) { const int o = mi - 10; d = {FIN(I_OWI) + (size_t)o * D * NOD, D, NOD, NOD, 2, WSP(f16, WS_WIN) + (size_t)site_off(6 * o + 4) * D}; }
    else if (mi < 20) { const int k = mi - 12; d = {FIN(I_FWO) + (size_t)k * FF * D, FF, D, D, 2, WSP(f16, WS_WFO) + (size_t)k * D * FF}; }
    else if (mi < 22) { const int e = mi - 20; d = {FIN(I_EWO) + (size_t)e * D * D, D, D, D, 2, WSP(f16, WS_WEO) + (size_t)e * D * D}; }
    else if (mi < 24) { const int o = mi - 22; d = {FIN(I_OWO) + (size_t)o * 512 * D, 512, D, D, 2, WSP(f16, WS_WOO) + (size_t)o * D * 512}; }
    else { const int l = mi - 24; d = {FIN(I_WMOD) + (size_t)l * D * NMODC, D, NMODC, NMODC, 0, WSP(f16, WS_WMOD) + (size_t)l * NMODC * D}; }
}
__device__ __forceinline__ void cache_shift(const float* in, float* out, int W, size_t gtid, size_t gstride) {
    const size_t per = (size_t)(W - 1) * 64, total = per * 256;
    for (size_t i = gtid; i < total; i += gstride) {
        const size_t es = i / per, off = i - es * per;
        const f32x4 v = __builtin_nontemporal_load((const f32x4*)(in + es * (size_t)W * 256 + 256) + off);
        __builtin_nontemporal_store(v, (f32x4*)(out + es * (size_t)W * 256) + off);
    }
}
__device__ __forceinline__ void phase_pr0(Frame& F, int mlo, int mhi, bool do_ac, unsigned* ctr) {
    LAS float* scr = (LAS float*)(F.lds + F.wave * 16384);
    const int gw = F.bid * 8 + F.wave, NGW = F.G * 8;
    if (ctr) {
        int total = 0;
        for (int mi = mlo; mi < mhi; ++mi) { MatDesc d; mat_desc(F, mi, d); total += (d.K / 64) * (d.Ndst / 32); }
        for (;;) {
            unsigned g0 = 0; if (F.lane == 0) g0 = xb_add(ctr, 4u);
            g0 = (unsigned)__builtin_amdgcn_readfirstlane((int)g0);
            if ((int)g0 >= total) break;
            for (int j = 0; j < 4 && (int)g0 + j < total; ++j) {
                int g = (int)g0 + j, mi = mlo; MatDesc d; mat_desc(F, mi, d); int items = (d.K / 64) * (d.Ndst / 32);
                while (g >= items) { g -= items; ++mi; mat_desc(F, mi, d); items = (d.K / 64) * (d.Ndst / 32); }
                tr_item(d.src, d.K, d.Nsrc, d.Ndst, d.perm, d.dst, scr, g, F.lane);
            }
        }
    } else {
    int base = 0;
    for (int mi = mlo; mi < mhi; ++mi) {
        MatDesc d; mat_desc(F, mi, d);
        const int items = (d.K / 64) * (d.Ndst / 32);
        int it = gw - (base % NGW); if (it < 0) it += NGW;
        for (; it < items; it += NGW) tr_item(d.src, d.K, d.Nsrc, d.Ndst, d.perm, d.dst, scr, it, F.lane);
        base += items;
    }
    }
    if (do_ac) { f16* AC = WSP(f16, WS_AC);
      for (int i = F.bid * 512 + F.tid; i < 256 * D; i += F.G * 512) { const int b = i >> 10, d = i & 1023; float v = 0.f;
          if (b < NBAT) { const float c = b < NB ? FIN(I_CP)[b * D + d] : FIN(I_CSMP)[(b - NB) * D + d]; v = c / (1.0f + __expf(-c)); }
          *tiled_ptr<f16>(AC, b, d, D) = (f16)v; } }
}
__device__ __forceinline__ void phase_pr2(Frame& F) {
    const float* CS0 = WSP(float, WS_CS);
    f16* X = WSP(f16, WS_X); f16* A = WSP(f16, WS_A); float* rowss = (float*)(F.ws + RSS_OFF);
    constexpr int NU = NWIN / 256, NIT = MALL / 4;
    const int nbw = (F.G < NU ? F.G : NU) * 8, nfw = F.G * 8 - nbw;
    int it_lo = 0, it_hi = NIT, it_idx = F.bid * 8 + F.wave, it_st = F.G * 8;
    if (nfw > 0) { const int ib = NIT < nbw ? NIT : nbw;
        if (F.bid < NU) { it_hi = ib; it_st = nbw; } else { it_lo = ib; it_idx = (F.bid - NU) * 8 + F.wave; it_st = nfw; } }
    for (int it = it_lo + it_idx; it < it_hi; it += it_st) { const int m0 = it * 4;
        f32x4 xv[4][4];
#pragma unroll
        for (int r = 0; r < 4; ++r) { const int m = m0 + r; const float* xr = m < MP ? FIN(I_XP) + (size_t)m * D : FIN(I_XS) + (size_t)(m - MP) * D;
#pragma unroll
            for (int q = 0; q < 4; ++q) xv[r][q] = __builtin_nontemporal_load((const f32x4*)(xr + q * 256 + F.lane * 4)); }
#pragma unroll
        for (int r = 0; r < 4; ++r) { const int m = m0 + r; const float* cs = CS0 + (size_t)row_batch(m) * D; float ss = 0.f;
#pragma unroll
            for (int q = 0; q < 4; ++q) { const int d = q * 256 + F.lane * 4;
                const f32x4 x = xv[r][q];
                ss += (x[0] * x[0] + x[1] * x[1]) + (x[2] * x[2] + x[3] * x[3]);
                const f16x4 av = cvt4(x * *(const f32x4*)(cs + d));
                if (m < MP) *tiled_ptr<f16x4>(A, m, d, D) = av; else *(f16x4*)(A + (size_t)m * D + d) = av; }
            ss = wave_sum(ss);
            if (F.lane == 0) rowss[m] = ss; }
    }
}
template <int O0, int O1, int O2, int O3, int O4, int O5, int O6, int O7>
__device__ __forceinline__ void tr_read8(unsigned base, f16x4 (&r)[8]) {
    asm volatile("ds_read_b64_tr_b16 %0, %8 offset:%9\n\tds_read_b64_tr_b16 %1, %8 offset:%10\n\tds_read_b64_tr_b16 %2, %8 offset:%11\n\tds_read_b64_tr_b16 %3, %8 offset:%12\n\t"
                 "ds_read_b64_tr_b16 %4, %8 offset:%13\n\tds_read_b64_tr_b16 %5, %8 offset:%14\n\tds_read_b64_tr_b16 %6, %8 offset:%15\n\tds_read_b64_tr_b16 %7, %8 offset:%16\n\ts_waitcnt lgkmcnt(0)"
                 : "=&v"(r[0]), "=&v"(r[1]), "=&v"(r[2]), "=&v"(r[3]), "=&v"(r[4]), "=&v"(r[5]), "=&v"(r[6]), "=&v"(r[7])
                 : "v"(base), "n"(O0), "n"(O1), "n"(O2), "n"(O3), "n"(O4), "n"(O5), "n"(O6), "n"(O7) : "memory");
}
__device__ __forceinline__ unsigned lds_addr(const LAS void* p) { return (unsigned)(unsigned long long)p; }
struct BandAttn { const f16* Z; int ldz, qcol, kcol, vcol; f16* O; int ldo, ocol; float* LSE; const float* sinks; int tiledO; };
constexpr int KS_STR = 72, VS_STR = 96;
constexpr int ATT_KS = 0, ATT_VS = 256 * KS_STR * 2;
__device__ __forceinline__ void band_attn_unit(ldsp_t lds, const BandAttn& P, int tokbase, int stride, int blk, int kvh) {
    const int tid = opaque_v(threadIdx.x), w = __builtin_amdgcn_readfirstlane(tid >> 6), lane = tid & 63, c = lane & 31, hh = lane >> 5;
    LAS f16* Ks = (LAS f16*)(lds + ATT_KS); LAS f16* Vs = (LAS f16*)(lds + ATT_VS);
    f16x8 qfa[2][4];
    { const int head_ = kvh * 4 + (w >> 1);
#pragma unroll
      for (int qt = 0; qt < 2; ++qt) { const int mr_ = tokbase + stride * (128 * blk + 64 * (w & 1) + 32 * qt + c);
#pragma unroll
          for (int ks = 0; ks < 4; ++ks) qfa[qt][ks] = *(const f16x8*)(P.Z + (size_t)mr_ * P.ldz + P.qcol + head_ * 64 + 16 * ks + 8 * hh); } }
#pragma unroll
    for (int i = 0; i < 4; ++i) {
        const int cid = tid + 512 * i, key = cid >> 3, ch = cid & 7, p = 128 * blk - 128 + key;
        f16x8 kv = {0, 0, 0, 0, 0, 0, 0, 0}, vv = {0, 0, 0, 0, 0, 0, 0, 0};
        if (p >= 0) { const f16* zr = P.Z + (size_t)(tokbase + stride * p) * P.ldz + kvh * 64 + 8 * ch; kv = *(const f16x8*)(zr + P.kcol); vv = *(const f16x8*)(zr + P.vcol); }
        *(LAS f16x8*)(Ks + key * KS_STR + 8 * ch) = kv;
        *(LAS f16x8*)(Vs + key * VS_STR + 8 * ch) = vv;
    }
    __syncthreads();
    const int g = w >> 1, qh = w & 1, head = kvh * 4 + g;
    const unsigned vlane = lds_addr(Vs) + (unsigned)((4 * hh + ((lane & 15) >> 2)) * (VS_STR * 2) + (16 * ((lane >> 4) & 1) + 4 * (lane & 3)) * 2);
    const float sink = P.sinks ? P.sinks[head] : -INFINITY;
    constexpr float SC = 0.125f, L2E = 1.4426950408889634f;
#pragma unroll
    for (int qt = 0; qt < 2; ++qt) {
        const int i0 = 64 * qh + 32 * qt;
        const int mrow = tokbase + stride * (128 * blk + i0 + c);
        f16x8 qf[4];
#pragma unroll
        for (int ks = 0; ks < 4; ++ks) qf[ks] = qt ? qfa[1][ks] : qfa[0][ks];
        f32x16 s[5];
#pragma unroll
        for (int kt = 0; kt < 5; ++kt) {
#pragma unroll
            for (int i = 0; i < 16; ++i) s[kt][i] = 0.f;
#pragma unroll
            for (int ks = 0; ks < 4; ++ks) {
                const f16x8 a = *(const LAS f16x8*)(Ks + (i0 + 32 * kt + c) * KS_STR + 16 * ks + 8 * hh);
                s[kt] = __builtin_amdgcn_mfma_f32_32x32x16_f16(a, qf[ks], s[kt], 0, 0, 0);
            }
        }
        float mx = -INFINITY;
        const int cm = c - 4 * hh;
#pragma unroll
        for (int i = 0; i < 16; ++i) { const int kb = (i & 3) + 8 * (i >> 2);
            s[0][i] = (kb >= cm) ? s[0][i] : -INFINITY; s[4][i] = (kb <= cm) ? s[4][i] : -INFINITY; }
        if (blk == 0) {
            asm volatile("" ::: "memory");
#pragma unroll
            for (int kt = 0; kt < 5; ++kt)
#pragma unroll
                for (int i = 0; i < 16; ++i) { const int kr = (i & 3) + 8 * (i >> 2) + 4 * hh; s[kt][i] = (i0 + 32 * kt + kr >= 128) ? s[kt][i] : -INFINITY; }
        }
#pragma unroll
        for (int kt = 0; kt < 5; ++kt)
#pragma unroll
            for (int i = 0; i < 16; ++i) mx = fmaxf(mx, s[kt][i]);
        mx = fmaxf(mx, __shfl_xor(mx, 32));
        mx = fmaxf(mx * SC, sink);
        constexpr float CE = SC * L2E; const float moff = mx * L2E;
        float sum = 0.f; f16x8 pf[5][2];
#pragma unroll
        for (int kt = 0; kt < 5; ++kt)
#pragma unroll
            for (int i = 0; i < 16; ++i) { const float pv = __builtin_amdgcn_exp2f(__builtin_fmaf(s[kt][i], CE, -moff)); sum += pv; pf[kt][i >> 3][i & 7] = (f16)pv; }
        sum += __shfl_xor(sum, 32);
        sum += __builtin_amdgcn_exp2f((sink - mx) * L2E);
        const float inv = __builtin_amdgcn_rcpf(sum);
        f32x16 o[2];
#pragma unroll
        for (int i = 0; i < 16; ++i) { o[0][i] = 0.f; o[1][i] = 0.f; }
        const unsigned vb = vlane + (unsigned)(i0 * (VS_STR * 2));
#define BA_PV(KT) { f16x4 r[8]; constexpr int B_ = (KT) * 32 * VS_STR * 2, S_ = 16 * VS_STR * 2, H_ = 8 * VS_STR * 2; \
            tr_read8<B_, B_ + H_, B_ + S_, B_ + S_ + H_, B_ + 64, B_ + 64 + H_, B_ + 64 + S_, B_ + 64 + S_ + H_>(vb, r); \
            o[0] = __builtin_amdgcn_mfma_f32_32x32x16_f16(cat4(r[0], r[1]), pf[KT][0], o[0], 0, 0, 0); o[0] = __builtin_amdgcn_mfma_f32_32x32x16_f16(cat4(r[2], r[3]), pf[KT][1], o[0], 0, 0, 0); \
            o[1] = __builtin_amdgcn_mfma_f32_32x32x16_f16(cat4(r[4], r[5]), pf[KT][0], o[1], 0, 0, 0); o[1] = __builtin_amdgcn_mfma_f32_32x32x16_f16(cat4(r[6], r[7]), pf[KT][1], o[1], 0, 0, 0); }
        BA_PV(0) BA_PV(1) BA_PV(2) BA_PV(3) BA_PV(4)
#undef BA_PV
#pragma unroll
        for (int dt = 0; dt < 2; ++dt) {
            const int ocol = P.ocol + head * 64 + 32 * dt + 4 * hh;
#pragma unroll
            for (int rg = 0; rg < 4; ++rg) { f32x4 v = {o[dt][4 * rg] * inv, o[dt][4 * rg + 1] * inv, o[dt][4 * rg + 2] * inv, o[dt][4 * rg + 3] * inv};
                f16x4* op = P.tiledO ? tiled_ptr<f16x4>(P.O, mrow, ocol + 8 * rg, P.ldo) : (f16x4*)(P.O + (size_t)mrow * P.ldo + ocol + 8 * rg);
                *op = cvt4(v); }
        }
        if (P.LSE && hh == 0) P.LSE[(size_t)mrow * 8 + head] = mx + __logf(sum);
    }
    __syncthreads();
}
__device__ __forceinline__ void kv_export(const f16* Z, int ldz, int kcol, int vcol, int m0, int nrows, float* out, int tid0, int nthr) {
    for (int i0 = tid0; i0 < nrows * 32; i0 += 8 * nthr) {
        f16x8 v[8];
#pragma unroll
        for (int j = 0; j < 8; ++j) { const int i = i0 + j * nthr, r = i >> 5, ch = i & 31, isv = ch >> 4, c8 = (ch & 15) * 8;
            v[j] = i < nrows * 32 ? *(const f16x8*)(Z + (size_t)(m0 + r) * ldz + (isv ? vcol : kcol) + c8) : (f16x8){0, 0, 0, 0, 0, 0, 0, 0}; }
#pragma unroll
        for (int j = 0; j < 8; ++j) { const int i = i0 + j * nthr, r = i >> 5, ch = i & 31, isv = ch >> 4, c8 = (ch & 15) * 8;
            if (i < nrows * 32) { float* o = out + (size_t)r * 256 + isv * 128 + c8;
                *(f32x4*)o = (f32x4){(float)v[j][0], (float)v[j][1], (float)v[j][2], (float)v[j][3]}; *(f32x4*)(o + 4) = (f32x4){(float)v[j][4], (float)v[j][5], (float)v[j][6], (float)v[j][7]}; } }
    }
}

__device__ __forceinline__ void gate_scan(const float* GATES, const float* bg, int m0, int h, int lane, LAS float* gb, LAS float* ga, LAS float* gcm, float& amax, float& bL, float& a0o, float& a1o) {
    const float* g0 = GATES + (size_t)(m0 + 2 * lane) * 16;
    const float ig0 = g0[h] + bg[h], ig1 = g0[16 + h] + bg[h];
    const float lf0 = logsigmoidf_(g0[8 + h] + bg[8 + h]), lf1 = logsigmoidf_(g0[24 + h] + bg[8 + h]);
    float s = lf0 + lf1;
#pragma unroll
    for (int o = 1; o < 64; o <<= 1) { const float t = __shfl_up(s, o); if (lane >= o) s += t; }
    const float b0 = (s - (lf0 + lf1)) + lf0, b1 = b0 + lf1;
    const float a0 = ig0 - b0, a1 = ig1 - b1;
    float mx = fmaxf(a0, a1);
#pragma unroll
    for (int o = 1; o < 64; o <<= 1) { const float t = __shfl_up(mx, o); if (lane >= o) mx = fmaxf(mx, t); }
    float ex = __shfl_up(mx, 1); if (lane == 0) ex = -INFINITY;
    const float c0 = fmaxf(ex, a0), c1 = fmaxf(c0, a1);
    gb[2 * lane] = b0; gb[2 * lane + 1] = b1; ga[2 * lane] = a0; ga[2 * lane + 1] = a1; gcm[2 * lane] = c0; gcm[2 * lane + 1] = c1;
    amax = __shfl(mx, 63); bL = __shfl(s, 63); a0o = a0; a1o = a1;
}
constexpr int X1_KS = 0, X1_VS = 18432, X1_G = 36864, X1_HEAD = 38912, X1_STR = 72;
__device__ __forceinline__ void mlstm_x1_unit(Frame& F, int e, int b, int ch, int hp) {
    const int tid = F.tid, w = F.wave, lane = F.lane, hg = w >> 2, wv = w & 3, gt = tid & 255, h = 2 * hp + hg;
    ldsp_t base = F.lds + hg * X1_HEAD;
    LAS f16* Ksm = (LAS f16*)(base + X1_KS); LAS f16* Vsm = (LAS f16*)(base + X1_VS);
    LAS float* gb = (LAS float*)(base + X1_G); LAS float* ga = gb + 128; LAS float* gcm = ga + 128; LAS float* gwk = gcm + 128;
    const f16* Z = WSP(f16, WS_Z); const float* GATES = WSP(float, WS_GATES); const float* bg = FIN(I_EBG) + e * 16;
    const int m0 = b * T + 128 * ch, idx = (b * 8 + h) * 64 + ch;
    float amax = 0.f, bL = 0.f;
    f16x8 kxa[4], vxa[4];
#pragma unroll
    for (int i = 0; i < 4; ++i) { const int cid = gt + 256 * i, s_ = cid >> 3, c8 = cid & 7; const f16* zr = Z + (size_t)(m0 + s_) * NEV + h * 64 + 8 * c8;
        kxa[i] = *(const f16x8*)(zr + 1280); vxa[i] = *(const f16x8*)(zr + 1792); }
    if (wv == 0) { float a0, a1; gate_scan(GATES, bg, m0, h, lane, gb, ga, gcm, amax, bL, a0, a1); gwk[2 * lane] = __expf(a0 - amax); gwk[2 * lane + 1] = __expf(a1 - amax); }
    __syncthreads();
#pragma unroll
    for (int i = 0; i < 4; ++i) {
        const int cid = gt + 256 * i, s_ = cid >> 3, c8 = cid & 7;
        const f16x8 kx = kxa[i], vx = vxa[i]; const float wk = gwk[s_];
        f16x8 ks;
#pragma unroll
        for (int q = 0; q < 8; ++q) ks[q] = (f16)((float)kx[q] * wk);
        *(LAS f16x8*)(Ksm + s_ * X1_STR + 8 * c8) = ks; *(LAS f16x8*)(Vsm + s_ * X1_STR + 8 * c8) = vx;
    }
    __syncthreads();
    const int fr = lane & 15, fq = lane >> 4;
    const unsigned lof = (unsigned)((8 * fq + (fr >> 2)) * (X1_STR * 2) + 4 * (fr & 3) * 2);
    const unsigned vaddr = lds_addr(Vsm) + lof + (unsigned)(16 * wv * 2), kaddr = lds_addr(Ksm) + lof;
    constexpr int R4 = 4 * X1_STR * 2, R32 = 32 * X1_STR * 2;
    f16x4 rv[8];
    tr_read8<0, R4, R32, R32 + R4, 2 * R32, 2 * R32 + R4, 3 * R32, 3 * R32 + R4>(vaddr, rv);
    float* DC = WSP(float, WS_DC) + (size_t)idx * 4096;
    f32x4 accn = {0.f, 0.f, 0.f, 0.f};
    f16x8 ones;
#pragma unroll
    for (int q = 0; q < 8; ++q) ones[q] = (fr == 0) ? (f16)1.0f : (f16)0.0f;
#define X1_TILE(DKT) { f16x4 rk[8]; tr_read8<(DKT) * 32, (DKT) * 32 + R4, (DKT) * 32 + R32, (DKT) * 32 + R32 + R4, (DKT) * 32 + 2 * R32, (DKT) * 32 + 2 * R32 + R4, (DKT) * 32 + 3 * R32, (DKT) * 32 + 3 * R32 + R4>(kaddr, rk); \
        f32x4 acc = {0.f, 0.f, 0.f, 0.f}; \
        _Pragma("unroll") for (int ks = 0; ks < 4; ++ks) { const f16x8 bf = cat4(rk[2 * ks], rk[2 * ks + 1]); acc = __builtin_amdgcn_mfma_f32_16x16x32_f16(cat4(rv[2 * ks], rv[2 * ks + 1]), bf, acc, 0, 0, 0); \
            if ((DKT) == wv) accn = __builtin_amdgcn_mfma_f32_16x16x32_f16(ones, bf, accn, 0, 0, 0); } \
        _Pragma("unroll") for (int r = 0; r < 4; ++r) DC[(16 * wv + 4 * fq + r) * 64 + 16 * (DKT) + fr] = acc[r]; }
    X1_TILE(0) X1_TILE(1) X1_TILE(2) X1_TILE(3)
#undef X1_TILE
    if (fq == 0) WSP(float, WS_DN)[(size_t)idx * 64 + 16 * wv + fr] = accn[0];
    if (gt == 0) { float* SC = WSP(float, WS_SC); SC[idx] = bL + amax; SC[1024 + idx] = bL; }
    __syncthreads();
}
__device__ __forceinline__ void mlstm_scan(Frame& F, int e) {
    const int gid0 = F.bid * 512; if (gid0 >= 16 * 4160) return;
    const int bh0 = gid0 / 4160;
    const float* SC = WSP(float, WS_SC); float* MPV = WSP(float, WS_SC) + 2048;
    LAS float* sc = (LAS float*)F.lds;
    if (F.tid < 256) { const int hw = F.tid >> 7, c = (F.tid >> 1) & 63, k = F.tid & 1, bhs = bh0 + hw; sc[F.tid] = bhs < 16 ? SC[k * 1024 + bhs * 64 + c] : 0.f; }
    __syncthreads();
    const int gid = gid0 + F.tid;
    if (gid < 16 * 4160) {
        const int bh = gid / 4160, el = gid - bh * 4160; const bool isc = el < 4096;
        const float* src = isc ? WSP(float, WS_DC) + (size_t)bh * 64 * 4096 + el : WSP(float, WS_DN) + (size_t)bh * 64 * 64 + (el - 4096);
        const int sstr = isc ? 4096 : 64;
        f16* cp = WSP(f16, WS_CP) + (size_t)bh * 64 * 4096 + el; float* np = WSP(float, WS_NP) + (size_t)bh * 64 * 64 + (el - 4096);
        const LAS float* scb = sc + (bh - bh0) * 128;
        float dvv[64];
#pragma unroll
        for (int c = 0; c < 64; ++c) dvv[c] = src[(size_t)c * sstr];
        float st = 0.f, mst = 0.f;
#pragma unroll
        for (int c = 0; c < 64; ++c) {
            const float mloc = scb[2 * c], bL = scb[2 * c + 1];
            if (isc) cp[(size_t)c * 4096] = (f16)st; else np[c * 64] = st;
            if (el == 0) MPV[bh * 64 + c] = mst;
            const float mnew = fmaxf(bL + mst, mloc);
            st = __expf(bL + mst - mnew) * st + __expf(mloc - mnew) * dvv[c]; mst = mnew;
        }
        const int b = bh >> 3, h = bh & 7;
        if (isc) { const int dv = el >> 6, dk = el & 63; F.out[O_BCP + ((size_t)((e * 2 + b) * 8 + h) * 64 + dk) * 64 + dv] = st; }
        else F.out[O_BNP + (size_t)((e * 2 + b) * 8 + h) * 64 + (el - 4096)] = st;
        if (el == 0) F.out[O_BMP + (e * 2 + b) * 8 + h] = mst;
    }
    __syncthreads();
}
constexpr int X3_KR = 0, X3_VS = 18432, X3_G = 43008, X3_HEAD = 45056;
__device__ __forceinline__ void mlstm_x3_unit(Frame& F, int e, int b, int ch, int hp) {
    const int tid = F.tid, w = F.wave, lane = F.lane, hg = w >> 2, tt = w & 3, gt = tid & 255, h = 2 * hp + hg, c = lane & 31, hh = lane >> 5;
    ldsp_t base = F.lds + hg * X3_HEAD;
    LAS f16* Kr = (LAS f16*)(base + X3_KR); LAS f16* Vs = (LAS f16*)(base + X3_VS);
    LAS float* gb = (LAS float*)(base + X3_G); LAS float* ga = gb + 128; LAS float* gcm = ga + 128; LAS float* npv = gcm + 128;
    const f16* Z = WSP(f16, WS_Z); const float* GATES = WSP(float, WS_GATES); const float* bg = FIN(I_EBG) + e * 16;
    const int m0 = b * T + 128 * ch, idx = (b * 8 + h) * 64 + ch;
    f16x8 kxa[4], vxa[4];
#pragma unroll
    for (int i = 0; i < 4; ++i) { const int cid = gt + 256 * i, s = cid >> 3, c8 = cid & 7; const f16* zr = Z + (size_t)(m0 + s) * NEV + h * 64 + 8 * c8;
        kxa[i] = *(const f16x8*)(zr + 1280); vxa[i] = *(const f16x8*)(zr + 1792); }
    if (tt == 0) { float t0, t1, t2, t3; gate_scan(GATES, bg, m0, h, lane, gb, ga, gcm, t0, t1, t2, t3); }
#pragma unroll
    for (int i = 0; i < 4; ++i) {
        const int cid = gt + 256 * i, s = cid >> 3, c8 = cid & 7;
        const f16x8 kx = kxa[i], vx = vxa[i];
        *(LAS f16x8*)(Kr + s * KS_STR + 8 * c8) = kx;
        *(LAS f16x8*)(Vs + s * VS_STR + 8 * c8) = vx;
    }
    if (gt < 64) npv[gt] = WSP(float, WS_NP)[(size_t)idx * 64 + gt];
    __syncthreads();
    const float mst = WSP(float, WS_SC)[2048 + idx];
    const int t = 32 * tt + c, mrow = m0 + t;
    const float bt = gb[t], mm = fmaxf(mst, gcm[t]), mt = bt + mm;
    f16x8 qf[4];
#pragma unroll
    for (int ks = 0; ks < 4; ++ks) qf[ks] = *(const f16x8*)(Z + (size_t)mrow * NEV + 768 + h * 64 + 16 * ks + 8 * hh);
    f32x16 num[2];
#pragma unroll
    for (int i = 0; i < 16; ++i) { num[0][i] = 0.f; num[1][i] = 0.f; }
    float qsum = 0.f;
    const unsigned vlane = lds_addr(Vs) + (unsigned)((4 * hh + ((lane & 15) >> 2)) * (VS_STR * 2) + (16 * ((lane >> 4) & 1) + 4 * (lane & 3)) * 2);
    for (int st = 0; st <= tt; ++st) {
        f32x16 sa;
#pragma unroll
        for (int i = 0; i < 16; ++i) sa[i] = 0.f;
#pragma unroll
        for (int ks = 0; ks < 4; ++ks) { const f16x8 a = *(const LAS f16x8*)(Kr + (32 * st + c) * KS_STR + 16 * ks + 8 * hh); sa = __builtin_amdgcn_mfma_f32_32x32x16_f16(a, qf[ks], sa, 0, 0, 0); }
        f16x8 wf[2];
        const bool diag = (st == tt);
        constexpr float L2E_ = 1.4426950408889634f; const float mml = mm * L2E_;
#pragma unroll
        for (int rg = 0; rg < 4; ++rg) {
            const int s0 = 32 * st + 8 * rg + 4 * hh;
            const f32x4 g4 = *(const LAS f32x4*)(ga + s0);
#pragma unroll
            for (int q = 0; q < 4; ++q) {
                const int i = 4 * rg + q;
                float dd = __builtin_amdgcn_exp2f(__builtin_fmaf(g4[q], L2E_, -mml));
                if (diag) dd = (s0 + q <= t) ? dd : 0.f;
                const float wv_ = sa[i] * dd;
                qsum += wv_; wf[i >> 3][i & 7] = (f16)wv_;
            }
        }
        { f16x4 r[8]; constexpr int S_ = 16 * VS_STR * 2, H_ = 8 * VS_STR * 2;
          tr_read8<0, H_, S_, S_ + H_, 64, 64 + H_, 64 + S_, 64 + S_ + H_>(vlane + (unsigned)(st * 32 * VS_STR * 2), r);
          num[0] = __builtin_amdgcn_mfma_f32_32x32x16_f16(cat4(r[0], r[1]), wf[0], num[0], 0, 0, 0); num[0] = __builtin_amdgcn_mfma_f32_32x32x16_f16(cat4(r[2], r[3]), wf[1], num[0], 0, 0, 0);
          num[1] = __builtin_amdgcn_mfma_f32_32x32x16_f16(cat4(r[4], r[5]), wf[0], num[1], 0, 0, 0); num[1] = __builtin_amdgcn_mfma_f32_32x32x16_f16(cat4(r[6], r[7]), wf[1], num[1], 0, 0, 0); }
    }
    qsum += __shfl_xor(qsum, 32);
    f32x16 ni[2];
#pragma unroll
    for (int i = 0; i < 16; ++i) { ni[0][i] = 0.f; ni[1][i] = 0.f; }
    const f16* CP = WSP(f16, WS_CP) + (size_t)idx * 4096;
#pragma unroll
    for (int dt = 0; dt < 2; ++dt)
#pragma unroll
        for (int ks = 0; ks < 4; ++ks) { const f16x8 a = *(const f16x8*)(CP + (32 * dt + c) * 64 + 16 * ks + 8 * hh); ni[dt] = __builtin_amdgcn_mfma_f32_32x32x16_f16(a, qf[ks], ni[dt], 0, 0, 0); }
    float qni = 0.f;
#pragma unroll
    for (int ks = 0; ks < 4; ++ks)
#pragma unroll
        for (int j = 0; j < 8; ++j) qni += (float)qf[ks][j] * npv[16 * ks + 8 * hh + j];
    qni += __shfl_xor(qni, 32);
    const float inter = __expf(mst - mm);
    const float qn = qsum + inter * qni, invd = __builtin_amdgcn_rcpf(fmaxf(fabsf(qn), __expf(-mt)));
    float ssq = 0.f;
#pragma unroll
    for (int dt = 0; dt < 2; ++dt)
#pragma unroll
        for (int i = 0; i < 16; ++i) { const float hv = (num[dt][i] + inter * ni[dt][i]) * invd; num[dt][i] = hv; ssq += hv * hv; }
    ssq += __shfl_xor(ssq, 32);
    const float rinv = rsqrtf(ssq * (1.0f / 64.0f) + EPS);
    const float* hgain = FIN(I_EHG) + (e * 8 + h) * 64;
    f16* O = WSP(f16, WS_O);
#pragma unroll
    for (int dt = 0; dt < 2; ++dt)
#pragma unroll
        for (int rg = 0; rg < 4; ++rg) {
            const int dv0 = 32 * dt + 8 * rg + 4 * hh;
            const f16x4 bo = *(const f16x4*)(Z + (size_t)mrow * NEV + 2304 + h * 64 + dv0); const f32x4 gn = *(const f32x4*)(hgain + dv0);
            f32x4 y;
#pragma unroll
            for (int q = 0; q < 4; ++q) y[q] = num[dt][4 * rg + q] * rinv * gn[q] * sigmoidf_((float)bo[q]);
            *tiled_ptr<f16x4>(O, mrow, 512 + h * 64 + dv0, D) = cvt4(y);
        }
    __syncthreads();
}

constexpr int DA_QS = 0, DA_KC = 1024, DA_VC = 36352, DA_SC = 69376, DA_RD = 71488, DA_KSTR = 68;
struct DecKV { f32x4 k[4], v[4]; };
__device__ __forceinline__ void dec_load(const Frame& F, const float* cache, int dil, int kvh, DecKV& r) {
#pragma unroll
    for (int i = 0; i < 4; ++i) { const int cid = F.tid + 512 * i, j = cid >> 4, c4 = cid & 15;
        const float* src = cache + (size_t)(dil * j) * 256 + kvh * 64 + 4 * c4;
        r.k[i] = *(const f32x4*)src; r.v[i] = *(const f32x4*)(src + 128); }
}
__device__ __forceinline__ void dec_attn(Frame& F, const DecKV& kv, int kvh, const f16* zrow, int qcol, int kcol, int vcol, const float* sinks, float& o_out, float& lse_out) {
    const int tid = F.tid, lane = F.lane, w = F.wave;
    LAS float* qs = (LAS float*)(F.lds + DA_QS); LAS float* Kc = (LAS float*)(F.lds + DA_KC); LAS float* Vc = (LAS float*)(F.lds + DA_VC);
    LAS float* sc = (LAS float*)(F.lds + DA_SC); LAS float* rd = (LAS float*)(F.lds + DA_RD);
#pragma unroll
    for (int i = 0; i < 4; ++i) {
        const int cid = tid + 512 * i, j = cid >> 4, c4 = cid & 15;
        *(LAS f32x4*)(Kc + j * DA_KSTR + 4 * c4) = kv.k[i];
        *(LAS f32x4*)(Vc + j * 64 + 4 * c4) = kv.v[i];
    }
    if (tid < 64) { Kc[128 * DA_KSTR + tid] = (float)zrow[kcol + kvh * 64 + tid]; Vc[128 * 64 + tid] = (float)zrow[vcol + kvh * 64 + tid]; }
    if (tid < 256) qs[tid] = (float)zrow[qcol + kvh * 256 + tid];
    __syncthreads();
    for (int jj = tid; jj < 516; jj += 512) {
        const int j = jj >> 2, g = jj & 3; f32x4 s4 = {0.f, 0.f, 0.f, 0.f};
#pragma unroll
        for (int d = 0; d < 64; d += 4) s4 = s4 + *(const LAS f32x4*)(qs + g * 64 + d) * *(const LAS f32x4*)(Kc + j * DA_KSTR + d);
        sc[g * 132 + j] = ((s4[0] + s4[1]) + (s4[2] + s4[3])) * 0.125f;
    }
    __syncthreads();
    if (w < 4) {
        const float sk = sinks ? sinks[kvh * 4 + w] : -INFINITY;
        const float v0 = sc[w * 132 + lane], v1 = sc[w * 132 + 64 + lane], v2 = lane == 0 ? sc[w * 132 + 128] : -INFINITY;
        float mx = wave_max(fmaxf(fmaxf(v0, v1), v2)); mx = fmaxf(mx, sk);
        const float p0 = __expf(v0 - mx), p1 = __expf(v1 - mx), p2 = lane == 0 ? __expf(v2 - mx) : 0.f;
        const float sum = wave_sum(p0 + p1 + p2) + __expf(sk - mx);
        sc[w * 132 + lane] = p0; sc[w * 132 + 64 + lane] = p1; if (lane == 0) { sc[w * 132 + 128] = p2; rd[w] = sum; rd[4 + w] = mx; }
    }
    __syncthreads();
    if (tid < 256) {
        const int g = tid >> 6, d = tid & 63; float o = 0.f;
#pragma unroll 4
        for (int j = 0; j < 128; j += 4) { const f32x4 p4 = *(const LAS f32x4*)(sc + g * 132 + j);
            o += p4[0] * Vc[j * 64 + d]; o += p4[1] * Vc[(j + 1) * 64 + d]; o += p4[2] * Vc[(j + 2) * 64 + d]; o += p4[3] * Vc[(j + 3) * 64 + d]; }
        o += sc[g * 132 + 128] * Vc[128 * 64 + d];
        const float den = rd[g]; o_out = o * __builtin_amdgcn_rcpf(den); lse_out = rd[4 + g] + __logf(den);
    }
    __syncthreads();
}
__device__ __forceinline__ void sample_attn_even(Frame& F, int e, int s, int kvh) {
    const f16* zrow = WSP(f16, WS_Z) + (size_t)(MP + s) * NEV;
    float o = 0.f, lse = 0.f;
    DecKV kv; dec_load(F, FIN(I_CA) + ((size_t)e * NS + s) * 128 * 256, 1, kvh, kv);
    dec_attn(F, kv, kvh, zrow, 0, 512, 640, FIN(I_ESK) + e * 8, o, lse);
    if (F.tid < 256) WSP(f16, WS_O)[(size_t)(MP + s) * D + kvh * 256 + F.tid] = (f16)o;
    if (F.tid < 128) { const int isv = F.tid >> 6, d = F.tid & 63;
        F.out[O_AKVS + (((size_t)e * NS + s) * 128 + 127) * 256 + isv * 128 + kvh * 64 + d] = (float)zrow[(isv ? 640 : 512) + kvh * 64 + d]; }
}
__device__ __forceinline__ void sample_attn_odd(Frame& F, int oi, int s, int kvh) {
    const f16* zrow = WSP(f16, WS_Z) + (size_t)(MP + s) * NOD;
    float o[3] = {0.f, 0.f, 0.f}, lse[3] = {0.f, 0.f, 0.f};
    DecKV kv0, kv1, kv2;
    dec_load(F, FIN(I_CC1) + ((size_t)oi * NS + s) * 128 * 256, 1, kvh, kv0);
    dec_load(F, FIN(I_CC2) + ((size_t)oi * NS + s) * 512 * 256, 4, kvh, kv1);
    dec_load(F, FIN(I_CC3) + ((size_t)oi * NS + s) * 2048 * 256, 16, kvh, kv2);
    dec_attn(F, kv0, kvh, zrow, 0, 512, 640, nullptr, o[0], lse[0]);
    dec_attn(F, kv1, kvh, zrow, 768, 1280, 1408, nullptr, o[1], lse[1]);
    dec_attn(F, kv2, kvh, zrow, 1536, 2048, 2176, nullptr, o[2], lse[2]);
    if (F.tid < 256) {
        const float mx = fmaxf(fmaxf(lse[0], lse[1]), lse[2]);
        const float w0 = __expf(lse[0] - mx), w1 = __expf(lse[1] - mx), w2 = __expf(lse[2] - mx);
        WSP(f16, WS_O)[(size_t)(MP + s) * 512 + kvh * 256 + F.tid] = (f16)((w0 * o[0] + w1 * o[1] + w2 * o[2]) / (w0 + w1 + w2));
    }
    if (F.tid < 384) { const int g = F.tid >> 7, r = F.tid & 127, isv = r >> 6, d = r & 63;
        const int W = g == 0 ? 128 : (g == 1 ? 512 : 2048); const size_t ob = g == 0 ? O_C1S : (g == 1 ? O_C2S : O_C3S);
        F.out[ob + (((size_t)oi * NS + s) * W + (W - 1)) * 256 + isv * 128 + kvh * 64 + d] = (float)zrow[768 * g + (isv ? 640 : 512) + kvh * 64 + d]; }
}
__device__ __forceinline__ void sample_mlstm(Frame& F, int e, int s) {
    const int h = F.wave, lane = F.lane, m = MP + s;
    const f16* zrow = WSP(f16, WS_Z) + (size_t)m * NEV; const float* gr = WSP(float, WS_GATES) + (size_t)m * 16; const float* bg = FIN(I_EBG) + e * 16;
    const float q = (float)zrow[768 + h * 64 + lane], k = (float)zrow[1280 + h * 64 + lane], v = (float)zrow[1792 + h * 64 + lane], bo = (float)zrow[2304 + h * 64 + lane];
    const float ig = gr[h] + bg[h], lf = logsigmoidf_(gr[8 + h] + bg[8 + h]);
    const size_t sh = ((size_t)e * NS + s) * 8 + h;
    const float mst = FIN(I_SBM)[sh], nst = FIN(I_SBN)[sh * 64 + lane];
    const float mt = fmaxf(lf + mst, ig), dsc = __expf(ig - mt), inter = __expf(lf + mst - mt);
    const float qk = wave_sum(q * k), qn_i = wave_sum(q * nst);
    const float* C = FIN(I_SBC) + sh * 4096; float* Co = F.out + O_BCS + sh * 4096;
    float qc = 0.f;
    float cvv[64];
#pragma unroll
    for (int dk = 0; dk < 64; ++dk) cvv[dk] = __builtin_nontemporal_load(C + dk * 64 + lane);
#pragma unroll
    for (int dk = 0; dk < 64; ++dk) {
        const float cv = cvv[dk], qd = __shfl(q, dk), kd = __shfl(k, dk);
        qc += qd * cv; Co[dk * 64 + lane] = inter * cv + dsc * kd * v;
    }
    const float wgt = qk * dsc, num = wgt * v + inter * qc, qn = wgt + inter * qn_i;
    const float hv = num / fmaxf(fabsf(qn), __expf(-mt));
    const float rinv = rsqrtf(wave_sum(hv * hv) * (1.0f / 64.0f) + EPS);
    WSP(f16, WS_O)[(size_t)m * D + 512 + h * 64 + lane] = (f16)(hv * rinv * FIN(I_EHG)[(e * 8 + h) * 64 + lane] * sigmoidf_(bo));
    F.out[O_BNS + sh * 64 + lane] = inter * nst + dsc * k;
    if (lane == 0) F.out[O_BMS + sh] = mt;
}

__device__ __forceinline__ void phase_e1(Frame& F, int e, int tmask) {
    BandAttn P{WSP(f16, WS_Z), NEV, 0, 512, 640, WSP(f16, WS_O), D, 0, nullptr, FIN(I_ESK) + e * 8, 1};
    for (int u = F.bid; u < 1152; u += F.G) {
        if (u < 256) { if (!(tmask & 1)) continue; const int kvh = u & 1, blk = (u >> 1) & 63, b = u >> 7;
            band_attn_unit(F.lds, P, b * T, 1, blk, kvh);
            if (blk == 63 && kvh == 0) kv_export(P.Z, NEV, 512, 640, b * T + T - 128, 128, F.out + O_AKVP + (size_t)(e * 2 + b) * 128 * 256, F.tid, 512);
        } else if (u < 768) { if (!(tmask & 2)) continue; const int v = u - 256; mlstm_x1_unit(F, e, v >> 8, (v >> 2) & 63, v & 3); }
        else if (u < 1024) { if (!(tmask & 4)) continue; const int v = u - 768; sample_attn_even(F, e, v >> 1, v & 1); }
        else { if (!(tmask & 8)) continue; sample_mlstm(F, e, u - 1024); }
    }
}
__device__ __forceinline__ void phase_e3(Frame& F, int e) {
    for (int u = F.bid; u < 512; u += F.G) mlstm_x3_unit(F, e, u >> 8, (u >> 2) & 63, u & 3);
}
__device__ __forceinline__ void phase_o1(Frame& F, int oi, int tmask) {
    const f16* Z = WSP(f16, WS_Z);
    for (int u = F.bid; u < 768 + 256 + 42; u += F.G) {
        if (u < 768) {
            if (!(tmask & 1)) continue;
            const int g = u >> 8, v = u & 255, kvh = v & 1, r = v >> 1;
            const int dil = g == 0 ? 1 : (g == 1 ? 4 : 16), nblk = 64 / dil;
            const int b = r >> 6, rr = r & 63, res = rr / nblk, blk = rr % nblk;
            BandAttn P{Z, NOD, 768 * g, 768 * g + 512, 768 * g + 640, WSP(f16, WS_OG) + (size_t)g * MP * 512, 512, 0, WSP(float, WS_LSE) + (size_t)g * MP * 8, nullptr, 0};
            band_attn_unit(F.lds, P, b * T + res, dil, blk, kvh);
        } else if (u < 1024) { if (!(tmask & 4)) continue; const int v = u - 768; sample_attn_odd(F, oi, v >> 1, v & 1); }
        else {
            if (!(tmask & 16)) continue;
            const int v = u - 1024; int g, q; if (v < 2) { g = 0; q = v; } else if (v < 10) { g = 1; q = v - 2; } else { g = 2; q = v - 10; }
            const int W = 128 << (2 * g), per = W / 128, b = q / per, part = q % per;
            const size_t ob = g == 0 ? O_C1P : (g == 1 ? O_C2P : O_C3P);
            kv_export(Z, NOD, 768 * g + 512, 768 * g + 640, b * T + T - W + part * 128, 128, F.out + ob + ((size_t)(oi * 2 + b) * W + part * 128) * 256, F.tid, 512);
        }
    }
}
__device__ __forceinline__ void phase_o2(Frame& F) {
    const f16* OG = WSP(f16, WS_OG); const float* LSE = WSP(float, WS_LSE); f16* O = WSP(f16, WS_O);
    for (int i0 = F.bid; i0 < MP / 8; i0 += 2 * F.G) {
        size_t m[2]; bool ok[2]; float l0[2], l1[2], l2[2]; f16x8 a[2], b[2], c[2];
        const int c8 = F.tid & 63, hd = c8 >> 3;
#pragma unroll
        for (int j = 0; j < 2; ++j) { const int ib = i0 + j * F.G; ok[j] = ib < MP / 8; const int ic = ok[j] ? ib : i0;
            m[j] = (size_t)((ic & 7) * (MP / 64) + (ic >> 3)) * 8 + (F.tid >> 6);
            l0[j] = LSE[m[j] * 8 + hd]; l1[j] = LSE[(size_t)MP * 8 + m[j] * 8 + hd]; l2[j] = LSE[(size_t)2 * MP * 8 + m[j] * 8 + hd];
            a[j] = *(const f16x8*)(OG + m[j] * 512 + c8 * 8); b[j] = *(const f16x8*)(OG + (size_t)MP * 512 + m[j] * 512 + c8 * 8); c[j] = *(const f16x8*)(OG + (size_t)2 * MP * 512 + m[j] * 512 + c8 * 8); }
#pragma unroll
        for (int j = 0; j < 2; ++j) {
            const float mx = fmaxf(fmaxf(l0[j], l1[j]), l2[j]); float w0 = __expf(l0[j] - mx), w1 = __expf(l1[j] - mx), w2 = __expf(l2[j] - mx); const float inv = 1.0f / (w0 + w1 + w2);
            w0 *= inv; w1 *= inv; w2 *= inv;
            f16x8 o;
#pragma unroll
            for (int q = 0; q < 8; ++q) o[q] = (f16)(w0 * (float)a[j][q] + w1 * (float)b[j][q] + w2 * (float)c[j][q]);
            if (ok[j]) *tiled_ptr<f16x8>(O, (int)m[j], c8 * 8, 512) = o;
        }
    }
}
__device__ __forceinline__ void phase_final(Frame& F) {
    const f16* X = WSP(f16, WS_X); const float* rss = (const float*)(F.ws + RSS_OFF) + (size_t)12 * MALL; const float* fg = FIN(I_FG);
    f32x4 g[4];
#pragma unroll
    for (int q = 0; q < 4; ++q) g[q] = *(const f32x4*)(fg + q * 256 + F.lane * 4);
    for (int m0 = F.bid * 8 + F.wave; m0 < MALL; m0 += F.G * 32) {
        f16x4 xh[4][4]; float rs[4];
#pragma unroll
        for (int j = 0; j < 4; ++j) { const int m = m0 + j * F.G * 8 < MALL ? m0 + j * F.G * 8 : m0; rs[j] = rss[m];
#pragma unroll
            for (int q = 0; q < 4; ++q) xh[j][q] = *(const f16x4*)(X + (size_t)m * D + q * 256 + F.lane * 4); }
#pragma unroll
        for (int j = 0; j < 4; ++j) { const int m = m0 + j * F.G * 8; if (m < MALL) { const float r = rsqrtf(rs[j] * (1.0f / D) + EPS);
#pragma unroll
            for (int q = 0; q < 4; ++q) { const f32x4 x = {(float)xh[j][q][0], (float)xh[j][q][1], (float)xh[j][q][2], (float)xh[j][q][3]};
                __builtin_nontemporal_store(x * r * g[q], (f32x4*)(F.out + O_Y + (size_t)m * D + q * 256 + F.lane * 4)); } } }
    }
}

struct Args;
__device__ __forceinline__ bool phase_enter(Frame& F, const Args& args);
#define REP(bit) _Pragma("unroll 1") for (int rep_ = 0; rep_ < ((PROBE_DUP & (bit)) ? 2 : 1); ++rep_)
#ifndef P_MASK
#define P_MASK 0
#endif
constexpr bool P_SK = !(P_MASK & 1), P_MIX = !(P_MASK & 2), P_Z = !(P_MASK & 4), P_RES = !(P_MASK & 8), P_SW = !(P_MASK & 16), P_PR = !(P_MASK & 32), P_E1 = !(P_MASK & 64), P_E3 = !(P_MASK & 128), P_O1 = !(P_MASK & 256);
struct Args { const float* in[N_IN]; float* out; unsigned char* ws; int ph_lo, ph_hi; };
constexpr int PH_LAYER0 = 4, PH_PER_LAYER = 9, PH_FINAL = PH_LAYER0 + 4 * PH_PER_LAYER, N_PHASES = PH_FINAL + 1;

__device__ __forceinline__ bool phase_enter(Frame& F, const Args& args) {
    F.tid = opaque_v(threadIdx.x); F.lane = F.tid & 63; F.wave = __builtin_amdgcn_readfirstlane(F.tid >> 6);
    F.out = opaque_p(args.out); F.ws = opaque_p(args.ws);
    return true;
}
__global__ void __launch_bounds__(512, 2) fwd_kernel(Args args) {
    extern __shared__ __attribute__((aligned(16))) unsigned char lds_raw[];
    Frame F;
    F.lds = (ldsp_t)lds_raw; F.tid = threadIdx.x; F.lane = F.tid & 63; F.wave = __builtin_amdgcn_readfirstlane(F.tid >> 6); F.G = gridDim.x; F.bid = blockIdx.x;
    F.out = args.out; F.ws = args.ws;
    volatile LAS unsigned* MISC = (volatile LAS unsigned*)(F.lds + MISC_OFF);
    if (F.tid < 32) MISC[F.tid] = 0u;
    __syncthreads();
    XcdBarrier bar = xcd_barrier_post((unsigned*)(F.ws + WS_CTL) + CW_BAR, MISC + 8);
    const int lo = args.ph_lo, hi = args.ph_hi;
    const CopyQ CQ{args.in[I_CC3], args.in[I_CC2], args.in[I_CA], args.in[I_CC1], args.out, (unsigned*)(args.ws + WS_CTL) + CW_Q};
#define IN(k) (lo <= (k) && (k) < hi && phase_enter(F, args))
#define SEAM(k) do { if (IN((k) + 1)) { xcd_barrier(bar, CQ); if constexpr ((PROBE_DUP & 64) != 0) xcd_barrier(bar, CQ); } } while (0)
#define LSEAM(k) do { if (IN((k) + 1)) { if (fastp) xcc_barrier(bar, CQ); else xcd_barrier(bar, CQ); } } while (0)
    unsigned fastp = 0u;
    float* rowss = (float*)(F.ws + RSS_OFF);

    _Pragma("unroll 1") for (int prep_ = 0; prep_ < ((PROBE_DUP & 32) ? 2 : 1); ++prep_) {
    if (IN(0)) { REP(1) { if constexpr (P_PR) phase_pr0(F, 24, 28, true, nullptr); } SEAM(0);
        if (MK_N_LAUNCHES == 1 && hi == N_PHASES && MISC[8 + 10] != 0u) { fastp = 1u; F.bid = (int)(MISC[8 + 12] * 8u + bar.x); } }
    if (IN(1)) {
        pg8::Gemm g{WSP(f16, WS_AC), WSP(f16, WS_WMOD), 256, 4 * NMODC, D}; pg8::StaticOrder S; S.init(256, 4 * NMODC, F.G, F.bid);
        EpiMod E{WSP(float, WS_CS), WSP(float, WS_GT), WSP(f16, WS_SHA), FIN(I_BMOD), FIN(I_NG), WSP(float, WS_RCS)};
        if constexpr (P_PR) pg8::gemm_phase<EpiMod, pg8::StaticOrder>(F.lds, g, S, E);
        if constexpr (P_PR) { phase_enter(F, args); phase_pr0(F, 0, 24, false, (unsigned*)(F.ws + WS_CTL) + CW_Q + 128); }
        SEAM(1);
    }
    if (IN(3)) {
        pg8::Gemm g{WSP(f16, WS_SHA), WSP(f16, WS_WIN), 256 * NSITE, NWIN, D}; pg8::DiagOrder S{F.G, F.bid};
        EpiBias E{WSP(float, WS_BW)};
        if constexpr (P_PR) pg8::gemm_phase<EpiBias, pg8::DiagOrder>(F.lds, g, S, E);
        if constexpr (P_PR) { phase_enter(F, args); phase_pr2(F); }
        SEAM(3);
    }
    }
    for (int l = 0; l < 4; ++l) {
        const int pb = PH_LAYER0 + PH_PER_LAYER * l, s0 = 3 * l; const bool even = (l & 1) == 0; const int ei = l >> 1;
#pragma unroll 1
        for (int ffn = 0; ffn < 2; ++ffn) {
            if (ffn == 1) {
                if (IN(pb + 2)) {
                    const int so = site_off(s0 + 1), N = even ? NEV : NOD;
                    pg8::Gemm g{WSP(f16, WS_A), WSP(f16, WS_WIN) + (size_t)so * D, MP, N, D}; pg8::StaticOrder S; S.init(MP, N, F.G, F.bid);
                    if (even) { EpiZ<true> E{rowss + (size_t)(s0 + 1) * MALL, WSP(float, WS_BW) + so, WSP(f16, WS_Z), WSP(float, WS_GATES)};
                        if constexpr (P_Z) pg8::gemm_phase<EpiZ<true>, pg8::StaticOrder>(F.lds, g, S, E);
                        if constexpr ((PROBE_DUP & 128) != 0) { phase_enter(F, args); pg8::gemm_phase<EpiZ<true>, pg8::StaticOrder>(F.lds, g, S, E); }
                        if constexpr (P_SK) skinny_phase<false, D>(F.lds, g.A + (size_t)MP * D, g.Bt, N, E, F.G, F.bid, S.nwg); }
                    else { EpiZ<false> E{rowss + (size_t)(s0 + 1) * MALL, WSP(float, WS_BW) + so, WSP(f16, WS_Z), WSP(float, WS_GATES)};
                        if constexpr (P_Z) pg8::gemm_phase<EpiZ<false>, pg8::StaticOrder>(F.lds, g, S, E);
                        if constexpr ((PROBE_DUP & 128) != 0) { phase_enter(F, args); pg8::gemm_phase<EpiZ<false>, pg8::StaticOrder>(F.lds, g, S, E); }
                        if constexpr (P_SK) skinny_phase<false, D>(F.lds, g.A + (size_t)MP * D, g.Bt, N, E, F.G, F.bid, S.nwg); }
                    SEAM(pb + 2);
                }
                if (IN(pb + 3)) { REP(2) if constexpr (P_MIX) { const int tm = rep_ ? PROBE_TMASK : 31; if (even) { if constexpr (P_E1) phase_e1(F, ei, tm); } else { if constexpr (P_O1) phase_o1(F, ei, tm); } } SEAM(pb + 3); }
                if (IN(pb + 4)) { REP(4096) if constexpr (P_MIX) { if (even) mlstm_scan(F, ei); else phase_o2(F); } if (even) SEAM(pb + 4); else LSEAM(pb + 4); }
                if (even && IN(pb + 5)) { REP(8192) if constexpr (P_MIX && P_E3) { phase_e3(F, ei); } SEAM(pb + 5); }
                if (IN(pb + 6)) {
                    const int K = even ? D : 512; const f16* Bt = even ? WSP(f16, WS_WEO) + (size_t)ei * D * D : WSP(f16, WS_WOO) + (size_t)ei * D * 512;
                    pg8::Gemm g{WSP(f16, WS_O), Bt, MP, D, K}; pg8::StaticOrder S; S.init(MP, D, F.G, F.bid);
                    EpiRes E{WSP(f16, WS_X), WSP(f16, WS_A), rowss + (size_t)(s0 + 2) * MALL, WSP(float, WS_GT) + (size_t)(s0 + 1) * NBAT * D, WSP(float, WS_CS) + (size_t)(s0 + 2) * NBAT * D, WSP(float, WS_RCS) + (size_t)(s0 + 1) * NBAT * D};
                    if constexpr ((PROBE_DUP & 256) != 0) { EpiRes E2{(f16*)(F.ws + WS_END), (f16*)(F.ws + WS_END + (size_t)MALL * D * 4), (float*)(F.ws + WS_END + (size_t)MALL * D * 6), E.GT, E.CS, E.RCS};
                        pg8::gemm_phase<EpiRes, pg8::StaticOrder>(F.lds, g, S, E2); phase_enter(F, args); }
                    if constexpr (P_RES) pg8::gemm_phase<EpiRes, pg8::StaticOrder>(F.lds, g, S, E);
                    if constexpr (P_SK) { if (even) skinny_phase<false, D>(F.lds, g.A + (size_t)MP * D, g.Bt, D, E, F.G, F.bid, S.nwg); else skinny_phase<false, 512>(F.lds, g.A + (size_t)MP * 512, g.Bt, D, E, F.G, F.bid, S.nwg); }
                    LSEAM(pb + 6);
                }
            }
            const int sf = s0 + 2 * ffn, pin = pb + (ffn ? 7 : 0);
            if (IN(pin)) {
                const int so = site_off(sf);
                pg8::Gemm g{WSP(f16, WS_A), WSP(f16, WS_WIN) + (size_t)so * D, MP, FF2, D}; pg8::StaticOrder S; S.init(MP, FF2, F.G, F.bid);
                EpiSwiglu E{rowss + (size_t)sf * MALL, WSP(float, WS_BW) + so, WSP(f16, WS_H)};
                if constexpr (P_SW) pg8::gemm_phase<EpiSwiglu, pg8::StaticOrder>(F.lds, g, S, E);
                if constexpr ((PROBE_DUP & 4) != 0) { phase_enter(F, args); pg8::gemm_phase<EpiSwiglu, pg8::StaticOrder>(F.lds, g, S, E); }
                REP(8) { if constexpr (P_SK) skinny_phase<true, D>(F.lds, g.A + (size_t)MP * D, g.Bt, FF2, E, F.G, F.bid, S.nwg); }
                if constexpr (P_SK) { if (fastp) { int grp_, nr_; if (skinny_member(F.G, F.bid, S.nwg, grp_, nr_)) {
                    phase_enter(F, args);
                    skinny_group_sync((unsigned*)(F.ws + WS_CTL) + CW_SKB + ((2 * l + ffn) * 8 + grp_) * 32, (unsigned)nr_, bar.bar);
                    EpiRes E2{WSP(f16, WS_X), WSP(f16, WS_A), rowss + (size_t)(sf + 1) * MALL, WSP(float, WS_GT) + (size_t)sf * NBAT * D, (sf + 1 < NSITE) ? WSP(float, WS_CS) + (size_t)(sf + 1) * NBAT * D : nullptr, WSP(float, WS_RCS) + (size_t)sf * NBAT * D};
                    skinny_phase<false, FF>(F.lds, WSP(f16, WS_H) + (size_t)MP * FF, WSP(f16, WS_WFO) + (size_t)(2 * l + ffn) * D * FF, D, E2, F.G, F.bid, S.nwg); } } }
                LSEAM(pin);
            }
            if (IN(pin + 1)) {
                pg8::Gemm g{WSP(f16, WS_H), WSP(f16, WS_WFO) + (size_t)(2 * l + ffn) * D * FF, MP, D, FF}; pg8::StaticOrder S; S.init(MP, D, F.G, F.bid);
                EpiRes E{WSP(f16, WS_X), WSP(f16, WS_A), rowss + (size_t)(sf + 1) * MALL, WSP(float, WS_GT) + (size_t)sf * NBAT * D, (sf + 1 < NSITE) ? WSP(float, WS_CS) + (size_t)(sf + 1) * NBAT * D : nullptr, WSP(float, WS_RCS) + (size_t)sf * NBAT * D};
                if constexpr ((PROBE_DUP & 16) != 0) { EpiRes E2{(f16*)(F.ws + WS_END), (f16*)(F.ws + WS_END + (size_t)MALL * D * 4), (float*)(F.ws + WS_END + (size_t)MALL * D * 6), E.GT, E.CS, E.RCS};
                    pg8::gemm_phase<EpiRes, pg8::StaticOrder>(F.lds, g, S, E2); phase_enter(F, args); }
                if constexpr (P_RES) pg8::gemm_phase<EpiRes, pg8::StaticOrder>(F.lds, g, S, E);
                if constexpr (P_SK) { if (!fastp) skinny_phase<false, FF>(F.lds, g.A + (size_t)MP * FF, g.Bt, D, E, F.G, F.bid, S.nwg); }
                if (pin + 1 == PH_FINAL - 1) SEAM(pin + 1); else LSEAM(pin + 1);
            }
        }
    }
    if (IN(PH_FINAL)) {
        phase_final(F);
        if constexpr ((PROBE_DUP & 512) != 0) { phase_enter(F, args); phase_final(F); }
        for (;;) {
            __syncthreads();
            if (F.tid == 0) MISC[24] = xb_add(CQ.head, 1u);
            __syncthreads();
            const unsigned ch = MISC[24];
            if (ch >= (unsigned)CQ_N) break;
            copy_chunk(CQ, (int)ch, F.tid);
        }
        if constexpr ((PROBE_DUP & 1024) != 0) {
            CopyQ CQ2 = CQ; CQ2.head = CQ.head + 64;
            for (;;) {
                __syncthreads();
                if (F.tid == 0) MISC[24] = xb_add(CQ2.head, 1u);
                __syncthreads();
                const unsigned ch = MISC[24];
                if (ch >= (unsigned)CQ_N) break;
                copy_chunk(CQ2, (int)ch, F.tid);
            }
        }
    }
#undef IN
#undef SEAM
}

extern "C" void kernel_launch(void* const* d_in, const int* in_sizes, int n_in, void* d_out, int out_size, void* d_ws, size_t ws_size, hipStream_t stream) {
    static int grid = 0;
    if (grid == 0) {
        if (n_in != N_IN || (size_t)out_size != O_END || ws_size < WS_END) { fprintf(stderr, "kernel_launch: unexpected shapes n_in %d out %d ws %zu (need %zu / %zu)\n", n_in, out_size, ws_size, (size_t)O_END, (size_t)WS_END); grid = -1; return; }
        int dev = 0, cus = 0, per_cu = 0;
        if (hipGetDevice(&dev) != hipSuccess || hipDeviceGetAttribute(&cus, hipDeviceAttributeMultiprocessorCount, dev) != hipSuccess) { grid = -1; return; }
        if (hipFuncSetAttribute((const void*)fwd_kernel, hipFuncAttributeMaxDynamicSharedMemorySize, LDS_BYTES) != hipSuccess) { fprintf(stderr, "kernel_launch: hipFuncSetAttribute failed\n"); grid = -1; return; }
        if (hipOccupancyMaxActiveBlocksPerMultiprocessor(&per_cu, (const void*)fwd_kernel, 512, LDS_BYTES) != hipSuccess || per_cu < 1) { fprintf(stderr, "kernel_launch: occupancy query says %d\n", per_cu); }
        (void)hipGetLastError();
        grid = cus;
    }
    if (grid < 0) return;
    (void)hipMemsetAsync((char*)d_ws + WS_CTL, 0, CTL_ZERO_BYTES, stream);
    Args a{};
    for (int i = 0; i < N_IN; ++i) a.in[i] = (const float*)d_in[i];
    a.out = (float*)d_out; a.ws = (unsigned char*)d_ws;
#if MK_N_LAUNCHES == 1
    a.ph_lo = 0; a.ph_hi = N_PHASES;
    hipLaunchKernelGGL(fwd_kernel, dim3(grid), dim3(512), LDS_BYTES, stream, a);
#else
    for (int p = 0; p < N_PHASES; ++p) { a.ph_lo = p; a.ph_hi = p + 1; hipLaunchKernelGGL(fwd_kernel, dim3(grid), dim3(512), LDS_BYTES, stream, a); }
#endif
}
```
